# Optimizing an MI355X kernel written in HIP

```python
import math
import jax
import jax.numpy as jnp
from jax import lax
import numpy as np

D_MODEL = 1024
BATCH = 16
SEQ = 256
DEPTH = 2
DEC_BATCH = 8
DEC_SEQ = 2048
PAST_LEN = 512

GRID_W = 64
ROPE_THETA = 10000.0
Q_BLOCK = 128
EPS = 1e-6
MLA_HEADS = 8
MLA_NOPE = 64
MLA_ROPE = 32
MLA_V = 64
MLA_Q_LORA = 384
MLA_KV_LORA = 256
MLA_WIDTH = MLA_HEADS * MLA_V
MLA_SCALE = (MLA_NOPE + MLA_ROPE) ** -0.5
SWA_HEADS = 8
SWA_KV_HEADS = 2
SWA_DH = 64
SWA_WIDTH = SWA_HEADS * SWA_DH
WINDOW = 128
SWA_SCALE = SWA_DH ** -0.5
GDN_HEADS = 4
GDN_DK = 128
GDN_DV = 128
GDN_WIDTH = GDN_HEADS * GDN_DV
CONV_K = 3
GDN_CHUNK = 64
ATT_HEADS = 4
ATT_KV_HEADS = 2
ATT_DH = 128
ATT_WIDTH = ATT_HEADS * ATT_DH
ATT_SCALE = ATT_DH ** -0.5
L0_SPLIT = (MLA_Q_LORA, MLA_KV_LORA, MLA_ROPE, MLA_WIDTH, SWA_WIDTH, SWA_KV_HEADS * SWA_DH, SWA_KV_HEADS * SWA_DH, SWA_WIDTH)
L1_SPLIT = (GDN_HEADS * (2 * GDN_DK + GDN_DV), 2 * GDN_HEADS, 2 * GDN_HEADS, GDN_WIDTH, ATT_WIDTH, ATT_KV_HEADS * ATT_DH, ATT_KV_HEADS * ATT_DH, ATT_WIDTH)
L0_COLS = sum(L0_SPLIT)
L1_COLS = sum(L1_SPLIT)
NEG = -1e30

kernel_name = 'hybrid_mla_swa_gdn_axial_step'


def _rms(x, g):
    xf = x.astype(jnp.float32)
    y = xf * lax.rsqrt(jnp.mean(xf * xf, axis=-1, keepdims=True) + EPS)
    return (y * g.astype(jnp.float32)).astype(x.dtype)


def _l2(x):
    xf = x.astype(jnp.float32)
    return (xf * lax.rsqrt(jnp.sum(xf * xf, axis=-1, keepdims=True) + EPS)).astype(x.dtype)


def _split(u, sizes):
    cuts, acc = [], 0
    for s in sizes[:-1]:
        acc += s
        cuts.append(acc)
    return jnp.split(u, cuts, axis=-1)


def _adaln(x, gain, mod):
    shift, scale, gate = jnp.split(mod, 3, axis=-1)
    return _rms(x, gain) * (1 + scale) + shift, gate


def _group(q, n_kv):
    B, T, H, d = q.shape
    return q.reshape(B, T, n_kv, H // n_kv, d)


def _rope_tables(n_tok, rot_dim):
    rows = n_tok // GRID_W
    quarter = rot_dim // 4
    inv = ROPE_THETA ** (-jnp.arange(quarter, dtype=jnp.float32) / quarter)
    t = jnp.arange(rows * GRID_W)
    pos = jnp.stack([t // GRID_W, t % GRID_W], axis=-1).astype(jnp.float32)
    ang = pos[:, :, None] * inv
    return jnp.cos(ang), jnp.sin(ang)


def _apply_rope(x, cos, sin):
    B, T, H, R = x.shape
    xs = x.astype(jnp.float32).reshape(B, T, H, 2, 2, R // 4)
    x1, x2 = xs[..., 0, :], xs[..., 1, :]
    c, s = cos[None, :, None], sin[None, :, None]
    out = jnp.stack([x1 * c - x2 * s, x2 * c + x1 * s], axis=-2)
    return out.reshape(B, T, H, R).astype(x.dtype)


def _attend(q, k, v, mask, sink, scale):
    s = jnp.einsum('bqhgd,bkhd->bhgqk', q, k).astype(jnp.float32) * scale
    if mask is not None:
        s = jnp.where(mask, s, NEG)
    if sink is not None:
        sk = jnp.broadcast_to(sink.astype(jnp.float32)[None, :, :, None, None], s.shape[:-1] + (1,))
        p = jax.nn.softmax(jnp.concatenate([s, sk], axis=-1), axis=-1)[..., :-1]
    else:
        p = jax.nn.softmax(s, axis=-1)
    return jnp.einsum('bhgqk,bkhd->bqhgd', p.astype(v.dtype), v)


def _sweep_queries(q, fn):
    B, Q = q.shape[0], q.shape[1]
    nb = Q // Q_BLOCK
    qb = jnp.moveaxis(q.reshape((B, nb, Q_BLOCK) + q.shape[2:]), 1, 0)
    out = lax.map(lambda a: fn(a[0], a[1]), (qb, jnp.arange(nb)))
    return jnp.moveaxis(out, 0, 1).reshape((B, Q) + out.shape[3:])


def _window_ctx_attend(q, k, v, k_ctx, v_ctx, sink):
    S, L = k.shape[1], k_ctx.shape[1]
    span = Q_BLOCK + 2 * WINDOW
    pad = ((0, 0), (WINDOW, WINDOW), (0, 0), (0, 0))
    kp, vp = jnp.pad(k, pad), jnp.pad(v, pad)
    a = jnp.arange(Q_BLOCK)[:, None]
    b = jnp.arange(span)[None, :]
    band = (b - a >= 0) & (b - a <= 2 * WINDOW)
    ctx_mask = jnp.ones((Q_BLOCK, L), dtype=bool)

    def blk(qb, n):
        start = n * Q_BLOCK
        ks = lax.dynamic_slice_in_dim(kp, start, span, axis=1)
        vs = lax.dynamic_slice_in_dim(vp, start, span, axis=1)
        j = start - WINDOW + b
        mask = jnp.concatenate([band & (j >= 0) & (j < S), ctx_mask], axis=1)
        return _attend(qb, jnp.concatenate([ks, k_ctx], axis=1), jnp.concatenate([vs, v_ctx], axis=1), mask, sink, SWA_SCALE)

    return _sweep_queries(q, blk)


def _short_conv(x, w):
    y = lax.conv_general_dilated(x, w[:, None, :].astype(x.dtype), window_strides=(1,),
                                 padding=((CONV_K // 2, CONV_K // 2),),
                                 dimension_numbers=('NWC', 'WIO', 'NWC'), feature_group_count=x.shape[-1])
    return jax.nn.silu(y)


def _gdn_chunked(q, k, v, g, beta, s0):
    out_dtype = v.dtype
    f32 = jnp.float32
    B, T, H, dk = k.shape
    dv = v.shape[-1]
    n = T // GDN_CHUNK

    def chunks(t):
        t = t.astype(f32).reshape((B, n, GDN_CHUNK, H) + t.shape[3:])
        return jnp.moveaxis(t, 3, 1)

    q = chunks(q) * dk ** -0.5
    k, v, beta, g = chunks(k), chunks(v), chunks(beta), chunks(g)
    gc = jnp.cumsum(g, axis=-1)
    causal = jnp.tril(jnp.ones((GDN_CHUNK, GDN_CHUNK), dtype=bool))
    strict = jnp.tril(jnp.ones((GDN_CHUNK, GDN_CHUNK), dtype=bool), -1)
    decay = jnp.exp(jnp.where(causal, gc[..., :, None] - gc[..., None, :], -jnp.inf))
    kb = k * beta[..., None]
    lmat = jnp.where(strict, jnp.einsum('bhncd,bhnsd->bhncs', kb, k) * decay, 0.0)
    amat = lmat + jnp.eye(GDN_CHUNK, dtype=f32)
    rhs = jnp.concatenate([v * beta[..., None], kb * jnp.exp(gc)[..., None]], axis=-1)
    sol = lax.linalg.triangular_solve(amat, rhs, left_side=True, lower=True)
    u, w = sol[..., :dv], sol[..., dv:]
    intra = jnp.einsum('bhncd,bhnsd->bhncs', q, k) * decay

    def step(S, xs):
        q_i, k_i, u_i, w_i, g_i, a_i = xs
        v_new = u_i - jnp.einsum('bhcd,bhde->bhce', w_i, S)
        o = jnp.einsum('bhcd,bhde->bhce', q_i * jnp.exp(g_i)[..., None], S) + jnp.einsum('bhcs,bhse->bhce', a_i, v_new)
        g_last = g_i[..., -1:]
        S = S * jnp.exp(g_last)[..., None] + jnp.einsum('bhcd,bhce->bhde', k_i * jnp.exp(g_last - g_i)[..., None], v_new)
        return S, o

    xs = tuple(jnp.moveaxis(t, 2, 0) for t in (q, k, u, w, gc, intra))
    S, o = lax.scan(step, s0.astype(f32), xs)
    o = jnp.moveaxis(jnp.moveaxis(o, 0, 2), 1, 3).reshape(B, T, H, dv)
    return o.astype(out_dtype), S.astype(out_dtype)


def _bidir_gdn(q, k, v, g, beta, s0):
    o_f, s_f = _gdn_chunked(q, k, v, g[:, :, 0], beta[:, :, 0], s0[:, 0])
    rev = lambda t: jnp.flip(t, axis=1)
    o_b, s_b = _gdn_chunked(rev(q), rev(k), rev(v), rev(g[:, :, 1]), rev(beta[:, :, 1]), s0[:, 1])
    return o_f + rev(o_b), jnp.stack([s_f, s_b], axis=1)


def _mla_expand(ckv, krope, w_ukv):
    B, T, _ = ckv.shape
    kv = (ckv @ w_ukv).reshape(B, T, MLA_HEADS, MLA_NOPE + MLA_V)
    k = jnp.concatenate([kv[..., :MLA_NOPE], jnp.broadcast_to(krope[:, :, None, :], (B, T, MLA_HEADS, MLA_ROPE))], axis=-1)
    return k, kv[..., MLA_NOPE:]


def _layer0(x, mod, ctx, ln, w_in, mla_q_norm, w_uq, mla_kv_norm, w_ukv, swa_sink, w_out):
    B, T, _ = x.shape
    h, gate = _adaln(x, ln, mod)
    cq, ckv, krope, z_a, q_b, k_b, v_b, z_b = _split(h @ w_in, L0_SPLIT)
    q_a = (_rms(cq, mla_q_norm) @ w_uq).reshape(B, T, MLA_HEADS, MLA_NOPE + MLA_ROPE)
    ckv = _rms(ckv, mla_kv_norm)
    q_b = q_b.reshape(B, T, SWA_HEADS, SWA_DH)
    k_b = k_b.reshape(B, T, SWA_KV_HEADS, SWA_DH)
    v_b = v_b.reshape(B, T, SWA_KV_HEADS, SWA_DH)
    sink = swa_sink.reshape(SWA_KV_HEADS, SWA_HEADS // SWA_KV_HEADS)
    if ctx is None:
        k_a, v_a = _mla_expand(ckv, krope, w_ukv)
        o_b = _sweep_queries(_group(q_b, SWA_KV_HEADS), lambda qb, n: _attend(qb, k_b, v_b, None, sink, SWA_SCALE))
        new_ctx = (ckv, krope, k_b, v_b)
    else:
        ckv_c, krope_c, k_c, v_c = ctx
        cos, sin = _rope_tables(T, MLA_ROPE)
        q_a = jnp.concatenate([q_a[..., :MLA_NOPE], _apply_rope(q_a[..., MLA_NOPE:], cos, sin)], axis=-1)
        krope_r = _apply_rope(krope[:, :, None, :], cos, sin)[:, :, 0]
        k_a, v_a = _mla_expand(jnp.concatenate([ckv, ckv_c], axis=1), jnp.concatenate([krope_r, krope_c], axis=1), w_ukv)
        cos, sin = _rope_tables(T, SWA_DH)
        o_b = _window_ctx_attend(_group(_apply_rope(q_b, cos, sin), SWA_KV_HEADS), _apply_rope(k_b, cos, sin), v_b, k_c, v_c, sink)
        new_ctx = ()
    o_a = _sweep_queries(q_a[:, :, :, None, :], lambda qb, n: _attend(qb, k_a, v_a, None, None, MLA_SCALE))
    y = jnp.concatenate([o_a.reshape(B, T, MLA_WIDTH) * jax.nn.silu(z_a),
                         o_b.reshape(B, T, SWA_WIDTH) * jax.nn.silu(z_b)], axis=-1) @ w_out
    return x + gate * y, new_ctx


def _layer1(x, mod, ctx, ln, w_in, gdn_conv, gdn_a_log, gdn_dt_bias, gdn_norm, att_q_norm, att_k_norm, w_out):
    B, T, _ = x.shape
    f32 = jnp.float32
    h, gate = _adaln(x, ln, mod)
    qkv, a, b, z_c, q_d, k_d, v_d, z_d = _split(h @ w_in, L1_SPLIT)
    q_c, k_c, v_c = _split(_short_conv(qkv, gdn_conv), (GDN_HEADS * GDN_DK, GDN_HEADS * GDN_DK, GDN_HEADS * GDN_DV))
    q_c = _l2(q_c.reshape(B, T, GDN_HEADS, GDN_DK))
    k_c = _l2(k_c.reshape(B, T, GDN_HEADS, GDN_DK))
    v_c = v_c.reshape(B, T, GDN_HEADS, GDN_DV)
    a = a.astype(f32).reshape(B, T, 2, GDN_HEADS)
    g = -jnp.exp(gdn_a_log.astype(f32)) * jax.nn.softplus(a + gdn_dt_bias.astype(f32))
    beta = jax.nn.sigmoid(b.astype(f32).reshape(B, T, 2, GDN_HEADS))
    s0 = jnp.zeros((B, 2, GDN_HEADS, GDN_DK, GDN_DV), x.dtype) if ctx is None else ctx[0]
    o_c, s_fin = _bidir_gdn(q_c, k_c, v_c, g, beta, s0)
    o_c = _rms(o_c, gdn_norm) * jax.nn.silu(z_c.reshape(B, T, GDN_HEADS, GDN_DV))
    q_d = _rms(q_d.reshape(B, T, ATT_HEADS, ATT_DH), att_q_norm)
    k_d = _rms(k_d.reshape(B, T, ATT_KV_HEADS, ATT_DH), att_k_norm)
    v_d = v_d.reshape(B, T, ATT_KV_HEADS, ATT_DH)
    if ctx is None:
        q_att, k_all, v_all = q_d, k_d, v_d
        new_ctx = (s_fin, k_d, v_d)
    else:
        cos, sin = _rope_tables(T, ATT_DH)
        q_att = _apply_rope(q_d, cos, sin)
        k_all = jnp.concatenate([_apply_rope(k_d, cos, sin), ctx[1]], axis=1)
        v_all = jnp.concatenate([v_d, ctx[2]], axis=1)
        new_ctx = ()
    o_d = _sweep_queries(_group(q_att, ATT_KV_HEADS), lambda qb, n: _attend(qb, k_all, v_all, None, None, ATT_SCALE))
    y = jnp.concatenate([o_c.reshape(B, T, GDN_WIDTH),
                         o_d.reshape(B, T, ATT_WIDTH) * jax.nn.silu(z_d)], axis=-1) @ w_out
    return x + gate * y, new_ctx


def setup_inputs(seed: int = 0) -> dict:
    key = jax.random.key(seed)
    ks = iter(jax.random.split(key, 48))
    f32 = jnp.float32

    def nrm(shape, scale=1.0):
        return jax.random.normal(next(ks), shape, f32) * scale

    D = D_MODEL
    inp = {}
    inp['x_prompt'] = nrm((BATCH, SEQ, D))
    inp['x_sample'] = nrm((DEC_BATCH, DEC_SEQ, D))
    inp['cache_l0_mla_ckv'] = nrm((DEC_BATCH, PAST_LEN, MLA_KV_LORA))
    inp['cache_l0_mla_krope'] = nrm((DEC_BATCH, PAST_LEN, MLA_ROPE))
    inp['cache_l0_swa_k'] = nrm((DEC_BATCH, PAST_LEN, SWA_KV_HEADS, SWA_DH))
    inp['cache_l0_swa_v'] = nrm((DEC_BATCH, PAST_LEN, SWA_KV_HEADS, SWA_DH))
    inp['state_l1_gdn'] = nrm((DEC_BATCH, 2, GDN_HEADS, GDN_DK, GDN_DV), 0.1)
    inp['cache_l1_attn_k'] = nrm((DEC_BATCH, PAST_LEN, ATT_KV_HEADS, ATT_DH))
    inp['cache_l1_attn_v'] = nrm((DEC_BATCH, PAST_LEN, ATT_KV_HEADS, ATT_DH))
    inp['c'] = nrm((DEC_BATCH, D))
    inp['c_ctx'] = nrm((D,))
    inp['w_mod0'] = nrm((D, 3 * D), 0.3 * D ** -0.5)
    inp['b_mod0'] = nrm((3 * D,), 0.02)
    inp['ln0'] = 1.0 + nrm((D,), 0.1)
    inp['w_in0'] = nrm((D, L0_COLS), D ** -0.5)
    inp['mla_q_norm'] = 1.0 + nrm((MLA_Q_LORA,), 0.1)
    inp['w_uq'] = nrm((MLA_Q_LORA, MLA_HEADS * (MLA_NOPE + MLA_ROPE)), MLA_Q_LORA ** -0.5)
    inp['mla_kv_norm'] = 1.0 + nrm((MLA_KV_LORA,), 0.1)
    inp['w_ukv'] = nrm((MLA_KV_LORA, MLA_HEADS * (MLA_NOPE + MLA_V)), MLA_KV_LORA ** -0.5)
    inp['swa_sink'] = nrm((SWA_HEADS,))
    inp['w_out0'] = nrm((MLA_WIDTH + SWA_WIDTH, D), (MLA_WIDTH + SWA_WIDTH) ** -0.5)
    inp['w_mod1'] = nrm((D, 3 * D), 0.3 * D ** -0.5)
    inp['b_mod1'] = nrm((3 * D,), 0.02)
    inp['ln1'] = 1.0 + nrm((D,), 0.1)
    inp['w_in1'] = nrm((D, L1_COLS), D ** -0.5)
    inp['gdn_conv'] = nrm((CONV_K, GDN_HEADS * (2 * GDN_DK + GDN_DV)), CONV_K ** -0.5)
    inp['gdn_a_log'] = jnp.log(jax.random.uniform(next(ks), (2, GDN_HEADS), f32, 1.0, 16.0))
    dt = jnp.exp(jax.random.uniform(next(ks), (2, GDN_HEADS), f32, math.log(1e-3), math.log(1e-1)))
    inp['gdn_dt_bias'] = dt + jnp.log(-jnp.expm1(-dt))
    inp['gdn_norm'] = 1.0 + nrm((GDN_DV,), 0.1)
    inp['att_q_norm'] = 1.0 + nrm((ATT_DH,), 0.1)
    inp['att_k_norm'] = 1.0 + nrm((ATT_DH,), 0.1)
    inp['w_out1'] = nrm((GDN_WIDTH + ATT_WIDTH, D), (GDN_WIDTH + ATT_WIDTH) ** -0.5)
    inp['ln_f'] = 1.0 + nrm((D,), 0.1)
    return inp


def reference(x_prompt, x_sample, cache_l0_mla_ckv, cache_l0_mla_krope, cache_l0_swa_k, cache_l0_swa_v,
              state_l1_gdn, cache_l1_attn_k, cache_l1_attn_v, c, c_ctx,
              w_mod0, b_mod0, ln0, w_in0, mla_q_norm, w_uq, mla_kv_norm, w_ukv, swa_sink, w_out0,
              w_mod1, b_mod1, ln1, w_in1, gdn_conv, gdn_a_log, gdn_dt_bias, gdn_norm, att_q_norm, att_k_norm, w_out1,
              ln_f):
    layer_fns = (_layer0, _layer1)
    layer_params = ((w_mod0, b_mod0, (ln0, w_in0, mla_q_norm, w_uq, mla_kv_norm, w_ukv, swa_sink, w_out0)),
                    (w_mod1, b_mod1, (ln1, w_in1, gdn_conv, gdn_a_log, gdn_dt_bias, gdn_norm, att_q_norm, att_k_norm, w_out1)))
    caches = ((cache_l0_mla_ckv, cache_l0_mla_krope, cache_l0_swa_k, cache_l0_swa_v),
              (state_l1_gdn, cache_l1_attn_k, cache_l1_attn_v))

    x = x_prompt
    ctx_out = []
    for l in range(DEPTH):
        w_mod, b_mod, params = layer_params[l]
        mod = (jax.nn.silu(c_ctx) @ w_mod + b_mod)[None, None, :]
        x, new_ctx = layer_fns[l](x, mod, None, *params)
        ctx_out.extend(new_ctx)
    y_prompt = _rms(x, ln_f)

    x = x_sample
    for l in range(DEPTH):
        w_mod, b_mod, params = layer_params[l]
        mod = (jax.nn.silu(c) @ w_mod + b_mod)[:, None, :]
        x, _ = layer_fns[l](x, mod, caches[l], *params)
    y_sample = _rms(x, ln_f)

    l0_mla_ckv, l0_mla_krope, l0_swa_k, l0_swa_v, l1_gdn_state, l1_attn_k, l1_attn_v = ctx_out
    return (y_prompt, y_sample, l0_mla_ckv, l0_mla_krope, l0_swa_k, l0_swa_v, l1_gdn_state, l1_attn_k, l1_attn_v)
```

```cpp
#include <hip/hip_runtime.h>
#include <hip/hip_cooperative_groups.h>
#include <cstdio>
#include <cstdint>
namespace cg = cooperative_groups;

#define DI __device__ __forceinline__
typedef unsigned short u16;
using bf16x8 = __attribute__((ext_vector_type(8))) short;
using bf16x4 = __attribute__((ext_vector_type(4))) short;
using f32x16 = __attribute__((ext_vector_type(16))) float;
using f32x4  = __attribute__((ext_vector_type(4))) float;
using u32x4  = __attribute__((ext_vector_type(4))) unsigned;
using u32x2  = __attribute__((ext_vector_type(2))) unsigned;

#ifndef PHASE_LIMIT
#define PHASE_LIMIT 99
#endif

constexpr int NTHREADS = 512;
constexpr int DM = 1024, NTOK = 20480, NCTX = 4096, NKROW = 24576;
constexpr int L0C = 2464, L0CP = 2560, L1C = 3600, L1CP = 3712;
constexpr int U1A_LD = 1536, U1B_LD = 2048;
constexpr int C0_CQ = 0, C0_CKV = 384, C0_KR = 640, C0_ZA = 672, C0_QB = 1184, C0_KB = 1696, C0_VB = 1824, C0_ZB = 1952;
constexpr int C1_ZC = 0, C1_QD = 512, C1_KD = 1024, C1_VD = 1280, C1_ZD = 1536;
constexpr float EPS = 1e-6f;
constexpr float LOG2E = 1.4426950408889634f;

constexpr size_t O_Y = 0;
constexpr size_t O_CKV = 20971520, O_KROPE = 22020096, O_SWAK = 22151168, O_SWAV = 22675456, O_STATE = 23199744, O_ATTK = 25296896, O_ATTV = 26345472;

constexpr size_t WS_WO1 = 0;
constexpr size_t WS_MOD = WS_WO1 + 2097152;
constexpr size_t WS_ROPE = WS_MOD + 221184;
constexpr size_t WS_W2 = WS_ROPE + 32768;
constexpr size_t WS_WT0 = WS_W2;
constexpr size_t WS_WUQ = WS_WT0 + 5242880;
constexpr size_t WS_WUKV = WS_WUQ + 589824;
constexpr size_t WS_WO0 = WS_WUKV + 524288;
constexpr size_t WS_WT1 = WS_WO0 + 2097152;
constexpr size_t WS_W2_END = WS_WT1 + 7602176;
constexpr size_t WS_VTATT = WS_W2;
constexpr size_t WS_KC = WS_VTATT + 12582912;
constexpr size_t WS_GB = WS_KC + 2097152;
static_assert(WS_GB + 1310720 <= WS_W2_END, "layer-1 reuse overflow");
constexpr size_t WS_H = WS_W2_END;
constexpr size_t WS_U = WS_H + 41943040;
constexpr size_t WS_U0X = WS_U + (size_t)NTOK * L0C * 2;
constexpr size_t WS_KSWA = WS_U0X;
constexpr size_t WS_VTSWA = WS_KSWA + 6291456;
constexpr size_t WS_CKVN = WS_VTSWA + 6291456;
constexpr size_t WS_KROPE = WS_CKVN + 12582912;
static_assert(WS_KROPE + 1572864 <= WS_U + 147456000, "layer-0 extras overflow");
constexpr size_t WS_U1A = WS_U;
constexpr size_t WS_U1B = WS_U + 62914560;
constexpr size_t WS_TB = WS_U1A;
constexpr size_t WS_AM = WS_TB + 20971520;
constexpr size_t WS_OB = WS_AM + 20971520;
constexpr size_t WS_X = WS_U + 147456000;
constexpr size_t WS_VC = WS_X;
constexpr size_t WS_OF = WS_VC + 20971520;
constexpr size_t WS_AB = WS_OF + 20971520;
constexpr size_t WS_END = WS_AB + 1310720;
static_assert(WS_END <= 268435456ull, "ws overflow");
constexpr size_t YS_QMLA = 0;
constexpr size_t YS_KN = YS_QMLA + 31457280;
constexpr size_t YS_VTMLA = YS_KN + 25165824;
static_assert(YS_VTMLA + 25165824 <= (size_t)NTOK * DM * 4, "y scratch overflow");

struct Params {
  const float *x_prompt, *x_sample, *c_ckv, *c_krope, *c_swak, *c_swav, *c_state, *c_attk, *c_attv, *c, *c_ctx;
  const float *w_mod0, *b_mod0, *ln0, *w_in0, *mla_q_norm, *w_uq, *mla_kv_norm, *w_ukv, *swa_sink, *w_out0;
  const float *w_mod1, *b_mod1, *ln1, *w_in1, *gdn_conv, *gdn_a_log, *gdn_dt_bias, *gdn_norm, *att_q_norm, *att_k_norm, *w_out1, *ln_f;
  float* out;
  char* ws;
};

DI float bf2f(u16 b) { return __uint_as_float(((unsigned)b) << 16); }
DI u16 f2bf(float x) { unsigned u = __float_as_uint(x); u += 0x7fffu + ((u >> 16) & 1u); return (u16)(u >> 16); }
DI unsigned pack2(float lo, float hi) { return (unsigned)f2bf(lo) | ((unsigned)f2bf(hi) << 16); }
DI int crow(int reg, int h) { return (reg & 3) + 8 * (reg >> 2) + 4 * h; }
DI int swz16(int k) { return (k & ~12) | ((k & 4) << 1) | ((k & 8) >> 1); }
DI float siluf(float x) { return x / (1.f + __expf(-x)); }
DI int seq_of_tok(int m) { return m < NCTX ? (m >> 8) : 16 + ((m - NCTX) >> 11); }
DI int tok0_of(int s) { return s < 16 ? s * 256 : NCTX + (s - 16) * 2048; }
DI int krow0_of(int s) { return s < 16 ? s * 256 : NCTX + (s - 16) * 2560; }
DI int cap_of(int s) { return s < 16 ? 256 : 2560; }
DI int len_of(int s) { return s < 16 ? 256 : 2048; }
DI int modidx_of_tok(int m) { return m < NCTX ? 0 : 1 + ((m - NCTX) >> 11); }
DI int krow_of_tok(int m) { return m < NCTX ? m : NCTX + ((m - NCTX) >> 11) * 2560 + ((m - NCTX) & 2047); }
DI int pos_of_tok(int m) { return m < NCTX ? (m & 255) : ((m - NCTX) & 2047); }
DI const float* xrow(const Params& p, int m) { return m < NCTX ? p.x_prompt + (size_t)m * DM : p.x_sample + (size_t)(m - NCTX) * DM; }
DI float wave_sum(float v) {
#pragma unroll
  for (int o = 32; o > 0; o >>= 1) v += __shfl_xor(v, o);
  return v;
}
DI bf16x8 pack8(const f32x16& x, int s) {
  u32x4 w = {pack2(x[8 * s + 0], x[8 * s + 1]), pack2(x[8 * s + 2], x[8 * s + 3]), pack2(x[8 * s + 4], x[8 * s + 5]), pack2(x[8 * s + 6], x[8 * s + 7])};
  return __builtin_bit_cast(bf16x8, w);
}
DI bf16x8 cat4(bf16x4 lo, bf16x4 hi) { return __builtin_shufflevector(lo, hi, 0, 1, 2, 3, 4, 5, 6, 7); }
#define MFMA(a, b, c) __builtin_amdgcn_mfma_f32_32x32x16_bf16((a), (b), (c), 0, 0, 0)

DI void transpose_tile(const float* __restrict__ W, int ldw, int k0, int srccol0, int nvalid, u16* __restrict__ Wt, int ldt, int dstrow0, char* lds) {
  u16* t = (u16*)lds;
  const int tid = threadIdx.x, kr = tid >> 3, cc = (tid & 7) * 8;
  float v[8];
  if (cc < nvalid) {
    const float4 a = *(const float4*)(W + (size_t)(k0 + kr) * ldw + srccol0 + cc);
    const float4 b = *(const float4*)(W + (size_t)(k0 + kr) * ldw + srccol0 + cc + 4);
    v[0] = a.x; v[1] = a.y; v[2] = a.z; v[3] = a.w; v[4] = b.x; v[5] = b.y; v[6] = b.z; v[7] = b.w;
  } else {
#pragma unroll
    for (int e = 0; e < 8; ++e) v[e] = 0.f;
  }
#pragma unroll
  for (int e = 0; e < 8; ++e) t[(cc + e) * 72 + kr] = f2bf(v[e]);
  __syncthreads();
  const int n = tid >> 3, kc = (tid & 7) * 8;
  *(bf16x8*)(Wt + (size_t)(dstrow0 + n) * ldt + k0 + kc) = *(const bf16x8*)(t + n * 72 + kc);
  __syncthreads();
}

DI void vt_store16(const u16* sv, int CS, int C, u16* __restrict__ vt, size_t cap, int key16base) {
  for (int i = threadIdx.x; i < C * 4; i += NTHREADS) {
    const int ch = i >> 2, q = i & 3;
    u16 e[4];
#pragma unroll
    for (int j = 0; j < 4; ++j) e[j] = sv[swz16(q * 4 + j) * CS + ch];
    u32x2 w = {(unsigned)e[0] | ((unsigned)e[1] << 16), (unsigned)e[2] | ((unsigned)e[3] << 16)};
    *(u32x2*)(vt + (size_t)ch * cap + key16base + q * 4) = w;
  }
}

DI void phase_prep(const Params& p, char* lds) {
  const int tid = threadIdx.x;
  constexpr int N_MOD = 192;
  constexpr int T_IN0 = 16 * 40, T_UQ = 6 * 12, T_UKV = 4 * 16, T_O0 = 256, T_IN1 = 16 * 58, T_O1 = 256;
  constexpr int N_TR = T_IN0 + T_UQ + T_UKV + T_O0 + T_IN1 + T_O1;
  constexpr int N_CV = 256 + 32 + 128;
  constexpr int N_VT = 256;
  constexpr int N_ITEMS = N_MOD + N_TR + N_CV + N_VT + 1;
  for (int it = blockIdx.x; it < N_ITEMS; it += gridDim.x) {
    if (it < N_MOD) {
      const int layer = it / 96, col0 = (it % 96) * 32;
      const float* Wm = layer ? p.w_mod1 : p.w_mod0;
      const float* bm = layer ? p.b_mod1 : p.b_mod0;
      float* sc = (float*)lds;
      float* red = sc + 9 * 1024;
      for (int i = tid; i < 9 * 1024; i += NTHREADS) {
        const int s = i >> 10, k = i & 1023;
        const float cv = s == 0 ? p.c_ctx[k] : p.c[(s - 1) * 1024 + k];
        sc[i] = siluf(cv);
      }
      __syncthreads();
      const int col = tid & 31, kg = tid >> 5;
      float acc[9];
#pragma unroll
      for (int s = 0; s < 9; ++s) acc[s] = 0.f;
      for (int kk = 0; kk < 64; ++kk) {
        const int k = kg * 64 + kk;
        const float w = Wm[(size_t)k * 3072 + col0 + col];
#pragma unroll
        for (int s = 0; s < 9; ++s) acc[s] += sc[s * 1024 + k] * w;
      }
#pragma unroll
      for (int s = 0; s < 9; ++s) red[(kg * 9 + s) * 32 + col] = acc[s];
      __syncthreads();
      if (tid < 288) {
        const int s = tid >> 5, c2 = tid & 31;
        float a = bm[col0 + c2];
        for (int g = 0; g < 16; ++g) a += red[(g * 9 + s) * 32 + c2];
        ((float*)(p.ws + WS_MOD))[(size_t)(layer * 9 + s) * 3072 + col0 + c2] = a;
      }
      __syncthreads();
    } else if (it < N_MOD + N_TR) {
      int t = it - N_MOD;
      if (t < T_IN0) { const int kt = t / 40, nt = t % 40; int nv = L0C - nt * 64; nv = nv < 0 ? 0 : (nv > 64 ? 64 : nv);
        transpose_tile(p.w_in0, L0C, kt * 64, nt * 64, nv, (u16*)(p.ws + WS_WT0), 1024, nt * 64, lds); continue; }
      t -= T_IN0;
      if (t < T_UQ) { const int kt = t / 12, nt = t % 12; transpose_tile(p.w_uq, 768, kt * 64, nt * 64, 64, (u16*)(p.ws + WS_WUQ), 384, nt * 64, lds); continue; }
      t -= T_UQ;
      if (t < T_UKV) { const int kt = t / 16, nt = t % 16; transpose_tile(p.w_ukv, 1024, kt * 64, nt * 64, 64, (u16*)(p.ws + WS_WUKV), 256, nt * 64, lds); continue; }
      t -= T_UKV;
      if (t < T_O0) { const int kt = t / 16, nt = t % 16; transpose_tile(p.w_out0, 1024, kt * 64, nt * 64, 64, (u16*)(p.ws + WS_WO0), 1024, nt * 64, lds); continue; }
      t -= T_O0;
      if (t < T_IN1) { const int kt = t / 58, nt = t % 58; const int n0 = nt * 64; int src, nv;
        if (n0 < 1536) { src = n0; nv = 64; } else if (n0 < 3584) { src = n0 + 16; nv = 64; } else if (n0 == 3584) { src = 1536; nv = 16; } else { src = 0; nv = 0; }
        transpose_tile(p.w_in1, L1C, kt * 64, src, nv, (u16*)(p.ws + WS_WT1), 1024, n0, lds); continue; }
      t -= T_IN1;
      { const int kt = t / 16, nt = t % 16; transpose_tile(p.w_out1, 1024, kt * 64, nt * 64, 64, (u16*)(p.ws + WS_WO1), 1024, nt * 64, lds); }
    } else if (it < N_MOD + N_TR + N_CV) {
      int t = it - N_MOD - N_TR;
      const int e0 = tid * 8;
      if (t < 256) {
        const size_t i = (size_t)t * 4096 + e0; const int b = (int)(i >> 17), rem = (int)(i & 131071), pp = rem >> 8, cc = rem & 255;
        const float4 a = *(const float4*)(p.c_ckv + i), b4 = *(const float4*)(p.c_ckv + i + 4);
        u32x4 w = {pack2(a.x, a.y), pack2(a.z, a.w), pack2(b4.x, b4.y), pack2(b4.z, b4.w)};
        *(u32x4*)((u16*)(p.ws + WS_CKVN) + (size_t)(NCTX + b * 2560 + 2048 + pp) * 256 + cc) = w;
      } else if (t < 288) {
        const size_t i = (size_t)(t - 256) * 4096 + e0; const int b = (int)(i >> 14), rem = (int)(i & 16383), pp = rem >> 5, cc = rem & 31;
        const float4 a = *(const float4*)(p.c_krope + i), b4 = *(const float4*)(p.c_krope + i + 4);
        u32x4 w = {pack2(a.x, a.y), pack2(a.z, a.w), pack2(b4.x, b4.y), pack2(b4.z, b4.w)};
        *(u32x4*)((u16*)(p.ws + WS_KROPE) + (size_t)(NCTX + b * 2560 + 2048 + pp) * 32 + cc) = w;
      } else {
        const size_t i = (size_t)(t - 288) * 4096 + e0; const int b = (int)(i >> 16), rem = (int)(i & 65535), pp = rem >> 7, cc = rem & 127;
        const float4 a = *(const float4*)(p.c_swak + i), b4 = *(const float4*)(p.c_swak + i + 4);
        u32x4 w = {pack2(a.x, a.y), pack2(a.z, a.w), pack2(b4.x, b4.y), pack2(b4.z, b4.w)};
        *(u32x4*)((u16*)(p.ws + WS_KSWA) + (size_t)(NCTX + b * 2560 + 2048 + pp) * 128 + cc) = w;
      }
    } else if (it < N_MOD + N_TR + N_CV + N_VT) {
      const int t = it - N_MOD - N_TR - N_CV; const int b = t >> 5, g = t & 31;
      u16* sv = (u16*)lds;
      {
        const int key = tid >> 5, c4 = (tid & 31) * 4;
        const float4 a = *(const float4*)(p.c_swav + ((size_t)(b * 512 + g * 16 + key)) * 128 + c4);
        u32x2 w = {pack2(a.x, a.y), pack2(a.z, a.w)};
        *(u32x2*)(sv + key * 136 + c4) = w;
      }
      __syncthreads();
      vt_store16(sv, 136, 128, (u16*)(p.ws + WS_VTSWA) + (size_t)krow0_of(16 + b) * 128, 2560, 2048 + g * 16);
      __syncthreads();
    } else {
      float2* tab = (float2*)(p.ws + WS_ROPE);
      for (int i = tid; i < 64 * 8 + 64 * 16 + 64 * 32; i += NTHREADS) {
        int q, pos, f, j = i;
        if (j < 512) { q = 8; } else if (j < 1536) { q = 16; j -= 512; } else { q = 32; j -= 1536; }
        pos = j / q; f = j % q;
        const float inv = powf(10000.f, -(float)f / (float)q);
        const float ang = (float)pos * inv;
        tab[i] = make_float2(cosf(ang), sinf(ang));
      }
    }
  }
}

DI void phase_adaln(const Params& p, int layer) {
  const int lane = threadIdx.x & 63, wid = threadIdx.x >> 6;
  const float* ln = layer ? p.ln1 : p.ln0;
  const float* mod = (const float*)(p.ws + WS_MOD) + (size_t)layer * 9 * 3072;
  u16* H = (u16*)(p.ws + WS_H);
  for (int m = blockIdx.x * 8 + wid; m < NTOK; m += gridDim.x * 8) {
    const float* x = layer ? (p.out + (size_t)m * DM) : xrow(p, m);
    const float* md = mod + (size_t)modidx_of_tok(m) * 3072;
    float4 v[4]; float ss = 0.f;
#pragma unroll
    for (int j = 0; j < 4; ++j) { v[j] = *(const float4*)(x + (j * 64 + lane) * 4); ss += v[j].x * v[j].x + v[j].y * v[j].y + v[j].z * v[j].z + v[j].w * v[j].w; }
    ss = wave_sum(ss);
    const float rs = rsqrtf(ss * (1.f / 1024.f) + EPS);
#pragma unroll
    for (int j = 0; j < 4; ++j) {
      const int c = (j * 64 + lane) * 4;
      const float4 g = *(const float4*)(ln + c), sh = *(const float4*)(md + c), scl = *(const float4*)(md + 1024 + c);
      const float a0 = v[j].x * rs * g.x * (1.f + scl.x) + sh.x, a1 = v[j].y * rs * g.y * (1.f + scl.y) + sh.y;
      const float a2 = v[j].z * rs * g.z * (1.f + scl.z) + sh.z, a3 = v[j].w * rs * g.w * (1.f + scl.w) + sh.w;
      u32x2 w = {pack2(a0, a1), pack2(a2, a3)};
      *(u32x2*)(H + (size_t)m * DM + c) = w;
    }
  }
}

struct GemmA { const u16* p0; int ld0; const u16* p1; int ld1; int ksplit; };
constexpr int G_LDS_A = 256 * 72 * 2;
template <class Epi>
DI void gemm_tile(const GemmA A, const u16* __restrict__ B, int ldb, int K, int m0, int n0, char* lds, Epi& epi) {
  u16* sA = (u16*)lds; u16* sB = (u16*)(lds + G_LDS_A);
  const int tid = threadIdx.x, lane = tid & 63, wid = tid >> 6, r32 = lane & 31, h = lane >> 5;
  const int wm = wid >> 1, wn = wid & 1;
  const int lr = tid >> 3, lc = (tid & 7) * 8;
  f32x16 acc[2][2];
#pragma unroll
  for (int i = 0; i < 2; ++i)
#pragma unroll
    for (int j = 0; j < 2; ++j)
#pragma unroll
      for (int r = 0; r < 16; ++r) acc[i][j][r] = 0.f;
  bf16x8 ra[4], rb[2];
  const int nk = K >> 6;
  auto gload = [&](int kt) {
    const int k0 = kt * 64;
    const u16* ap; int lda, kk;
    if (k0 < A.ksplit) { ap = A.p0; lda = A.ld0; kk = k0; } else { ap = A.p1; lda = A.ld1; kk = k0 - A.ksplit; }
#pragma unroll
    for (int i = 0; i < 4; ++i) ra[i] = *(const bf16x8*)(ap + (size_t)(m0 + lr + 64 * i) * lda + kk + lc);
#pragma unroll
    for (int i = 0; i < 2; ++i) rb[i] = *(const bf16x8*)(B + (size_t)(n0 + lr + 64 * i) * ldb + k0 + lc);
  };
  gload(0);
  for (int kt = 0; kt < nk; ++kt) {
    __syncthreads();
#pragma unroll
    for (int i = 0; i < 4; ++i) *(bf16x8*)(sA + (lr + 64 * i) * 72 + lc) = ra[i];
#pragma unroll
    for (int i = 0; i < 2; ++i) *(bf16x8*)(sB + (lr + 64 * i) * 72 + lc) = rb[i];
    __syncthreads();
    if (kt + 1 < nk) gload(kt + 1);
#pragma unroll
    for (int ks = 0; ks < 4; ++ks) {
      bf16x8 a0 = *(const bf16x8*)(sA + (wm * 64 + r32) * 72 + ks * 16 + h * 8);
      bf16x8 a1 = *(const bf16x8*)(sA + (wm * 64 + 32 + r32) * 72 + ks * 16 + h * 8);
      bf16x8 b0 = *(const bf16x8*)(sB + (wn * 64 + r32) * 72 + ks * 16 + h * 8);
      bf16x8 b1 = *(const bf16x8*)(sB + (wn * 64 + 32 + r32) * 72 + ks * 16 + h * 8);
      acc[0][0] = MFMA(a0, b0, acc[0][0]); acc[0][1] = MFMA(a0, b1, acc[0][1]);
      acc[1][0] = MFMA(a1, b0, acc[1][0]); acc[1][1] = MFMA(a1, b1, acc[1][1]);
    }
  }
#pragma unroll
  for (int i = 0; i < 2; ++i)
#pragma unroll
    for (int j = 0; j < 2; ++j) epi(acc[i][j], m0 + wm * 64 + i * 32, n0 + wn * 64 + j * 32 + r32, h);
}

struct EpiU0 {
  u16* U;
  DI void operator()(const f32x16& a, int row0, int col, int h) const {
    if (col < L0C) {
#pragma unroll
      for (int r = 0; r < 16; ++r) U[(size_t)(row0 + crow(r, h)) * L0C + col] = f2bf(a[r]);
    }
  }
};
struct EpiQmla {
  u16* Q; const float2* tab;
  DI void operator()(const f32x16& a, int f0, int tok, int h) const {
    float v[16];
#pragma unroll
    for (int r = 0; r < 16; ++r) v[r] = a[r];
    if ((f0 % 96) == 64 && tok >= NCTX) {
      const int pos = pos_of_tok(tok), prow = pos >> 6, pcol = pos & 63;
#pragma unroll
      for (int j = 0; j < 4; ++j) {
        const int fi = 4 * h + j;
        const float2 cr = tab[prow * 8 + fi], cc = tab[pcol * 8 + fi];
        const float x1 = v[j], x2 = v[4 + j];
        v[j] = x1 * cr.x - x2 * cr.y; v[4 + j] = x2 * cr.x + x1 * cr.y;
        const float y1 = v[8 + j], y2 = v[12 + j];
        v[8 + j] = y1 * cc.x - y2 * cc.y; v[12 + j] = y2 * cc.x + y1 * cc.y;
      }
    }
#pragma unroll
    for (int g = 0; g < 4; ++g) {
      u32x2 w = {pack2(v[4 * g], v[4 * g + 1]), pack2(v[4 * g + 2], v[4 * g + 3])};
      *(u32x2*)(Q + (size_t)tok * 768 + f0 + 8 * g + 4 * h) = w;
    }
  }
};
struct EpiKvexp {
  u16* Kn; u16* Vt;
  DI void operator()(const f32x16& a, int kr0, int n, int h) const {
    const int head = n >> 7, within = n & 127;
    if (within < 64) {
#pragma unroll
      for (int r = 0; r < 16; ++r) Kn[((size_t)(kr0 + crow(r, h)) * 8 + head) * 64 + within] = f2bf(a[r]);
    } else {
      int seq, key0;
      if (kr0 < NCTX) { seq = kr0 >> 8; key0 = kr0 & 255; } else { const int r = kr0 - NCTX; seq = 16 + r / 2560; key0 = r % 2560; }
      const size_t cap = cap_of(seq);
      u16* base = Vt + (size_t)krow0_of(seq) * 512 + (size_t)(head * 64 + within - 64) * cap;
#pragma unroll
      for (int g = 0; g < 4; ++g) {
        const int pos = key0 + 16 * (g >> 1) + 8 * h + 4 * (g & 1);
        u32x2 w = {pack2(a[4 * g], a[4 * g + 1]), pack2(a[4 * g + 2], a[4 * g + 3])};
        *(u32x2*)(base + pos) = w;
      }
    }
  }
};
struct EpiOut {
  const Params* p; int layer;
  DI void operator()(const f32x16& a, int row0, int col, int h) const {
    const float* mod = (const float*)(p->ws + WS_MOD) + (size_t)(layer * 9 + modidx_of_tok(row0)) * 3072 + 2048;
    const float gate = mod[col];
#pragma unroll
    for (int r = 0; r < 16; ++r) {
      const int m = row0 + crow(r, h);
      const float xv = layer ? p->out[(size_t)m * DM + col] : xrow(*p, m)[col];
      p->out[(size_t)m * DM + col] = xv + gate * a[r];
    }
  }
};
struct EpiU1 {
  u16* UA; u16* UB; float* AB;
  DI void operator()(const f32x16& a, int row0, int col, int h) const {
    if (col < 1536) {
#pragma unroll
      for (int r = 0; r < 16; ++r) UA[(size_t)(row0 + crow(r, h)) * U1A_LD + col] = f2bf(a[r]);
    } else if (col < 3584) {
#pragma unroll
      for (int r = 0; r < 16; ++r) UB[(size_t)(row0 + crow(r, h)) * U1B_LD + col - 1536] = f2bf(a[r]);
    } else if (col < 3600) {
#pragma unroll
      for (int r = 0; r < 16; ++r) AB[(size_t)(row0 + crow(r, h)) * 16 + col - 3584] = a[r];
    }
  }
};

DI void phase_inproj0(const Params& p, char* lds) {
  EpiU0 epi{(u16*)(p.ws + WS_U)};
  const u16* H = (const u16*)(p.ws + WS_H);
  const GemmA A{H, DM, H, DM, 1 << 30};
  for (int it = blockIdx.x; it < 80 * 20; it += gridDim.x) {
    const int mt = it / 20, nt = it % 20;
    gemm_tile(A, (const u16*)(p.ws + WS_WT0), DM, DM, mt * 256, nt * 128, lds, epi);
  }
}
DI void phase_l0gemms(const Params& p, char* lds) {
  const u16* U0 = (const u16*)(p.ws + WS_U);
  EpiKvexp ek{(u16*)((char*)p.out + YS_KN), (u16*)((char*)p.out + YS_VTMLA)};
  EpiQmla eq{(u16*)((char*)p.out + YS_QMLA), (const float2*)(p.ws + WS_ROPE)};
  const u16* ck = (const u16*)(p.ws + WS_CKVN);
  const u16* wq = (const u16*)(p.ws + WS_WUQ);
  const GemmA Ak{ck, 256, ck, 256, 1 << 30};
  const GemmA Aq{wq, 384, wq, 384, 1 << 30};
  for (int it = blockIdx.x; it < 768 + 480; it += gridDim.x) {
    if (it < 768) { const int mt = it >> 3, nt = it & 7; gemm_tile(Ak, (const u16*)(p.ws + WS_WUKV), 256, 256, mt * 256, nt * 128, lds, ek); }
    else { const int t = it - 768; const int mt = t % 3, nt = t / 3; gemm_tile(Aq, U0 + C0_CQ, L0C, 384, mt * 256, nt * 128, lds, eq); }
  }
}
DI void phase_outproj(const Params& p, int layer, char* lds) {
  EpiOut epi{&p, layer};
  const u16* H = (const u16*)(p.ws + WS_H);
  GemmA A;
  if (layer == 0) A = GemmA{H, DM, H, DM, 1 << 30};
  else A = GemmA{H, DM, (const u16*)(p.ws + WS_U1B) + C1_QD, U1B_LD, 512};
  const u16* W = (const u16*)(p.ws + (layer ? WS_WO1 : WS_WO0));
  for (int it = blockIdx.x; it < 80 * 8; it += gridDim.x) {
    const int mt = it >> 3, nt = it & 7;
    gemm_tile(A, W, DM, DM, mt * 256, nt * 128, lds, epi);
  }
}
DI void phase_inproj1(const Params& p, char* lds) {
  EpiU1 epi{(u16*)(p.ws + WS_U1A), (u16*)(p.ws + WS_U1B), (float*)(p.ws + WS_AB)};
  const u16* H = (const u16*)(p.ws + WS_H);
  const GemmA A{H, DM, H, DM, 1 << 30};
  for (int it = blockIdx.x; it < 80 * 29; it += gridDim.x) {
    const int mt = it / 29, nt = it % 29;
    gemm_tile(A, (const u16*)(p.ws + WS_WT1), DM, DM, mt * 256, nt * 128, lds, epi);
  }
}

DI void rope8(float (&x)[8], const float (&xp)[8], const float2* tab, int q, int pp, int fi0, bool is_x2) {
#pragma unroll
  for (int e = 0; e < 8; ++e) {
    const float2 cs = tab[pp * q + fi0 + e];
    x[e] = is_x2 ? (x[e] * cs.x + xp[e] * cs.y) : (x[e] * cs.x - xp[e] * cs.y);
  }
}
DI void unpack8(const u32x4 w, float (&x)[8]) {
#pragma unroll
  for (int i = 0; i < 4; ++i) { x[2 * i] = bf2f((u16)(w[i] & 0xffffu)); x[2 * i + 1] = bf2f((u16)(w[i] >> 16)); }
}
DI u32x4 pack8f(const float (&x)[8]) { u32x4 w = {pack2(x[0], x[1]), pack2(x[2], x[3]), pack2(x[4], x[5]), pack2(x[6], x[7])}; return w; }
DI void shfl8(const float (&x)[8], float (&xp)[8], int mask) {
#pragma unroll
  for (int e = 0; e < 8; ++e) xp[e] = __shfl_xor(x[e], mask);
}

DI void phase_l0prep(const Params& p, char* lds) {
  const int tid = threadIdx.x, lane = tid & 63, wid = tid >> 6;
  u16* U0 = (u16*)(p.ws + WS_U);
  u16* sv = (u16*)lds;
  const float2* tabM = (const float2*)(p.ws + WS_ROPE);
  const float2* tabS = tabM + 512;
  u16* CKVN = (u16*)(p.ws + WS_CKVN); u16* KROPE = (u16*)(p.ws + WS_KROPE); u16* KSWA = (u16*)(p.ws + WS_KSWA);
  for (int it = blockIdx.x; it < NTOK / 16; it += gridDim.x) {
    const int m0 = it * 16;
    for (int tt = 0; tt < 2; ++tt) {
      const int ml = wid * 2 + tt, m = m0 + ml;
      u16* row = U0 + (size_t)m * L0C;
      const bool ctx = m < NCTX;
      const int pos = pos_of_tok(m), prow = pos >> 6, pcol = pos & 63, krow = krow_of_tok(m);
      {
        float lo[3], hi[3], ss = 0.f;
#pragma unroll
        for (int j = 0; j < 3; ++j) { const unsigned w = *(const unsigned*)(row + C0_CQ + 128 * j + 2 * lane); lo[j] = bf2f((u16)(w & 0xffffu)); hi[j] = bf2f((u16)(w >> 16)); ss += lo[j] * lo[j] + hi[j] * hi[j]; }
        ss = wave_sum(ss);
        const float rs = rsqrtf(ss * (1.f / 384.f) + EPS);
#pragma unroll
        for (int j = 0; j < 3; ++j) { const int c = 128 * j + 2 * lane; *(unsigned*)(row + C0_CQ + c) = pack2(lo[j] * rs * p.mla_q_norm[c], hi[j] * rs * p.mla_q_norm[c + 1]); }
      }
      {
        const u32x2 w = *(const u32x2*)(row + C0_CKV + 4 * lane);
        float x[4] = {bf2f((u16)(w[0] & 0xffffu)), bf2f((u16)(w[0] >> 16)), bf2f((u16)(w[1] & 0xffffu)), bf2f((u16)(w[1] >> 16))};
        float ss = x[0] * x[0] + x[1] * x[1] + x[2] * x[2] + x[3] * x[3];
        ss = wave_sum(ss);
        const float rs = rsqrtf(ss * (1.f / 256.f) + EPS);
        const float4 g = *(const float4*)(p.mla_kv_norm + 4 * lane);
        x[0] *= rs * g.x; x[1] *= rs * g.y; x[2] *= rs * g.z; x[3] *= rs * g.w;
        u32x2 o = {pack2(x[0], x[1]), pack2(x[2], x[3])};
        *(u32x2*)(CKVN + (size_t)krow * 256 + 4 * lane) = o;
        if (ctx) *(float4*)(p.out + O_CKV + (size_t)m * 256 + 4 * lane) = make_float4(x[0], x[1], x[2], x[3]);
      }
      {
        const float x = bf2f(row[C0_KR + (lane & 31)]);
        const float xp = __shfl_xor(x, 8);
        float val = x;
        if (!ctx) {
          const int half = (lane >> 4) & 1, within = lane & 15, fi = lane & 7;
          const float2 cs = tabM[(half ? pcol : prow) * 8 + fi];
          val = within < 8 ? (x * cs.x - xp * cs.y) : (x * cs.x + xp * cs.y);
        }
        if (lane < 32) {
          KROPE[(size_t)krow * 32 + lane] = f2bf(val);
          if (ctx) p.out[O_KROPE + (size_t)m * 32 + lane] = x;
        }
      }
      if (!ctx) {
        float x[8], xp[8];
        unpack8(*(const u32x4*)(row + C0_QB + lane * 8), x);
        shfl8(x, xp, 2);
        const int b16 = (lane & 7) >> 1;
        rope8(x, xp, tabS, 16, (b16 >= 2) ? pcol : prow, (lane & 1) * 8, (b16 & 1) != 0);
        *(u32x4*)(row + C0_QB + lane * 8) = pack8f(x);
      }
      {
        float x[8], xp[8];
        unpack8(*(const u32x4*)(row + C0_KB + (lane & 15) * 8), x);
        if (ctx && lane < 16) {
          *(float4*)(p.out + O_SWAK + (size_t)m * 128 + lane * 8) = make_float4(x[0], x[1], x[2], x[3]);
          *(float4*)(p.out + O_SWAK + (size_t)m * 128 + lane * 8 + 4) = make_float4(x[4], x[5], x[6], x[7]);
        }
        shfl8(x, xp, 2);
        if (!ctx) {
          const int b16 = (lane & 7) >> 1;
          rope8(x, xp, tabS, 16, (b16 >= 2) ? pcol : prow, (lane & 1) * 8, (b16 & 1) != 0);
        }
        if (lane < 16) *(u32x4*)(KSWA + (size_t)krow * 128 + lane * 8) = pack8f(x);
        if (lane < 16) {
          const u32x4 vw = *(const u32x4*)(row + C0_VB + lane * 8);
          *(u32x4*)(sv + ml * 136 + lane * 8) = vw;
          if (ctx) {
            float v[8]; unpack8(vw, v);
            *(float4*)(p.out + O_SWAV + (size_t)m * 128 + lane * 8) = make_float4(v[0], v[1], v[2], v[3]);
            *(float4*)(p.out + O_SWAV + (size_t)m * 128 + lane * 8 + 4) = make_float4(v[4], v[5], v[6], v[7]);
          }
        }
      }
    }
    __syncthreads();
    {
      const int s = seq_of_tok(m0);
      vt_store16(sv, 136, 128, (u16*)(p.ws + WS_VTSWA) + (size_t)krow0_of(s) * 128, cap_of(s), pos_of_tok(m0));
    }
    __syncthreads();
  }
}

template <int KIND>
DI void attn_item(const Params& p, int s, int hsel, int q0, char* lds) {
  constexpr int DQK = KIND == 0 ? 96 : (KIND == 1 ? 64 : 128);
  constexpr int DV = KIND == 2 ? 128 : 64;
  constexpr int KS = DQK + 8, VS = 72;
  constexpr int CPR = DQK / 8;
  constexpr int KCH = 64 * CPR, NKC = (KCH + 511) / 512;
  constexpr int VCH = DV * 8, NVC = VCH / 512;
  constexpr float SCALE = KIND == 0 ? 0.10206207261596577f : (KIND == 1 ? 0.125f : 0.08838834764831845f);
  constexpr float C = SCALE * LOG2E;
  const int tid = threadIdx.x, lane = tid & 63, wid = tid >> 6, r32 = lane & 31, h = lane >> 5;
  u16* sK = (u16*)lds; u16* sV = sK + 64 * KS;
  const int tok0 = tok0_of(s), kr0 = krow0_of(s), cap = cap_of(s), len = len_of(s);
  const bool smp = s >= 16;
  int hq, hkv, qrow0;
  if (KIND == 0) { hq = hsel; hkv = hsel; qrow0 = q0 + 32 * wid; }
  else if (KIND == 1) { hkv = hsel >> 1; hq = hkv * 4 + (hsel & 1) * 2 + (wid >> 2); qrow0 = q0 + 32 * (wid & 3); }
  else { hkv = hsel; hq = hkv * 2 + (wid >> 2); qrow0 = q0 + 32 * (wid & 3); }
  const int tok = tok0 + qrow0 + r32;
  const u16* U0 = (const u16*)(p.ws + WS_U);
  u16* U1B = (u16*)(p.ws + WS_U1B);
  const u16* qp;
  if (KIND == 0) qp = (const u16*)((const char*)p.out + YS_QMLA) + (size_t)tok * 768 + hq * 96 + h * 8;
  else if (KIND == 1) qp = U0 + (size_t)tok * L0C + C0_QB + hq * 64 + h * 8;
  else qp = U1B + (size_t)tok * U1B_LD + C1_QD + hq * 128 + h * 8;
  bf16x8 qf[DQK / 16];
#pragma unroll
  for (int d0 = 0; d0 < DQK / 16; ++d0) qf[d0] = *(const bf16x8*)(qp + d0 * 16);
  int nwin = 0, wlo = 0, nt = cap >> 6;
  if (KIND == 1 && smp) { wlo = q0 - 128 < 0 ? 0 : q0 - 128; const int whi = q0 + 256 > 2048 ? 2048 : q0 + 256; nwin = (whi - wlo) >> 6; nt = nwin + 8; }
  const u16* Kn = (const u16*)((const char*)p.out + YS_KN);
  const u16* KR = (const u16*)(p.ws + WS_KROPE);
  const u16* KSW = (const u16*)(p.ws + WS_KSWA);
  const u16* KCc = (const u16*)(p.ws + WS_KC);
  const u16* VT;
  if (KIND == 0) VT = (const u16*)((const char*)p.out + YS_VTMLA) + (size_t)kr0 * 512;
  else if (KIND == 1) VT = (const u16*)(p.ws + WS_VTSWA) + (size_t)kr0 * 128;
  else VT = (const u16*)(p.ws + WS_VTATT) + (size_t)kr0 * 256;
  bf16x8 rk[NKC], rv[NVC];
  int kkey[NKC], kd[NKC];
#pragma unroll
  for (int i = 0; i < NKC; ++i) { const int c = tid + 512 * i; kkey[i] = c / CPR; kd[i] = (c % CPR) * 8; }
  auto kt0_of = [&](int t) -> int { return (KIND == 1 && smp) ? (t < nwin ? wlo + 64 * t : 2048 + 64 * (t - nwin)) : 64 * t; };
  auto gload = [&](int t) {
    const int kt0 = kt0_of(t);
#pragma unroll
    for (int i = 0; i < NKC; ++i) {
      if (tid + 512 * i < KCH) {
        const int g = kt0 + kkey[i], d = kd[i];
        const u16* src;
        if (KIND == 0) src = d < 64 ? Kn + ((size_t)(kr0 + g) * 8 + hkv) * 64 + d : KR + (size_t)(kr0 + g) * 32 + (d - 64);
        else if (KIND == 1) src = KSW + ((size_t)(kr0 + g) * 2 + hkv) * 64 + d;
        else src = g < len ? U1B + (size_t)(tok0 + g) * U1B_LD + C1_KD + hkv * 128 + d : KCc + ((size_t)((s - 16) * 512 + g - 2048) * 2 + hkv) * 128 + d;
        rk[i] = *(const bf16x8*)src;
      }
    }
#pragma unroll
    for (int i = 0; i < NVC; ++i) {
      const int c = tid + 512 * i, dv = c >> 3, kc = c & 7;
      rv[i] = *(const bf16x8*)(VT + (size_t)(hkv * DV + dv) * cap + kt0 + kc * 8);
    }
  };
  auto swrite = [&]() {
#pragma unroll
    for (int i = 0; i < NKC; ++i) if (tid + 512 * i < KCH) *(bf16x8*)(sK + kkey[i] * KS + kd[i]) = rk[i];
#pragma unroll
    for (int i = 0; i < NVC; ++i) { const int c = tid + 512 * i; *(bf16x8*)(sV + (c >> 3) * VS + (c & 7) * 8) = rv[i]; }
  };
  f32x16 o[DV / 32];
#pragma unroll
  for (int db = 0; db < DV / 32; ++db)
#pragma unroll
    for (int r = 0; r < 16; ++r) o[db][r] = 0.f;
  float m = -1e30f, l = 0.f;
  gload(0);
  for (int t = 0; t < nt; ++t) {
    __syncthreads();
    swrite();
    __syncthreads();
    if (t + 1 < nt) gload(t + 1);
    f32x16 s0, s1;
#pragma unroll
    for (int r = 0; r < 16; ++r) { s0[r] = 0.f; s1[r] = 0.f; }
#pragma unroll
    for (int d0 = 0; d0 < DQK / 16; ++d0) {
      const bf16x8 k0 = *(const bf16x8*)(sK + r32 * KS + d0 * 16 + h * 8);
      const bf16x8 k1 = *(const bf16x8*)(sK + (32 + r32) * KS + d0 * 16 + h * 8);
      s0 = MFMA(k0, qf[d0], s0); s1 = MFMA(k1, qf[d0], s1);
    }
    if (KIND == 1 && smp && t < nwin) {
      const int kt0 = kt0_of(t), qi = qrow0 + r32;
#pragma unroll
      for (int r = 0; r < 16; ++r) {
        const int d0 = qi - (kt0 + crow(r, h)), d1 = d0 - 32;
        s0[r] = (d0 <= 128 && d0 >= -128) ? s0[r] : -INFINITY;
        s1[r] = (d1 <= 128 && d1 >= -128) ? s1[r] : -INFINITY;
      }
    }
    float mx = s0[0];
#pragma unroll
    for (int r = 1; r < 16; ++r) mx = fmaxf(mx, s0[r]);
#pragma unroll
    for (int r = 0; r < 16; ++r) mx = fmaxf(mx, s1[r]);
    mx = fmaxf(mx, __shfl_xor(mx, 32));
    const float mnew = fmaxf(m, mx * C);
    const float alpha = __builtin_amdgcn_exp2f(m - mnew);
    m = mnew;
    float ps = 0.f;
#pragma unroll
    for (int r = 0; r < 16; ++r) { s0[r] = __builtin_amdgcn_exp2f(s0[r] * C - mnew); ps += s0[r]; }
#pragma unroll
    for (int r = 0; r < 16; ++r) { s1[r] = __builtin_amdgcn_exp2f(s1[r] * C - mnew); ps += s1[r]; }
    l = l * alpha + ps;
#pragma unroll
    for (int db = 0; db < DV / 32; ++db)
#pragma unroll
      for (int r = 0; r < 16; ++r) o[db][r] *= alpha;
    const bf16x8 pf0 = pack8(s0, 0), pf1 = pack8(s0, 1), pf2 = pack8(s1, 0), pf3 = pack8(s1, 1);
#pragma unroll
    for (int db = 0; db < DV / 32; ++db) {
      const u16* vb = sV + (db * 32 + r32) * VS + h * 8;
      o[db] = MFMA(*(const bf16x8*)(vb), pf0, o[db]);
      o[db] = MFMA(*(const bf16x8*)(vb + 16), pf1, o[db]);
      o[db] = MFMA(*(const bf16x8*)(vb + 32), pf2, o[db]);
      o[db] = MFMA(*(const bf16x8*)(vb + 48), pf3, o[db]);
    }
  }
  float lt = l + __shfl_xor(l, 32);
  if (KIND == 1) lt += __builtin_amdgcn_exp2f(p.swa_sink[hq] * LOG2E - m);
  const float inv = 1.f / lt;
  const u16* zp; u16* op;
  if (KIND == 0) { zp = U0 + (size_t)tok * L0C + C0_ZA + hq * 64; op = (u16*)(p.ws + WS_H) + (size_t)tok * DM + hq * 64; }
  else if (KIND == 1) { zp = U0 + (size_t)tok * L0C + C0_ZB + hq * 64; op = (u16*)(p.ws + WS_H) + (size_t)tok * DM + 512 + hq * 64; }
  else { zp = U1B + (size_t)tok * U1B_LD + C1_ZD + hq * 128; op = U1B + (size_t)tok * U1B_LD + C1_QD + hq * 128; }
#pragma unroll
  for (int db = 0; db < DV / 32; ++db)
#pragma unroll
    for (int g = 0; g < 4; ++g) {
      const int dv = db * 32 + 8 * g + 4 * h;
      const u32x2 zw = *(const u32x2*)(zp + dv);
      const float z0 = bf2f((u16)(zw[0] & 0xffffu)), z1 = bf2f((u16)(zw[0] >> 16)), z2 = bf2f((u16)(zw[1] & 0xffffu)), z3 = bf2f((u16)(zw[1] >> 16));
      u32x2 w = {pack2(o[db][4 * g] * inv * siluf(z0), o[db][4 * g + 1] * inv * siluf(z1)), pack2(o[db][4 * g + 2] * inv * siluf(z2), o[db][4 * g + 3] * inv * siluf(z3))};
      *(u32x2*)(op + dv) = w;
    }
  __syncthreads();
}

DI void phase_attn0(const Params& p, char* lds) {
  for (int it = blockIdx.x; it < 1280; it += gridDim.x) {
    if (it < 512) { const int s = 16 + (it >> 6), rem = it & 63; attn_item<0>(p, s, rem >> 3, (rem & 7) * 256, lds); }
    else if (it < 1024) { const int j = it - 512; const int s = 16 + (j >> 6), rem = j & 63; attn_item<1>(p, s, rem >> 4, (rem & 15) * 128, lds); }
    else if (it < 1152) { const int j = it - 1024; attn_item<0>(p, j >> 3, j & 7, 0, lds); }
    else { const int j = it - 1152; const int s = j >> 3, rem = j & 7; attn_item<1>(p, s, rem >> 1, (rem & 1) * 128, lds); }
  }
}
DI void phase_attn1(const Params& p, char* lds) {
  for (int it = blockIdx.x; it < 320; it += gridDim.x) {
    if (it < 256) { const int s = 16 + (it >> 5), rem = it & 31; attn_item<2>(p, s, rem >> 4, (rem & 15) * 128, lds); }
    else { const int j = it - 256; const int s = j >> 2, rem = j & 3; attn_item<2>(p, s, rem >> 1, (rem & 1) * 128, lds); }
  }
}

DI float group16_sum(float v) {
#pragma unroll
  for (int o = 8; o > 0; o >>= 1) v += __shfl_xor(v, o);
  return v;
}
DI void phase_l1prep(const Params& p, char* lds) {
  const int tid = threadIdx.x, lane = tid & 63, wid = tid >> 6;
  const u16* UA = (const u16*)(p.ws + WS_U1A);
  u16* UB = (u16*)(p.ws + WS_U1B);
  u16* QK = (u16*)(p.ws + WS_H);
  u16* VC = (u16*)(p.ws + WS_VC);
  float* GB = (float*)(p.ws + WS_GB);
  const float* AB = (const float*)(p.ws + WS_AB);
  const float2* tabA = (const float2*)(p.ws + WS_ROPE) + 1536;
  u16* sv = (u16*)lds;
  constexpr int N_TOK_ITEMS = NTOK / 16;
  constexpr int N_KC_ITEMS = 256;
  constexpr int N_VC_ITEMS = 256;
  for (int it = blockIdx.x; it < N_TOK_ITEMS + N_KC_ITEMS + N_VC_ITEMS; it += gridDim.x) {
    if (it >= N_TOK_ITEMS + N_KC_ITEMS) {
      const int t = it - N_TOK_ITEMS - N_KC_ITEMS; const int b = t >> 5, g = t & 31;
      {
        const int key = tid >> 5, c8 = (tid & 31) * 8;
        const float* src = p.c_attv + ((size_t)(b * 512 + g * 16 + key)) * 256 + c8;
        const float4 a = *(const float4*)src, b4 = *(const float4*)(src + 4);
        u32x4 w = {pack2(a.x, a.y), pack2(a.z, a.w), pack2(b4.x, b4.y), pack2(b4.z, b4.w)};
        *(u32x4*)(sv + key * 264 + c8) = w;
      }
      __syncthreads();
      vt_store16(sv, 264, 256, (u16*)(p.ws + WS_VTATT) + (size_t)krow0_of(16 + b) * 256, 2560, 2048 + g * 16);
      __syncthreads();
      continue;
    }
    if (it >= N_TOK_ITEMS) {
      const size_t i = (size_t)(it - N_TOK_ITEMS) * 4096 + tid * 8;
      const float4 a = *(const float4*)(p.c_attk + i), b4 = *(const float4*)(p.c_attk + i + 4);
      u32x4 w = {pack2(a.x, a.y), pack2(a.z, a.w), pack2(b4.x, b4.y), pack2(b4.z, b4.w)};
      *(u32x4*)((u16*)(p.ws + WS_KC) + i) = w;
      continue;
    }
    const int m0 = it * 16;
    for (int tt = 0; tt < 2; ++tt) {
      const int ml = wid * 2 + tt, m = m0 + ml;
      const bool ctx = m < NCTX;
      const int pos = pos_of_tok(m), prow = pos >> 6, pcol = pos & 63, len = ctx ? 256 : 2048;
      {
        const u16* r1 = UA + (size_t)m * U1A_LD;
#pragma unroll
        for (int j = 0; j < 3; ++j) {
          const int ch = j * 512 + lane * 8;
          float x0[8], x1[8], x2[8], y[8];
          unpack8(*(const u32x4*)(r1 + ch), x1);
          if (pos > 0) unpack8(*(const u32x4*)(r1 - U1A_LD + ch), x0); else {
#pragma unroll
            for (int e = 0; e < 8; ++e) x0[e] = 0.f; }
          if (pos < len - 1) unpack8(*(const u32x4*)(r1 + U1A_LD + ch), x2); else {
#pragma unroll
            for (int e = 0; e < 8; ++e) x2[e] = 0.f; }
          float ss = 0.f;
#pragma unroll
          for (int e = 0; e < 8; ++e) {
            const float a = p.gdn_conv[ch + e] * x0[e] + p.gdn_conv[1536 + ch + e] * x1[e] + p.gdn_conv[3072 + ch + e] * x2[e];
            y[e] = siluf(a); ss += y[e] * y[e];
          }
          if (j < 2) {
            ss = group16_sum(ss);
            const float rs = rsqrtf(ss + EPS) * (j == 0 ? 0.08838834764831845f : 1.f);
#pragma unroll
            for (int e = 0; e < 8; ++e) y[e] *= rs;
            *(u32x4*)(QK + (size_t)m * DM + j * 512 + lane * 8) = pack8f(y);
          } else {
            *(u32x4*)(VC + (size_t)m * 512 + lane * 8) = pack8f(y);
          }
        }
      }
      if (lane < 16) {
        const float a = AB[(size_t)m * 16 + lane];
        float r;
        if (lane < 8) { const float x = a + p.gdn_dt_bias[lane]; const float sp = x > 20.f ? x : log1pf(expf(x)); r = -expf(p.gdn_a_log[lane]) * sp; }
        else r = 1.f / (1.f + expf(-a));
        GB[(size_t)m * 16 + lane] = r;
      }
      {
        u16* qp = UB + (size_t)m * U1B_LD + C1_QD + lane * 8;
        float x[8], xp[8];
        unpack8(*(const u32x4*)qp, x);
        float ss = 0.f;
#pragma unroll
        for (int e = 0; e < 8; ++e) ss += x[e] * x[e];
        ss = group16_sum(ss);
        const float rs = rsqrtf(ss * (1.f / 128.f) + EPS);
        const int li = lane & 15;
#pragma unroll
        for (int e = 0; e < 8; ++e) x[e] *= rs * p.att_q_norm[li * 8 + e];
        shfl8(x, xp, 4);
        if (!ctx) { const int b32 = li >> 2; rope8(x, xp, tabA, 32, (b32 >= 2) ? pcol : prow, (li & 3) * 8, (b32 & 1) != 0); }
        *(u32x4*)qp = pack8f(x);
      }
      {
        u16* kp = UB + (size_t)m * U1B_LD + C1_KD + (lane & 31) * 8;
        float x[8], xp[8];
        unpack8(*(const u32x4*)kp, x);
        float ss = 0.f;
#pragma unroll
        for (int e = 0; e < 8; ++e) ss += x[e] * x[e];
        ss = group16_sum(ss);
        const float rs = rsqrtf(ss * (1.f / 128.f) + EPS);
        const int li = lane & 15;
#pragma unroll
        for (int e = 0; e < 8; ++e) x[e] *= rs * p.att_k_norm[li * 8 + e];
        if (ctx && lane < 32) {
          *(float4*)(p.out + O_ATTK + (size_t)m * 256 + lane * 8) = make_float4(x[0], x[1], x[2], x[3]);
          *(float4*)(p.out + O_ATTK + (size_t)m * 256 + lane * 8 + 4) = make_float4(x[4], x[5], x[6], x[7]);
        }
        shfl8(x, xp, 4);
        if (!ctx) { const int b32 = li >> 2; rope8(x, xp, tabA, 32, (b32 >= 2) ? pcol : prow, (li & 3) * 8, (b32 & 1) != 0); }
        if (lane < 32) {
          *(u32x4*)kp = pack8f(x);
          const u32x4 vw = *(const u32x4*)(UB + (size_t)m * U1B_LD + C1_VD + lane * 8);
          *(u32x4*)(sv + ml * 264 + lane * 8) = vw;
          if (ctx) {
            float v[8]; unpack8(vw, v);
            *(float4*)(p.out + O_ATTV + (size_t)m * 256 + lane * 8) = make_float4(v[0], v[1], v[2], v[3]);
            *(float4*)(p.out + O_ATTV + (size_t)m * 256 + lane * 8 + 4) = make_float4(v[4], v[5], v[6], v[7]);
          }
        }
      }
    }
    __syncthreads();
    {
      const int s = seq_of_tok(m0);
      vt_store16(sv, 264, 256, (u16*)(p.ws + WS_VTATT) + (size_t)krow0_of(s) * 256, cap_of(s), pos_of_tok(m0));
    }
    __syncthreads();
  }
}

DI void phase_gdnfinal(const Params& p) {
  const int lane = threadIdx.x & 63, wid = threadIdx.x >> 6;
  const u16* OF = (const u16*)(p.ws + WS_OF); const u16* OBk = (const u16*)(p.ws + WS_OB);
  const u16* UB = (const u16*)(p.ws + WS_U1B);
  u16* H = (u16*)(p.ws + WS_H);
  for (int m = blockIdx.x * 8 + wid; m < NTOK; m += gridDim.x * 8) {
    float a[8], b[8], z[8];
    unpack8(*(const u32x4*)(OF + (size_t)m * 512 + lane * 8), a);
    unpack8(*(const u32x4*)(OBk + (size_t)m * 512 + lane * 8), b);
    unpack8(*(const u32x4*)(UB + (size_t)m * U1B_LD + C1_ZC + lane * 8), z);
    float ss = 0.f;
#pragma unroll
    for (int e = 0; e < 8; ++e) { a[e] += b[e]; ss += a[e] * a[e]; }
    ss = group16_sum(ss);
    const float rs = rsqrtf(ss * (1.f / 128.f) + EPS);
    const int li = lane & 15;
#pragma unroll
    for (int e = 0; e < 8; ++e) a[e] = a[e] * rs * p.gdn_norm[li * 8 + e] * siluf(z[e]);
    *(u32x4*)(H + (size_t)m * DM + lane * 8) = pack8f(a);
  }
}

DI void phase_final(const Params& p) {
  const int lane = threadIdx.x & 63, wid = threadIdx.x >> 6;
  for (int m = blockIdx.x * 8 + wid; m < NTOK; m += gridDim.x * 8) {
    float* x = p.out + (size_t)m * DM;
    float4 v[4]; float ss = 0.f;
#pragma unroll
    for (int j = 0; j < 4; ++j) { v[j] = *(const float4*)(x + (j * 64 + lane) * 4); ss += v[j].x * v[j].x + v[j].y * v[j].y + v[j].z * v[j].z + v[j].w * v[j].w; }
    ss = wave_sum(ss);
    const float rs = rsqrtf(ss * (1.f / 1024.f) + EPS);
#pragma unroll
    for (int j = 0; j < 4; ++j) {
      const int c = (j * 64 + lane) * 4;
      const float4 g = *(const float4*)(p.ln_f + c);
      *(float4*)(x + c) = make_float4(v[j].x * rs * g.x, v[j].y * rs * g.y, v[j].z * rs * g.z, v[j].w * rs * g.w);
    }
  }
}

template <class F>
DI void ngemm(const GemmA A, const u16* __restrict__ Wt, int ldw, int K, int M, int N, char* lds, F f) {
  u16* sA = (u16*)lds;
  const int tid = threadIdx.x;
  const int ncol = (N + 511) / 512;
  for (int it = blockIdx.x; it < (M / 8) * ncol; it += gridDim.x) {
    const int m0 = (it / ncol) * 8, n = (it % ncol) * 512 + tid;
    __syncthreads();
    for (int i = tid; i < 8 * (K / 8); i += NTHREADS) {
      const int r = i / (K / 8), k8 = (i % (K / 8)) * 8;
      const u16* src = k8 < A.ksplit ? A.p0 + (size_t)(m0 + r) * A.ld0 + k8 : A.p1 + (size_t)(m0 + r) * A.ld1 + (k8 - A.ksplit);
      *(u32x4*)(sA + r * K + k8) = *(const u32x4*)src;
    }
    __syncthreads();
    if (n < N) {
      float acc[8];
#pragma unroll
      for (int r = 0; r < 8; ++r) acc[r] = 0.f;
      for (int k8 = 0; k8 < K; k8 += 8) {
        float w[8]; unpack8(*(const u32x4*)(Wt + (size_t)n * ldw + k8), w);
#pragma unroll
        for (int r = 0; r < 8; ++r) {
          float a[8]; unpack8(*(const u32x4*)(sA + r * K + k8), a);
#pragma unroll
          for (int e = 0; e < 8; ++e) acc[r] += a[e] * w[e];
        }
      }
#pragma unroll
      for (int r = 0; r < 8; ++r) f(m0 + r, n, acc[r]);
    }
  }
}
DI void nphase_inproj0(const Params& p, char* lds) {
  u16* U = (u16*)(p.ws + WS_U); const u16* H = (const u16*)(p.ws + WS_H);
  ngemm(GemmA{H, DM, H, DM, 1 << 30}, (const u16*)(p.ws + WS_WT0), DM, DM, NTOK, L0C, lds, [=](int m, int n, float v) { U[(size_t)m * L0C + n] = f2bf(v); });
}
DI void nphase_l0gemms(const Params& p, char* lds) {
  const u16* U0 = (const u16*)(p.ws + WS_U); const u16* ck = (const u16*)(p.ws + WS_CKVN);
  u16* Kn = (u16*)((char*)p.out + YS_KN); u16* Vt = (u16*)((char*)p.out + YS_VTMLA); u16* Q = (u16*)((char*)p.out + YS_QMLA);
  ngemm(GemmA{ck, 256, ck, 256, 1 << 30}, (const u16*)(p.ws + WS_WUKV), 256, 256, NKROW, 1024, lds, [=](int kr, int n, float v) {
    const int head = n >> 7, within = n & 127;
    if (within < 64) Kn[((size_t)kr * 8 + head) * 64 + within] = f2bf(v);
    else {
      int seq, key;
      if (kr < NCTX) { seq = kr >> 8; key = kr & 255; } else { const int r = kr - NCTX; seq = 16 + r / 2560; key = r % 2560; }
      Vt[(size_t)krow0_of(seq) * 512 + (size_t)(head * 64 + within - 64) * cap_of(seq) + (key & ~15) + swz16(key & 15)] = f2bf(v);
    }
  });
  ngemm(GemmA{U0 + C0_CQ, L0C, U0 + C0_CQ, L0C, 1 << 30}, (const u16*)(p.ws + WS_WUQ), 384, 384, NTOK, 768, lds, [=](int m, int n, float v) { Q[(size_t)m * 768 + n] = f2bf(v); });
}
DI void nphase_qmla_rope(const Params& p) {
  u16* Q = (u16*)((char*)p.out + YS_QMLA);
  const float2* tab = (const float2*)(p.ws + WS_ROPE);
  for (size_t i = (size_t)blockIdx.x * NTHREADS + threadIdx.x; i < (size_t)(NTOK - NCTX) * 8 * 16; i += (size_t)gridDim.x * NTHREADS) {
    const int m = NCTX + (int)(i >> 7), head = (int)(i >> 4) & 7, j = (int)i & 15;
    const int pos = pos_of_tok(m), pp = (j >> 3) ? (pos & 63) : (pos >> 6);
    u16* q = Q + (size_t)m * 768 + head * 96 + 64 + (j >> 3) * 16 + (j & 7);
    const float x1 = bf2f(q[0]), x2 = bf2f(q[8]);
    const float2 cs = tab[pp * 8 + (j & 7)];
    q[0] = f2bf(x1 * cs.x - x2 * cs.y); q[8] = f2bf(x2 * cs.x + x1 * cs.y);
  }
}
DI void nphase_outproj(const Params& p, int layer, char* lds) {
  const u16* H = (const u16*)(p.ws + WS_H);
  GemmA A = layer == 0 ? GemmA{H, DM, H, DM, 1 << 30} : GemmA{H, DM, (const u16*)(p.ws + WS_U1B) + C1_QD, U1B_LD, 512};
  const float* mod = (const float*)(p.ws + WS_MOD) + (size_t)layer * 9 * 3072 + 2048;
  const Params* pp = &p;
  ngemm(A, (const u16*)(p.ws + (layer ? WS_WO1 : WS_WO0)), DM, DM, NTOK, DM, lds, [=](int m, int n, float v) {
    const float gate = mod[(size_t)modidx_of_tok(m) * 3072 + n];
    const float xv = layer ? pp->out[(size_t)m * DM + n] : xrow(*pp, m)[n];
    pp->out[(size_t)m * DM + n] = xv + gate * v;
  });
}
DI void nphase_inproj1(const Params& p, char* lds) {
  u16* UA = (u16*)(p.ws + WS_U1A); u16* UB = (u16*)(p.ws + WS_U1B); float* AB = (float*)(p.ws + WS_AB);
  const u16* H = (const u16*)(p.ws + WS_H);
  ngemm(GemmA{H, DM, H, DM, 1 << 30}, (const u16*)(p.ws + WS_WT1), DM, DM, NTOK, L1C, lds, [=](int m, int n, float v) {
    if (n < 1536) UA[(size_t)m * U1A_LD + n] = f2bf(v);
    else if (n < 3584) UB[(size_t)m * U1B_LD + n - 1536] = f2bf(v);
    else AB[(size_t)m * 16 + n - 3584] = v;
  });
}

template <int KIND>
DI void nattn(const Params& p) {
  constexpr int DQK = KIND == 0 ? 96 : (KIND == 1 ? 64 : 128);
  constexpr int DV = KIND == 2 ? 128 : 64;
  constexpr int NH = KIND == 2 ? 4 : 8;
  constexpr float SCALE = KIND == 0 ? 0.10206207261596577f : (KIND == 1 ? 0.125f : 0.08838834764831845f);
  const int lane = threadIdx.x & 63, wid = threadIdx.x >> 6;
  const u16* U0 = (const u16*)(p.ws + WS_U);
  u16* U1B = (u16*)(p.ws + WS_U1B);
  for (int it = blockIdx.x * 8 + wid; it < NTOK * NH; it += gridDim.x * 8) {
    const int tok = it / NH, hq = it % NH;
    const int s = seq_of_tok(tok), tok0 = tok0_of(s), kr0 = krow0_of(s), cap = cap_of(s), len = len_of(s), qi = tok - tok0;
    const bool smp = s >= 16;
    const int hkv = KIND == 0 ? hq : (KIND == 1 ? hq >> 2 : hq >> 1);
    const u16* qp; const u16* VT;
    if (KIND == 0) { qp = (const u16*)((const char*)p.out + YS_QMLA) + (size_t)tok * 768 + hq * 96; VT = (const u16*)((const char*)p.out + YS_VTMLA) + (size_t)kr0 * 512; }
    else if (KIND == 1) { qp = U0 + (size_t)tok * L0C + C0_QB + hq * 64; VT = (const u16*)(p.ws + WS_VTSWA) + (size_t)kr0 * 128; }
    else { qp = U1B + (size_t)tok * U1B_LD + C1_QD + hq * 128; VT = (const u16*)(p.ws + WS_VTATT) + (size_t)kr0 * 256; }
    const float q0 = bf2f(qp[lane]);
    const float q1 = (DQK > 64 && lane + 64 < DQK) ? bf2f(qp[lane + 64]) : 0.f;
    float m = -1e30f, l = 0.f, o0 = 0.f, o1 = 0.f;
    int glo = 0, ghi = cap >> 4;
    const int nseqg = len >> 4;
    for (int gidx = glo; gidx < ghi; ++gidx) {
      const int g0 = gidx * 16;
      if (KIND == 1 && smp && g0 < 2048) { if (g0 + 15 < qi - 128 || g0 > qi + 128) continue; }
      float sc[16];
#pragma unroll
      for (int j = 0; j < 16; ++j) {
        const int g = g0 + j;
        const u16* kp;
        float part;
        if (KIND == 0) {
          const u16* kn = (const u16*)((const char*)p.out + YS_KN) + ((size_t)(kr0 + g) * 8 + hkv) * 64;
          const u16* kr = (const u16*)(p.ws + WS_KROPE) + (size_t)(kr0 + g) * 32;
          part = q0 * bf2f(kn[lane]) + (lane < 32 ? q1 * bf2f(kr[lane]) : 0.f);
        } else if (KIND == 1) {
          kp = (const u16*)(p.ws + WS_KSWA) + ((size_t)(kr0 + g) * 2 + hkv) * 64;
          part = q0 * bf2f(kp[lane]);
        } else {
          kp = g < len ? U1B + (size_t)(tok0 + g) * U1B_LD + C1_KD + hkv * 128 : (const u16*)(p.ws + WS_KC) + ((size_t)((s - 16) * 512 + g - 2048) * 2 + hkv) * 128;
          part = q0 * bf2f(kp[lane]) + q1 * bf2f(kp[lane + 64]);
        }
        float sv_ = wave_sum(part) * SCALE;
        if (KIND == 1 && smp && g < 2048) { const int d = qi - g; if (d > 128 || d < -128) sv_ = -INFINITY; }
        sc[j] = sv_;
      }
      float mx = sc[0];
#pragma unroll
      for (int j = 1; j < 16; ++j) mx = fmaxf(mx, sc[j]);
      const float mnew = fmaxf(m, mx);
      const float alpha = __expf(m - mnew);
      m = mnew; l *= alpha; o0 *= alpha; o1 *= alpha;
      const u32x4 va = *(const u32x4*)(VT + (size_t)(hkv * DV + lane) * cap + g0), vb = *(const u32x4*)(VT + (size_t)(hkv * DV + lane) * cap + g0 + 8);
      float v0[16]; { float t8[8]; unpack8(va, t8); for (int e = 0; e < 8; ++e) v0[e] = t8[e]; unpack8(vb, t8); for (int e = 0; e < 8; ++e) v0[8 + e] = t8[e]; }
      float v1[16];
      if (DV > 64) {
        const u32x4 vc = *(const u32x4*)(VT + (size_t)(hkv * DV + 64 + lane) * cap + g0), vd = *(const u32x4*)(VT + (size_t)(hkv * DV + 64 + lane) * cap + g0 + 8);
        float t8[8]; unpack8(vc, t8); for (int e = 0; e < 8; ++e) v1[e] = t8[e]; unpack8(vd, t8); for (int e = 0; e < 8; ++e) v1[8 + e] = t8[e];
      }
#pragma unroll
      for (int j = 0; j < 16; ++j) {
        const float pj = __expf(sc[j] - mnew);
        l += pj;
        o0 += pj * v0[swz16(j)];
        if (DV > 64) o1 += pj * v1[swz16(j)];
      }
    }
    (void)nseqg; (void)glo;
    if (KIND == 1) l += __expf(p.swa_sink[hq] - m);
    const float inv = 1.f / l;
    if (KIND == 0) { const float z = bf2f(U0[(size_t)tok * L0C + C0_ZA + hq * 64 + lane]); ((u16*)(p.ws + WS_H))[(size_t)tok * DM + hq * 64 + lane] = f2bf(o0 * inv * siluf(z)); }
    else if (KIND == 1) { const float z = bf2f(U0[(size_t)tok * L0C + C0_ZB + hq * 64 + lane]); ((u16*)(p.ws + WS_H))[(size_t)tok * DM + 512 + hq * 64 + lane] = f2bf(o0 * inv * siluf(z)); }
    else {
      const float z0 = bf2f(U1B[(size_t)tok * U1B_LD + C1_ZD + hq * 128 + lane]), z1 = bf2f(U1B[(size_t)tok * U1B_LD + C1_ZD + hq * 128 + 64 + lane]);
      U1B[(size_t)tok * U1B_LD + C1_QD + hq * 128 + lane] = f2bf(o0 * inv * siluf(z0));
      U1B[(size_t)tok * U1B_LD + C1_QD + hq * 128 + 64 + lane] = f2bf(o1 * inv * siluf(z1));
    }
  }
}

DI void nphase_gdn(const Params& p, char* lds) {
  const int tid = threadIdx.x;
  float* sq = (float*)lds; float* sk = sq + 128;
  const u16* QK = (const u16*)(p.ws + WS_H); const u16* VC = (const u16*)(p.ws + WS_VC); const float* GB = (const float*)(p.ws + WS_GB);
  for (int it = blockIdx.x; it < 192; it += gridDim.x) {
    int s, head, dir;
    if (it < 64) { s = 16 + (it >> 3); head = (it >> 1) & 3; dir = it & 1; } else { const int j = it - 64; s = j >> 3; head = (j >> 1) & 3; dir = j & 1; }
    const int tok0 = tok0_of(s), T = len_of(s);
    u16* O = (u16*)(p.ws + (dir ? WS_OB : WS_OF));
    float S[128];
    if (tid < 128) {
      if (s >= 16) {
        const float* st = p.c_state + ((size_t)(((s - 16) * 2 + dir) * 4 + head)) * 16384;
#pragma unroll
        for (int d = 0; d < 128; ++d) S[d] = st[d * 128 + tid];
      } else {
#pragma unroll
        for (int d = 0; d < 128; ++d) S[d] = 0.f;
      }
    }
    for (int tau = 0; tau < T; ++tau) {
      const int m = tok0 + (dir ? T - 1 - tau : tau);
      __syncthreads();
      if (tid < 128) { sq[tid] = bf2f(QK[(size_t)m * DM + head * 128 + tid]); sk[tid] = bf2f(QK[(size_t)m * DM + 512 + head * 128 + tid]); }
      __syncthreads();
      if (tid < 128) {
        const float g = GB[(size_t)m * 16 + dir * 4 + head], beta = GB[(size_t)m * 16 + 8 + dir * 4 + head];
        const float alpha = __expf(g);
        const float v = bf2f(VC[(size_t)m * 512 + head * 128 + tid]);
        float r = 0.f;
#pragma unroll
        for (int c = 0; c < 16; ++c) {
          const float4 ka = *(const float4*)(sk + c * 8), kb = *(const float4*)(sk + c * 8 + 4);
          r += ka.x * S[c * 8] + ka.y * S[c * 8 + 1] + ka.z * S[c * 8 + 2] + ka.w * S[c * 8 + 3] + kb.x * S[c * 8 + 4] + kb.y * S[c * 8 + 5] + kb.z * S[c * 8 + 6] + kb.w * S[c * 8 + 7];
          asm volatile("" ::: "memory");
        }
        const float dd = beta * (v - alpha * r);
        float o = 0.f;
#pragma unroll
        for (int c = 0; c < 16; ++c) {
          const float4 ka = *(const float4*)(sk + c * 8), kb = *(const float4*)(sk + c * 8 + 4);
          const float4 qa = *(const float4*)(sq + c * 8), qb = *(const float4*)(sq + c * 8 + 4);
          const float kk[8] = {ka.x, ka.y, ka.z, ka.w, kb.x, kb.y, kb.z, kb.w};
          const float qq[8] = {qa.x, qa.y, qa.z, qa.w, qb.x, qb.y, qb.z, qb.w};
#pragma unroll
          for (int e = 0; e < 8; ++e) { S[c * 8 + e] = alpha * S[c * 8 + e] + kk[e] * dd; o += qq[e] * S[c * 8 + e]; }
          asm volatile("" ::: "memory");
        }
        O[(size_t)m * 512 + head * 128 + tid] = f2bf(o);
      }
    }
    if (tid < 128 && s < 16) {
      float* st = p.out + O_STATE + ((size_t)((s * 2 + dir) * 4 + head)) * 16384;
#pragma unroll
      for (int d = 0; d < 128; ++d) st[d * 128 + tid] = S[d];
    }
    __syncthreads();
  }
}

extern __shared__ __attribute__((aligned(16))) char smem[];
constexpr int LDS_BYTES = 98304;

#ifndef FAST_MASK
#define FAST_MASK 0
#endif
#define GSYNC() grid.sync()

__global__ void __launch_bounds__(NTHREADS) fwd_megakernel(Params p) {
  cg::grid_group grid = cg::this_grid();
  char* lds = smem;
  phase_prep(p, lds);
  GSYNC();
  phase_adaln(p, 0);
  GSYNC();
  if (FAST_MASK & 1) phase_inproj0(p, lds); else nphase_inproj0(p, lds);
  GSYNC();
  phase_l0prep(p, lds);
  GSYNC();
  if (FAST_MASK & 2) phase_l0gemms(p, lds); else { nphase_l0gemms(p, lds); GSYNC(); nphase_qmla_rope(p); }
  GSYNC();
  if (FAST_MASK & 4) phase_attn0(p, lds); else { nattn<0>(p); nattn<1>(p); }
  GSYNC();
  if (FAST_MASK & 8) phase_outproj(p, 0, lds); else nphase_outproj(p, 0, lds);
  GSYNC();
  phase_adaln(p, 1);
  GSYNC();
  if (FAST_MASK & 16) phase_inproj1(p, lds); else nphase_inproj1(p, lds);
  GSYNC();
  phase_l1prep(p, lds);
  GSYNC();
  nphase_gdn(p, lds);
  GSYNC();
  if (FAST_MASK & 64) phase_attn1(p, lds); else nattn<2>(p);
  phase_gdnfinal(p);
  GSYNC();
  if (FAST_MASK & 128) phase_outproj(p, 1, lds); else nphase_outproj(p, 1, lds);
  GSYNC();
  phase_final(p);
}

extern "C" void kernel_launch(void* const* d_in, const int* in_sizes, int n_in, void* d_out, int out_size, void* d_ws, size_t ws_size, hipStream_t stream) {
  static int grid_blocks = 0;
  if (!grid_blocks) {
    int dev = 0, cus = 0, per_cu = 0;
    (void)hipGetDevice(&dev);
    (void)hipDeviceGetAttribute(&cus, hipDeviceAttributeMultiprocessorCount, dev);
    (void)hipFuncSetAttribute((const void*)fwd_megakernel, hipFuncAttributeMaxDynamicSharedMemorySize, LDS_BYTES);
    (void)hipOccupancyMaxActiveBlocksPerMultiprocessor(&per_cu, fwd_megakernel, NTHREADS, LDS_BYTES);
    if (per_cu > 1) per_cu = 1;
    grid_blocks = cus * per_cu;
    if (grid_blocks <= 0) { fprintf(stderr, "occupancy query failed (cus %d per_cu %d)\n", cus, per_cu); grid_blocks = 0; return; }
  }
  if (n_in != 33 || ws_size < WS_END) { fprintf(stderr, "kernel_launch: unexpected n_in %d / ws %zu\n", n_in, ws_size); return; }
  Params p{};
  const float** pp = (const float**)&p;
  for (int i = 0; i < 33; ++i) pp[i] = (const float*)d_in[i];
  p.out = (float*)d_out;
  p.ws = (char*)d_ws;
  void* args[] = {&p};
  hipError_t e = hipLaunchCooperativeKernel((void*)fwd_megakernel, dim3(grid_blocks), dim3(NTHREADS), args, LDS_BYTES, stream);
  if (e != hipSuccess) fprintf(stderr, "cooperative launch failed: %s (grid %d)\n", hipGetErrorString(e), grid_blocks);
}
```

```cpp
#include <hip/hip_runtime.h>
#include <hip/hip_cooperative_groups.h>
#include <cstdio>
#include <cstdint>
namespace cg = cooperative_groups;

#define DI __device__ __forceinline__
typedef unsigned short u16;
using bf16x8 = __attribute__((ext_vector_type(8))) short;
using bf16x4 = __attribute__((ext_vector_type(4))) short;
using f32x16 = __attribute__((ext_vector_type(16))) float;
using f32x4  = __attribute__((ext_vector_type(4))) float;
using u32x4  = __attribute__((ext_vector_type(4))) unsigned;
using u32x2  = __attribute__((ext_vector_type(2))) unsigned;

#ifndef PHASE_LIMIT
#define PHASE_LIMIT 99
#endif

constexpr int NTHREADS = 512;
constexpr int DM = 1024, NTOK = 20480, NCTX = 4096, NKROW = 24576;
constexpr int L0C = 2464, L0CP = 2560, L1C = 3600, L1CP = 3712;
constexpr int U1A_LD = 1536, U1B_LD = 2048;
constexpr int C0_CQ = 0, C0_CKV = 384, C0_KR = 640, C0_ZA = 672, C0_QB = 1184, C0_KB = 1696, C0_VB = 1824, C0_ZB = 1952;
constexpr int C1_ZC = 0, C1_QD = 512, C1_KD = 1024, C1_VD = 1280, C1_ZD = 1536;
constexpr float EPS = 1e-6f;
constexpr float LOG2E = 1.4426950408889634f;

constexpr size_t O_Y = 0;
constexpr size_t O_CKV = 20971520, O_KROPE = 22020096, O_SWAK = 22151168, O_SWAV = 22675456, O_STATE = 23199744, O_ATTK = 25296896, O_ATTV = 26345472;

constexpr size_t WS_WO1 = 0;
constexpr size_t WS_MOD = WS_WO1 + 2097152;
constexpr size_t WS_ROPE = WS_MOD + 221184;
constexpr size_t WS_W2 = WS_ROPE + 32768;
constexpr size_t WS_WT0 = WS_W2;
constexpr size_t WS_WUQ = WS_WT0 + 5242880;
constexpr size_t WS_WUKV = WS_WUQ + 589824;
constexpr size_t WS_WO0 = WS_WUKV + 524288;
constexpr size_t WS_WT1 = WS_WO0 + 2097152;
constexpr size_t WS_W2_END = WS_WT1 + 7602176;
constexpr size_t WS_VTATT = WS_W2;
constexpr size_t WS_KC = WS_VTATT + 12582912;
constexpr size_t WS_GB = WS_KC + 2097152;
static_assert(WS_GB + 1310720 <= WS_W2_END, "layer-1 reuse overflow");
constexpr size_t WS_H = WS_W2_END;
constexpr size_t WS_U = WS_H + 41943040;
constexpr size_t WS_U0X = WS_U + (size_t)NTOK * L0C * 2;
constexpr size_t WS_KSWA = WS_U0X;
constexpr size_t WS_VTSWA = WS_KSWA + 6291456;
constexpr size_t WS_CKVN = WS_VTSWA + 6291456;
constexpr size_t WS_KROPE = WS_CKVN + 12582912;
static_assert(WS_KROPE + 1572864 <= WS_U + 147456000, "layer-0 extras overflow");
constexpr size_t WS_U1A = WS_U;
constexpr size_t WS_U1B = WS_U + 62914560;
constexpr size_t WS_TB = WS_U1A;
constexpr size_t WS_AM = WS_TB + 20971520;
constexpr size_t WS_OB = WS_AM + 20971520;
constexpr size_t WS_X = WS_U + 147456000;
constexpr size_t WS_VC = WS_X;
constexpr size_t WS_OF = WS_VC + 20971520;
constexpr size_t WS_AB = WS_OF + 20971520;
constexpr size_t WS_END = WS_AB + 1310720;
static_assert(WS_END <= 268435456ull, "ws overflow");
constexpr size_t YS_QMLA = 0;
constexpr size_t YS_KN = YS_QMLA + 31457280;
constexpr size_t YS_VTMLA = YS_KN + 25165824;
static_assert(YS_VTMLA + 25165824 <= (size_t)NTOK * DM * 4, "y scratch overflow");

struct Params {
  const float *x_prompt, *x_sample, *c_ckv, *c_krope, *c_swak, *c_swav, *c_state, *c_attk, *c_attv, *c, *c_ctx;
  const float *w_mod0, *b_mod0, *ln0, *w_in0, *mla_q_norm, *w_uq, *mla_kv_norm, *w_ukv, *swa_sink, *w_out0;
  const float *w_mod1, *b_mod1, *ln1, *w_in1, *gdn_conv, *gdn_a_log, *gdn_dt_bias, *gdn_norm, *att_q_norm, *att_k_norm, *w_out1, *ln_f;
  float* out;
  char* ws;
};

DI float bf2f(u16 b) { return __uint_as_float(((unsigned)b) << 16); }
DI u16 f2bf(float x) { unsigned u = __float_as_uint(x); u += 0x7fffu + ((u >> 16) & 1u); return (u16)(u >> 16); }
DI unsigned pack2(float lo, float hi) { return (unsigned)f2bf(lo) | ((unsigned)f2bf(hi) << 16); }
DI int crow(int reg, int h) { return (reg & 3) + 8 * (reg >> 2) + 4 * h; }
DI int swz16(int k) { return (k & ~12) | ((k & 4) << 1) | ((k & 8) >> 1); }
DI float siluf(float x) { return x / (1.f + __expf(-x)); }
DI int seq_of_tok(int m) { return m < NCTX ? (m >> 8) : 16 + ((m - NCTX) >> 11); }
DI int tok0_of(int s) { return s < 16 ? s * 256 : NCTX + (s - 16) * 2048; }
DI int krow0_of(int s) { return s < 16 ? s * 256 : NCTX + (s - 16) * 2560; }
DI int cap_of(int s) { return s < 16 ? 256 : 2560; }
DI int len_of(int s) { return s < 16 ? 256 : 2048; }
DI int modidx_of_tok(int m) { return m < NCTX ? 0 : 1 + ((m - NCTX) >> 11); }
DI int krow_of_tok(int m) { return m < NCTX ? m : NCTX + ((m - NCTX) >> 11) * 2560 + ((m - NCTX) & 2047); }
DI int pos_of_tok(int m) { return m < NCTX ? (m & 255) : ((m - NCTX) & 2047); }
DI const float* xrow(const Params& p, int m) { return m < NCTX ? p.x_prompt + (size_t)m * DM : p.x_sample + (size_t)(m - NCTX) * DM; }
DI float wave_sum(float v) {
#pragma unroll
  for (int o = 32; o > 0; o >>= 1) v += __shfl_xor(v, o);
  return v;
}
DI bf16x8 pack8(const f32x16& x, int s) {
  u32x4 w = {pack2(x[8 * s + 0], x[8 * s + 1]), pack2(x[8 * s + 2], x[8 * s + 3]), pack2(x[8 * s + 4], x[8 * s + 5]), pack2(x[8 * s + 6], x[8 * s + 7])};
  return __builtin_bit_cast(bf16x8, w);
}
DI bf16x8 cat4(bf16x4 lo, bf16x4 hi) { return __builtin_shufflevector(lo, hi, 0, 1, 2, 3, 4, 5, 6, 7); }
#define MFMA(a, b, c) __builtin_amdgcn_mfma_f32_32x32x16_bf16((a), (b), (c), 0, 0, 0)

DI void transpose_tile(const float* __restrict__ W, int ldw, int k0, int srccol0, int nvalid, u16* __restrict__ Wt, int ldt, int dstrow0, char* lds) {
  u16* t = (u16*)lds;
  const int tid = threadIdx.x, kr = tid >> 3, cc = (tid & 7) * 8;
  float v[8];
  if (cc < nvalid) {
    const float4 a = *(const float4*)(W + (size_t)(k0 + kr) * ldw + srccol0 + cc);
    const float4 b = *(const float4*)(W + (size_t)(k0 + kr) * ldw + srccol0 + cc + 4);
    v[0] = a.x; v[1] = a.y; v[2] = a.z; v[3] = a.w; v[4] = b.x; v[5] = b.y; v[6] = b.z; v[7] = b.w;
  } else {
#pragma unroll
    for (int e = 0; e < 8; ++e) v[e] = 0.f;
  }
#pragma unroll
  for (int e = 0; e < 8; ++e) t[(cc + e) * 72 + kr] = f2bf(v[e]);
  __syncthreads();
  const int n = tid >> 3, kc = (tid & 7) * 8;
  *(bf16x8*)(Wt + (size_t)(dstrow0 + n) * ldt + k0 + kc) = *(const bf16x8*)(t + n * 72 + kc);
  __syncthreads();
}

DI void vt_store16(const u16* sv, int CS, int C, u16* __restrict__ vt, size_t cap, int key16base) {
  for (int i = threadIdx.x; i < C * 4; i += NTHREADS) {
    const int ch = i >> 2, q = i & 3;
    u16 e[4];
#pragma unroll
    for (int j = 0; j < 4; ++j) e[j] = sv[swz16(q * 4 + j) * CS + ch];
    u32x2 w = {(unsigned)e[0] | ((unsigned)e[1] << 16), (unsigned)e[2] | ((unsigned)e[3] << 16)};
    *(u32x2*)(vt + (size_t)ch * cap + key16base + q * 4) = w;
  }
}

DI void phase_prep(const Params& p, char* lds) {
  const int tid = threadIdx.x;
  constexpr int N_MOD = 192;
  constexpr int T_IN0 = 16 * 40, T_UQ = 6 * 12, T_UKV = 4 * 16, T_O0 = 256, T_IN1 = 16 * 58, T_O1 = 256;
  constexpr int N_TR = T_IN0 + T_UQ + T_UKV + T_O0 + T_IN1 + T_O1;
  constexpr int N_CV = 256 + 32 + 128;
  constexpr int N_VT = 256;
  constexpr int N_ITEMS = N_MOD + N_TR + N_CV + N_VT + 1;
  for (int it = blockIdx.x; it < N_ITEMS; it += gridDim.x) {
    if (it < N_MOD) {
      const int layer = it / 96, col0 = (it % 96) * 32;
      const float* Wm = layer ? p.w_mod1 : p.w_mod0;
      const float* bm = layer ? p.b_mod1 : p.b_mod0;
      float* sc = (float*)lds;
      float* red = sc + 9 * 1024;
      for (int i = tid; i < 9 * 1024; i += NTHREADS) {
        const int s = i >> 10, k = i & 1023;
        const float cv = s == 0 ? p.c_ctx[k] : p.c[(s - 1) * 1024 + k];
        sc[i] = siluf(cv);
      }
      __syncthreads();
      const int col = tid & 31, kg = tid >> 5;
      float acc[9];
#pragma unroll
      for (int s = 0; s < 9; ++s) acc[s] = 0.f;
      for (int kk = 0; kk < 64; ++kk) {
        const int k = kg * 64 + kk;
        const float w = Wm[(size_t)k * 3072 + col0 + col];
#pragma unroll
        for (int s = 0; s < 9; ++s) acc[s] += sc[s * 1024 + k] * w;
      }
#pragma unroll
      for (int s = 0; s < 9; ++s) red[(kg * 9 + s) * 32 + col] = acc[s];
      __syncthreads();
      if (tid < 288) {
        const int s = tid >> 5, c2 = tid & 31;
        float a = bm[col0 + c2];
        for (int g = 0; g < 16; ++g) a += red[(g * 9 + s) * 32 + c2];
        ((float*)(p.ws + WS_MOD))[(size_t)(layer * 9 + s) * 3072 + col0 + c2] = a;
      }
      __syncthreads();
    } else if (it < N_MOD + N_TR) {
      int t = it - N_MOD;
      if (t < T_IN0) { const int kt = t / 40, nt = t % 40; int nv = L0C - nt * 64; nv = nv < 0 ? 0 : (nv > 64 ? 64 : nv);
        transpose_tile(p.w_in0, L0C, kt * 64, nt * 64, nv, (u16*)(p.ws + WS_WT0), 1024, nt * 64, lds); continue; }
      t -= T_IN0;
      if (t < T_UQ) { const int kt = t / 12, nt = t % 12; transpose_tile(p.w_uq, 768, kt * 64, nt * 64, 64, (u16*)(p.ws + WS_WUQ), 384, nt * 64, lds); continue; }
      t -= T_UQ;
      if (t < T_UKV) { const int kt = t / 16, nt = t % 16; transpose_tile(p.w_ukv, 1024, kt * 64, nt * 64, 64, (u16*)(p.ws + WS_WUKV), 256, nt * 64, lds); continue; }
      t -= T_UKV;
      if (t < T_O0) { const int kt = t / 16, nt = t % 16; transpose_tile(p.w_out0, 1024, kt * 64, nt * 64, 64, (u16*)(p.ws + WS_WO0), 1024, nt * 64, lds); continue; }
      t -= T_O0;
      if (t < T_IN1) { const int kt = t / 58, nt = t % 58; const int n0 = nt * 64; int src, nv;
        if (n0 < 1536) { src = n0; nv = 64; } else if (n0 < 3584) { src = n0 + 16; nv = 64; } else if (n0 == 3584) { src = 1536; nv = 16; } else { src = 0; nv = 0; }
        transpose_tile(p.w_in1, L1C, kt * 64, src, nv, (u16*)(p.ws + WS_WT1), 1024, n0, lds); continue; }
      t -= T_IN1;
      { const int kt = t / 16, nt = t % 16; transpose_tile(p.w_out1, 1024, kt * 64, nt * 64, 64, (u16*)(p.ws + WS_WO1), 1024, nt * 64, lds); }
    } else if (it < N_MOD + N_TR + N_CV) {
      int t = it - N_MOD - N_TR;
      const int e0 = tid * 8;
      if (t < 256) {
        const size_t i = (size_t)t * 4096 + e0; const int b = (int)(i >> 17), rem = (int)(i & 131071), pp = rem >> 8, cc = rem & 255;
        const float4 a = *(const float4*)(p.c_ckv + i), b4 = *(const float4*)(p.c_ckv + i + 4);
        u32x4 w = {pack2(a.x, a.y), pack2(a.z, a.w), pack2(b4.x, b4.y), pack2(b4.z, b4.w)};
        *(u32x4*)((u16*)(p.ws + WS_CKVN) + (size_t)(NCTX + b * 2560 + 2048 + pp) * 256 + cc) = w;
      } else if (t < 288) {
        const size_t i = (size_t)(t - 256) * 4096 + e0; const int b = (int)(i >> 14), rem = (int)(i & 16383), pp = rem >> 5, cc = rem & 31;
        const float4 a = *(const float4*)(p.c_krope + i), b4 = *(const float4*)(p.c_krope + i + 4);
        u32x4 w = {pack2(a.x, a.y), pack2(a.z, a.w), pack2(b4.x, b4.y), pack2(b4.z, b4.w)};
        *(u32x4*)((u16*)(p.ws + WS_KROPE) + (size_t)(NCTX + b * 2560 + 2048 + pp) * 32 + cc) = w;
      } else {
        const size_t i = (size_t)(t - 288) * 4096 + e0; const int b = (int)(i >> 16), rem = (int)(i & 65535), pp = rem >> 7, cc = rem & 127;
        const float4 a = *(const float4*)(p.c_swak + i), b4 = *(const float4*)(p.c_swak + i + 4);
        u32x4 w = {pack2(a.x, a.y), pack2(a.z, a.w), pack2(b4.x, b4.y), pack2(b4.z, b4.w)};
        *(u32x4*)((u16*)(p.ws + WS_KSWA) + (size_t)(NCTX + b * 2560 + 2048 + pp) * 128 + cc) = w;
      }
    } else if (it < N_MOD + N_TR + N_CV + N_VT) {
      const int t = it - N_MOD - N_TR - N_CV; const int b = t >> 5, g = t & 31;
      u16* sv = (u16*)lds;
      {
        const int key = tid >> 5, c4 = (tid & 31) * 4;
        const float4 a = *(const float4*)(p.c_swav + ((size_t)(b * 512 + g * 16 + key)) * 128 + c4);
        u32x2 w = {pack2(a.x, a.y), pack2(a.z, a.w)};
        *(u32x2*)(sv + key * 136 + c4) = w;
      }
      __syncthreads();
      vt_store16(sv, 136, 128, (u16*)(p.ws + WS_VTSWA) + (size_t)krow0_of(16 + b) * 128, 2560, 2048 + g * 16);
      __syncthreads();
    } else {
      float2* tab = (float2*)(p.ws + WS_ROPE);
      for (int i = tid; i < 64 * 8 + 64 * 16 + 64 * 32; i += NTHREADS) {
        int q, pos, f, j = i;
        if (j < 512) { q = 8; } else if (j < 1536) { q = 16; j -= 512; } else { q = 32; j -= 1536; }
        pos = j / q; f = j % q;
        const float inv = powf(10000.f, -(float)f / (float)q);
        const float ang = (float)pos * inv;
        tab[i] = make_float2(cosf(ang), sinf(ang));
      }
    }
  }
}

DI void phase_adaln(const Params& p, int layer) {
  const int lane = threadIdx.x & 63, wid = threadIdx.x >> 6;
  const float* ln = layer ? p.ln1 : p.ln0;
  const float* mod = (const float*)(p.ws + WS_MOD) + (size_t)layer * 9 * 3072;
  u16* H = (u16*)(p.ws + WS_H);
  for (int m = blockIdx.x * 8 + wid; m < NTOK; m += gridDim.x * 8) {
    const float* x = layer ? (p.out + (size_t)m * DM) : xrow(p, m);
    const float* md = mod + (size_t)modidx_of_tok(m) * 3072;
    float4 v[4]; float ss = 0.f;
#pragma unroll
    for (int j = 0; j < 4; ++j) { v[j] = *(const float4*)(x + (j * 64 + lane) * 4); ss += v[j].x * v[j].x + v[j].y * v[j].y + v[j].z * v[j].z + v[j].w * v[j].w; }
    ss = wave_sum(ss);
    const float rs = rsqrtf(ss * (1.f / 1024.f) + EPS);
#pragma unroll
    for (int j = 0; j < 4; ++j) {
      const int c = (j * 64 + lane) * 4;
      const float4 g = *(const float4*)(ln + c), sh = *(const float4*)(md + c), scl = *(const float4*)(md + 1024 + c);
      const float a0 = v[j].x * rs * g.x * (1.f + scl.x) + sh.x, a1 = v[j].y * rs * g.y * (1.f + scl.y) + sh.y;
      const float a2 = v[j].z * rs * g.z * (1.f + scl.z) + sh.z, a3 = v[j].w * rs * g.w * (1.f + scl.w) + sh.w;
      u32x2 w = {pack2(a0, a1), pack2(a2, a3)};
      *(u32x2*)(H + (size_t)m * DM + c) = w;
    }
  }
}

struct GemmA { const u16* p0; int ld0; const u16* p1; int ld1; int ksplit; };
constexpr int G_LDS_A = 256 * 72 * 2;
template <class Epi>
DI void gemm_tile(const GemmA A, const u16* __restrict__ B, int ldb, int K, int m0, int n0, char* lds, Epi& epi) {
  u16* sA = (u16*)lds; u16* sB = (u16*)(lds + G_LDS_A);
  const int tid = threadIdx.x, lane = tid & 63, wid = tid >> 6, r32 = lane & 31, h = lane >> 5;
  const int wm = wid >> 1, wn = wid & 1;
  const int lr = tid >> 3, lc = (tid & 7) * 8;
  f32x16 acc[2][2];
#pragma unroll
  for (int i = 0; i < 2; ++i)
#pragma unroll
    for (int j = 0; j < 2; ++j)
#pragma unroll
      for (int r = 0; r < 16; ++r) acc[i][j][r] = 0.f;
  bf16x8 ra[4], rb[2];
  const int nk = K >> 6;
  auto gload = [&](int kt) {
    const int k0 = kt * 64;
    const u16* ap; int lda, kk;
    if (k0 < A.ksplit) { ap = A.p0; lda = A.ld0; kk = k0; } else { ap = A.p1; lda = A.ld1; kk = k0 - A.ksplit; }
#pragma unroll
    for (int i = 0; i < 4; ++i) ra[i] = *(const bf16x8*)(ap + (size_t)(m0 + lr + 64 * i) * lda + kk + lc);
#pragma unroll
    for (int i = 0; i < 2; ++i) rb[i] = *(const bf16x8*)(B + (size_t)(n0 + lr + 64 * i) * ldb + k0 + lc);
  };
  gload(0);
  for (int kt = 0; kt < nk; ++kt) {
    __syncthreads();
#pragma unroll
    for (int i = 0; i < 4; ++i) *(bf16x8*)(sA + (lr + 64 * i) * 72 + lc) = ra[i];
#pragma unroll
    for (int i = 0; i < 2; ++i) *(bf16x8*)(sB + (lr + 64 * i) * 72 + lc) = rb[i];
    __syncthreads();
    if (kt + 1 < nk) gload(kt + 1);
#pragma unroll
    for (int ks = 0; ks < 4; ++ks) {
      bf16x8 a0 = *(const bf16x8*)(sA + (wm * 64 + r32) * 72 + ks * 16 + h * 8);
      bf16x8 a1 = *(const bf16x8*)(sA + (wm * 64 + 32 + r32) * 72 + ks * 16 + h * 8);
      bf16x8 b0 = *(const bf16x8*)(sB + (wn * 64 + r32) * 72 + ks * 16 + h * 8);
      bf16x8 b1 = *(const bf16x8*)(sB + (wn * 64 + 32 + r32) * 72 + ks * 16 + h * 8);
      acc[0][0] = MFMA(a0, b0, acc[0][0]); acc[0][1] = MFMA(a0, b1, acc[0][1]);
      acc[1][0] = MFMA(a1, b0, acc[1][0]); acc[1][1] = MFMA(a1, b1, acc[1][1]);
    }
  }
#pragma unroll
  for (int i = 0; i < 2; ++i)
#pragma unroll
    for (int j = 0; j < 2; ++j) epi(acc[i][j], m0 + wm * 64 + i * 32, n0 + wn * 64 + j * 32 + r32, h);
}

struct EpiU0 {
  u16* U;
  DI void operator()(const f32x16& a, int row0, int col, int h) const {
    if (col < L0C) {
#pragma unroll
      for (int r = 0; r < 16; ++r) U[(size_t)(row0 + crow(r, h)) * L0C + col] = f2bf(a[r]);
    }
  }
};
struct EpiQmla {
  u16* Q; const float2* tab;
  DI void operator()(const f32x16& a, int f0, int tok, int h) const {
    float v[16];
#pragma unroll
    for (int r = 0; r < 16; ++r) v[r] = a[r];
    if ((f0 % 96) == 64 && tok >= NCTX) {
      const int pos = pos_of_tok(tok), prow = pos >> 6, pcol = pos & 63;
#pragma unroll
      for (int j = 0; j < 4; ++j) {
        const int fi = 4 * h + j;
        const float2 cr = tab[prow * 8 + fi], cc = tab[pcol * 8 + fi];
        const float x1 = v[j], x2 = v[4 + j];
        v[j] = x1 * cr.x - x2 * cr.y; v[4 + j] = x2 * cr.x + x1 * cr.y;
        const float y1 = v[8 + j], y2 = v[12 + j];
        v[8 + j] = y1 * cc.x - y2 * cc.y; v[12 + j] = y2 * cc.x + y1 * cc.y;
      }
    }
#pragma unroll
    for (int g = 0; g < 4; ++g) {
      u32x2 w = {pack2(v[4 * g], v[4 * g + 1]), pack2(v[4 * g + 2], v[4 * g + 3])};
      *(u32x2*)(Q + (size_t)tok * 768 + f0 + 8 * g + 4 * h) = w;
    }
  }
};
struct EpiKvexp {
  u16* Kn; u16* Vt;
  DI void operator()(const f32x16& a, int kr0, int n, int h) const {
    const int head = n >> 7, within = n & 127;
    if (within < 64) {
#pragma unroll
      for (int r = 0; r < 16; ++r) Kn[((size_t)(kr0 + crow(r, h)) * 8 + head) * 64 + within] = f2bf(a[r]);
    } else {
      int seq, key0;
      if (kr0 < NCTX) { seq = kr0 >> 8; key0 = kr0 & 255; } else { const int r = kr0 - NCTX; seq = 16 + r / 2560; key0 = r % 2560; }
      const size_t cap = cap_of(seq);
      u16* base = Vt + (size_t)krow0_of(seq) * 512 + (size_t)(head * 64 + within - 64) * cap;
#pragma unroll
      for (int g = 0; g < 4; ++g) {
        const int pos = key0 + 16 * (g >> 1) + 8 * h + 4 * (g & 1);
        u32x2 w = {pack2(a[4 * g], a[4 * g + 1]), pack2(a[4 * g + 2], a[4 * g + 3])};
        *(u32x2*)(base + pos) = w;
      }
    }
  }
};
struct EpiOut {
  const Params* p; int layer;
  DI void operator()(const f32x16& a, int row0, int col, int h) const {
    const float* mod = (const float*)(p->ws + WS_MOD) + (size_t)(layer * 9 + modidx_of_tok(row0)) * 3072 + 2048;
    const float gate = mod[col];
#pragma unroll
    for (int r = 0; r < 16; ++r) {
      const int m = row0 + crow(r, h);
      const float xv = layer ? p->out[(size_t)m * DM + col] : xrow(*p, m)[col];
      p->out[(size_t)m * DM + col] = xv + gate * a[r];
    }
  }
};
struct EpiU1 {
  u16* UA; u16* UB; float* AB;
  DI void operator()(const f32x16& a, int row0, int col, int h) const {
    if (col < 1536) {
#pragma unroll
      for (int r = 0; r < 16; ++r) UA[(size_t)(row0 + crow(r, h)) * U1A_LD + col] = f2bf(a[r]);
    } else if (col < 3584) {
#pragma unroll
      for (int r = 0; r < 16; ++r) UB[(size_t)(row0 + crow(r, h)) * U1B_LD + col - 1536] = f2bf(a[r]);
    } else if (col < 3600) {
#pragma unroll
      for (int r = 0; r < 16; ++r) AB[(size_t)(row0 + crow(r, h)) * 16 + col - 3584] = a[r];
    }
  }
};

DI void phase_inproj0(const Params& p, char* lds) {
  EpiU0 epi{(u16*)(p.ws + WS_U)};
  const u16* H = (const u16*)(p.ws + WS_H);
  const GemmA A{H, DM, H, DM, 1 << 30};
  for (int it = blockIdx.x; it < 80 * 20; it += gridDim.x) {
    const int mt = it / 20, nt = it % 20;
    gemm_tile(A, (const u16*)(p.ws + WS_WT0), DM, DM, mt * 256, nt * 128, lds, epi);
  }
}
DI void phase_l0gemms(const Params& p, char* lds) {
  const u16* U0 = (const u16*)(p.ws + WS_U);
  EpiKvexp ek{(u16*)((char*)p.out + YS_KN), (u16*)((char*)p.out + YS_VTMLA)};
  EpiQmla eq{(u16*)((char*)p.out + YS_QMLA), (const float2*)(p.ws + WS_ROPE)};
  const u16* ck = (const u16*)(p.ws + WS_CKVN);
  const u16* wq = (const u16*)(p.ws + WS_WUQ);
  const GemmA Ak{ck, 256, ck, 256, 1 << 30};
  const GemmA Aq{wq, 384, wq, 384, 1 << 30};
  for (int it = blockIdx.x; it < 768 + 480; it += gridDim.x) {
    if (it < 768) { const int mt = it >> 3, nt = it & 7; gemm_tile(Ak, (const u16*)(p.ws + WS_WUKV), 256, 256, mt * 256, nt * 128, lds, ek); }
    else { const int t = it - 768; const int mt = t % 3, nt = t / 3; gemm_tile(Aq, U0 + C0_CQ, L0C, 384, mt * 256, nt * 128, lds, eq); }
  }
}
DI void phase_outproj(const Params& p, int layer, char* lds) {
  EpiOut epi{&p, layer};
  const u16* H = (const u16*)(p.ws + WS_H);
  GemmA A;
  if (layer == 0) A = GemmA{H, DM, H, DM, 1 << 30};
  else A = GemmA{H, DM, (const u16*)(p.ws + WS_U1B) + C1_QD, U1B_LD, 512};
  const u16* W = (const u16*)(p.ws + (layer ? WS_WO1 : WS_WO0));
  for (int it = blockIdx.x; it < 80 * 8; it += gridDim.x) {
    const int mt = it >> 3, nt = it & 7;
    gemm_tile(A, W, DM, DM, mt * 256, nt * 128, lds, epi);
  }
}
DI void phase_inproj1(const Params& p, char* lds) {
  EpiU1 epi{(u16*)(p.ws + WS_U1A), (u16*)(p.ws + WS_U1B), (float*)(p.ws + WS_AB)};
  const u16* H = (const u16*)(p.ws + WS_H);
  const GemmA A{H, DM, H, DM, 1 << 30};
  for (int it = blockIdx.x; it < 80 * 29; it += gridDim.x) {
    const int mt = it / 29, nt = it % 29;
    gemm_tile(A, (const u16*)(p.ws + WS_WT1), DM, DM, mt * 256, nt * 128, lds, epi);
  }
}

DI void rope8(float (&x)[8], const float (&xp)[8], const float2* tab, int q, int pp, int fi0, bool is_x2) {
#pragma unroll
  for (int e = 0; e < 8; ++e) {
    const float2 cs = tab[pp * q + fi0 + e];
    x[e] = is_x2 ? (x[e] * cs.x + xp[e] * cs.y) : (x[e] * cs.x - xp[e] * cs.y);
  }
}
DI void unpack8(const u32x4 w, float (&x)[8]) {
#pragma unroll
  for (int i = 0; i < 4; ++i) { x[2 * i] = bf2f((u16)(w[i] & 0xffffu)); x[2 * i + 1] = bf2f((u16)(w[i] >> 16)); }
}
DI u32x4 pack8f(const float (&x)[8]) { u32x4 w = {pack2(x[0], x[1]), pack2(x[2], x[3]), pack2(x[4], x[5]), pack2(x[6], x[7])}; return w; }
DI void shfl8(const float (&x)[8], float (&xp)[8], int mask) {
#pragma unroll
  for (int e = 0; e < 8; ++e) xp[e] = __shfl_xor(x[e], mask);
}

DI void phase_l0prep(const Params& p, char* lds) {
  const int tid = threadIdx.x, lane = tid & 63, wid = tid >> 6;
  u16* U0 = (u16*)(p.ws + WS_U);
  u16* sv = (u16*)lds;
  const float2* tabM = (const float2*)(p.ws + WS_ROPE);
  const float2* tabS = tabM + 512;
  u16* CKVN = (u16*)(p.ws + WS_CKVN); u16* KROPE = (u16*)(p.ws + WS_KROPE); u16* KSWA = (u16*)(p.ws + WS_KSWA);
  for (int it = blockIdx.x; it < NTOK / 16; it += gridDim.x) {
    const int m0 = it * 16;
    for (int tt = 0; tt < 2; ++tt) {
      const int ml = wid * 2 + tt, m = m0 + ml;
      u16* row = U0 + (size_t)m * L0C;
      const bool ctx = m < NCTX;
      const int pos = pos_of_tok(m), prow = pos >> 6, pcol = pos & 63, krow = krow_of_tok(m);
      {
        float lo[3], hi[3], ss = 0.f;
#pragma unroll
        for (int j = 0; j < 3; ++j) { const unsigned w = *(const unsigned*)(row + C0_CQ + 128 * j + 2 * lane); lo[j] = bf2f((u16)(w & 0xffffu)); hi[j] = bf2f((u16)(w >> 16)); ss += lo[j] * lo[j] + hi[j] * hi[j]; }
        ss = wave_sum(ss);
        const float rs = rsqrtf(ss * (1.f / 384.f) + EPS);
#pragma unroll
        for (int j = 0; j < 3; ++j) { const int c = 128 * j + 2 * lane; *(unsigned*)(row + C0_CQ + c) = pack2(lo[j] * rs * p.mla_q_norm[c], hi[j] * rs * p.mla_q_norm[c + 1]); }
      }
      {
        const u32x2 w = *(const u32x2*)(row + C0_CKV + 4 * lane);
        float x[4] = {bf2f((u16)(w[0] & 0xffffu)), bf2f((u16)(w[0] >> 16)), bf2f((u16)(w[1] & 0xffffu)), bf2f((u16)(w[1] >> 16))};
        float ss = x[0] * x[0] + x[1] * x[1] + x[2] * x[2] + x[3] * x[3];
        ss = wave_sum(ss);
        const float rs = rsqrtf(ss * (1.f / 256.f) + EPS);
        const float4 g = *(const float4*)(p.mla_kv_norm + 4 * lane);
        x[0] *= rs * g.x; x[1] *= rs * g.y; x[2] *= rs * g.z; x[3] *= rs * g.w;
        u32x2 o = {pack2(x[0], x[1]), pack2(x[2], x[3])};
        *(u32x2*)(CKVN + (size_t)krow * 256 + 4 * lane) = o;
        if (ctx) *(float4*)(p.out + O_CKV + (size_t)m * 256 + 4 * lane) = make_float4(x[0], x[1], x[2], x[3]);
      }
      {
        const float x = bf2f(row[C0_KR + (lane & 31)]);
        const float xp = __shfl_xor(x, 8);
        float val = x;
        if (!ctx) {
          const int half = (lane >> 4) & 1, within = lane & 15, fi = lane & 7;
          const float2 cs = tabM[(half ? pcol : prow) * 8 + fi];
          val = within < 8 ? (x * cs.x - xp * cs.y) : (x * cs.x + xp * cs.y);
        }
        if (lane < 32) {
          KROPE[(size_t)krow * 32 + lane] = f2bf(val);
          if (ctx) p.out[O_KROPE + (size_t)m * 32 + lane] = x;
        }
      }
      if (!ctx) {
        float x[8], xp[8];
        unpack8(*(const u32x4*)(row + C0_QB + lane * 8), x);
        shfl8(x, xp, 2);
        const int b16 = (lane & 7) >> 1;
        rope8(x, xp, tabS, 16, (b16 >= 2) ? pcol : prow, (lane & 1) * 8, (b16 & 1) != 0);
        *(u32x4*)(row + C0_QB + lane * 8) = pack8f(x);
      }
      {
        float x[8], xp[8];
        unpack8(*(const u32x4*)(row + C0_KB + (lane & 15) * 8), x);
        if (ctx && lane < 16) {
          *(float4*)(p.out + O_SWAK + (size_t)m * 128 + lane * 8) = make_float4(x[0], x[1], x[2], x[3]);
          *(float4*)(p.out + O_SWAK + (size_t)m * 128 + lane * 8 + 4) = make_float4(x[4], x[5], x[6], x[7]);
        }
        shfl8(x, xp, 2);
        if (!ctx) {
          const int b16 = (lane & 7) >> 1;
          rope8(x, xp, tabS, 16, (b16 >= 2) ? pcol : prow, (lane & 1) * 8, (b16 & 1) != 0);
        }
        if (lane < 16) *(u32x4*)(KSWA + (size_t)krow * 128 + lane * 8) = pack8f(x);
        if (lane < 16) {
          const u32x4 vw = *(const u32x4*)(row + C0_VB + lane * 8);
          *(u32x4*)(sv + ml * 136 + lane * 8) = vw;
          if (ctx) {
            float v[8]; unpack8(vw, v);
            *(float4*)(p.out + O_SWAV + (size_t)m * 128 + lane * 8) = make_float4(v[0], v[1], v[2], v[3]);
            *(float4*)(p.out + O_SWAV + (size_t)m * 128 + lane * 8 + 4) = make_float4(v[4], v[5], v[6], v[7]);
          }
        }
      }
    }
    __syncthreads();
    {
      const int s = seq_of_tok(m0);
      vt_store16(sv, 136, 128, (u16*)(p.ws + WS_VTSWA) + (size_t)krow0_of(s) * 128, cap_of(s), pos_of_tok(m0));
    }
    __syncthreads();
  }
}

template <int KIND>
DI void attn_item(const Params& p, int s, int hsel, int q0, char* lds) {
  constexpr int DQK = KIND == 0 ? 96 : (KIND == 1 ? 64 : 128);
  constexpr int DV = KIND == 2 ? 128 : 64;
  constexpr int KS = DQK + 8, VS = 72;
  constexpr int CPR = DQK / 8;
  constexpr int KCH = 64 * CPR, NKC = (KCH + 511) / 512;
  constexpr int VCH = DV * 8, NVC = VCH / 512;
  constexpr float SCALE = KIND == 0 ? 0.10206207261596577f : (KIND == 1 ? 0.125f : 0.08838834764831845f);
  constexpr float C = SCALE * LOG2E;
  const int tid = threadIdx.x, lane = tid & 63, wid = tid >> 6, r32 = lane & 31, h = lane >> 5;
  u16* sK = (u16*)lds; u16* sV = sK + 64 * KS;
  const int tok0 = tok0_of(s), kr0 = krow0_of(s), cap = cap_of(s), len = len_of(s);
  const bool smp = s >= 16;
  int hq, hkv, qrow0;
  if (KIND == 0) { hq = hsel; hkv = hsel; qrow0 = q0 + 32 * wid; }
  else if (KIND == 1) { hkv = hsel >> 1; hq = hkv * 4 + (hsel & 1) * 2 + (wid >> 2); qrow0 = q0 + 32 * (wid & 3); }
  else { hkv = hsel; hq = hkv * 2 + (wid >> 2); qrow0 = q0 + 32 * (wid & 3); }
  const int tok = tok0 + qrow0 + r32;
  const u16* U0 = (const u16*)(p.ws + WS_U);
  u16* U1B = (u16*)(p.ws + WS_U1B);
  const u16* qp;
  if (KIND == 0) qp = (const u16*)((const char*)p.out + YS_QMLA) + (size_t)tok * 768 + hq * 96 + h * 8;
  else if (KIND == 1) qp = U0 + (size_t)tok * L0C + C0_QB + hq * 64 + h * 8;
  else qp = U1B + (size_t)tok * U1B_LD + C1_QD + hq * 128 + h * 8;
  bf16x8 qf[DQK / 16];
#pragma unroll
  for (int d0 = 0; d0 < DQK / 16; ++d0) qf[d0] = *(const bf16x8*)(qp + d0 * 16);
  int nwin = 0, wlo = 0, nt = cap >> 6;
  if (KIND == 1 && smp) { wlo = q0 - 128 < 0 ? 0 : q0 - 128; const int whi = q0 + 256 > 2048 ? 2048 : q0 + 256; nwin = (whi - wlo) >> 6; nt = nwin + 8; }
  const u16* Kn = (const u16*)((const char*)p.out + YS_KN);
  const u16* KR = (const u16*)(p.ws + WS_KROPE);
  const u16* KSW = (const u16*)(p.ws + WS_KSWA);
  const u16* KCc = (const u16*)(p.ws + WS_KC);
  const u16* VT;
  if (KIND == 0) VT = (const u16*)((const char*)p.out + YS_VTMLA) + (size_t)kr0 * 512;
  else if (KIND == 1) VT = (const u16*)(p.ws + WS_VTSWA) + (size_t)kr0 * 128;
  else VT = (const u16*)(p.ws + WS_VTATT) + (size_t)kr0 * 256;
  bf16x8 rk[NKC], rv[NVC];
  int kkey[NKC], kd[NKC];
#pragma unroll
  for (int i = 0; i < NKC; ++i) { const int c = tid + 512 * i; kkey[i] = c / CPR; kd[i] = (c % CPR) * 8; }
  auto kt0_of = [&](int t) -> int { return (KIND == 1 && smp) ? (t < nwin ? wlo + 64 * t : 2048 + 64 * (t - nwin)) : 64 * t; };
  auto gload = [&](int t) {
    const int kt0 = kt0_of(t);
#pragma unroll
    for (int i = 0; i < NKC; ++i) {
      if (tid + 512 * i < KCH) {
        const int g = kt0 + kkey[i], d = kd[i];
        const u16* src;
        if (KIND == 0) src = d < 64 ? Kn + ((size_t)(kr0 + g) * 8 + hkv) * 64 + d : KR + (size_t)(kr0 + g) * 32 + (d - 64);
        else if (KIND == 1) src = KSW + ((size_t)(kr0 + g) * 2 + hkv) * 64 + d;
        else src = g < len ? U1B + (size_t)(tok0 + g) * U1B_LD + C1_KD + hkv * 128 + d : KCc + ((size_t)((s - 16) * 512 + g - 2048) * 2 + hkv) * 128 + d;
        rk[i] = *(const bf16x8*)src;
      }
    }
#pragma unroll
    for (int i = 0; i < NVC; ++i) {
      const int c = tid + 512 * i, dv = c >> 3, kc = c & 7;
      rv[i] = *(const bf16x8*)(VT + (size_t)(hkv * DV + dv) * cap + kt0 + kc * 8);
    }
  };
  auto swrite = [&]() {
#pragma unroll
    for (int i = 0; i < NKC; ++i) if (tid + 512 * i < KCH) *(bf16x8*)(sK + kkey[i] * KS + kd[i]) = rk[i];
#pragma unroll
    for (int i = 0; i < NVC; ++i) { const int c = tid + 512 * i; *(bf16x8*)(sV + (c >> 3) * VS + (c & 7) * 8) = rv[i]; }
  };
  f32x16 o[DV / 32];
#pragma unroll
  for (int db = 0; db < DV / 32; ++db)
#pragma unroll
    for (int r = 0; r < 16; ++r) o[db][r] = 0.f;
  float m = -1e30f, l = 0.f;
  gload(0);
  for (int t = 0; t < nt; ++t) {
    __syncthreads();
    swrite();
    __syncthreads();
    if (t + 1 < nt) gload(t + 1);
    f32x16 s0, s1;
#pragma unroll
    for (int r = 0; r < 16; ++r) { s0[r] = 0.f; s1[r] = 0.f; }
#pragma unroll
    for (int d0 = 0; d0 < DQK / 16; ++d0) {
      const bf16x8 k0 = *(const bf16x8*)(sK + r32 * KS + d0 * 16 + h * 8);
      const bf16x8 k1 = *(const bf16x8*)(sK + (32 + r32) * KS + d0 * 16 + h * 8);
      s0 = MFMA(k0, qf[d0], s0); s1 = MFMA(k1, qf[d0], s1);
    }
    if (KIND == 1 && smp && t < nwin) {
      const int kt0 = kt0_of(t), qi = qrow0 + r32;
#pragma unroll
      for (int r = 0; r < 16; ++r) {
        const int d0 = qi - (kt0 + crow(r, h)), d1 = d0 - 32;
        s0[r] = (d0 <= 128 && d0 >= -128) ? s0[r] : -INFINITY;
        s1[r] = (d1 <= 128 && d1 >= -128) ? s1[r] : -INFINITY;
      }
    }
    float mx = s0[0];
#pragma unroll
    for (int r = 1; r < 16; ++r) mx = fmaxf(mx, s0[r]);
#pragma unroll
    for (int r = 0; r < 16; ++r) mx = fmaxf(mx, s1[r]);
    mx = fmaxf(mx, __shfl_xor(mx, 32));
    const float mnew = fmaxf(m, mx * C);
    const float alpha = __builtin_amdgcn_exp2f(m - mnew);
    m = mnew;
    float ps = 0.f;
#pragma unroll
    for (int r = 0; r < 16; ++r) { s0[r] = __builtin_amdgcn_exp2f(s0[r] * C - mnew); ps += s0[r]; }
#pragma unroll
    for (int r = 0; r < 16; ++r) { s1[r] = __builtin_amdgcn_exp2f(s1[r] * C - mnew); ps += s1[r]; }
    l = l * alpha + ps;
#pragma unroll
    for (int db = 0; db < DV / 32; ++db)
#pragma unroll
      for (int r = 0; r < 16; ++r) o[db][r] *= alpha;
    const bf16x8 pf0 = pack8(s0, 0), pf1 = pack8(s0, 1), pf2 = pack8(s1, 0), pf3 = pack8(s1, 1);
#pragma unroll
    for (int db = 0; db < DV / 32; ++db) {
      const u16* vb = sV + (db * 32 + r32) * VS + h * 8;
      o[db] = MFMA(*(const bf16x8*)(vb), pf0, o[db]);
      o[db] = MFMA(*(const bf16x8*)(vb + 16), pf1, o[db]);
      o[db] = MFMA(*(const bf16x8*)(vb + 32), pf2, o[db]);
      o[db] = MFMA(*(const bf16x8*)(vb + 48), pf3, o[db]);
    }
  }
  float lt = l + __shfl_xor(l, 32);
  if (KIND == 1) lt += __builtin_amdgcn_exp2f(p.swa_sink[hq] * LOG2E - m);
  const float inv = 1.f / lt;
  const u16* zp; u16* op;
  if (KIND == 0) { zp = U0 + (size_t)tok * L0C + C0_ZA + hq * 64; op = (u16*)(p.ws + WS_H) + (size_t)tok * DM + hq * 64; }
  else if (KIND == 1) { zp = U0 + (size_t)tok * L0C + C0_ZB + hq * 64; op = (u16*)(p.ws + WS_H) + (size_t)tok * DM + 512 + hq * 64; }
  else { zp = U1B + (size_t)tok * U1B_LD + C1_ZD + hq * 128; op = U1B + (size_t)tok * U1B_LD + C1_QD + hq * 128; }
#pragma unroll
  for (int db = 0; db < DV / 32; ++db)
#pragma unroll
    for (int g = 0; g < 4; ++g) {
      const int dv = db * 32 + 8 * g + 4 * h;
      const u32x2 zw = *(const u32x2*)(zp + dv);
      const float z0 = bf2f((u16)(zw[0] & 0xffffu)), z1 = bf2f((u16)(zw[0] >> 16)), z2 = bf2f((u16)(zw[1] & 0xffffu)), z3 = bf2f((u16)(zw[1] >> 16));
      u32x2 w = {pack2(o[db][4 * g] * inv * siluf(z0), o[db][4 * g + 1] * inv * siluf(z1)), pack2(o[db][4 * g + 2] * inv * siluf(z2), o[db][4 * g + 3] * inv * siluf(z3))};
      *(u32x2*)(op + dv) = w;
    }
  __syncthreads();
}

DI void phase_attn0(const Params& p, char* lds) {
  for (int it = blockIdx.x; it < 1280; it += gridDim.x) {
    if (it < 512) { const int s = 16 + (it >> 6), rem = it & 63; attn_item<0>(p, s, rem >> 3, (rem & 7) * 256, lds); }
    else if (it < 1024) { const int j = it - 512; const int s = 16 + (j >> 6), rem = j & 63; attn_item<1>(p, s, rem >> 4, (rem & 15) * 128, lds); }
    else if (it < 1152) { const int j = it - 1024; attn_item<0>(p, j >> 3, j & 7, 0, lds); }
    else { const int j = it - 1152; const int s = j >> 3, rem = j & 7; attn_item<1>(p, s, rem >> 1, (rem & 1) * 128, lds); }
  }
}
DI void phase_attn1(const Params& p, char* lds) {
  for (int it = blockIdx.x; it < 320; it += gridDim.x) {
    if (it < 256) { const int s = 16 + (it >> 5), rem = it & 31; attn_item<2>(p, s, rem >> 4, (rem & 15) * 128, lds); }
    else { const int j = it - 256; const int s = j >> 2, rem = j & 3; attn_item<2>(p, s, rem >> 1, (rem & 1) * 128, lds); }
  }
}

DI float group16_sum(float v) {
#pragma unroll
  for (int o = 8; o > 0; o >>= 1) v += __shfl_xor(v, o);
  return v;
}
DI void phase_l1prep(const Params& p, char* lds) {
  const int tid = threadIdx.x, lane = tid & 63, wid = tid >> 6;
  const u16* UA = (const u16*)(p.ws + WS_U1A);
  u16* UB = (u16*)(p.ws + WS_U1B);
  u16* QK = (u16*)(p.ws + WS_H);
  u16* VC = (u16*)(p.ws + WS_VC);
  float* GB = (float*)(p.ws + WS_GB);
  const float* AB = (const float*)(p.ws + WS_AB);
  const float2* tabA = (const float2*)(p.ws + WS_ROPE) + 1536;
  u16* sv = (u16*)lds;
  constexpr int N_TOK_ITEMS = NTOK / 16;
  constexpr int N_KC_ITEMS = 256;
  constexpr int N_VC_ITEMS = 256;
  for (int it = blockIdx.x; it < N_TOK_ITEMS + N_KC_ITEMS + N_VC_ITEMS; it += gridDim.x) {
    if (it >= N_TOK_ITEMS + N_KC_ITEMS) {
      const int t = it - N_TOK_ITEMS - N_KC_ITEMS; const int b = t >> 5, g = t & 31;
      {
        const int key = tid >> 5, c8 = (tid & 31) * 8;
        const float* src = p.c_attv + ((size_t)(b * 512 + g * 16 + key)) * 256 + c8;
        const float4 a = *(const float4*)src, b4 = *(const float4*)(src + 4);
        u32x4 w = {pack2(a.x, a.y), pack2(a.z, a.w), pack2(b4.x, b4.y), pack2(b4.z, b4.w)};
        *(u32x4*)(sv + key * 264 + c8) = w;
      }
      __syncthreads();
      vt_store16(sv, 264, 256, (u16*)(p.ws + WS_VTATT) + (size_t)krow0_of(16 + b) * 256, 2560, 2048 + g * 16);
      __syncthreads();
      continue;
    }
    if (it >= N_TOK_ITEMS) {
      const size_t i = (size_t)(it - N_TOK_ITEMS) * 4096 + tid * 8;
      const float4 a = *(const float4*)(p.c_attk + i), b4 = *(const float4*)(p.c_attk + i + 4);
      u32x4 w = {pack2(a.x, a.y), pack2(a.z, a.w), pack2(b4.x, b4.y), pack2(b4.z, b4.w)};
      *(u32x4*)((u16*)(p.ws + WS_KC) + i) = w;
      continue;
    }
    const int m0 = it * 16;
    for (int tt = 0; tt < 2; ++tt) {
      const int ml = wid * 2 + tt, m = m0 + ml;
      const bool ctx = m < NCTX;
      const int pos = pos_of_tok(m), prow = pos >> 6, pcol = pos & 63, len = ctx ? 256 : 2048;
      {
        const u16* r1 = UA + (size_t)m * U1A_LD;
#pragma unroll
        for (int j = 0; j < 3; ++j) {
          const int ch = j * 512 + lane * 8;
          float x0[8], x1[8], x2[8], y[8];
          unpack8(*(const u32x4*)(r1 + ch), x1);
          if (pos > 0) unpack8(*(const u32x4*)(r1 - U1A_LD + ch), x0); else {
#pragma unroll
            for (int e = 0; e < 8; ++e) x0[e] = 0.f; }
          if (pos < len - 1) unpack8(*(const u32x4*)(r1 + U1A_LD + ch), x2); else {
#pragma unroll
            for (int e = 0; e < 8; ++e) x2[e] = 0.f; }
          float ss = 0.f;
#pragma unroll
          for (int e = 0; e < 8; ++e) {
            const float a = p.gdn_conv[ch + e] * x0[e] + p.gdn_conv[1536 + ch + e] * x1[e] + p.gdn_conv[3072 + ch + e] * x2[e];
            y[e] = siluf(a); ss += y[e] * y[e];
          }
          if (j < 2) {
            ss = group16_sum(ss);
            const float rs = rsqrtf(ss + EPS) * (j == 0 ? 0.08838834764831845f : 1.f);
#pragma unroll
            for (int e = 0; e < 8; ++e) y[e] *= rs;
            *(u32x4*)(QK + (size_t)m * DM + j * 512 + lane * 8) = pack8f(y);
          } else {
            *(u32x4*)(VC + (size_t)m * 512 + lane * 8) = pack8f(y);
          }
        }
      }
      if (lane < 16) {
        const float a = AB[(size_t)m * 16 + lane];
        float r;
        if (lane < 8) { const float x = a + p.gdn_dt_bias[lane]; const float sp = x > 20.f ? x : log1pf(expf(x)); r = -expf(p.gdn_a_log[lane]) * sp; }
        else r = 1.f / (1.f + expf(-a));
        GB[(size_t)m * 16 + lane] = r;
      }
      {
        u16* qp = UB + (size_t)m * U1B_LD + C1_QD + lane * 8;
        float x[8], xp[8];
        unpack8(*(const u32x4*)qp, x);
        float ss = 0.f;
#pragma unroll
        for (int e = 0; e < 8; ++e) ss += x[e] * x[e];
        ss = group16_sum(ss);
        const float rs = rsqrtf(ss * (1.f / 128.f) + EPS);
        const int li = lane & 15;
#pragma unroll
        for (int e = 0; e < 8; ++e) x[e] *= rs * p.att_q_norm[li * 8 + e];
        shfl8(x, xp, 4);
        if (!ctx) { const int b32 = li >> 2; rope8(x, xp, tabA, 32, (b32 >= 2) ? pcol : prow, (li & 3) * 8, (b32 & 1) != 0); }
        *(u32x4*)qp = pack8f(x);
      }
      {
        u16* kp = UB + (size_t)m * U1B_LD + C1_KD + (lane & 31) * 8;
        float x[8], xp[8];
        unpack8(*(const u32x4*)kp, x);
        float ss = 0.f;
#pragma unroll
        for (int e = 0; e < 8; ++e) ss += x[e] * x[e];
        ss = group16_sum(ss);
        const float rs = rsqrtf(ss * (1.f / 128.f) + EPS);
        const int li = lane & 15;
#pragma unroll
        for (int e = 0; e < 8; ++e) x[e] *= rs * p.att_k_norm[li * 8 + e];
        if (ctx && lane < 32) {
          *(float4*)(p.out + O_ATTK + (size_t)m * 256 + lane * 8) = make_float4(x[0], x[1], x[2], x[3]);
          *(float4*)(p.out + O_ATTK + (size_t)m * 256 + lane * 8 + 4) = make_float4(x[4], x[5], x[6], x[7]);
        }
        shfl8(x, xp, 4);
        if (!ctx) { const int b32 = li >> 2; rope8(x, xp, tabA, 32, (b32 >= 2) ? pcol : prow, (li & 3) * 8, (b32 & 1) != 0); }
        if (lane < 32) {
          *(u32x4*)kp = pack8f(x);
          const u32x4 vw = *(const u32x4*)(UB + (size_t)m * U1B_LD + C1_VD + lane * 8);
          *(u32x4*)(sv + ml * 264 + lane * 8) = vw;
          if (ctx) {
            float v[8]; unpack8(vw, v);
            *(float4*)(p.out + O_ATTV + (size_t)m * 256 + lane * 8) = make_float4(v[0], v[1], v[2], v[3]);
            *(float4*)(p.out + O_ATTV + (size_t)m * 256 + lane * 8 + 4) = make_float4(v[4], v[5], v[6], v[7]);
          }
        }
      }
    }
    __syncthreads();
    {
      const int s = seq_of_tok(m0);
      vt_store16(sv, 264, 256, (u16*)(p.ws + WS_VTATT) + (size_t)krow0_of(s) * 256, cap_of(s), pos_of_tok(m0));
    }
    __syncthreads();
  }
}

DI void phase_gdnfinal(const Params& p) {
  const int lane = threadIdx.x & 63, wid = threadIdx.x >> 6;
  const u16* OF = (const u16*)(p.ws + WS_OF); const u16* OBk = (const u16*)(p.ws + WS_OB);
  const u16* UB = (const u16*)(p.ws + WS_U1B);
  u16* H = (u16*)(p.ws + WS_H);
  for (int m = blockIdx.x * 8 + wid; m < NTOK; m += gridDim.x * 8) {
    float a[8], b[8], z[8];
    unpack8(*(const u32x4*)(OF + (size_t)m * 512 + lane * 8), a);
    unpack8(*(const u32x4*)(OBk + (size_t)m * 512 + lane * 8), b);
    unpack8(*(const u32x4*)(UB + (size_t)m * U1B_LD + C1_ZC + lane * 8), z);
    float ss = 0.f;
#pragma unroll
    for (int e = 0; e < 8; ++e) { a[e] += b[e]; ss += a[e] * a[e]; }
    ss = group16_sum(ss);
    const float rs = rsqrtf(ss * (1.f / 128.f) + EPS);
    const int li = lane & 15;
#pragma unroll
    for (int e = 0; e < 8; ++e) a[e] = a[e] * rs * p.gdn_norm[li * 8 + e] * siluf(z[e]);
    *(u32x4*)(H + (size_t)m * DM + lane * 8) = pack8f(a);
  }
}

DI void phase_final(const Params& p) {
  const int lane = threadIdx.x & 63, wid = threadIdx.x >> 6;
  for (int m = blockIdx.x * 8 + wid; m < NTOK; m += gridDim.x * 8) {
    float* x = p.out + (size_t)m * DM;
    float4 v[4]; float ss = 0.f;
#pragma unroll
    for (int j = 0; j < 4; ++j) { v[j] = *(const float4*)(x + (j * 64 + lane) * 4); ss += v[j].x * v[j].x + v[j].y * v[j].y + v[j].z * v[j].z + v[j].w * v[j].w; }
    ss = wave_sum(ss);
    const float rs = rsqrtf(ss * (1.f / 1024.f) + EPS);
#pragma unroll
    for (int j = 0; j < 4; ++j) {
      const int c = (j * 64 + lane) * 4;
      const float4 g = *(const float4*)(p.ln_f + c);
      *(float4*)(x + c) = make_float4(v[j].x * rs * g.x, v[j].y * rs * g.y, v[j].z * rs * g.z, v[j].w * rs * g.w);
    }
  }
}

template <class F>
DI void ngemm(const GemmA A, const u16* __restrict__ Wt, int ldw, int K, int M, int N, char* lds, F f) {
  u16* sA = (u16*)lds;
  const int tid = threadIdx.x;
  const int ncol = (N + 511) / 512;
  for (int it = blockIdx.x; it < (M / 8) * ncol; it += gridDim.x) {
    const int m0 = (it / ncol) * 8, n = (it % ncol) * 512 + tid;
    __syncthreads();
    for (int i = tid; i < 8 * (K / 8); i += NTHREADS) {
      const int r = i / (K / 8), k8 = (i % (K / 8)) * 8;
      const u16* src = k8 < A.ksplit ? A.p0 + (size_t)(m0 + r) * A.ld0 + k8 : A.p1 + (size_t)(m0 + r) * A.ld1 + (k8 - A.ksplit);
      *(u32x4*)(sA + r * K + k8) = *(const u32x4*)src;
    }
    __syncthreads();
    if (n < N) {
      float acc[8];
#pragma unroll
      for (int r = 0; r < 8; ++r) acc[r] = 0.f;
      for (int k8 = 0; k8 < K; k8 += 8) {
        float w[8]; unpack8(*(const u32x4*)(Wt + (size_t)n * ldw + k8), w);
#pragma unroll
        for (int r = 0; r < 8; ++r) {
          float a[8]; unpack8(*(const u32x4*)(sA + r * K + k8), a);
#pragma unroll
          for (int e = 0; e < 8; ++e) acc[r] += a[e] * w[e];
        }
      }
#pragma unroll
      for (int r = 0; r < 8; ++r) f(m0 + r, n, acc[r]);
    }
  }
}
DI void nphase_inproj0(const Params& p, char* lds) {
  u16* U = (u16*)(p.ws + WS_U); const u16* H = (const u16*)(p.ws + WS_H);
  ngemm(GemmA{H, DM, H, DM, 1 << 30}, (const u16*)(p.ws + WS_WT0), DM, DM, NTOK, L0C, lds, [=](int m, int n, float v) { U[(size_t)m * L0C + n] = f2bf(v); });
}
DI void nphase_l0gemms(const Params& p, char* lds) {
  const u16* U0 = (const u16*)(p.ws + WS_U); const u16* ck = (const u16*)(p.ws + WS_CKVN);
  u16* Kn = (u16*)((char*)p.out + YS_KN); u16* Vt = (u16*)((char*)p.out + YS_VTMLA); u16* Q = (u16*)((char*)p.out + YS_QMLA);
  ngemm(GemmA{ck, 256, ck, 256, 1 << 30}, (const u16*)(p.ws + WS_WUKV), 256, 256, NKROW, 1024, lds, [=](int kr, int n, float v) {
    const int head = n >> 7, within = n & 127;
    if (within < 64) Kn[((size_t)kr * 8 + head) * 64 + within] = f2bf(v);
    else {
      int seq, key;
      if (kr < NCTX) { seq = kr >> 8; key = kr & 255; } else { const int r = kr - NCTX; seq = 16 + r / 2560; key = r % 2560; }
      Vt[(size_t)krow0_of(seq) * 512 + (size_t)(head * 64 + within - 64) * cap_of(seq) + (key & ~15) + swz16(key & 15)] = f2bf(v);
    }
  });
  ngemm(GemmA{U0 + C0_CQ, L0C, U0 + C0_CQ, L0C, 1 << 30}, (const u16*)(p.ws + WS_WUQ), 384, 384, NTOK, 768, lds, [=](int m, int n, float v) { Q[(size_t)m * 768 + n] = f2bf(v); });
}
DI void nphase_qmla_rope(const Params& p) {
  u16* Q = (u16*)((char*)p.out + YS_QMLA);
  const float2* tab = (const float2*)(p.ws + WS_ROPE);
  for (size_t i = (size_t)blockIdx.x * NTHREADS + threadIdx.x; i < (size_t)(NTOK - NCTX) * 8 * 16; i += (size_t)gridDim.x * NTHREADS) {
    const int m = NCTX + (int)(i >> 7), head = (int)(i >> 4) & 7, j = (int)i & 15;
    const int pos = pos_of_tok(m), pp = (j >> 3) ? (pos & 63) : (pos >> 6);
    u16* q = Q + (size_t)m * 768 + head * 96 + 64 + (j >> 3) * 16 + (j & 7);
    const float x1 = bf2f(q[0]), x2 = bf2f(q[8]);
    const float2 cs = tab[pp * 8 + (j & 7)];
    q[0] = f2bf(x1 * cs.x - x2 * cs.y); q[8] = f2bf(x2 * cs.x + x1 * cs.y);
  }
}
DI void nphase_outproj(const Params& p, int layer, char* lds) {
  const u16* H = (const u16*)(p.ws + WS_H);
  GemmA A = layer == 0 ? GemmA{H, DM, H, DM, 1 << 30} : GemmA{H, DM, (const u16*)(p.ws + WS_U1B) + C1_QD, U1B_LD, 512};
  const float* mod = (const float*)(p.ws + WS_MOD) + (size_t)layer * 9 * 3072 + 2048;
  const Params* pp = &p;
  ngemm(A, (const u16*)(p.ws + (layer ? WS_WO1 : WS_WO0)), DM, DM, NTOK, DM, lds, [=](int m, int n, float v) {
    const float gate = mod[(size_t)modidx_of_tok(m) * 3072 + n];
    const float xv = layer ? pp->out[(size_t)m * DM + n] : xrow(*pp, m)[n];
    pp->out[(size_t)m * DM + n] = xv + gate * v;
  });
}
DI void nphase_inproj1(const Params& p, char* lds) {
  u16* UA = (u16*)(p.ws + WS_U1A); u16* UB = (u16*)(p.ws + WS_U1B); float* AB = (float*)(p.ws + WS_AB);
  const u16* H = (const u16*)(p.ws + WS_H);
  ngemm(GemmA{H, DM, H, DM, 1 << 30}, (const u16*)(p.ws + WS_WT1), DM, DM, NTOK, L1C, lds, [=](int m, int n, float v) {
    if (n < 1536) UA[(size_t)m * U1A_LD + n] = f2bf(v);
    else if (n < 3584) UB[(size_t)m * U1B_LD + n - 1536] = f2bf(v);
    else AB[(size_t)m * 16 + n - 3584] = v;
  });
}

template <int KIND>
DI void nattn(const Params& p) {
  constexpr int DQK = KIND == 0 ? 96 : (KIND == 1 ? 64 : 128);
  constexpr int DV = KIND == 2 ? 128 : 64;
  constexpr int NH = KIND == 2 ? 4 : 8;
  constexpr float SCALE = KIND == 0 ? 0.10206207261596577f : (KIND == 1 ? 0.125f : 0.08838834764831845f);
  const int lane = threadIdx.x & 63, wid = threadIdx.x >> 6;
  const u16* U0 = (const u16*)(p.ws + WS_U);
  u16* U1B = (u16*)(p.ws + WS_U1B);
  for (int it = blockIdx.x * 8 + wid; it < NTOK * NH; it += gridDim.x * 8) {
    const int tok = it / NH, hq = it % NH;
    const int s = seq_of_tok(tok), tok0 = tok0_of(s), kr0 = krow0_of(s), cap = cap_of(s), len = len_of(s), qi = tok - tok0;
    const bool smp = s >= 16;
    const int hkv = KIND == 0 ? hq : (KIND == 1 ? hq >> 2 : hq >> 1);
    const u16* qp; const u16* VT;
    if (KIND == 0) { qp = (const u16*)((const char*)p.out + YS_QMLA) + (size_t)tok * 768 + hq * 96; VT = (const u16*)((const char*)p.out + YS_VTMLA) + (size_t)kr0 * 512; }
    else if (KIND == 1) { qp = U0 + (size_t)tok * L0C + C0_QB + hq * 64; VT = (const u16*)(p.ws + WS_VTSWA) + (size_t)kr0 * 128; }
    else { qp = U1B + (size_t)tok * U1B_LD + C1_QD + hq * 128; VT = (const u16*)(p.ws + WS_VTATT) + (size_t)kr0 * 256; }
    const float q0 = bf2f(qp[lane]);
    const float q1 = (DQK > 64 && lane + 64 < DQK) ? bf2f(qp[lane + 64]) : 0.f;
    float m = -1e30f, l = 0.f, o0 = 0.f, o1 = 0.f;
    int glo = 0, ghi = cap >> 4;
    const int nseqg = len >> 4;
    for (int gidx = glo; gidx < ghi; ++gidx) {
      const int g0 = gidx * 16;
      if (KIND == 1 && smp && g0 < 2048) { if (g0 + 15 < qi - 128 || g0 > qi + 128) continue; }
      float sc[16];
#pragma unroll
      for (int j = 0; j < 16; ++j) {
        const int g = g0 + j;
        const u16* kp;
        float part;
        if (KIND == 0) {
          const u16* kn = (const u16*)((const char*)p.out + YS_KN) + ((size_t)(kr0 + g) * 8 + hkv) * 64;
          const u16* kr = (const u16*)(p.ws + WS_KROPE) + (size_t)(kr0 + g) * 32;
          part = q0 * bf2f(kn[lane]) + (lane < 32 ? q1 * bf2f(kr[lane]) : 0.f);
        } else if (KIND == 1) {
          kp = (const u16*)(p.ws + WS_KSWA) + ((size_t)(kr0 + g) * 2 + hkv) * 64;
          part = q0 * bf2f(kp[lane]);
        } else {
          kp = g < len ? U1B + (size_t)(tok0 + g) * U1B_LD + C1_KD + hkv * 128 : (const u16*)(p.ws + WS_KC) + ((size_t)((s - 16) * 512 + g - 2048) * 2 + hkv) * 128;
          part = q0 * bf2f(kp[lane]) + q1 * bf2f(kp[lane + 64]);
        }
        float sv_ = wave_sum(part) * SCALE;
        if (KIND == 1 && smp && g < 2048) { const int d = qi - g; if (d > 128 || d < -128) sv_ = -INFINITY; }
        sc[j] = sv_;
      }
      float mx = sc[0];
#pragma unroll
      for (int j = 1; j < 16; ++j) mx = fmaxf(mx, sc[j]);
      const float mnew = fmaxf(m, mx);
      const float alpha = __expf(m - mnew);
      m = mnew; l *= alpha; o0 *= alpha; o1 *= alpha;
      const u32x4 va = *(const u32x4*)(VT + (size_t)(hkv * DV + lane) * cap + g0), vb = *(const u32x4*)(VT + (size_t)(hkv * DV + lane) * cap + g0 + 8);
      float v0[16]; { float t8[8]; unpack8(va, t8); for (int e = 0; e < 8; ++e) v0[e] = t8[e]; unpack8(vb, t8); for (int e = 0; e < 8; ++e) v0[8 + e] = t8[e]; }
      float v1[16];
      if (DV > 64) {
        const u32x4 vc = *(const u32x4*)(VT + (size_t)(hkv * DV + 64 + lane) * cap + g0), vd = *(const u32x4*)(VT + (size_t)(hkv * DV + 64 + lane) * cap + g0 + 8);
        float t8[8]; unpack8(vc, t8); for (int e = 0; e < 8; ++e) v1[e] = t8[e]; unpack8(vd, t8); for (int e = 0; e < 8; ++e) v1[8 + e] = t8[e];
      }
#pragma unroll
      for (int j = 0; j < 16; ++j) {
        const float pj = __expf(sc[j] - mnew);
        l += pj;
        o0 += pj * v0[swz16(j)];
        if (DV > 64) o1 += pj * v1[swz16(j)];
      }
    }
    (void)nseqg; (void)glo;
    if (KIND == 1) l += __expf(p.swa_sink[hq] - m);
    const float inv = 1.f / l;
    if (KIND == 0) { const float z = bf2f(U0[(size_t)tok * L0C + C0_ZA + hq * 64 + lane]); ((u16*)(p.ws + WS_H))[(size_t)tok * DM + hq * 64 + lane] = f2bf(o0 * inv * siluf(z)); }
    else if (KIND == 1) { const float z = bf2f(U0[(size_t)tok * L0C + C0_ZB + hq * 64 + lane]); ((u16*)(p.ws + WS_H))[(size_t)tok * DM + 512 + hq * 64 + lane] = f2bf(o0 * inv * siluf(z)); }
    else {
      const float z0 = bf2f(U1B[(size_t)tok * U1B_LD + C1_ZD + hq * 128 + lane]), z1 = bf2f(U1B[(size_t)tok * U1B_LD + C1_ZD + hq * 128 + 64 + lane]);
      U1B[(size_t)tok * U1B_LD + C1_QD + hq * 128 + lane] = f2bf(o0 * inv * siluf(z0));
      U1B[(size_t)tok * U1B_LD + C1_QD + hq * 128 + 64 + lane] = f2bf(o1 * inv * siluf(z1));
    }
  }
}

DI void nphase_gdn(const Params& p, char* lds) {
  const int tid = threadIdx.x;
  float* sq = (float*)lds; float* sk = sq + 128;
  const u16* QK = (const u16*)(p.ws + WS_H); const u16* VC = (const u16*)(p.ws + WS_VC); const float* GB = (const float*)(p.ws + WS_GB);
  for (int it = blockIdx.x; it < 192; it += gridDim.x) {
    int s, head, dir;
    if (it < 64) { s = 16 + (it >> 3); head = (it >> 1) & 3; dir = it & 1; } else { const int j = it - 64; s = j >> 3; head = (j >> 1) & 3; dir = j & 1; }
    const int tok0 = tok0_of(s), T = len_of(s);
    u16* O = (u16*)(p.ws + (dir ? WS_OB : WS_OF));
    float S[128];
    if (tid < 128) {
      if (s >= 16) {
        const float* st = p.c_state + ((size_t)(((s - 16) * 2 + dir) * 4 + head)) * 16384;
#pragma unroll
        for (int d = 0; d < 128; ++d) S[d] = st[d * 128 + tid];
      } else {
#pragma unroll
        for (int d = 0; d < 128; ++d) S[d] = 0.f;
      }
    }
    for (int tau = 0; tau < T; ++tau) {
      const int m = tok0 + (dir ? T - 1 - tau : tau);
      __syncthreads();
      if (tid < 128) { sq[tid] = bf2f(QK[(size_t)m * DM + head * 128 + tid]); sk[tid] = bf2f(QK[(size_t)m * DM + 512 + head * 128 + tid]); }
      __syncthreads();
      if (tid < 128) {
        const float g = GB[(size_t)m * 16 + dir * 4 + head], beta = GB[(size_t)m * 16 + 8 + dir * 4 + head];
        const float alpha = __expf(g);
        const float v = bf2f(VC[(size_t)m * 512 + head * 128 + tid]);
        float r = 0.f;
#pragma unroll
        for (int c = 0; c < 16; ++c) {
          const float4 ka = *(const float4*)(sk + c * 8), kb = *(const float4*)(sk + c * 8 + 4);
          r += ka.x * S[c * 8] + ka.y * S[c * 8 + 1] + ka.z * S[c * 8 + 2] + ka.w * S[c * 8 + 3] + kb.x * S[c * 8 + 4] + kb.y * S[c * 8 + 5] + kb.z * S[c * 8 + 6] + kb.w * S[c * 8 + 7];
          asm volatile("" ::: "memory");
        }
        const float dd = beta * (v - alpha * r);
        float o = 0.f;
#pragma unroll
        for (int c = 0; c < 16; ++c) {
          const float4 ka = *(const float4*)(sk + c * 8), kb = *(const float4*)(sk + c * 8 + 4);
          const float4 qa = *(const float4*)(sq + c * 8), qb = *(const float4*)(sq + c * 8 + 4);
          const float kk[8] = {ka.x, ka.y, ka.z, ka.w, kb.x, kb.y, kb.z, kb.w};
          const float qq[8] = {qa.x, qa.y, qa.z, qa.w, qb.x, qb.y, qb.z, qb.w};
#pragma unroll
          for (int e = 0; e < 8; ++e) { S[c * 8 + e] = alpha * S[c * 8 + e] + kk[e] * dd; o += qq[e] * S[c * 8 + e]; }
          asm volatile("" ::: "memory");
        }
        O[(size_t)m * 512 + head * 128 + tid] = f2bf(o);
      }
    }
    if (tid < 128 && s < 16) {
      float* st = p.out + O_STATE + ((size_t)((s * 2 + dir) * 4 + head)) * 16384;
#pragma unroll
      for (int d = 0; d < 128; ++d) st[d * 128 + tid] = S[d];
    }
    __syncthreads();
  }
}

extern __shared__ __attribute__((aligned(16))) char smem[];
constexpr int LDS_BYTES = 98304;

#ifndef FAST_MASK
#define FAST_MASK 223
#endif
#define GSYNC() grid.sync()

__global__ void __launch_bounds__(NTHREADS) fwd_megakernel(Params p) {
  cg::grid_group grid = cg::this_grid();
  char* lds = smem;
  phase_prep(p, lds);
  GSYNC();
  phase_adaln(p, 0);
  GSYNC();
  if (FAST_MASK & 1) phase_inproj0(p, lds); else nphase_inproj0(p, lds);
  GSYNC();
  phase_l0prep(p, lds);
  GSYNC();
  if (FAST_MASK & 2) phase_l0gemms(p, lds); else { nphase_l0gemms(p, lds); GSYNC(); nphase_qmla_rope(p); }
  GSYNC();
  if (FAST_MASK & 4) phase_attn0(p, lds); else { nattn<0>(p); nattn<1>(p); }
  GSYNC();
  if (FAST_MASK & 8) phase_outproj(p, 0, lds); else nphase_outproj(p, 0, lds);
  GSYNC();
  phase_adaln(p, 1);
  GSYNC();
  if (FAST_MASK & 16) phase_inproj1(p, lds); else nphase_inproj1(p, lds);
  GSYNC();
  phase_l1prep(p, lds);
  GSYNC();
  nphase_gdn(p, lds);
  GSYNC();
  if (FAST_MASK & 64) phase_attn1(p, lds); else nattn<2>(p);
  phase_gdnfinal(p);
  GSYNC();
  if (FAST_MASK & 128) phase_outproj(p, 1, lds); else nphase_outproj(p, 1, lds);
  GSYNC();
  phase_final(p);
}

extern "C" void kernel_launch(void* const* d_in, const int* in_sizes, int n_in, void* d_out, int out_size, void* d_ws, size_t ws_size, hipStream_t stream) {
  static int grid_blocks = 0;
  if (!grid_blocks) {
    int dev = 0, cus = 0, per_cu = 0;
    (void)hipGetDevice(&dev);
    (void)hipDeviceGetAttribute(&cus, hipDeviceAttributeMultiprocessorCount, dev);
    (void)hipFuncSetAttribute((const void*)fwd_megakernel, hipFuncAttributeMaxDynamicSharedMemorySize, LDS_BYTES);
    (void)hipOccupancyMaxActiveBlocksPerMultiprocessor(&per_cu, fwd_megakernel, NTHREADS, LDS_BYTES);
    if (per_cu > 1) per_cu = 1;
    grid_blocks = cus * per_cu;
    if (grid_blocks <= 0) { fprintf(stderr, "occupancy query failed (cus %d per_cu %d)\n", cus, per_cu); grid_blocks = 0; return; }
  }
  if (n_in != 33 || ws_size < WS_END) { fprintf(stderr, "kernel_launch: unexpected n_in %d / ws %zu\n", n_in, ws_size); return; }
  Params p{};
  const float** pp = (const float**)&p;
  for (int i = 0; i < 33; ++i) pp[i] = (const float*)d_in[i];
  p.out = (float*)d_out;
  p.ws = (char*)d_ws;
  void* args[] = {&p};
  hipError_t e = hipLaunchCooperativeKernel((void*)fwd_megakernel, dim3(grid_blocks), dim3(NTHREADS), args, LDS_BYTES, stream);
  if (e != hipSuccess) fprintf(stderr, "cooperative launch failed: %s (grid %d)\n", hipGetErrorString(e), grid_blocks);
}
```

```cpp
#include <hip/hip_runtime.h>
#include <hip/hip_cooperative_groups.h>
#include <cstdio>
#include <cstdint>
namespace cg = cooperative_groups;

#define DI __device__ __forceinline__
typedef unsigned short u16;
using bf16x8 = __attribute__((ext_vector_type(8))) short;
using bf16x4 = __attribute__((ext_vector_type(4))) short;
using f32x16 = __attribute__((ext_vector_type(16))) float;
using f32x4  = __attribute__((ext_vector_type(4))) float;
using u32x4  = __attribute__((ext_vector_type(4))) unsigned;
using u32x2  = __attribute__((ext_vector_type(2))) unsigned;

#ifndef PHASE_LIMIT
#define PHASE_LIMIT 99
#endif

constexpr int NTHREADS = 512;
constexpr int DM = 1024, NTOK = 20480, NCTX = 4096, NKROW = 24576;
constexpr int L0C = 2464, L0CP = 2560, L1C = 3600, L1CP = 3712;
constexpr int U1A_LD = 1536, U1B_LD = 2048;
constexpr int C0_CQ = 0, C0_CKV = 384, C0_KR = 640, C0_ZA = 672, C0_QB = 1184, C0_KB = 1696, C0_VB = 1824, C0_ZB = 1952;
constexpr int C1_ZC = 0, C1_QD = 512, C1_KD = 1024, C1_VD = 1280, C1_ZD = 1536;
constexpr float EPS = 1e-6f;
constexpr float LOG2E = 1.4426950408889634f;

constexpr size_t O_Y = 0;
constexpr size_t O_CKV = 20971520, O_KROPE = 22020096, O_SWAK = 22151168, O_SWAV = 22675456, O_STATE = 23199744, O_ATTK = 25296896, O_ATTV = 26345472;

constexpr size_t WS_WO1 = 0;
constexpr size_t WS_MOD = WS_WO1 + 2097152;
constexpr size_t WS_ROPE = WS_MOD + 221184;
constexpr size_t WS_W2 = WS_ROPE + 32768;
constexpr size_t WS_WT0 = WS_W2;
constexpr size_t WS_WUQ = WS_WT0 + 5242880;
constexpr size_t WS_WUKV = WS_WUQ + 589824;
constexpr size_t WS_WO0 = WS_WUKV + 524288;
constexpr size_t WS_WT1 = WS_WO0 + 2097152;
constexpr size_t WS_W2_END = WS_WT1 + 7602176;
constexpr size_t WS_VTATT = WS_W2;
constexpr size_t WS_KC = WS_VTATT + 12582912;
constexpr size_t WS_GB = WS_KC + 2097152;
static_assert(WS_GB + 1310720 <= WS_W2_END, "layer-1 reuse overflow");
constexpr size_t WS_H = WS_W2_END;
constexpr size_t WS_U = WS_H + 41943040;
constexpr size_t WS_U0X = WS_U + (size_t)NTOK * L0C * 2;
constexpr size_t WS_KSWA = WS_U0X;
constexpr size_t WS_VTSWA = WS_KSWA + 6291456;
constexpr size_t WS_CKVN = WS_VTSWA + 6291456;
constexpr size_t WS_KROPE = WS_CKVN + 12582912;
static_assert(WS_KROPE + 1572864 <= WS_U + 147456000, "layer-0 extras overflow");
constexpr size_t WS_U1A = WS_U;
constexpr size_t WS_U1B = WS_U + 62914560;
constexpr size_t WS_TB = WS_U1A;
constexpr size_t WS_AM = WS_TB + 20971520;
constexpr size_t WS_OB = WS_AM + 20971520;
constexpr size_t WS_X = WS_U + 147456000;
constexpr size_t WS_VC = WS_X;
constexpr size_t WS_OF = WS_VC + 20971520;
constexpr size_t WS_AB = WS_OF + 20971520;
constexpr size_t WS_END = WS_AB + 1310720;
static_assert(WS_END <= 268435456ull, "ws overflow");
constexpr size_t YS_QMLA = 0;
constexpr size_t YS_KN = YS_QMLA + 31457280;
constexpr size_t YS_VTMLA = YS_KN + 25165824;
static_assert(YS_VTMLA + 25165824 <= (size_t)NTOK * DM * 4, "y scratch overflow");

struct Params {
  const float *x_prompt, *x_sample, *c_ckv, *c_krope, *c_swak, *c_swav, *c_state, *c_attk, *c_attv, *c, *c_ctx;
  const float *w_mod0, *b_mod0, *ln0, *w_in0, *mla_q_norm, *w_uq, *mla_kv_norm, *w_ukv, *swa_sink, *w_out0;
  const float *w_mod1, *b_mod1, *ln1, *w_in1, *gdn_conv, *gdn_a_log, *gdn_dt_bias, *gdn_norm, *att_q_norm, *att_k_norm, *w_out1, *ln_f;
  float* out;
  char* ws;
};

DI int opaque_zero() { int z = 0; asm volatile("" : "+v"(z)); return z; }
#define TIDX() ((int)threadIdx.x + opaque_zero())
DI float bf2f(u16 b) { return __uint_as_float(((unsigned)b) << 16); }
DI u16 f2bf(float x) { unsigned u = __float_as_uint(x); u += 0x7fffu + ((u >> 16) & 1u); return (u16)(u >> 16); }
DI unsigned pack2(float lo, float hi) { return (unsigned)f2bf(lo) | ((unsigned)f2bf(hi) << 16); }
DI int crow(int reg, int h) { return (reg & 3) + 8 * (reg >> 2) + 4 * h; }
DI int swz16(int k) { return (k & ~12) | ((k & 4) << 1) | ((k & 8) >> 1); }
DI float siluf(float x) { return x / (1.f + __expf(-x)); }
DI int seq_of_tok(int m) { return m < NCTX ? (m >> 8) : 16 + ((m - NCTX) >> 11); }
DI int tok0_of(int s) { return s < 16 ? s * 256 : NCTX + (s - 16) * 2048; }
DI int krow0_of(int s) { return s < 16 ? s * 256 : NCTX + (s - 16) * 2560; }
DI int cap_of(int s) { return s < 16 ? 256 : 2560; }
DI int len_of(int s) { return s < 16 ? 256 : 2048; }
DI int modidx_of_tok(int m) { return m < NCTX ? 0 : 1 + ((m - NCTX) >> 11); }
DI int krow_of_tok(int m) { return m < NCTX ? m : NCTX + ((m - NCTX) >> 11) * 2560 + ((m - NCTX) & 2047); }
DI int pos_of_tok(int m) { return m < NCTX ? (m & 255) : ((m - NCTX) & 2047); }
DI const float* xrow(const Params& p, int m) { return m < NCTX ? p.x_prompt + (size_t)m * DM : p.x_sample + (size_t)(m - NCTX) * DM; }
DI float wave_sum(float v) {
#pragma unroll
  for (int o = 32; o > 0; o >>= 1) v += __shfl_xor(v, o);
  return v;
}
DI bf16x8 pack8(const f32x16& x, int s) {
  u32x4 w = {pack2(x[8 * s + 0], x[8 * s + 1]), pack2(x[8 * s + 2], x[8 * s + 3]), pack2(x[8 * s + 4], x[8 * s + 5]), pack2(x[8 * s + 6], x[8 * s + 7])};
  return __builtin_bit_cast(bf16x8, w);
}
DI bf16x8 cat4(bf16x4 lo, bf16x4 hi) { return __builtin_shufflevector(lo, hi, 0, 1, 2, 3, 4, 5, 6, 7); }
#define MFMA(a, b, c) __builtin_amdgcn_mfma_f32_32x32x16_bf16((a), (b), (c), 0, 0, 0)

DI void transpose_tile(const float* __restrict__ W, int ldw, int k0, int srccol0, int nvalid, u16* __restrict__ Wt, int ldt, int dstrow0, char* lds) {
  u16* t = (u16*)lds;
  const int tid = TIDX(), kr = tid >> 3, cc = (tid & 7) * 8;
  float v[8];
  if (cc < nvalid) {
    const float4 a = *(const float4*)(W + (size_t)(k0 + kr) * ldw + srccol0 + cc);
    const float4 b = *(const float4*)(W + (size_t)(k0 + kr) * ldw + srccol0 + cc + 4);
    v[0] = a.x; v[1] = a.y; v[2] = a.z; v[3] = a.w; v[4] = b.x; v[5] = b.y; v[6] = b.z; v[7] = b.w;
  } else {
#pragma unroll
    for (int e = 0; e < 8; ++e) v[e] = 0.f;
  }
#pragma unroll
  for (int e = 0; e < 8; ++e) t[(cc + e) * 72 + kr] = f2bf(v[e]);
  __syncthreads();
  const int n = tid >> 3, kc = (tid & 7) * 8;
  *(bf16x8*)(Wt + (size_t)(dstrow0 + n) * ldt + k0 + kc) = *(const bf16x8*)(t + n * 72 + kc);
  __syncthreads();
}

DI void vt_store16(const u16* sv, int CS, int C, u16* __restrict__ vt, size_t cap, int key16base) {
  for (int i = threadIdx.x; i < C * 4; i += NTHREADS) {
    const int ch = i >> 2, q = i & 3;
    u16 e[4];
#pragma unroll
    for (int j = 0; j < 4; ++j) e[j] = sv[swz16(q * 4 + j) * CS + ch];
    u32x2 w = {(unsigned)e[0] | ((unsigned)e[1] << 16), (unsigned)e[2] | ((unsigned)e[3] << 16)};
    *(u32x2*)(vt + (size_t)ch * cap + key16base + q * 4) = w;
  }
}

DI void phase_prep(const Params& p, char* lds) {
  const int tid = TIDX();
  constexpr int N_MOD = 192;
  constexpr int T_IN0 = 16 * 40, T_UQ = 6 * 12, T_UKV = 4 * 16, T_O0 = 256, T_IN1 = 16 * 58, T_O1 = 256;
  constexpr int N_TR = T_IN0 + T_UQ + T_UKV + T_O0 + T_IN1 + T_O1;
  constexpr int N_CV = 256 + 32 + 128;
  constexpr int N_VT = 256;
  constexpr int N_ITEMS = N_MOD + N_TR + N_CV + N_VT + 1;
  for (int it = blockIdx.x; it < N_ITEMS; it += gridDim.x) {
    if (it < N_MOD) {
      const int layer = it / 96, col0 = (it % 96) * 32;
      const float* Wm = layer ? p.w_mod1 : p.w_mod0;
      const float* bm = layer ? p.b_mod1 : p.b_mod0;
      float* sc = (float*)lds;
      float* red = sc + 9 * 1024;
      for (int i = tid; i < 9 * 1024; i += NTHREADS) {
        const int s = i >> 10, k = i & 1023;
        const float cv = s == 0 ? p.c_ctx[k] : p.c[(s - 1) * 1024 + k];
        sc[i] = siluf(cv);
      }
      __syncthreads();
      const int col = tid & 31, kg = tid >> 5;
      float acc[9];
#pragma unroll
      for (int s = 0; s < 9; ++s) acc[s] = 0.f;
      for (int kk = 0; kk < 64; ++kk) {
        const int k = kg * 64 + kk;
        const float w = Wm[(size_t)k * 3072 + col0 + col];
#pragma unroll
        for (int s = 0; s < 9; ++s) acc[s] += sc[s * 1024 + k] * w;
      }
#pragma unroll
      for (int s = 0; s < 9; ++s) red[(kg * 9 + s) * 32 + col] = acc[s];
      __syncthreads();
      if (tid < 288) {
        const int s = tid >> 5, c2 = tid & 31;
        float a = bm[col0 + c2];
        for (int g = 0; g < 16; ++g) a += red[(g * 9 + s) * 32 + c2];
        ((float*)(p.ws + WS_MOD))[(size_t)(layer * 9 + s) * 3072 + col0 + c2] = a;
      }
      __syncthreads();
    } else if (it < N_MOD + N_TR) {
      int t = it - N_MOD;
      if (t < T_IN0) { const int kt = t / 40, nt = t % 40; int nv = L0C - nt * 64; nv = nv < 0 ? 0 : (nv > 64 ? 64 : nv);
        transpose_tile(p.w_in0, L0C, kt * 64, nt * 64, nv, (u16*)(p.ws + WS_WT0), 1024, nt * 64, lds); continue; }
      t -= T_IN0;
      if (t < T_UQ) { const int kt = t / 12, nt = t % 12; transpose_tile(p.w_uq, 768, kt * 64, nt * 64, 64, (u16*)(p.ws + WS_WUQ), 384, nt * 64, lds); continue; }
      t -= T_UQ;
      if (t < T_UKV) { const int kt = t / 16, nt = t % 16; transpose_tile(p.w_ukv, 1024, kt * 64, nt * 64, 64, (u16*)(p.ws + WS_WUKV), 256, nt * 64, lds); continue; }
      t -= T_UKV;
      if (t < T_O0) { const int kt = t / 16, nt = t % 16; transpose_tile(p.w_out0, 1024, kt * 64, nt * 64, 64, (u16*)(p.ws + WS_WO0), 1024, nt * 64, lds); continue; }
      t -= T_O0;
      if (t < T_IN1) { const int kt = t / 58, nt = t % 58; const int n0 = nt * 64; int src, nv;
        if (n0 < 1536) { src = n0; nv = 64; } else if (n0 < 3584) { src = n0 + 16; nv = 64; } else if (n0 == 3584) { src = 1536; nv = 16; } else { src = 0; nv = 0; }
        transpose_tile(p.w_in1, L1C, kt * 64, src, nv, (u16*)(p.ws + WS_WT1), 1024, n0, lds); continue; }
      t -= T_IN1;
      { const int kt = t / 16, nt = t % 16; transpose_tile(p.w_out1, 1024, kt * 64, nt * 64, 64, (u16*)(p.ws + WS_WO1), 1024, nt * 64, lds); }
    } else if (it < N_MOD + N_TR + N_CV) {
      int t = it - N_MOD - N_TR;
      const int e0 = tid * 8;
      if (t < 256) {
        const size_t i = (size_t)t * 4096 + e0; const int b = (int)(i >> 17), rem = (int)(i & 131071), pp = rem >> 8, cc = rem & 255;
        const float4 a = *(const float4*)(p.c_ckv + i), b4 = *(const float4*)(p.c_ckv + i + 4);
        u32x4 w = {pack2(a.x, a.y), pack2(a.z, a.w), pack2(b4.x, b4.y), pack2(b4.z, b4.w)};
        *(u32x4*)((u16*)(p.ws + WS_CKVN) + (size_t)(NCTX + b * 2560 + 2048 + pp) * 256 + cc) = w;
      } else if (t < 288) {
        const size_t i = (size_t)(t - 256) * 4096 + e0; const int b = (int)(i >> 14), rem = (int)(i & 16383), pp = rem >> 5, cc = rem & 31;
        const float4 a = *(const float4*)(p.c_krope + i), b4 = *(const float4*)(p.c_krope + i + 4);
        u32x4 w = {pack2(a.x, a.y), pack2(a.z, a.w), pack2(b4.x, b4.y), pack2(b4.z, b4.w)};
        *(u32x4*)((u16*)(p.ws + WS_KROPE) + (size_t)(NCTX + b * 2560 + 2048 + pp) * 32 + cc) = w;
      } else {
        const size_t i = (size_t)(t - 288) * 4096 + e0; const int b = (int)(i >> 16), rem = (int)(i & 65535), pp = rem >> 7, cc = rem & 127;
        const float4 a = *(const float4*)(p.c_swak + i), b4 = *(const float4*)(p.c_swak + i + 4);
        u32x4 w = {pack2(a.x, a.y), pack2(a.z, a.w), pack2(b4.x, b4.y), pack2(b4.z, b4.w)};
        *(u32x4*)((u16*)(p.ws + WS_KSWA) + (size_t)(NCTX + b * 2560 + 2048 + pp) * 128 + cc) = w;
      }
    } else if (it < N_MOD + N_TR + N_CV + N_VT) {
      const int t = it - N_MOD - N_TR - N_CV; const int b = t >> 5, g = t & 31;
      u16* sv = (u16*)lds;
      {
        const int key = tid >> 5, c4 = (tid & 31) * 4;
        const float4 a = *(const float4*)(p.c_swav + ((size_t)(b * 512 + g * 16 + key)) * 128 + c4);
        u32x2 w = {pack2(a.x, a.y), pack2(a.z, a.w)};
        *(u32x2*)(sv + key * 136 + c4) = w;
      }
      __syncthreads();
      vt_store16(sv, 136, 128, (u16*)(p.ws + WS_VTSWA) + (size_t)krow0_of(16 + b) * 128, 2560, 2048 + g * 16);
      __syncthreads();
    } else {
      float2* tab = (float2*)(p.ws + WS_ROPE);
      for (int i = tid; i < 64 * 8 + 64 * 16 + 64 * 32; i += NTHREADS) {
        int q, pos, f, j = i;
        if (j < 512) { q = 8; } else if (j < 1536) { q = 16; j -= 512; } else { q = 32; j -= 1536; }
        pos = j / q; f = j % q;
        const float inv = powf(10000.f, -(float)f / (float)q);
        const float ang = (float)pos * inv;
        tab[i] = make_float2(cosf(ang), sinf(ang));
      }
    }
  }
}

DI void phase_adaln(const Params& p, int layer) {
  const int tid_ = TIDX(), lane = tid_ & 63, wid = tid_ >> 6;
  const float* ln = layer ? p.ln1 : p.ln0;
  const float* mod = (const float*)(p.ws + WS_MOD) + (size_t)layer * 9 * 3072;
  u16* H = (u16*)(p.ws + WS_H);
  for (int m = blockIdx.x * 8 + wid; m < NTOK; m += gridDim.x * 8) {
    const float* x = layer ? (p.out + (size_t)m * DM) : xrow(p, m);
    const float* md = mod + (size_t)modidx_of_tok(m) * 3072;
    float4 v[4]; float ss = 0.f;
#pragma unroll
    for (int j = 0; j < 4; ++j) { v[j] = *(const float4*)(x + (j * 64 + lane) * 4); ss += v[j].x * v[j].x + v[j].y * v[j].y + v[j].z * v[j].z + v[j].w * v[j].w; }
    ss = wave_sum(ss);
    const float rs = rsqrtf(ss * (1.f / 1024.f) + EPS);
#pragma unroll
    for (int j = 0; j < 4; ++j) {
      const int c = (j * 64 + lane) * 4;
      const float4 g = *(const float4*)(ln + c), sh = *(const float4*)(md + c), scl = *(const float4*)(md + 1024 + c);
      const float a0 = v[j].x * rs * g.x * (1.f + scl.x) + sh.x, a1 = v[j].y * rs * g.y * (1.f + scl.y) + sh.y;
      const float a2 = v[j].z * rs * g.z * (1.f + scl.z) + sh.z, a3 = v[j].w * rs * g.w * (1.f + scl.w) + sh.w;
      u32x2 w = {pack2(a0, a1), pack2(a2, a3)};
      *(u32x2*)(H + (size_t)m * DM + c) = w;
    }
  }
}

struct GemmA { const u16* p0; int ld0; const u16* p1; int ld1; int ksplit; };
constexpr int G_LDS_A = 256 * 72 * 2;
template <class Epi>
DI void gemm_tile(const GemmA A, const u16* __restrict__ B, int ldb, int K, int m0, int n0, char* lds, Epi& epi) {
  u16* sA = (u16*)lds; u16* sB = (u16*)(lds + G_LDS_A);
  const int tid = TIDX(), lane = tid & 63, wid = tid >> 6, r32 = lane & 31, h = lane >> 5;
  const int wm = wid >> 1, wn = wid & 1;
  const int lr = tid >> 3, lc = (tid & 7) * 8;
  f32x16 acc[2][2];
#pragma unroll
  for (int i = 0; i < 2; ++i)
#pragma unroll
    for (int j = 0; j < 2; ++j)
#pragma unroll
      for (int r = 0; r < 16; ++r) acc[i][j][r] = 0.f;
  bf16x8 ra[4], rb[2];
  const int nk = K >> 6;
  auto gload = [&](int kt) {
    const int k0 = kt * 64;
    const u16* ap; int lda, kk;
    if (k0 < A.ksplit) { ap = A.p0; lda = A.ld0; kk = k0; } else { ap = A.p1; lda = A.ld1; kk = k0 - A.ksplit; }
#pragma unroll
    for (int i = 0; i < 4; ++i) ra[i] = *(const bf16x8*)(ap + (size_t)(m0 + lr + 64 * i) * lda + kk + lc);
#pragma unroll
    for (int i = 0; i < 2; ++i) rb[i] = *(const bf16x8*)(B + (size_t)(n0 + lr + 64 * i) * ldb + k0 + lc);
  };
  gload(0);
  for (int kt = 0; kt < nk; ++kt) {
    __syncthreads();
#pragma unroll
    for (int i = 0; i < 4; ++i) *(bf16x8*)(sA + (lr + 64 * i) * 72 + lc) = ra[i];
#pragma unroll
    for (int i = 0; i < 2; ++i) *(bf16x8*)(sB + (lr + 64 * i) * 72 + lc) = rb[i];
    __syncthreads();
    if (kt + 1 < nk) gload(kt + 1);
#pragma unroll
    for (int ks = 0; ks < 4; ++ks) {
      bf16x8 a0 = *(const bf16x8*)(sA + (wm * 64 + r32) * 72 + ks * 16 + h * 8);
      bf16x8 a1 = *(const bf16x8*)(sA + (wm * 64 + 32 + r32) * 72 + ks * 16 + h * 8);
      bf16x8 b0 = *(const bf16x8*)(sB + (wn * 64 + r32) * 72 + ks * 16 + h * 8);
      bf16x8 b1 = *(const bf16x8*)(sB + (wn * 64 + 32 + r32) * 72 + ks * 16 + h * 8);
      acc[0][0] = MFMA(a0, b0, acc[0][0]); acc[0][1] = MFMA(a0, b1, acc[0][1]);
      acc[1][0] = MFMA(a1, b0, acc[1][0]); acc[1][1] = MFMA(a1, b1, acc[1][1]);
    }
  }
#pragma unroll
  for (int i = 0; i < 2; ++i)
#pragma unroll
    for (int j = 0; j < 2; ++j) epi(acc[i][j], m0 + wm * 64 + i * 32, n0 + wn * 64 + j * 32 + r32, h);
}

struct EpiU0 {
  u16* U;
  DI void operator()(const f32x16& a, int row0, int col, int h) const {
    if (col < L0C) {
#pragma unroll
      for (int r = 0; r < 16; ++r) U[(size_t)(row0 + crow(r, h)) * L0C + col] = f2bf(a[r]);
    }
  }
};
struct EpiQmla {
  u16* Q; const float2* tab;
  DI void operator()(const f32x16& a, int f0, int tok, int h) const {
    float v[16];
#pragma unroll
    for (int r = 0; r < 16; ++r) v[r] = a[r];
    if ((f0 % 96) == 64 && tok >= NCTX) {
      const int pos = pos_of_tok(tok), prow = pos >> 6, pcol = pos & 63;
#pragma unroll
      for (int j = 0; j < 4; ++j) {
        const int fi = 4 * h + j;
        const float2 cr = tab[prow * 8 + fi], cc = tab[pcol * 8 + fi];
        const float x1 = v[j], x2 = v[4 + j];
        v[j] = x1 * cr.x - x2 * cr.y; v[4 + j] = x2 * cr.x + x1 * cr.y;
        const float y1 = v[8 + j], y2 = v[12 + j];
        v[8 + j] = y1 * cc.x - y2 * cc.y; v[12 + j] = y2 * cc.x + y1 * cc.y;
      }
    }
#pragma unroll
    for (int g = 0; g < 4; ++g) {
      u32x2 w = {pack2(v[4 * g], v[4 * g + 1]), pack2(v[4 * g + 2], v[4 * g + 3])};
      *(u32x2*)(Q + (size_t)tok * 768 + f0 + 8 * g + 4 * h) = w;
    }
  }
};
struct EpiKvexp {
  u16* Kn; u16* Vt;
  DI void operator()(const f32x16& a, int kr0, int n, int h) const {
    const int head = n >> 7, within = n & 127;
    if (within < 64) {
#pragma unroll
      for (int r = 0; r < 16; ++r) Kn[((size_t)(kr0 + crow(r, h)) * 8 + head) * 64 + within] = f2bf(a[r]);
    } else {
      int seq, key0;
      if (kr0 < NCTX) { seq = kr0 >> 8; key0 = kr0 & 255; } else { const int r = kr0 - NCTX; seq = 16 + r / 2560; key0 = r % 2560; }
      const size_t cap = cap_of(seq);
      u16* base = Vt + (size_t)krow0_of(seq) * 512 + (size_t)(head * 64 + within - 64) * cap;
#pragma unroll
      for (int g = 0; g < 4; ++g) {
        const int pos = key0 + 16 * (g >> 1) + 8 * h + 4 * (g & 1);
        u32x2 w = {pack2(a[4 * g], a[4 * g + 1]), pack2(a[4 * g + 2], a[4 * g + 3])};
        *(u32x2*)(base + pos) = w;
      }
    }
  }
};
struct EpiOut {
  const Params* p; int layer;
  DI void operator()(const f32x16& a, int row0, int col, int h) const {
    const float* mod = (const float*)(p->ws + WS_MOD) + (size_t)(layer * 9 + modidx_of_tok(row0)) * 3072 + 2048;
    const float gate = mod[col];
#pragma unroll
    for (int r = 0; r < 16; ++r) {
      const int m = row0 + crow(r, h);
      const float xv = layer ? p->out[(size_t)m * DM + col] : xrow(*p, m)[col];
      p->out[(size_t)m * DM + col] = xv + gate * a[r];
    }
  }
};
struct EpiU1 {
  u16* UA; u16* UB; float* AB;
  DI void operator()(const f32x16& a, int row0, int col, int h) const {
    if (col < 1536) {
#pragma unroll
      for (int r = 0; r < 16; ++r) UA[(size_t)(row0 + crow(r, h)) * U1A_LD + col] = f2bf(a[r]);
    } else if (col < 3584) {
#pragma unroll
      for (int r = 0; r < 16; ++r) UB[(size_t)(row0 + crow(r, h)) * U1B_LD + col - 1536] = f2bf(a[r]);
    } else if (col < 3600) {
#pragma unroll
      for (int r = 0; r < 16; ++r) AB[(size_t)(row0 + crow(r, h)) * 16 + col - 3584] = a[r];
    }
  }
};

DI void phase_inproj0(const Params& p, char* lds) {
  EpiU0 epi{(u16*)(p.ws + WS_U)};
  const u16* H = (const u16*)(p.ws + WS_H);
  const GemmA A{H, DM, H, DM, 1 << 30};
  for (int it = blockIdx.x; it < 80 * 20; it += gridDim.x) {
    const int mt = it / 20, nt = it % 20;
    gemm_tile(A, (const u16*)(p.ws + WS_WT0), DM, DM, mt * 256, nt * 128, lds, epi);
  }
}
DI void phase_l0gemms(const Params& p, char* lds) {
  const u16* U0 = (const u16*)(p.ws + WS_U);
  EpiKvexp ek{(u16*)((char*)p.out + YS_KN), (u16*)((char*)p.out + YS_VTMLA)};
  EpiQmla eq{(u16*)((char*)p.out + YS_QMLA), (const float2*)(p.ws + WS_ROPE)};
  const u16* ck = (const u16*)(p.ws + WS_CKVN);
  const u16* wq = (const u16*)(p.ws + WS_WUQ);
  const GemmA Ak{ck, 256, ck, 256, 1 << 30};
  const GemmA Aq{wq, 384, wq, 384, 1 << 30};
  for (int it = blockIdx.x; it < 768 + 480; it += gridDim.x) {
    if (it < 768) { const int mt = it >> 3, nt = it & 7; gemm_tile(Ak, (const u16*)(p.ws + WS_WUKV), 256, 256, mt * 256, nt * 128, lds, ek); }
    else { const int t = it - 768; const int mt = t % 3, nt = t / 3; gemm_tile(Aq, U0 + C0_CQ, L0C, 384, mt * 256, nt * 128, lds, eq); }
  }
}
DI void phase_outproj(const Params& p, int layer, char* lds) {
  EpiOut epi{&p, layer};
  const u16* H = (const u16*)(p.ws + WS_H);
  const GemmA A{H, DM, H, DM, 1 << 30};
  const u16* W = (const u16*)(p.ws + (layer ? WS_WO1 : WS_WO0));
  for (int it = blockIdx.x; it < 80 * 8; it += gridDim.x) {
    const int mt = it >> 3, nt = it & 7;
    gemm_tile(A, W, DM, DM, mt * 256, nt * 128, lds, epi);
  }
}
DI void phase_inproj1(const Params& p, char* lds) {
  EpiU1 epi{(u16*)(p.ws + WS_U1A), (u16*)(p.ws + WS_U1B), (float*)(p.ws + WS_AB)};
  const u16* H = (const u16*)(p.ws + WS_H);
  const GemmA A{H, DM, H, DM, 1 << 30};
  for (int it = blockIdx.x; it < 80 * 29; it += gridDim.x) {
    const int mt = it / 29, nt = it % 29;
    gemm_tile(A, (const u16*)(p.ws + WS_WT1), DM, DM, mt * 256, nt * 128, lds, epi);
  }
}

DI void rope8(float (&x)[8], const float (&xp)[8], const float2* tab, int q, int pp, int fi0, bool is_x2) {
#pragma unroll
  for (int e = 0; e < 8; ++e) {
    const float2 cs = tab[pp * q + fi0 + e];
    x[e] = is_x2 ? (x[e] * cs.x + xp[e] * cs.y) : (x[e] * cs.x - xp[e] * cs.y);
  }
}
DI void unpack8(const u32x4 w, float (&x)[8]) {
#pragma unroll
  for (int i = 0; i < 4; ++i) { x[2 * i] = bf2f((u16)(w[i] & 0xffffu)); x[2 * i + 1] = bf2f((u16)(w[i] >> 16)); }
}
DI u32x4 pack8f(const float (&x)[8]) { u32x4 w = {pack2(x[0], x[1]), pack2(x[2], x[3]), pack2(x[4], x[5]), pack2(x[6], x[7])}; return w; }
DI void shfl8(const float (&x)[8], float (&xp)[8], int mask) {
#pragma unroll
  for (int e = 0; e < 8; ++e) xp[e] = __shfl_xor(x[e], mask);
}

DI void phase_l0prep(const Params& p, char* lds) {
  const int tid = TIDX(), lane = tid & 63, wid = tid >> 6;
  u16* U0 = (u16*)(p.ws + WS_U);
  u16* sv = (u16*)lds;
  const float2* tabM = (const float2*)(p.ws + WS_ROPE);
  const float2* tabS = tabM + 512;
  u16* CKVN = (u16*)(p.ws + WS_CKVN); u16* KROPE = (u16*)(p.ws + WS_KROPE); u16* KSWA = (u16*)(p.ws + WS_KSWA);
  for (int it = blockIdx.x; it < NTOK / 16; it += gridDim.x) {
    const int m0 = it * 16;
    for (int tt = 0; tt < 2; ++tt) {
      const int ml = wid * 2 + tt, m = m0 + ml;
      u16* row = U0 + (size_t)m * L0C;
      const bool ctx = m < NCTX;
      const int pos = pos_of_tok(m), prow = pos >> 6, pcol = pos & 63, krow = krow_of_tok(m);
      {
        float lo[3], hi[3], ss = 0.f;
#pragma unroll
        for (int j = 0; j < 3; ++j) { const unsigned w = *(const unsigned*)(row + C0_CQ + 128 * j + 2 * lane); lo[j] = bf2f((u16)(w & 0xffffu)); hi[j] = bf2f((u16)(w >> 16)); ss += lo[j] * lo[j] + hi[j] * hi[j]; }
        ss = wave_sum(ss);
        const float rs = rsqrtf(ss * (1.f / 384.f) + EPS);
#pragma unroll
        for (int j = 0; j < 3; ++j) { const int c = 128 * j + 2 * lane; *(unsigned*)(row + C0_CQ + c) = pack2(lo[j] * rs * p.mla_q_norm[c], hi[j] * rs * p.mla_q_norm[c + 1]); }
      }
      {
        const u32x2 w = *(const u32x2*)(row + C0_CKV + 4 * lane);
        float x[4] = {bf2f((u16)(w[0] & 0xffffu)), bf2f((u16)(w[0] >> 16)), bf2f((u16)(w[1] & 0xffffu)), bf2f((u16)(w[1] >> 16))};
        float ss = x[0] * x[0] + x[1] * x[1] + x[2] * x[2] + x[3] * x[3];
        ss = wave_sum(ss);
        const float rs = rsqrtf(ss * (1.f / 256.f) + EPS);
        const float4 g = *(const float4*)(p.mla_kv_norm + 4 * lane);
        x[0] *= rs * g.x; x[1] *= rs * g.y; x[2] *= rs * g.z; x[3] *= rs * g.w;
        u32x2 o = {pack2(x[0], x[1]), pack2(x[2], x[3])};
        *(u32x2*)(CKVN + (size_t)krow * 256 + 4 * lane) = o;
        if (ctx) *(float4*)(p.out + O_CKV + (size_t)m * 256 + 4 * lane) = make_float4(x[0], x[1], x[2], x[3]);
      }
      {
        const float x = bf2f(row[C0_KR + (lane & 31)]);
        const float xp = __shfl_xor(x, 8);
        float val = x;
        if (!ctx) {
          const int half = (lane >> 4) & 1, within = lane & 15, fi = lane & 7;
          const float2 cs = tabM[(half ? pcol : prow) * 8 + fi];
          val = within < 8 ? (x * cs.x - xp * cs.y) : (x * cs.x + xp * cs.y);
        }
        if (lane < 32) {
          KROPE[(size_t)krow * 32 + lane] = f2bf(val);
          if (ctx) p.out[O_KROPE + (size_t)m * 32 + lane] = x;
        }
      }
      if (!ctx) {
        float x[8], xp[8];
        unpack8(*(const u32x4*)(row + C0_QB + lane * 8), x);
        shfl8(x, xp, 2);
        const int b16 = (lane & 7) >> 1;
        rope8(x, xp, tabS, 16, (b16 >= 2) ? pcol : prow, (lane & 1) * 8, (b16 & 1) != 0);
        *(u32x4*)(row + C0_QB + lane * 8) = pack8f(x);
      }
      {
        float x[8], xp[8];
        unpack8(*(const u32x4*)(row + C0_KB + (lane & 15) * 8), x);
        if (ctx && lane < 16) {
          *(float4*)(p.out + O_SWAK + (size_t)m * 128 + lane * 8) = make_float4(x[0], x[1], x[2], x[3]);
          *(float4*)(p.out + O_SWAK + (size_t)m * 128 + lane * 8 + 4) = make_float4(x[4], x[5], x[6], x[7]);
        }
        shfl8(x, xp, 2);
        if (!ctx) {
          const int b16 = (lane & 7) >> 1;
          rope8(x, xp, tabS, 16, (b16 >= 2) ? pcol : prow, (lane & 1) * 8, (b16 & 1) != 0);
        }
        if (lane < 16) *(u32x4*)(KSWA + (size_t)krow * 128 + lane * 8) = pack8f(x);
        if (lane < 16) {
          const u32x4 vw = *(const u32x4*)(row + C0_VB + lane * 8);
          *(u32x4*)(sv + ml * 136 + lane * 8) = vw;
          if (ctx) {
            float v[8]; unpack8(vw, v);
            *(float4*)(p.out + O_SWAV + (size_t)m * 128 + lane * 8) = make_float4(v[0], v[1], v[2], v[3]);
            *(float4*)(p.out + O_SWAV + (size_t)m * 128 + lane * 8 + 4) = make_float4(v[4], v[5], v[6], v[7]);
          }
        }
      }
    }
    __syncthreads();
    {
      const int s = seq_of_tok(m0);
      vt_store16(sv, 136, 128, (u16*)(p.ws + WS_VTSWA) + (size_t)krow0_of(s) * 128, cap_of(s), pos_of_tok(m0));
    }
    __syncthreads();
  }
}

template <int KIND>
DI void attn_item(const Params& p, int s, int hsel, int q0, char* lds) {
  constexpr int DQK = KIND == 0 ? 96 : (KIND == 1 ? 64 : 128);
  constexpr int DV = KIND == 2 ? 128 : 64;
  constexpr int KS = DQK + 8, VS = 72;
  constexpr int CPR = DQK / 8;
  constexpr int KCH = 64 * CPR, NKC = (KCH + 511) / 512;
  constexpr int VCH = DV * 8, NVC = VCH / 512;
  constexpr float SCALE = KIND == 0 ? 0.10206207261596577f : (KIND == 1 ? 0.125f : 0.08838834764831845f);
  constexpr float C = SCALE * LOG2E;
  const int tid = TIDX(), lane = tid & 63, wid = tid >> 6, r32 = lane & 31, h = lane >> 5;
  u16* sK = (u16*)lds; u16* sV = sK + 64 * KS;
  const int tok0 = tok0_of(s), kr0 = krow0_of(s), cap = cap_of(s), len = len_of(s);
  const bool smp = s >= 16;
  int hq, hkv, qrow0;
  if (KIND == 0) { hq = hsel; hkv = hsel; qrow0 = q0 + 32 * wid; }
  else if (KIND == 1) { hkv = hsel >> 1; hq = hkv * 4 + (hsel & 1) * 2 + (wid >> 2); qrow0 = q0 + 32 * (wid & 3); }
  else { hkv = hsel; hq = hkv * 2 + (wid >> 2); qrow0 = q0 + 32 * (wid & 3); }
  const int tok = tok0 + qrow0 + r32;
  const u16* U0 = (const u16*)(p.ws + WS_U);
  u16* U1B = (u16*)(p.ws + WS_U1B);
  const u16* qp;
  if (KIND == 0) qp = (const u16*)((const char*)p.out + YS_QMLA) + (size_t)tok * 768 + hq * 96 + h * 8;
  else if (KIND == 1) qp = U0 + (size_t)tok * L0C + C0_QB + hq * 64 + h * 8;
  else qp = U1B + (size_t)tok * U1B_LD + C1_QD + hq * 128 + h * 8;
  bf16x8 qf[DQK / 16];
#pragma unroll
  for (int d0 = 0; d0 < DQK / 16; ++d0) qf[d0] = *(const bf16x8*)(qp + d0 * 16);
  int nwin = 0, wlo = 0, nt = cap >> 6;
  if (KIND == 1 && smp) { wlo = q0 - 128 < 0 ? 0 : q0 - 128; const int whi = q0 + 256 > 2048 ? 2048 : q0 + 256; nwin = (whi - wlo) >> 6; nt = nwin + 8; }
  const u16* Kn = (const u16*)((const char*)p.out + YS_KN);
  const u16* KR = (const u16*)(p.ws + WS_KROPE);
  const u16* KSW = (const u16*)(p.ws + WS_KSWA);
  const u16* KCc = (const u16*)(p.ws + WS_KC);
  const u16* VT;
  if (KIND == 0) VT = (const u16*)((const char*)p.out + YS_VTMLA) + (size_t)kr0 * 512;
  else if (KIND == 1) VT = (const u16*)(p.ws + WS_VTSWA) + (size_t)kr0 * 128;
  else VT = (const u16*)(p.ws + WS_VTATT) + (size_t)kr0 * 256;
  bf16x8 rk[NKC], rv[NVC];
  int kkey[NKC], kd[NKC];
#pragma unroll
  for (int i = 0; i < NKC; ++i) { const int c = tid + 512 * i; kkey[i] = c / CPR; kd[i] = (c % CPR) * 8; }
  auto kt0_of = [&](int t) -> int { return (KIND == 1 && smp) ? (t < nwin ? wlo + 64 * t : 2048 + 64 * (t - nwin)) : 64 * t; };
  auto gload = [&](int t) {
    const int kt0 = kt0_of(t);
#pragma unroll
    for (int i = 0; i < NKC; ++i) {
      if (tid + 512 * i < KCH) {
        const int g = kt0 + kkey[i], d = kd[i];
        const u16* src;
        if (KIND == 0) src = d < 64 ? Kn + ((size_t)(kr0 + g) * 8 + hkv) * 64 + d : KR + (size_t)(kr0 + g) * 32 + (d - 64);
        else if (KIND == 1) src = KSW + ((size_t)(kr0 + g) * 2 + hkv) * 64 + d;
        else src = g < len ? U1B + (size_t)(tok0 + g) * U1B_LD + C1_KD + hkv * 128 + d : KCc + ((size_t)((s - 16) * 512 + g - 2048) * 2 + hkv) * 128 + d;
        rk[i] = *(const bf16x8*)src;
      }
    }
#pragma unroll
    for (int i = 0; i < NVC; ++i) {
      const int c = tid + 512 * i, dv = c >> 3, kc = c & 7;
      rv[i] = *(const bf16x8*)(VT + (size_t)(hkv * DV + dv) * cap + kt0 + kc * 8);
    }
  };
  auto swrite = [&]() {
#pragma unroll
    for (int i = 0; i < NKC; ++i) if (tid + 512 * i < KCH) *(bf16x8*)(sK + kkey[i] * KS + kd[i]) = rk[i];
#pragma unroll
    for (int i = 0; i < NVC; ++i) { const int c = tid + 512 * i; *(bf16x8*)(sV + (c >> 3) * VS + (c & 7) * 8) = rv[i]; }
  };
  f32x16 o[DV / 32];
#pragma unroll
  for (int db = 0; db < DV / 32; ++db)
#pragma unroll
    for (int r = 0; r < 16; ++r) o[db][r] = 0.f;
  float m = -1e30f, l = 0.f;
  gload(0);
  for (int t = 0; t < nt; ++t) {
    __syncthreads();
    swrite();
    __syncthreads();
    if (t + 1 < nt) gload(t + 1);
    f32x16 s0, s1;
#pragma unroll
    for (int r = 0; r < 16; ++r) { s0[r] = 0.f; s1[r] = 0.f; }
#pragma unroll
    for (int d0 = 0; d0 < DQK / 16; ++d0) {
      const bf16x8 k0 = *(const bf16x8*)(sK + r32 * KS + d0 * 16 + h * 8);
      const bf16x8 k1 = *(const bf16x8*)(sK + (32 + r32) * KS + d0 * 16 + h * 8);
      s0 = MFMA(k0, qf[d0], s0); s1 = MFMA(k1, qf[d0], s1);
    }
    if (KIND == 1 && smp && t < nwin) {
      const int kt0 = kt0_of(t), qi = qrow0 + r32;
#pragma unroll
      for (int r = 0; r < 16; ++r) {
        const int d0 = qi - (kt0 + crow(r, h)), d1 = d0 - 32;
        s0[r] = (d0 <= 128 && d0 >= -128) ? s0[r] : -INFINITY;
        s1[r] = (d1 <= 128 && d1 >= -128) ? s1[r] : -INFINITY;
      }
    }
    float mx = s0[0];
#pragma unroll
    for (int r = 1; r < 16; ++r) mx = fmaxf(mx, s0[r]);
#pragma unroll
    for (int r = 0; r < 16; ++r) mx = fmaxf(mx, s1[r]);
    mx = fmaxf(mx, __shfl_xor(mx, 32));
    const float mnew = fmaxf(m, mx * C);
    const float alpha = __builtin_amdgcn_exp2f(m - mnew);
    m = mnew;
    float ps = 0.f;
#pragma unroll
    for (int r = 0; r < 16; ++r) { s0[r] = __builtin_amdgcn_exp2f(s0[r] * C - mnew); ps += s0[r]; }
#pragma unroll
    for (int r = 0; r < 16; ++r) { s1[r] = __builtin_amdgcn_exp2f(s1[r] * C - mnew); ps += s1[r]; }
    l = l * alpha + ps;
#pragma unroll
    for (int db = 0; db < DV / 32; ++db)
#pragma unroll
      for (int r = 0; r < 16; ++r) o[db][r] *= alpha;
    const bf16x8 pf0 = pack8(s0, 0), pf1 = pack8(s0, 1), pf2 = pack8(s1, 0), pf3 = pack8(s1, 1);
#pragma unroll
    for (int db = 0; db < DV / 32; ++db) {
      const u16* vb = sV + (db * 32 + r32) * VS + h * 8;
      o[db] = MFMA(*(const bf16x8*)(vb), pf0, o[db]);
      o[db] = MFMA(*(const bf16x8*)(vb + 16), pf1, o[db]);
      o[db] = MFMA(*(const bf16x8*)(vb + 32), pf2, o[db]);
      o[db] = MFMA(*(const bf16x8*)(vb + 48), pf3, o[db]);
    }
  }
  float lt = l + __shfl_xor(l, 32);
  if (KIND == 1) lt += __builtin_amdgcn_exp2f(p.swa_sink[hq] * LOG2E - m);
  const float inv = 1.f / lt;
  const u16* zp; u16* op;
  if (KIND == 0) { zp = U0 + (size_t)tok * L0C + C0_ZA + hq * 64; op = (u16*)(p.ws + WS_H) + (size_t)tok * DM + hq * 64; }
  else if (KIND == 1) { zp = U0 + (size_t)tok * L0C + C0_ZB + hq * 64; op = (u16*)(p.ws + WS_H) + (size_t)tok * DM + 512 + hq * 64; }
  else { zp = U1B + (size_t)tok * U1B_LD + C1_ZD + hq * 128; op = (u16*)(p.ws + WS_H) + (size_t)tok * DM + 512 + hq * 128; }
#pragma unroll
  for (int db = 0; db < DV / 32; ++db)
#pragma unroll
    for (int g = 0; g < 4; ++g) {
      const int dv = db * 32 + 8 * g + 4 * h;
      const u32x2 zw = *(const u32x2*)(zp + dv);
      const float z0 = bf2f((u16)(zw[0] & 0xffffu)), z1 = bf2f((u16)(zw[0] >> 16)), z2 = bf2f((u16)(zw[1] & 0xffffu)), z3 = bf2f((u16)(zw[1] >> 16));
      u32x2 w = {pack2(o[db][4 * g] * inv * siluf(z0), o[db][4 * g + 1] * inv * siluf(z1)), pack2(o[db][4 * g + 2] * inv * siluf(z2), o[db][4 * g + 3] * inv * siluf(z3))};
      *(u32x2*)(op + dv) = w;
    }
  __syncthreads();
}

DI void phase_attn0(const Params& p, char* lds) {
  for (int it = blockIdx.x; it < 1280; it += gridDim.x) {
    if (it < 512) { const int s = 16 + (it >> 6), rem = it & 63; attn_item<0>(p, s, rem >> 3, (rem & 7) * 256, lds); }
    else if (it < 1024) { const int j = it - 512; const int s = 16 + (j >> 6), rem = j & 63; attn_item<1>(p, s, rem >> 4, (rem & 15) * 128, lds); }
    else if (it < 1152) { const int j = it - 1024; attn_item<0>(p, j >> 3, j & 7, 0, lds); }
    else { const int j = it - 1152; const int s = j >> 3, rem = j & 7; attn_item<1>(p, s, rem >> 1, (rem & 1) * 128, lds); }
  }
}
DI void phase_attn1(const Params& p, char* lds) {
  for (int it = blockIdx.x; it < 320; it += gridDim.x) {
    if (it < 256) { const int s = 16 + (it >> 5), rem = it & 31; attn_item<2>(p, s, rem >> 4, (rem & 15) * 128, lds); }
    else { const int j = it - 256; const int s = j >> 2, rem = j & 3; attn_item<2>(p, s, rem >> 1, (rem & 1) * 128, lds); }
  }
}

DI float group16_sum(float v) {
#pragma unroll
  for (int o = 8; o > 0; o >>= 1) v += __shfl_xor(v, o);
  return v;
}
DI void phase_l1prep(const Params& p, char* lds) {
  const int tid = TIDX(), lane = tid & 63, wid = tid >> 6;
  const u16* UA = (const u16*)(p.ws + WS_U1A);
  u16* UB = (u16*)(p.ws + WS_U1B);
  u16* QK = (u16*)(p.ws + WS_H);
  u16* VC = (u16*)(p.ws + WS_VC);
  float* GB = (float*)(p.ws + WS_GB);
  const float* AB = (const float*)(p.ws + WS_AB);
  const float2* tabA = (const float2*)(p.ws + WS_ROPE) + 1536;
  u16* sv = (u16*)lds;
  constexpr int N_TOK_ITEMS = NTOK / 16;
  constexpr int N_KC_ITEMS = 256;
  constexpr int N_VC_ITEMS = 256;
  for (int it = blockIdx.x; it < N_TOK_ITEMS + N_KC_ITEMS + N_VC_ITEMS; it += gridDim.x) {
    if (it >= N_TOK_ITEMS + N_KC_ITEMS) {
      const int t = it - N_TOK_ITEMS - N_KC_ITEMS; const int b = t >> 5, g = t & 31;
      {
        const int key = tid >> 5, c8 = (tid & 31) * 8;
        const float* src = p.c_attv + ((size_t)(b * 512 + g * 16 + key)) * 256 + c8;
        const float4 a = *(const float4*)src, b4 = *(const float4*)(src + 4);
        u32x4 w = {pack2(a.x, a.y), pack2(a.z, a.w), pack2(b4.x, b4.y), pack2(b4.z, b4.w)};
        *(u32x4*)(sv + key * 264 + c8) = w;
      }
      __syncthreads();
      vt_store16(sv, 264, 256, (u16*)(p.ws + WS_VTATT) + (size_t)krow0_of(16 + b) * 256, 2560, 2048 + g * 16);
      __syncthreads();
      continue;
    }
    if (it >= N_TOK_ITEMS) {
      const size_t i = (size_t)(it - N_TOK_ITEMS) * 4096 + tid * 8;
      const float4 a = *(const float4*)(p.c_attk + i), b4 = *(const float4*)(p.c_attk + i + 4);
      u32x4 w = {pack2(a.x, a.y), pack2(a.z, a.w), pack2(b4.x, b4.y), pack2(b4.z, b4.w)};
      *(u32x4*)((u16*)(p.ws + WS_KC) + i) = w;
      continue;
    }
    const int m0 = it * 16;
    for (int tt = 0; tt < 2; ++tt) {
      const int ml = wid * 2 + tt, m = m0 + ml;
      const bool ctx = m < NCTX;
      const int pos = pos_of_tok(m), prow = pos >> 6, pcol = pos & 63, len = ctx ? 256 : 2048;
      {
        const u16* r1 = UA + (size_t)m * U1A_LD;
#pragma unroll
        for (int j = 0; j < 3; ++j) {
          const int ch = j * 512 + lane * 8;
          float x0[8], x1[8], x2[8], y[8];
          unpack8(*(const u32x4*)(r1 + ch), x1);
          if (pos > 0) unpack8(*(const u32x4*)(r1 - U1A_LD + ch), x0); else {
#pragma unroll
            for (int e = 0; e < 8; ++e) x0[e] = 0.f; }
          if (pos < len - 1) unpack8(*(const u32x4*)(r1 + U1A_LD + ch), x2); else {
#pragma unroll
            for (int e = 0; e < 8; ++e) x2[e] = 0.f; }
          float ss = 0.f;
#pragma unroll
          for (int e = 0; e < 8; ++e) {
            const float a = p.gdn_conv[ch + e] * x0[e] + p.gdn_conv[1536 + ch + e] * x1[e] + p.gdn_conv[3072 + ch + e] * x2[e];
            y[e] = siluf(a); ss += y[e] * y[e];
          }
          if (j < 2) {
            ss = group16_sum(ss);
            const float rs = rsqrtf(ss + EPS) * (j == 0 ? 0.08838834764831845f : 1.f);
#pragma unroll
            for (int e = 0; e < 8; ++e) y[e] *= rs;
            *(u32x4*)(QK + (size_t)m * DM + j * 512 + lane * 8) = pack8f(y);
          } else {
            *(u32x4*)(VC + (size_t)m * 512 + lane * 8) = pack8f(y);
          }
        }
      }
      if (lane < 16) {
        const float a = AB[(size_t)m * 16 + lane];
        float r;
        if (lane < 8) { const float x = a + p.gdn_dt_bias[lane]; const float sp = x > 20.f ? x : log1pf(expf(x)); r = -expf(p.gdn_a_log[lane]) * sp; }
        else r = 1.f / (1.f + expf(-a));
        GB[(size_t)m * 16 + lane] = r;
      }
      {
        u16* qp = UB + (size_t)m * U1B_LD + C1_QD + lane * 8;
        float x[8], xp[8];
        unpack8(*(const u32x4*)qp, x);
        float ss = 0.f;
#pragma unroll
        for (int e = 0; e < 8; ++e) ss += x[e] * x[e];
        ss = group16_sum(ss);
        const float rs = rsqrtf(ss * (1.f / 128.f) + EPS);
        const int li = lane & 15;
#pragma unroll
        for (int e = 0; e < 8; ++e) x[e] *= rs * p.att_q_norm[li * 8 + e];
        shfl8(x, xp, 4);
        if (!ctx) { const int b32 = li >> 2; rope8(x, xp, tabA, 32, (b32 >= 2) ? pcol : prow, (li & 3) * 8, (b32 & 1) != 0); }
        *(u32x4*)qp = pack8f(x);
      }
      {
        u16* kp = UB + (size_t)m * U1B_LD + C1_KD + (lane & 31) * 8;
        float x[8], xp[8];
        unpack8(*(const u32x4*)kp, x);
        float ss = 0.f;
#pragma unroll
        for (int e = 0; e < 8; ++e) ss += x[e] * x[e];
        ss = group16_sum(ss);
        const float rs = rsqrtf(ss * (1.f / 128.f) + EPS);
        const int li = lane & 15;
#pragma unroll
        for (int e = 0; e < 8; ++e) x[e] *= rs * p.att_k_norm[li * 8 + e];
        if (ctx && lane < 32) {
          *(float4*)(p.out + O_ATTK + (size_t)m * 256 + lane * 8) = make_float4(x[0], x[1], x[2], x[3]);
          *(float4*)(p.out + O_ATTK + (size_t)m * 256 + lane * 8 + 4) = make_float4(x[4], x[5], x[6], x[7]);
        }
        shfl8(x, xp, 4);
        if (!ctx) { const int b32 = li >> 2; rope8(x, xp, tabA, 32, (b32 >= 2) ? pcol : prow, (li & 3) * 8, (b32 & 1) != 0); }
        if (lane < 32) {
          *(u32x4*)kp = pack8f(x);
          const u32x4 vw = *(const u32x4*)(UB + (size_t)m * U1B_LD + C1_VD + lane * 8);
          *(u32x4*)(sv + ml * 264 + lane * 8) = vw;
          if (ctx) {
            float v[8]; unpack8(vw, v);
            *(float4*)(p.out + O_ATTV + (size_t)m * 256 + lane * 8) = make_float4(v[0], v[1], v[2], v[3]);
            *(float4*)(p.out + O_ATTV + (size_t)m * 256 + lane * 8 + 4) = make_float4(v[4], v[5], v[6], v[7]);
          }
        }
      }
    }
    __syncthreads();
    {
      const int s = seq_of_tok(m0);
      vt_store16(sv, 264, 256, (u16*)(p.ws + WS_VTATT) + (size_t)krow0_of(s) * 256, cap_of(s), pos_of_tok(m0));
    }
    __syncthreads();
  }
}

DI void phase_gdnfinal(const Params& p) {
  const int tid_ = TIDX(), lane = tid_ & 63, wid = tid_ >> 6;
  const u16* OF = (const u16*)(p.ws + WS_OF); const u16* OBk = (const u16*)(p.ws + WS_OB);
  const u16* UB = (const u16*)(p.ws + WS_U1B);
  u16* H = (u16*)(p.ws + WS_H);
  for (int m = blockIdx.x * 8 + wid; m < NTOK; m += gridDim.x * 8) {
    float a[8], b[8], z[8];
    unpack8(*(const u32x4*)(OF + (size_t)m * 512 + lane * 8), a);
    unpack8(*(const u32x4*)(OBk + (size_t)m * 512 + lane * 8), b);
    unpack8(*(const u32x4*)(UB + (size_t)m * U1B_LD + C1_ZC + lane * 8), z);
    float ss = 0.f;
#pragma unroll
    for (int e = 0; e < 8; ++e) { a[e] += b[e]; ss += a[e] * a[e]; }
    ss = group16_sum(ss);
    const float rs = rsqrtf(ss * (1.f / 128.f) + EPS);
    const int li = lane & 15;
#pragma unroll
    for (int e = 0; e < 8; ++e) a[e] = a[e] * rs * p.gdn_norm[li * 8 + e] * siluf(z[e]);
    *(u32x4*)(H + (size_t)m * DM + lane * 8) = pack8f(a);
  }
}

DI float dbg_rel(const Params& p);
#ifndef DBG_CHECK
#define DBG_CHECK 0
#endif
#ifndef DBG_AMP
#define DBG_AMP 10.f
#endif
DI void phase_final(const Params& p) {
  const int tid_ = TIDX(), lane = tid_ & 63, wid = tid_ >> 6;
  float dscale = 1.f;
  if (DBG_CHECK) dscale = 1.f + DBG_AMP * dbg_rel(p);
  for (int m = blockIdx.x * 8 + wid; m < NTOK; m += gridDim.x * 8) {
    float* x = p.out + (size_t)m * DM;
    float4 v[4]; float ss = 0.f;
#pragma unroll
    for (int j = 0; j < 4; ++j) { v[j] = *(const float4*)(x + (j * 64 + lane) * 4); ss += v[j].x * v[j].x + v[j].y * v[j].y + v[j].z * v[j].z + v[j].w * v[j].w; }
    ss = wave_sum(ss);
    const float rs = rsqrtf(ss * (1.f / 1024.f) + EPS);
#pragma unroll
    for (int j = 0; j < 4; ++j) {
      const int c = (j * 64 + lane) * 4;
      const float4 g = *(const float4*)(p.ln_f + c);
      const float rr = (DBG_CHECK && m < NCTX) ? rs * dscale : rs;
      *(float4*)(x + c) = make_float4(v[j].x * rr * g.x, v[j].y * rr * g.y, v[j].z * rr * g.z, v[j].w * rr * g.w);
    }
  }
}

template <class F>
DI void ngemm(const GemmA A, const u16* __restrict__ Wt, int ldw, int K, int M, int N, char* lds, F f) {
  u16* sA = (u16*)lds;
  const int tid = TIDX();
  const int ncol = (N + 511) / 512;
  for (int it = blockIdx.x; it < (M / 8) * ncol; it += gridDim.x) {
    const int m0 = (it / ncol) * 8, n = (it % ncol) * 512 + tid;
    __syncthreads();
    for (int i = tid; i < 8 * (K / 8); i += NTHREADS) {
      const int r = i / (K / 8), k8 = (i % (K / 8)) * 8;
      const u16* src = k8 < A.ksplit ? A.p0 + (size_t)(m0 + r) * A.ld0 + k8 : A.p1 + (size_t)(m0 + r) * A.ld1 + (k8 - A.ksplit);
      *(u32x4*)(sA + r * K + k8) = *(const u32x4*)src;
    }
    __syncthreads();
    if (n < N) {
      float acc[8];
#pragma unroll
      for (int r = 0; r < 8; ++r) acc[r] = 0.f;
      for (int k8 = 0; k8 < K; k8 += 8) {
        float w[8]; unpack8(*(const u32x4*)(Wt + (size_t)n * ldw + k8), w);
#pragma unroll
        for (int r = 0; r < 8; ++r) {
          float a[8]; unpack8(*(const u32x4*)(sA + r * K + k8), a);
#pragma unroll
          for (int e = 0; e < 8; ++e) acc[r] += a[e] * w[e];
        }
      }
#pragma unroll
      for (int r = 0; r < 8; ++r) f(m0 + r, n, acc[r]);
    }
  }
}
DI void nphase_inproj0(const Params& p, char* lds) {
  u16* U = (u16*)(p.ws + WS_U); const u16* H = (const u16*)(p.ws + WS_H);
  ngemm(GemmA{H, DM, H, DM, 1 << 30}, (const u16*)(p.ws + WS_WT0), DM, DM, NTOK, L0C, lds, [=](int m, int n, float v) { U[(size_t)m * L0C + n] = f2bf(v); });
}
DI void nphase_l0gemms(const Params& p, char* lds) {
  const u16* U0 = (const u16*)(p.ws + WS_U); const u16* ck = (const u16*)(p.ws + WS_CKVN);
  u16* Kn = (u16*)((char*)p.out + YS_KN); u16* Vt = (u16*)((char*)p.out + YS_VTMLA); u16* Q = (u16*)((char*)p.out + YS_QMLA);
  ngemm(GemmA{ck, 256, ck, 256, 1 << 30}, (const u16*)(p.ws + WS_WUKV), 256, 256, NKROW, 1024, lds, [=](int kr, int n, float v) {
    const int head = n >> 7, within = n & 127;
    if (within < 64) Kn[((size_t)kr * 8 + head) * 64 + within] = f2bf(v);
    else {
      int seq, key;
      if (kr < NCTX) { seq = kr >> 8; key = kr & 255; } else { const int r = kr - NCTX; seq = 16 + r / 2560; key = r % 2560; }
      Vt[(size_t)krow0_of(seq) * 512 + (size_t)(head * 64 + within - 64) * cap_of(seq) + (key & ~15) + swz16(key & 15)] = f2bf(v);
    }
  });
  ngemm(GemmA{U0 + C0_CQ, L0C, U0 + C0_CQ, L0C, 1 << 30}, (const u16*)(p.ws + WS_WUQ), 384, 384, NTOK, 768, lds, [=](int m, int n, float v) { Q[(size_t)m * 768 + n] = f2bf(v); });
}
DI void nphase_qmla_rope(const Params& p) {
  u16* Q = (u16*)((char*)p.out + YS_QMLA);
  const float2* tab = (const float2*)(p.ws + WS_ROPE);
  for (size_t i = (size_t)blockIdx.x * NTHREADS + threadIdx.x; i < (size_t)(NTOK - NCTX) * 8 * 16; i += (size_t)gridDim.x * NTHREADS) {
    const int m = NCTX + (int)(i >> 7), head = (int)(i >> 4) & 7, j = (int)i & 15;
    const int pos = pos_of_tok(m), pp = (j >> 3) ? (pos & 63) : (pos >> 6);
    u16* q = Q + (size_t)m * 768 + head * 96 + 64 + (j >> 3) * 16 + (j & 7);
    const float x1 = bf2f(q[0]), x2 = bf2f(q[8]);
    const float2 cs = tab[pp * 8 + (j & 7)];
    q[0] = f2bf(x1 * cs.x - x2 * cs.y); q[8] = f2bf(x2 * cs.x + x1 * cs.y);
  }
}
DI void nphase_outproj(const Params& p, int layer, char* lds) {
  const u16* H = (const u16*)(p.ws + WS_H);
  const GemmA A{H, DM, H, DM, 1 << 30};
  const float* mod = (const float*)(p.ws + WS_MOD) + (size_t)layer * 9 * 3072 + 2048;
  const Params* pp = &p;
  ngemm(A, (const u16*)(p.ws + (layer ? WS_WO1 : WS_WO0)), DM, DM, NTOK, DM, lds, [=](int m, int n, float v) {
    const float gate = mod[(size_t)modidx_of_tok(m) * 3072 + n];
    const float xv = layer ? pp->out[(size_t)m * DM + n] : xrow(*pp, m)[n];
    pp->out[(size_t)m * DM + n] = xv + gate * v;
  });
}
DI void nphase_inproj1(const Params& p, char* lds) {
  u16* UA = (u16*)(p.ws + WS_U1A); u16* UB = (u16*)(p.ws + WS_U1B); float* AB = (float*)(p.ws + WS_AB);
  const u16* H = (const u16*)(p.ws + WS_H);
  ngemm(GemmA{H, DM, H, DM, 1 << 30}, (const u16*)(p.ws + WS_WT1), DM, DM, NTOK, L1C, lds, [=](int m, int n, float v) {
    if (n < 1536) UA[(size_t)m * U1A_LD + n] = f2bf(v);
    else if (n < 3584) UB[(size_t)m * U1B_LD + n - 1536] = f2bf(v);
    else AB[(size_t)m * 16 + n - 3584] = v;
  });
}

template <int KIND>
DI void nattn(const Params& p) {
  constexpr int DQK = KIND == 0 ? 96 : (KIND == 1 ? 64 : 128);
  constexpr int DV = KIND == 2 ? 128 : 64;
  constexpr int NH = KIND == 2 ? 4 : 8;
  constexpr float SCALE = KIND == 0 ? 0.10206207261596577f : (KIND == 1 ? 0.125f : 0.08838834764831845f);
  const int tid_ = TIDX(), lane = tid_ & 63, wid = tid_ >> 6;
  const u16* U0 = (const u16*)(p.ws + WS_U);
  u16* U1B = (u16*)(p.ws + WS_U1B);
  for (int it = blockIdx.x * 8 + wid; it < NTOK * NH; it += gridDim.x * 8) {
    const int tok = it / NH, hq = it % NH;
    const int s = seq_of_tok(tok), tok0 = tok0_of(s), kr0 = krow0_of(s), cap = cap_of(s), len = len_of(s), qi = tok - tok0;
    const bool smp = s >= 16;
    const int hkv = KIND == 0 ? hq : (KIND == 1 ? hq >> 2 : hq >> 1);
    const u16* qp; const u16* VT;
    if (KIND == 0) { qp = (const u16*)((const char*)p.out + YS_QMLA) + (size_t)tok * 768 + hq * 96; VT = (const u16*)((const char*)p.out + YS_VTMLA) + (size_t)kr0 * 512; }
    else if (KIND == 1) { qp = U0 + (size_t)tok * L0C + C0_QB + hq * 64; VT = (const u16*)(p.ws + WS_VTSWA) + (size_t)kr0 * 128; }
    else { qp = U1B + (size_t)tok * U1B_LD + C1_QD + hq * 128; VT = (const u16*)(p.ws + WS_VTATT) + (size_t)kr0 * 256; }
    const float q0 = bf2f(qp[lane]);
    const float q1 = (DQK > 64 && lane + 64 < DQK) ? bf2f(qp[lane + 64]) : 0.f;
    float m = -1e30f, l = 0.f, o0 = 0.f, o1 = 0.f;
    int glo = 0, ghi = cap >> 4;
    const int nseqg = len >> 4;
    for (int gidx = glo; gidx < ghi; ++gidx) {
      const int g0 = gidx * 16;
      if (KIND == 1 && smp && g0 < 2048) { if (g0 + 15 < qi - 128 || g0 > qi + 128) continue; }
      float sc[16];
#pragma unroll
      for (int j = 0; j < 16; ++j) {
        const int g = g0 + j;
        const u16* kp;
        float part;
        if (KIND == 0) {
          const u16* kn = (const u16*)((const char*)p.out + YS_KN) + ((size_t)(kr0 + g) * 8 + hkv) * 64;
          const u16* kr = (const u16*)(p.ws + WS_KROPE) + (size_t)(kr0 + g) * 32;
          part = q0 * bf2f(kn[lane]) + (lane < 32 ? q1 * bf2f(kr[lane]) : 0.f);
        } else if (KIND == 1) {
          kp = (const u16*)(p.ws + WS_KSWA) + ((size_t)(kr0 + g) * 2 + hkv) * 64;
          part = q0 * bf2f(kp[lane]);
        } else {
          kp = g < len ? U1B + (size_t)(tok0 + g) * U1B_LD + C1_KD + hkv * 128 : (const u16*)(p.ws + WS_KC) + ((size_t)((s - 16) * 512 + g - 2048) * 2 + hkv) * 128;
          part = q0 * bf2f(kp[lane]) + q1 * bf2f(kp[lane + 64]);
        }
        float sv_ = wave_sum(part) * SCALE;
        if (KIND == 1 && smp && g < 2048) { const int d = qi - g; if (d > 128 || d < -128) sv_ = -INFINITY; }
        sc[j] = sv_;
      }
      float mx = sc[0];
#pragma unroll
      for (int j = 1; j < 16; ++j) mx = fmaxf(mx, sc[j]);
      const float mnew = fmaxf(m, mx);
      const float alpha = __expf(m - mnew);
      m = mnew; l *= alpha; o0 *= alpha; o1 *= alpha;
      const u32x4 va = *(const u32x4*)(VT + (size_t)(hkv * DV + lane) * cap + g0), vb = *(const u32x4*)(VT + (size_t)(hkv * DV + lane) * cap + g0 + 8);
      float v0[16]; { float t8[8]; unpack8(va, t8); for (int e = 0; e < 8; ++e) v0[e] = t8[e]; unpack8(vb, t8); for (int e = 0; e < 8; ++e) v0[8 + e] = t8[e]; }
      float v1[16];
      if (DV > 64) {
        const u32x4 vc = *(const u32x4*)(VT + (size_t)(hkv * DV + 64 + lane) * cap + g0), vd = *(const u32x4*)(VT + (size_t)(hkv * DV + 64 + lane) * cap + g0 + 8);
        float t8[8]; unpack8(vc, t8); for (int e = 0; e < 8; ++e) v1[e] = t8[e]; unpack8(vd, t8); for (int e = 0; e < 8; ++e) v1[8 + e] = t8[e];
      }
#pragma unroll
      for (int j = 0; j < 16; ++j) {
        const float pj = __expf(sc[j] - mnew);
        l += pj;
        o0 += pj * v0[swz16(j)];
        if (DV > 64) o1 += pj * v1[swz16(j)];
      }
    }
    (void)nseqg; (void)glo;
    if (KIND == 1) l += __expf(p.swa_sink[hq] - m);
    const float inv = 1.f / l;
    if (KIND == 0) { const float z = bf2f(U0[(size_t)tok * L0C + C0_ZA + hq * 64 + lane]); ((u16*)(p.ws + WS_H))[(size_t)tok * DM + hq * 64 + lane] = f2bf(o0 * inv * siluf(z)); }
    else if (KIND == 1) { const float z = bf2f(U0[(size_t)tok * L0C + C0_ZB + hq * 64 + lane]); ((u16*)(p.ws + WS_H))[(size_t)tok * DM + 512 + hq * 64 + lane] = f2bf(o0 * inv * siluf(z)); }
    else {
      const float z0 = bf2f(U1B[(size_t)tok * U1B_LD + C1_ZD + hq * 128 + lane]), z1 = bf2f(U1B[(size_t)tok * U1B_LD + C1_ZD + hq * 128 + 64 + lane]);
      ((u16*)(p.ws + WS_H))[(size_t)tok * DM + 512 + hq * 128 + lane] = f2bf(o0 * inv * siluf(z0));
      ((u16*)(p.ws + WS_H))[(size_t)tok * DM + 512 + hq * 128 + 64 + lane] = f2bf(o1 * inv * siluf(z1));
    }
  }
}

DI void nphase_gdn(const Params& p, char* lds) {
  const int tid = TIDX();
  float* sq = (float*)lds; float* sk = sq + 128;
  const u16* QK = (const u16*)(p.ws + WS_H); const u16* VC = (const u16*)(p.ws + WS_VC); const float* GB = (const float*)(p.ws + WS_GB);
  for (int it = blockIdx.x; it < 192; it += gridDim.x) {
    int s, head, dir;
    if (it < 64) { s = 16 + (it >> 3); head = (it >> 1) & 3; dir = it & 1; } else { const int j = it - 64; s = j >> 3; head = (j >> 1) & 3; dir = j & 1; }
    const int tok0 = tok0_of(s), T = len_of(s);
    u16* O = (u16*)(p.ws + (dir ? WS_OB : WS_OF));
    float S[128];
    if (tid < 128) {
      if (s >= 16) {
        const float* st = p.c_state + ((size_t)(((s - 16) * 2 + dir) * 4 + head)) * 16384;
#pragma unroll
        for (int d = 0; d < 128; ++d) S[d] = st[d * 128 + tid];
      } else {
#pragma unroll
        for (int d = 0; d < 128; ++d) S[d] = 0.f;
      }
    }
    for (int tau = 0; tau < T; ++tau) {
      const int m = tok0 + (dir ? T - 1 - tau : tau);
      __syncthreads();
      if (tid < 128) { sq[tid] = bf2f(QK[(size_t)m * DM + head * 128 + tid]); sk[tid] = bf2f(QK[(size_t)m * DM + 512 + head * 128 + tid]); }
      __syncthreads();
      if (tid < 128) {
        const float g = GB[(size_t)m * 16 + dir * 4 + head], beta = GB[(size_t)m * 16 + 8 + dir * 4 + head];
        const float alpha = __expf(g);
        const float v = bf2f(VC[(size_t)m * 512 + head * 128 + tid]);
        float r = 0.f;
#pragma unroll
        for (int c = 0; c < 16; ++c) {
          const float4 ka = *(const float4*)(sk + c * 8), kb = *(const float4*)(sk + c * 8 + 4);
          r += ka.x * S[c * 8] + ka.y * S[c * 8 + 1] + ka.z * S[c * 8 + 2] + ka.w * S[c * 8 + 3] + kb.x * S[c * 8 + 4] + kb.y * S[c * 8 + 5] + kb.z * S[c * 8 + 6] + kb.w * S[c * 8 + 7];
          asm volatile("" ::: "memory");
        }
        const float dd = beta * (v - alpha * r);
        float o = 0.f;
#pragma unroll
        for (int c = 0; c < 16; ++c) {
          const float4 ka = *(const float4*)(sk + c * 8), kb = *(const float4*)(sk + c * 8 + 4);
          const float4 qa = *(const float4*)(sq + c * 8), qb = *(const float4*)(sq + c * 8 + 4);
          const float kk[8] = {ka.x, ka.y, ka.z, ka.w, kb.x, kb.y, kb.z, kb.w};
          const float qq[8] = {qa.x, qa.y, qa.z, qa.w, qb.x, qb.y, qb.z, qb.w};
#pragma unroll
          for (int e = 0; e < 8; ++e) { S[c * 8 + e] = alpha * S[c * 8 + e] + kk[e] * dd; o += qq[e] * S[c * 8 + e]; }
          asm volatile("" ::: "memory");
        }
        O[(size_t)m * 512 + head * 128 + tid] = f2bf(o);
      }
    }
    if (tid < 128 && s < 16) {
      float* st = p.out + O_STATE + ((size_t)((s * 2 + dir) * 4 + head)) * 16384;
#pragma unroll
      for (int d = 0; d < 128; ++d) st[d * 128 + tid] = S[d];
    }
    __syncthreads();
  }
}


DI bf16x8 afrag(const u16* base, int stride, int row, int kbase, int h) {
  const bf16x4 lo = *(const bf16x4*)(base + row * stride + kbase + 4 * h);
  const bf16x4 hi = *(const bf16x4*)(base + row * stride + kbase + 8 + 4 * h);
  return cat4(lo, hi);
}
DI void phase_chunkprep(const Params& p, char* lds) {
  const int tid = TIDX(), lane = tid & 63, wid = tid >> 6, r32 = lane & 31, h = lane >> 5;
  u16* sq = (u16*)lds; u16* sk = sq + 64 * 136;
  float* Lt = (float*)(sk + 64 * 136);
  float* gcd = Lt + 2 * 64 * 68;
  float* bet = gcd + 128;
  const u16* QK = (const u16*)(p.ws + WS_H); const float* GB = (const float*)(p.ws + WS_GB);
  const int dir = wid >> 2, wq = wid & 3;
  for (int it = blockIdx.x; it < 320 * 4; it += gridDim.x) {
    const int cgi = it >> 2, head = it & 3, tok0 = cgi * 64;
    const int oz = opaque_zero();
    const int tid = threadIdx.x + oz, lane = tid & 63, r32 = lane & 31, h = lane >> 5;
    __syncthreads();
#pragma unroll
    for (int i = 0; i < 4; ++i) {
      const int c = tid + 512 * i, which = c >> 10, cc = c & 1023, row = cc >> 4, d8 = (cc & 15) * 8;
      const u32x4 w = *(const u32x4*)(QK + (size_t)(tok0 + row) * DM + which * 512 + head * 128 + d8);
      *(u32x4*)((which ? sk : sq) + row * 136 + d8) = w;
    }
    if (wq == 0) {
      const float g = GB[(size_t)(tok0 + lane) * 16 + dir * 4 + head];
      float pre = g;
#pragma unroll
      for (int o = 1; o < 64; o <<= 1) { const float t = __shfl_up(pre, o); if (lane >= o) pre += t; }
      const float tot = __shfl(pre, 63);
      gcd[dir * 64 + lane] = dir ? (tot - pre + g) : pre;
      bet[dir * 64 + lane] = GB[(size_t)(tok0 + lane) * 16 + 8 + dir * 4 + head];
    }
    __syncthreads();
    const size_t tm = ((size_t)(cgi * 4 + head) * 2 + dir) * 4096;
    {
      const int ib = wq >> 1, jb = wq & 1;
      const bool skipL = dir ? (ib == 1 && jb == 0) : (ib == 0 && jb == 1);
      f32x16 kk, qk;
#pragma unroll
      for (int r = 0; r < 16; ++r) { kk[r] = 0.f; qk[r] = 0.f; }
#pragma unroll
      for (int s = 0; s < 8; ++s) {
        const bf16x8 ka = *(const bf16x8*)(sk + (32 * ib + r32) * 136 + 16 * s + 8 * h);
        const bf16x8 kb = *(const bf16x8*)(sk + (32 * jb + r32) * 136 + 16 * s + 8 * h);
        const bf16x8 qb = *(const bf16x8*)(sq + (32 * jb + r32) * 136 + 16 * s + 8 * h);
        kk = MFMA(ka, kb, kk);
        qk = MFMA(ka, qb, qk);
      }
      const float* gc = gcd + dir * 64; const float* be = bet + dir * 64;
      if (!skipL) {
        const int b = 32 * jb + r32; const float gb = gc[b];
        float* Ls = Lt + dir * 64 * 68;
#pragma unroll
        for (int r = 0; r < 16; ++r) {
          const int a = 32 * ib + crow(r, h);
          const bool valid = dir ? (b > a) : (b < a);
          const float v = valid ? be[a] * kk[r] * __expf(gc[a] - gb) : 0.f;
          if (dir == 0) Ls[a * 68 + b] = v; else Ls[(63 - a) * 68 + (63 - b)] = v;
        }
      }
      {
        u16* AM = (u16*)(p.ws + WS_AM) + tm;
        const int a = 32 * jb + r32; const float ga = gc[a];
#pragma unroll
        for (int g4 = 0; g4 < 4; ++g4) {
          const int b0 = 32 * ib + 8 * g4 + 4 * h;
          float v[4];
#pragma unroll
          for (int j = 0; j < 4; ++j) {
            const int b = b0 + j;
            const bool valid = dir ? (b >= a) : (b <= a);
            v[j] = valid ? qk[4 * g4 + j] * __expf(ga - gc[b]) : 0.f;
          }
          u32x2 w = {pack2(v[0], v[1]), pack2(v[2], v[3])};
          *(u32x2*)(AM + a * 64 + b0) = w;
        }
      }
    }
    __syncthreads();
    if (wq == 0) {
      const float* L = Lt + dir * 64 * 68;
      float T[64];
#pragma unroll
      for (int c = 0; c < 64; ++c) T[c] = (lane == c) ? 1.f : 0.f;
#pragma unroll
      for (int c = 63; c >= 1; --c) {
        const float tc = T[c];
#pragma unroll
        for (int c4 = 0; c4 < c; c4 += 4) {
          const float4 l4 = *(const float4*)(L + c * 68 + c4);
          T[c4] -= tc * l4.x;
          if (c4 + 1 < c) T[c4 + 1] -= tc * l4.y;
          if (c4 + 2 < c) T[c4 + 2] -= tc * l4.z;
          if (c4 + 3 < c) T[c4 + 3] -= tc * l4.w;
        }
        asm volatile("" ::: "memory");
      }
      u16* TB = (u16*)(p.ws + WS_TB) + tm;
      const int arow = dir ? 63 - lane : lane;
      const float* be = bet + dir * 64;
#pragma unroll
      for (int b8 = 0; b8 < 8; ++b8) {
        float o[8];
#pragma unroll
        for (int e = 0; e < 8; ++e) { const int b = b8 * 8 + e; o[e] = (dir ? T[63 - b] : T[b]) * be[b]; }
        *(u32x4*)(TB + arow * 64 + b8 * 8) = pack8f(o);
      }
    }
  }
}

DI void phase_scan(const Params& p, char* lds) {
  const int tid = TIDX(), lane = tid & 63, wid = tid >> 6, r32 = lane & 31, h = lane >> 5;
  u16* sq = (u16*)lds; u16* sk = sq + 64 * 136; u16* skT = sk + 64 * 136; u16* sv = skT + 128 * 72; u16* sTb = sv + 64 * 136; u16* sA = sTb + 64 * 72;
  float* vec = (float*)(sA + 64 * 72);
  const u16* QK = (const u16*)(p.ws + WS_H); const u16* VC = (const u16*)(p.ws + WS_VC); const float* GB = (const float*)(p.ws + WS_GB);
  for (int it = blockIdx.x; it < 192; it += gridDim.x) {
    int s, head, dir;
    if (it < 64) { s = 16 + (it >> 3); head = (it >> 1) & 3; dir = it & 1; } else { const int j = it - 64; s = j >> 3; head = (j >> 1) & 3; dir = j & 1; }
    const int tokS = tok0_of(s), nch = len_of(s) >> 6;
    u16* O = (u16*)(p.ws + (dir ? WS_OB : WS_OF));
    const int e0 = 32 * (wid & 3);
    f32x16 S[4];
    if (wid < 4) {
      if (s >= 16) {
        const float* st = p.c_state + ((size_t)(((s - 16) * 2 + dir) * 4 + head)) * 16384;
#pragma unroll
        for (int db = 0; db < 4; ++db)
#pragma unroll
          for (int r = 0; r < 16; ++r) S[db][r] = st[(32 * db + crow(r, h)) * 128 + e0 + r32];
      } else {
#pragma unroll
        for (int db = 0; db < 4; ++db)
#pragma unroll
          for (int r = 0; r < 16; ++r) S[db][r] = 0.f;
      }
    }
    u32x4 rg[8]; float r_egc = 0.f, r_dl = 0.f, r_eg = 0.f;
    auto prefetch = [&](int step) {
      const int tid = TIDX(), lane = tid & 63, wid = tid >> 6;
      const int ch = dir ? nch - 1 - step : step;
      const int tok0 = tokS + ch * 64;
      const size_t tm = ((size_t)((tok0 >> 6) * 4 + head) * 2 + dir) * 4096;
#pragma unroll
      for (int i = 0; i < 6; ++i) {
        const int c = tid + 512 * (i & 1), row = c >> 4, d8 = (c & 15) * 8;
        const u16* src = (i < 2) ? QK + (size_t)(tok0 + row) * DM + head * 128 + d8 : (i < 4) ? QK + (size_t)(tok0 + row) * DM + 512 + head * 128 + d8 : VC + (size_t)(tok0 + row) * 512 + head * 128 + d8;
        rg[i] = *(const u32x4*)src;
      }
      rg[6] = *(const u32x4*)((const u16*)(p.ws + WS_TB) + tm + (tid >> 3) * 64 + (tid & 7) * 8);
      rg[7] = *(const u32x4*)((const u16*)(p.ws + WS_AM) + tm + (tid >> 3) * 64 + (tid & 7) * 8);
      if (wid == 7) {
        const float g = GB[(size_t)(tok0 + lane) * 16 + dir * 4 + head];
        float pre = g;
#pragma unroll
        for (int o = 1; o < 64; o <<= 1) { const float t = __shfl_up(pre, o); if (lane >= o) pre += t; }
        const float tot = __shfl(pre, 63);
        const float gc = dir ? (tot - pre + g) : pre;
        r_egc = __expf(gc); r_dl = __expf(tot - gc); r_eg = __expf(tot);
      }
    };
    prefetch(0);
    for (int step = 0; step < nch; ++step) {
      const int ch = dir ? nch - 1 - step : step;
      const int tok0 = tokS + ch * 64;
      __syncthreads();
      {
      const int tid = TIDX(), lane = tid & 63, wid = tid >> 6;
#pragma unroll
      for (int i = 0; i < 6; ++i) {
        const int c = tid + 512 * (i & 1), row = c >> 4, d8 = (c & 15) * 8;
        u16* dst = (i < 2) ? sq : (i < 4) ? sk : sv;
        *(u32x4*)(dst + row * 136 + d8) = rg[i];
        if (i >= 2 && i < 4) {
#pragma unroll
          for (int e = 0; e < 4; ++e) { skT[(d8 + 2 * e) * 72 + row] = (u16)(rg[i][e] & 0xffffu); skT[(d8 + 2 * e + 1) * 72 + row] = (u16)(rg[i][e] >> 16); }
        }
      }
      *(u32x4*)(sTb + (tid >> 3) * 72 + (tid & 7) * 8) = rg[6];
      *(u32x4*)(sA + (tid >> 3) * 72 + (tid & 7) * 8) = rg[7];
      if (wid == 7) { vec[lane] = r_egc; vec[64 + lane] = r_dl; if (lane == 0) vec[128] = r_eg; }
      }
      __syncthreads();
      if (step + 1 < nch) prefetch(step + 1);
      if (wid < 4) {
        const int oz = opaque_zero();
        const int lane = (threadIdx.x + oz) & 63, r32 = lane & 31, h = lane >> 5;
        f32x16 VN[2];
        {
          f32x16 KS[2];
#pragma unroll
          for (int ib = 0; ib < 2; ++ib)
#pragma unroll
            for (int r = 0; r < 16; ++r) { KS[ib][r] = 0.f; VN[ib][r] = 0.f; }
#pragma unroll
          for (int db = 0; db < 4; ++db)
#pragma unroll
            for (int s2 = 0; s2 < 2; ++s2) {
              const bf16x8 sb = pack8(S[db], s2);
#pragma unroll
              for (int ib = 0; ib < 2; ++ib) KS[ib] = MFMA(afrag(sk, 136, 32 * ib + r32, 32 * db + 16 * s2, h), sb, KS[ib]);
            }
#pragma unroll
          for (int ib = 0; ib < 2; ++ib)
#pragma unroll
            for (int r = 0; r < 16; ++r) {
              const int i = 32 * ib + crow(r, h);
              KS[ib][r] = bf2f(sv[i * 136 + e0 + r32]) - vec[i] * KS[ib][r];
            }
#pragma unroll
          for (int ib = 0; ib < 2; ++ib)
#pragma unroll
            for (int s2 = 0; s2 < 2; ++s2) {
              const bf16x8 xb = pack8(KS[ib], s2);
#pragma unroll
              for (int i2 = 0; i2 < 2; ++i2) VN[i2] = MFMA(afrag(sTb, 72, 32 * i2 + r32, 32 * ib + 16 * s2, h), xb, VN[i2]);
            }
        }
        {
          f32x16 Oa[2];
#pragma unroll
          for (int ib = 0; ib < 2; ++ib)
#pragma unroll
            for (int r = 0; r < 16; ++r) Oa[ib][r] = 0.f;
#pragma unroll
          for (int db = 0; db < 4; ++db)
#pragma unroll
            for (int s2 = 0; s2 < 2; ++s2) {
              const bf16x8 sb = pack8(S[db], s2);
#pragma unroll
              for (int ib = 0; ib < 2; ++ib) Oa[ib] = MFMA(afrag(sq, 136, 32 * ib + r32, 32 * db + 16 * s2, h), sb, Oa[ib]);
            }
#pragma unroll
          for (int ib = 0; ib < 2; ++ib)
#pragma unroll
            for (int r = 0; r < 16; ++r) Oa[ib][r] *= vec[32 * ib + crow(r, h)];
#pragma unroll
          for (int ib = 0; ib < 2; ++ib)
#pragma unroll
            for (int s2 = 0; s2 < 2; ++s2) {
              const bf16x8 vb = pack8(VN[ib], s2);
#pragma unroll
              for (int i2 = 0; i2 < 2; ++i2) Oa[i2] = MFMA(afrag(sA, 72, 32 * i2 + r32, 32 * ib + 16 * s2, h), vb, Oa[i2]);
            }
#pragma unroll
          for (int ib = 0; ib < 2; ++ib)
#pragma unroll
            for (int r = 0; r < 16; ++r) O[(size_t)(tok0 + 32 * ib + crow(r, h)) * 512 + head * 128 + e0 + r32] = f2bf(Oa[ib][r]);
        }
        const float eg = vec[128];
#pragma unroll
        for (int db = 0; db < 4; ++db)
#pragma unroll
          for (int r = 0; r < 16; ++r) S[db][r] *= eg;
#pragma unroll
        for (int ib = 0; ib < 2; ++ib) {
#pragma unroll
          for (int r = 0; r < 16; ++r) VN[ib][r] *= vec[64 + 32 * ib + crow(r, h)];
#pragma unroll
          for (int s2 = 0; s2 < 2; ++s2) {
            const bf16x8 vb = pack8(VN[ib], s2);
#pragma unroll
            for (int db = 0; db < 4; ++db) S[db] = MFMA(afrag(skT, 72, 32 * db + r32, 32 * ib + 16 * s2, h), vb, S[db]);
          }
        }
      }
    }
    if (wid < 4 && s < 16) {
      float* st = p.out + O_STATE + ((size_t)((s * 2 + dir) * 4 + head)) * 16384;
#pragma unroll
      for (int db = 0; db < 4; ++db)
#pragma unroll
        for (int r = 0; r < 16; ++r) st[(32 * db + crow(r, h)) * 128 + e0 + r32] = S[db][r];
    }
    __syncthreads();
  }
}

#ifndef DBG_CHECK
#define DBG_CHECK 0
#endif
#ifndef DBG_AMP
#define DBG_AMP 10.f
#endif
constexpr size_t WS_DBG = WS_END;
DI void fingerprint(const Params& p, const void* buf, size_t n, bool isf32, int slot, char* lds) {
  float acc[9];
#pragma unroll
  for (int k = 0; k < 9; ++k) acc[k] = 0.f;
  for (size_t i = (size_t)blockIdx.x * NTHREADS + threadIdx.x; i < n; i += (size_t)gridDim.x * NTHREADS) {
    const float x = isf32 ? ((const float*)buf)[i] : bf2f(((const u16*)buf)[i]);
    unsigned hsh = (unsigned)i * 0x9E3779B1u; hsh ^= hsh >> 15; hsh *= 0x85EBCA77u; hsh ^= hsh >> 13;
#pragma unroll
    for (int k = 0; k < 8; ++k) acc[k] += ((hsh >> k) & 1u) ? x : -x;
    acc[8] += x * x;
  }
  float* red = (float*)lds;
  __syncthreads();
#pragma unroll
  for (int k = 0; k < 9; ++k) { const float v = wave_sum(acc[k]); if ((threadIdx.x & 63) == 0) red[(threadIdx.x >> 6) * 9 + k] = v; }
  __syncthreads();
  if (threadIdx.x < 9) {
    float v = 0.f;
    for (int w = 0; w < 8; ++w) v += red[w * 9 + threadIdx.x];
    ((float*)(p.ws + WS_DBG))[((size_t)slot * 256 + blockIdx.x) * 16 + threadIdx.x] = v;
  }
  __syncthreads();
}
DI float dbg_rel(const Params& p) {
  const float* d = (const float*)(p.ws + WS_DBG);
  float fn[9], ff[9];
#pragma unroll
  for (int k = 0; k < 9; ++k) { fn[k] = 0.f; ff[k] = 0.f; }
  for (int b = 0; b < (int)gridDim.x; ++b)
#pragma unroll
    for (int k = 0; k < 9; ++k) { fn[k] += d[((size_t)b) * 16 + k]; ff[k] += d[((size_t)256 + b) * 16 + k]; }
  float s = 0.f;
#pragma unroll
  for (int k = 0; k < 8; ++k) s += (ff[k] - fn[k]) * (ff[k] - fn[k]);
  return sqrtf(s * 0.125f / fn[8]);
}

extern __shared__ __attribute__((aligned(16))) char smem[];
constexpr int LDS_BYTES = 98304;

#ifndef FAST_MASK
#define FAST_MASK 255
#endif
#define GSYNC() grid.sync()

__global__ void __launch_bounds__(NTHREADS) fwd_megakernel(Params p) {
  cg::grid_group grid = cg::this_grid();
  char* lds = smem;
  phase_prep(p, lds);
  GSYNC();
  phase_adaln(p, 0);
  GSYNC();
  if (FAST_MASK & 1) phase_inproj0(p, lds); else nphase_inproj0(p, lds);
  GSYNC();
  phase_l0prep(p, lds);
  GSYNC();
#if DBG_CHECK == 1
  nphase_l0gemms(p, lds); GSYNC(); nphase_qmla_rope(p); GSYNC();
  fingerprint(p, p.out, (YS_VTMLA + 25165824) / 2, false, 0, lds); GSYNC();
  phase_l0gemms(p, lds); GSYNC();
  fingerprint(p, p.out, (YS_VTMLA + 25165824) / 2, false, 1, lds);
#else
  if (FAST_MASK & 2) phase_l0gemms(p, lds); else { nphase_l0gemms(p, lds); GSYNC(); nphase_qmla_rope(p); }
#endif
  GSYNC();
#if DBG_CHECK == 2
  nattn<0>(p); nattn<1>(p); GSYNC();
  fingerprint(p, p.ws + WS_H, (size_t)NTOK * DM, false, 0, lds); GSYNC();
  phase_attn0(p, lds); GSYNC();
  fingerprint(p, p.ws + WS_H, (size_t)NTOK * DM, false, 1, lds);
#else
  if (FAST_MASK & 4) phase_attn0(p, lds); else { nattn<0>(p); nattn<1>(p); }
#endif
  GSYNC();
#if DBG_CHECK == 3
  nphase_outproj(p, 0, lds); GSYNC();
  fingerprint(p, p.out, (size_t)NTOK * DM, true, 0, lds); GSYNC();
  phase_outproj(p, 0, lds); GSYNC();
  fingerprint(p, p.out, (size_t)NTOK * DM, true, 1, lds);
#else
  if (FAST_MASK & 8) phase_outproj(p, 0, lds); else nphase_outproj(p, 0, lds);
#endif
  GSYNC();
  phase_adaln(p, 1);
  GSYNC();
  if (FAST_MASK & 16) phase_inproj1(p, lds); else nphase_inproj1(p, lds);
  GSYNC();
  phase_l1prep(p, lds);
  GSYNC();
#if DBG_CHECK == 5
  nphase_gdn(p, lds); GSYNC();
  fingerprint(p, p.ws + WS_OF, (size_t)NTOK * 512, false, 0, lds); GSYNC();
  phase_chunkprep(p, lds); GSYNC();
  phase_scan(p, lds); GSYNC();
  fingerprint(p, p.ws + WS_OF, (size_t)NTOK * 512, false, 1, lds);
#elif DBG_CHECK == 6
  nphase_gdn(p, lds); GSYNC();
  fingerprint(p, p.ws + WS_OB, (size_t)NTOK * 512, false, 0, lds); GSYNC();
  phase_chunkprep(p, lds); GSYNC();
  phase_scan(p, lds); GSYNC();
  fingerprint(p, p.ws + WS_OB, (size_t)NTOK * 512, false, 1, lds);
#else
  if (FAST_MASK & 32) { phase_chunkprep(p, lds); GSYNC(); phase_scan(p, lds); } else nphase_gdn(p, lds);
#endif
  GSYNC();
  phase_gdnfinal(p);
#if DBG_CHECK == 4
  nattn<2>(p); GSYNC();
  fingerprint(p, p.ws + WS_H, (size_t)NTOK * DM, false, 0, lds); GSYNC();
  phase_attn1(p, lds); GSYNC();
  fingerprint(p, p.ws + WS_H, (size_t)NTOK * DM, false, 1, lds);
#else
  if (FAST_MASK & 64) phase_attn1(p, lds); else nattn<2>(p);
#endif
  GSYNC();
  if (FAST_MASK & 128) phase_outproj(p, 1, lds); else nphase_outproj(p, 1, lds);
  GSYNC();
  phase_final(p);
}

extern "C" void kernel_launch(void* const* d_in, const int* in_sizes, int n_in, void* d_out, int out_size, void* d_ws, size_t ws_size, hipStream_t stream) {
  static int grid_blocks = 0;
  if (!grid_blocks) {
    int dev = 0, cus = 0, per_cu = 0;
    (void)hipGetDevice(&dev);
    (void)hipDeviceGetAttribute(&cus, hipDeviceAttributeMultiprocessorCount, dev);
    (void)hipFuncSetAttribute((const void*)fwd_megakernel, hipFuncAttributeMaxDynamicSharedMemorySize, LDS_BYTES);
    (void)hipOccupancyMaxActiveBlocksPerMultiprocessor(&per_cu, fwd_megakernel, NTHREADS, LDS_BYTES);
    if (per_cu > 1) per_cu = 1;
    grid_blocks = cus * per_cu;
    if (grid_blocks <= 0) { fprintf(stderr, "occupancy query failed (cus %d per_cu %d)\n", cus, per_cu); grid_blocks = 0; return; }
  }
  if (n_in != 33 || ws_size < WS_END + 65536) { fprintf(stderr, "kernel_launch: unexpected n_in %d / ws %zu\n", n_in, ws_size); return; }
  Params p{};
  const float** pp = (const float**)&p;
  for (int i = 0; i < 33; ++i) pp[i] = (const float*)d_in[i];
  p.out = (float*)d_out;
  p.ws = (char*)d_ws;
  void* args[] = {&p};
  hipError_t e = hipLaunchCooperativeKernel((void*)fwd_megakernel, dim3(grid_blocks), dim3(NTHREADS), args, LDS_BYTES, stream);
  if (e != hipSuccess) fprintf(stderr, "cooperative launch failed: %s (grid %d)\n", hipGetErrorString(e), grid_blocks);
}
```

```cpp
#include <hip/hip_runtime.h>
#include <hip/hip_cooperative_groups.h>
#include <cstdio>
#include <cstdint>
namespace cg = cooperative_groups;

#define DI __device__ __forceinline__
typedef unsigned short u16;
using bf16x8 = __attribute__((ext_vector_type(8))) short;
using bf16x4 = __attribute__((ext_vector_type(4))) short;
using f32x16 = __attribute__((ext_vector_type(16))) float;
using f32x4  = __attribute__((ext_vector_type(4))) float;
using u32x4  = __attribute__((ext_vector_type(4))) unsigned;
using u32x2  = __attribute__((ext_vector_type(2))) unsigned;

#ifndef PHASE_LIMIT
#define PHASE_LIMIT 99
#endif

constexpr int NTHREADS = 512;
constexpr int DM = 1024, NTOK = 20480, NCTX = 4096, NKROW = 24576;
constexpr int L0C = 2464, L0CP = 2560, L1C = 3600, L1CP = 3712;
constexpr int U1A_LD = 1536, U1B_LD = 2048;
constexpr int C0_CQ = 0, C0_CKV = 384, C0_KR = 640, C0_ZA = 672, C0_QB = 1184, C0_KB = 1696, C0_VB = 1824, C0_ZB = 1952;
constexpr int C1_ZC = 0, C1_QD = 512, C1_KD = 1024, C1_VD = 1280, C1_ZD = 1536;
constexpr float EPS = 1e-6f;
constexpr float LOG2E = 1.4426950408889634f;

constexpr size_t O_Y = 0;
constexpr size_t O_CKV = 20971520, O_KROPE = 22020096, O_SWAK = 22151168, O_SWAV = 22675456, O_STATE = 23199744, O_ATTK = 25296896, O_ATTV = 26345472;

constexpr size_t WS_WO1 = 0;
constexpr size_t WS_MOD = WS_WO1 + 2097152;
constexpr size_t WS_ROPE = WS_MOD + 221184;
constexpr size_t WS_W2 = WS_ROPE + 32768;
constexpr size_t WS_WT0 = WS_W2;
constexpr size_t WS_WUQ = WS_WT0 + 5242880;
constexpr size_t WS_WUKV = WS_WUQ + 589824;
constexpr size_t WS_WO0 = WS_WUKV + 524288;
constexpr size_t WS_WT1 = WS_WO0 + 2097152;
constexpr size_t WS_W2_END = WS_WT1 + 7602176;
constexpr size_t WS_VTATT = WS_W2;
constexpr size_t WS_KC = WS_VTATT + 12582912;
constexpr size_t WS_GB = WS_KC + 2097152;
static_assert(WS_GB + 1310720 <= WS_W2_END, "layer-1 reuse overflow");
constexpr size_t WS_H = WS_W2_END;
constexpr size_t WS_U = WS_H + 41943040;
constexpr size_t WS_U0X = WS_U + (size_t)NTOK * L0C * 2;
constexpr size_t WS_KSWA = WS_U0X;
constexpr size_t WS_VTSWA = WS_KSWA + 6291456;
constexpr size_t WS_CKVN = WS_VTSWA + 6291456;
constexpr size_t WS_KROPE = WS_CKVN + 12582912;
static_assert(WS_KROPE + 1572864 <= WS_U + 147456000, "layer-0 extras overflow");
constexpr size_t WS_U1A = WS_U;
constexpr size_t WS_U1B = WS_U + 62914560;
constexpr size_t WS_TB = WS_U1A;
constexpr size_t WS_AM = WS_TB + 20971520;
constexpr size_t WS_OB = WS_AM + 20971520;
constexpr size_t WS_X = WS_U + 147456000;
constexpr size_t WS_VC = WS_X;
constexpr size_t WS_OF = WS_VC + 20971520;
constexpr size_t WS_AB = WS_OF + 20971520;
constexpr size_t WS_END = WS_AB + 1310720;
static_assert(WS_END <= 268435456ull, "ws overflow");
constexpr size_t WS_BAR = WS_END;
constexpr size_t YS_QMLA = 0;
constexpr size_t YS_KN = YS_QMLA + 31457280;
constexpr size_t YS_VTMLA = YS_KN + 25165824;
static_assert(YS_VTMLA + 25165824 <= (size_t)NTOK * DM * 4, "y scratch overflow");

struct Params {
  const float *x_prompt, *x_sample, *c_ckv, *c_krope, *c_swak, *c_swav, *c_state, *c_attk, *c_attv, *c, *c_ctx;
  const float *w_mod0, *b_mod0, *ln0, *w_in0, *mla_q_norm, *w_uq, *mla_kv_norm, *w_ukv, *swa_sink, *w_out0;
  const float *w_mod1, *b_mod1, *ln1, *w_in1, *gdn_conv, *gdn_a_log, *gdn_dt_bias, *gdn_norm, *att_q_norm, *att_k_norm, *w_out1, *ln_f;
  float* out;
  char* ws;
};

DI int opaque_zero() { int z = 0; asm volatile("" : "+v"(z)); return z; }
#define TIDX() ((int)threadIdx.x + opaque_zero())
DI float bf2f(u16 b) { return __uint_as_float(((unsigned)b) << 16); }
DI u16 f2bf(float x) { unsigned u = __float_as_uint(x); u += 0x7fffu + ((u >> 16) & 1u); return (u16)(u >> 16); }
DI unsigned pack2(float lo, float hi) { unsigned r; asm volatile("v_cvt_pk_bf16_f32 %0, %1, %2" : "=v"(r) : "v"(lo), "v"(hi)); return r; }
DI int crow(int reg, int h) { return (reg & 3) + 8 * (reg >> 2) + 4 * h; }
DI int swz16(int k) { return (k & ~12) | ((k & 4) << 1) | ((k & 8) >> 1); }
DI float siluf(float x) { return x / (1.f + __expf(-x)); }
DI int seq_of_tok(int m) { return m < NCTX ? (m >> 8) : 16 + ((m - NCTX) >> 11); }
DI int tok0_of(int s) { return s < 16 ? s * 256 : NCTX + (s - 16) * 2048; }
DI int krow0_of(int s) { return s < 16 ? s * 256 : NCTX + (s - 16) * 2560; }
DI int cap_of(int s) { return s < 16 ? 256 : 2560; }
DI int len_of(int s) { return s < 16 ? 256 : 2048; }
DI int modidx_of_tok(int m) { return m < NCTX ? 0 : 1 + ((m - NCTX) >> 11); }
DI int krow_of_tok(int m) { return m < NCTX ? m : NCTX + ((m - NCTX) >> 11) * 2560 + ((m - NCTX) & 2047); }
DI int pos_of_tok(int m) { return m < NCTX ? (m & 255) : ((m - NCTX) & 2047); }
DI const float* xrow(const Params& p, int m) { return m < NCTX ? p.x_prompt + (size_t)m * DM : p.x_sample + (size_t)(m - NCTX) * DM; }
DI float wave_sum(float v) {
#pragma unroll
  for (int o = 32; o > 0; o >>= 1) v += __shfl_xor(v, o);
  return v;
}
DI bf16x8 pack8(const f32x16& x, int s) {
  u32x4 w = {pack2(x[8 * s + 0], x[8 * s + 1]), pack2(x[8 * s + 2], x[8 * s + 3]), pack2(x[8 * s + 4], x[8 * s + 5]), pack2(x[8 * s + 6], x[8 * s + 7])};
  return __builtin_bit_cast(bf16x8, w);
}
DI bf16x8 cat4(bf16x4 lo, bf16x4 hi) { return __builtin_shufflevector(lo, hi, 0, 1, 2, 3, 4, 5, 6, 7); }
#define MFMA(a, b, c) __builtin_amdgcn_mfma_f32_32x32x16_bf16((a), (b), (c), 0, 0, 0)

DI void transpose_tile(const float* __restrict__ W, int ldw, int k0, int srccol0, int nvalid, u16* __restrict__ Wt, int ldt, int dstrow0, char* lds) {
  u16* t = (u16*)lds;
  const int tid = TIDX(), kr = tid >> 3, cc = (tid & 7) * 8;
  float v[8];
  if (cc < nvalid) {
    const float4 a = *(const float4*)(W + (size_t)(k0 + kr) * ldw + srccol0 + cc);
    const float4 b = *(const float4*)(W + (size_t)(k0 + kr) * ldw + srccol0 + cc + 4);
    v[0] = a.x; v[1] = a.y; v[2] = a.z; v[3] = a.w; v[4] = b.x; v[5] = b.y; v[6] = b.z; v[7] = b.w;
  } else {
#pragma unroll
    for (int e = 0; e < 8; ++e) v[e] = 0.f;
  }
#pragma unroll
  for (int e = 0; e < 8; ++e) t[(cc + e) * 72 + kr] = f2bf(v[e]);
  __syncthreads();
  const int n = tid >> 3, kc = (tid & 7) * 8;
  *(bf16x8*)(Wt + (size_t)(dstrow0 + n) * ldt + k0 + kc) = *(const bf16x8*)(t + n * 72 + kc);
  __syncthreads();
}

DI void vt_store16(const u16* sv, int CS, int C, u16* __restrict__ vt, size_t cap, int key16base) {
  for (int i = threadIdx.x; i < C * 4; i += NTHREADS) {
    const int ch = i >> 2, q = i & 3;
    u16 e[4];
#pragma unroll
    for (int j = 0; j < 4; ++j) e[j] = sv[swz16(q * 4 + j) * CS + ch];
    u32x2 w = {(unsigned)e[0] | ((unsigned)e[1] << 16), (unsigned)e[2] | ((unsigned)e[3] << 16)};
    *(u32x2*)(vt + (size_t)ch * cap + key16base + q * 4) = w;
  }
}

DI void phase_prep(const Params& p, char* lds) {
  const int tid = TIDX();
  constexpr int N_MOD = 192;
  constexpr int T_IN0 = 16 * 40, T_UQ = 6 * 12, T_UKV = 4 * 16, T_O0 = 256, T_IN1 = 16 * 58, T_O1 = 256;
  constexpr int N_TR = T_IN0 + T_UQ + T_UKV + T_O0 + T_IN1 + T_O1;
  constexpr int N_CV = 256 + 32 + 128;
  constexpr int N_VT = 256;
  constexpr int N_ITEMS = N_MOD + N_TR + N_CV + N_VT + 1;
  for (int it = blockIdx.x; it < N_ITEMS; it += gridDim.x) {
    if (it < N_MOD) {
      const int layer = it / 96, col0 = (it % 96) * 32;
      const float* Wm = layer ? p.w_mod1 : p.w_mod0;
      const float* bm = layer ? p.b_mod1 : p.b_mod0;
      float* sc = (float*)lds;
      float* red = sc + 9 * 1024;
      for (int i = tid; i < 9 * 1024; i += NTHREADS) {
        const int s = i >> 10, k = i & 1023;
        const float cv = s == 0 ? p.c_ctx[k] : p.c[(s - 1) * 1024 + k];
        sc[i] = siluf(cv);
      }
      __syncthreads();
      const int col = tid & 31, kg = tid >> 5;
      float acc[9];
#pragma unroll
      for (int s = 0; s < 9; ++s) acc[s] = 0.f;
      for (int kk = 0; kk < 64; ++kk) {
        const int k = kg * 64 + kk;
        const float w = Wm[(size_t)k * 3072 + col0 + col];
#pragma unroll
        for (int s = 0; s < 9; ++s) acc[s] += sc[s * 1024 + k] * w;
      }
#pragma unroll
      for (int s = 0; s < 9; ++s) red[(kg * 9 + s) * 32 + col] = acc[s];
      __syncthreads();
      if (tid < 288) {
        const int s = tid >> 5, c2 = tid & 31;
        float a = bm[col0 + c2];
        for (int g = 0; g < 16; ++g) a += red[(g * 9 + s) * 32 + c2];
        ((float*)(p.ws + WS_MOD))[(size_t)(layer * 9 + s) * 3072 + col0 + c2] = a;
      }
      __syncthreads();
    } else if (it < N_MOD + N_TR) {
      int t = it - N_MOD;
      if (t < T_IN0) { const int kt = t / 40, nt = t % 40; int nv = L0C - nt * 64; nv = nv < 0 ? 0 : (nv > 64 ? 64 : nv);
        transpose_tile(p.w_in0, L0C, kt * 64, nt * 64, nv, (u16*)(p.ws + WS_WT0), 1024, nt * 64, lds); continue; }
      t -= T_IN0;
      if (t < T_UQ) { const int kt = t / 12, nt = t % 12; transpose_tile(p.w_uq, 768, kt * 64, nt * 64, 64, (u16*)(p.ws + WS_WUQ), 384, nt * 64, lds); continue; }
      t -= T_UQ;
      if (t < T_UKV) { const int kt = t / 16, nt = t % 16; transpose_tile(p.w_ukv, 1024, kt * 64, nt * 64, 64, (u16*)(p.ws + WS_WUKV), 256, nt * 64, lds); continue; }
      t -= T_UKV;
      if (t < T_O0) { const int kt = t / 16, nt = t % 16; transpose_tile(p.w_out0, 1024, kt * 64, nt * 64, 64, (u16*)(p.ws + WS_WO0), 1024, nt * 64, lds); continue; }
      t -= T_O0;
      if (t < T_IN1) { const int kt = t / 58, nt = t % 58; const int n0 = nt * 64; int src, nv;
        if (n0 < 1536) { src = n0; nv = 64; } else if (n0 < 3584) { src = n0 + 16; nv = 64; } else if (n0 == 3584) { src = 1536; nv = 16; } else { src = 0; nv = 0; }
        transpose_tile(p.w_in1, L1C, kt * 64, src, nv, (u16*)(p.ws + WS_WT1), 1024, n0, lds); continue; }
      t -= T_IN1;
      { const int kt = t / 16, nt = t % 16; transpose_tile(p.w_out1, 1024, kt * 64, nt * 64, 64, (u16*)(p.ws + WS_WO1), 1024, nt * 64, lds); }
    } else if (it < N_MOD + N_TR + N_CV) {
      int t = it - N_MOD - N_TR;
      const int e0 = tid * 8;
      if (t < 256) {
        const size_t i = (size_t)t * 4096 + e0; const int b = (int)(i >> 17), rem = (int)(i & 131071), pp = rem >> 8, cc = rem & 255;
        const float4 a = *(const float4*)(p.c_ckv + i), b4 = *(const float4*)(p.c_ckv + i + 4);
        u32x4 w = {pack2(a.x, a.y), pack2(a.z, a.w), pack2(b4.x, b4.y), pack2(b4.z, b4.w)};
        *(u32x4*)((u16*)(p.ws + WS_CKVN) + (size_t)(NCTX + b * 2560 + 2048 + pp) * 256 + cc) = w;
      } else if (t < 288) {
        const size_t i = (size_t)(t - 256) * 4096 + e0; const int b = (int)(i >> 14), rem = (int)(i & 16383), pp = rem >> 5, cc = rem & 31;
        const float4 a = *(const float4*)(p.c_krope + i), b4 = *(const float4*)(p.c_krope + i + 4);
        u32x4 w = {pack2(a.x, a.y), pack2(a.z, a.w), pack2(b4.x, b4.y), pack2(b4.z, b4.w)};
        *(u32x4*)((u16*)(p.ws + WS_KROPE) + (size_t)(NCTX + b * 2560 + 2048 + pp) * 32 + cc) = w;
      } else {
        const size_t i = (size_t)(t - 288) * 4096 + e0; const int b = (int)(i >> 16), rem = (int)(i & 65535), pp = rem >> 7, cc = rem & 127;
        const float4 a = *(const float4*)(p.c_swak + i), b4 = *(const float4*)(p.c_swak + i + 4);
        u32x4 w = {pack2(a.x, a.y), pack2(a.z, a.w), pack2(b4.x, b4.y), pack2(b4.z, b4.w)};
        *(u32x4*)((u16*)(p.ws + WS_KSWA) + (size_t)(NCTX + b * 2560 + 2048 + pp) * 128 + cc) = w;
      }
    } else if (it < N_MOD + N_TR + N_CV + N_VT) {
      const int t = it - N_MOD - N_TR - N_CV; const int b = t >> 5, g = t & 31;
      u16* sv = (u16*)lds;
      {
        const int key = tid >> 5, c4 = (tid & 31) * 4;
        const float4 a = *(const float4*)(p.c_swav + ((size_t)(b * 512 + g * 16 + key)) * 128 + c4);
        u32x2 w = {pack2(a.x, a.y), pack2(a.z, a.w)};
        *(u32x2*)(sv + key * 136 + c4) = w;
      }
      __syncthreads();
      vt_store16(sv, 136, 128, (u16*)(p.ws + WS_VTSWA) + (size_t)krow0_of(16 + b) * 128, 2560, 2048 + g * 16);
      __syncthreads();
    } else {
      float2* tab = (float2*)(p.ws + WS_ROPE);
      for (int i = tid; i < 64 * 8 + 64 * 16 + 64 * 32; i += NTHREADS) {
        int q, pos, f, j = i;
        if (j < 512) { q = 8; } else if (j < 1536) { q = 16; j -= 512; } else { q = 32; j -= 1536; }
        pos = j / q; f = j % q;
        const float inv = powf(10000.f, -(float)f / (float)q);
        const float ang = (float)pos * inv;
        tab[i] = make_float2(cosf(ang), sinf(ang));
      }
    }
  }
}

DI void phase_adaln(const Params& p, int layer) {
  const int tid_ = TIDX(), lane = tid_ & 63, wid = tid_ >> 6;
  const float* ln = layer ? p.ln1 : p.ln0;
  const float* mod = (const float*)(p.ws + WS_MOD) + (size_t)layer * 9 * 3072;
  u16* H = (u16*)(p.ws + WS_H);
  for (int m = blockIdx.x * 8 + wid; m < NTOK; m += gridDim.x * 8) {
    const float* x = layer ? (p.out + (size_t)m * DM) : xrow(p, m);
    const float* md = mod + (size_t)modidx_of_tok(m) * 3072;
    float4 v[4]; float ss = 0.f;
#pragma unroll
    for (int j = 0; j < 4; ++j) { v[j] = *(const float4*)(x + (j * 64 + lane) * 4); ss += v[j].x * v[j].x + v[j].y * v[j].y + v[j].z * v[j].z + v[j].w * v[j].w; }
    ss = wave_sum(ss);
    const float rs = rsqrtf(ss * (1.f / 1024.f) + EPS);
#pragma unroll
    for (int j = 0; j < 4; ++j) {
      const int c = (j * 64 + lane) * 4;
      const float4 g = *(const float4*)(ln + c), sh = *(const float4*)(md + c), scl = *(const float4*)(md + 1024 + c);
      const float a0 = v[j].x * rs * g.x * (1.f + scl.x) + sh.x, a1 = v[j].y * rs * g.y * (1.f + scl.y) + sh.y;
      const float a2 = v[j].z * rs * g.z * (1.f + scl.z) + sh.z, a3 = v[j].w * rs * g.w * (1.f + scl.w) + sh.w;
      u32x2 w = {pack2(a0, a1), pack2(a2, a3)};
      *(u32x2*)(H + (size_t)m * DM + c) = w;
    }
  }
}

struct GemmA { const u16* p0; int ld0; const u16* p1; int ld1; int ksplit; };
constexpr int G_LDS_A = 256 * 72 * 2;
template <class Epi>
DI void gemm_tile(const GemmA A, const u16* __restrict__ B, int ldb, int K, int m0, int n0, char* lds, Epi& epi) {
  u16* sA = (u16*)lds; u16* sB = (u16*)(lds + G_LDS_A);
  const int tid = TIDX(), lane = tid & 63, wid = tid >> 6, r32 = lane & 31, h = lane >> 5;
  const int wm = wid >> 1, wn = wid & 1;
  const int lr = tid >> 3, lc = (tid & 7) * 8;
  f32x16 acc[2][2];
#pragma unroll
  for (int i = 0; i < 2; ++i)
#pragma unroll
    for (int j = 0; j < 2; ++j)
#pragma unroll
      for (int r = 0; r < 16; ++r) acc[i][j][r] = 0.f;
  bf16x8 ra[4], rb[2];
  const int nk = K >> 6;
  auto gload = [&](int kt) {
    const int k0 = kt * 64;
    const u16* ap; int lda, kk;
    if (k0 < A.ksplit) { ap = A.p0; lda = A.ld0; kk = k0; } else { ap = A.p1; lda = A.ld1; kk = k0 - A.ksplit; }
#pragma unroll
    for (int i = 0; i < 4; ++i) ra[i] = *(const bf16x8*)(ap + (size_t)(m0 + lr + 64 * i) * lda + kk + lc);
#pragma unroll
    for (int i = 0; i < 2; ++i) rb[i] = *(const bf16x8*)(B + (size_t)(n0 + lr + 64 * i) * ldb + k0 + lc);
  };
  gload(0);
  for (int kt = 0; kt < nk; ++kt) {
    __syncthreads();
#pragma unroll
    for (int i = 0; i < 4; ++i) *(bf16x8*)(sA + (lr + 64 * i) * 72 + lc) = ra[i];
#pragma unroll
    for (int i = 0; i < 2; ++i) *(bf16x8*)(sB + (lr + 64 * i) * 72 + lc) = rb[i];
    __syncthreads();
    if (kt + 1 < nk) gload(kt + 1);
#pragma unroll
    for (int ks = 0; ks < 4; ++ks) {
      bf16x8 a0 = *(const bf16x8*)(sA + (wm * 64 + r32) * 72 + ks * 16 + h * 8);
      bf16x8 a1 = *(const bf16x8*)(sA + (wm * 64 + 32 + r32) * 72 + ks * 16 + h * 8);
      bf16x8 b0 = *(const bf16x8*)(sB + (wn * 64 + r32) * 72 + ks * 16 + h * 8);
      bf16x8 b1 = *(const bf16x8*)(sB + (wn * 64 + 32 + r32) * 72 + ks * 16 + h * 8);
      acc[0][0] = MFMA(a0, b0, acc[0][0]); acc[0][1] = MFMA(a0, b1, acc[0][1]);
      acc[1][0] = MFMA(a1, b0, acc[1][0]); acc[1][1] = MFMA(a1, b1, acc[1][1]);
    }
  }
#pragma unroll
  for (int i = 0; i < 2; ++i)
#pragma unroll
    for (int j = 0; j < 2; ++j) epi(acc[i][j], m0 + wm * 64 + i * 32, n0 + wn * 64 + j * 32 + r32, h);
}

struct EpiU0 {
  u16* U;
  DI void operator()(const f32x16& a, int row0, int col, int h) const {
    if (col < L0C) {
#pragma unroll
      for (int r = 0; r < 16; ++r) U[(size_t)(row0 + crow(r, h)) * L0C + col] = f2bf(a[r]);
    }
  }
};
struct EpiQmla {
  u16* Q; const float2* tab;
  DI void operator()(const f32x16& a, int f0, int tok, int h) const {
    float v[16];
#pragma unroll
    for (int r = 0; r < 16; ++r) v[r] = a[r];
    if ((f0 % 96) == 64 && tok >= NCTX) {
      const int pos = pos_of_tok(tok), prow = pos >> 6, pcol = pos & 63;
#pragma unroll
      for (int j = 0; j < 4; ++j) {
        const int fi = 4 * h + j;
        const float2 cr = tab[prow * 8 + fi], cc = tab[pcol * 8 + fi];
        const float x1 = v[j], x2 = v[4 + j];
        v[j] = x1 * cr.x - x2 * cr.y; v[4 + j] = x2 * cr.x + x1 * cr.y;
        const float y1 = v[8 + j], y2 = v[12 + j];
        v[8 + j] = y1 * cc.x - y2 * cc.y; v[12 + j] = y2 * cc.x + y1 * cc.y;
      }
    }
#pragma unroll
    for (int g = 0; g < 4; ++g) {
      u32x2 w = {pack2(v[4 * g], v[4 * g + 1]), pack2(v[4 * g + 2], v[4 * g + 3])};
      *(u32x2*)(Q + (size_t)tok * 768 + f0 + 8 * g + 4 * h) = w;
    }
  }
};
struct EpiKvexp {
  u16* Kn; u16* Vt;
  DI void operator()(const f32x16& a, int kr0, int n, int h) const {
    const int head = n >> 7, within = n & 127;
    if (within < 64) {
#pragma unroll
      for (int r = 0; r < 16; ++r) Kn[((size_t)(kr0 + crow(r, h)) * 8 + head) * 64 + within] = f2bf(a[r]);
    } else {
      int seq, key0;
      if (kr0 < NCTX) { seq = kr0 >> 8; key0 = kr0 & 255; } else { const int r = kr0 - NCTX; seq = 16 + r / 2560; key0 = r % 2560; }
      const size_t cap = cap_of(seq);
      u16* base = Vt + (size_t)krow0_of(seq) * 512 + (size_t)(head * 64 + within - 64) * cap;
#pragma unroll
      for (int g = 0; g < 4; ++g) {
        const int pos = key0 + 16 * (g >> 1) + 8 * h + 4 * (g & 1);
        u32x2 w = {pack2(a[4 * g], a[4 * g + 1]), pack2(a[4 * g + 2], a[4 * g + 3])};
        *(u32x2*)(base + pos) = w;
      }
    }
  }
};
struct EpiOut {
  const Params* p; int layer;
  DI void operator()(const f32x16& a, int row0, int col, int h) const {
    const float* mod = (const float*)(p->ws + WS_MOD) + (size_t)(layer * 9 + modidx_of_tok(row0)) * 3072 + 2048;
    const float gate = mod[col];
#pragma unroll
    for (int r = 0; r < 16; ++r) {
      const int m = row0 + crow(r, h);
      const float xv = layer ? p->out[(size_t)m * DM + col] : xrow(*p, m)[col];
      p->out[(size_t)m * DM + col] = xv + gate * a[r];
    }
  }
};
struct EpiU1 {
  u16* UA; u16* UB; float* AB;
  DI void operator()(const f32x16& a, int row0, int col, int h) const {
    if (col < 1536) {
#pragma unroll
      for (int r = 0; r < 16; ++r) UA[(size_t)(row0 + crow(r, h)) * U1A_LD + col] = f2bf(a[r]);
    } else if (col < 3584) {
#pragma unroll
      for (int r = 0; r < 16; ++r) UB[(size_t)(row0 + crow(r, h)) * U1B_LD + col - 1536] = f2bf(a[r]);
    } else if (col < 3600) {
#pragma unroll
      for (int r = 0; r < 16; ++r) AB[(size_t)(row0 + crow(r, h)) * 16 + col - 3584] = a[r];
    }
  }
};

DI void phase_inproj0(const Params& p, char* lds) {
  EpiU0 epi{(u16*)(p.ws + WS_U)};
  const u16* H = (const u16*)(p.ws + WS_H);
  const GemmA A{H, DM, H, DM, 1 << 30};
  for (int it = blockIdx.x; it < 80 * 20; it += gridDim.x) {
    const int mt = it / 20, nt = it % 20;
    gemm_tile(A, (const u16*)(p.ws + WS_WT0), DM, DM, mt * 256, nt * 128, lds, epi);
  }
}
DI void phase_l0gemms(const Params& p, char* lds) {
  const u16* U0 = (const u16*)(p.ws + WS_U);
  EpiKvexp ek{(u16*)((char*)p.out + YS_KN), (u16*)((char*)p.out + YS_VTMLA)};
  EpiQmla eq{(u16*)((char*)p.out + YS_QMLA), (const float2*)(p.ws + WS_ROPE)};
  const u16* ck = (const u16*)(p.ws + WS_CKVN);
  const u16* wq = (const u16*)(p.ws + WS_WUQ);
  const GemmA Ak{ck, 256, ck, 256, 1 << 30};
  const GemmA Aq{wq, 384, wq, 384, 1 << 30};
  for (int it = blockIdx.x; it < 768 + 480; it += gridDim.x) {
    if (it < 768) { const int mt = it >> 3, nt = it & 7; gemm_tile(Ak, (const u16*)(p.ws + WS_WUKV), 256, 256, mt * 256, nt * 128, lds, ek); }
    else { const int t = it - 768; const int mt = t % 3, nt = t / 3; gemm_tile(Aq, U0 + C0_CQ, L0C, 384, mt * 256, nt * 128, lds, eq); }
  }
}
DI void phase_outproj(const Params& p, int layer, char* lds) {
  EpiOut epi{&p, layer};
  const u16* H = (const u16*)(p.ws + WS_H);
  const GemmA A{H, DM, H, DM, 1 << 30};
  const u16* W = (const u16*)(p.ws + (layer ? WS_WO1 : WS_WO0));
  for (int it = blockIdx.x; it < 80 * 8; it += gridDim.x) {
    const int mt = it >> 3, nt = it & 7;
    gemm_tile(A, W, DM, DM, mt * 256, nt * 128, lds, epi);
  }
}
DI void phase_inproj1(const Params& p, char* lds) {
  EpiU1 epi{(u16*)(p.ws + WS_U1A), (u16*)(p.ws + WS_U1B), (float*)(p.ws + WS_AB)};
  const u16* H = (const u16*)(p.ws + WS_H);
  const GemmA A{H, DM, H, DM, 1 << 30};
  for (int it = blockIdx.x; it < 80 * 29; it += gridDim.x) {
    const int mt = it / 29, nt = it % 29;
    gemm_tile(A, (const u16*)(p.ws + WS_WT1), DM, DM, mt * 256, nt * 128, lds, epi);
  }
}

DI void rope8(float (&x)[8], const float (&xp)[8], const float2* tab, int q, int pp, int fi0, bool is_x2) {
#pragma unroll
  for (int e = 0; e < 8; ++e) {
    const float2 cs = tab[pp * q + fi0 + e];
    x[e] = is_x2 ? (x[e] * cs.x + xp[e] * cs.y) : (x[e] * cs.x - xp[e] * cs.y);
  }
}
DI void unpack8(const u32x4 w, float (&x)[8]) {
#pragma unroll
  for (int i = 0; i < 4; ++i) { x[2 * i] = bf2f((u16)(w[i] & 0xffffu)); x[2 * i + 1] = bf2f((u16)(w[i] >> 16)); }
}
DI u32x4 pack8f(const float (&x)[8]) { u32x4 w = {pack2(x[0], x[1]), pack2(x[2], x[3]), pack2(x[4], x[5]), pack2(x[6], x[7])}; return w; }
DI void shfl8(const float (&x)[8], float (&xp)[8], int mask) {
#pragma unroll
  for (int e = 0; e < 8; ++e) xp[e] = __shfl_xor(x[e], mask);
}

DI void phase_l0prep(const Params& p, char* lds) {
  const int tid = TIDX(), lane = tid & 63, wid = tid >> 6;
  u16* U0 = (u16*)(p.ws + WS_U);
  u16* sv = (u16*)lds;
  const float2* tabM = (const float2*)(p.ws + WS_ROPE);
  const float2* tabS = tabM + 512;
  u16* CKVN = (u16*)(p.ws + WS_CKVN); u16* KROPE = (u16*)(p.ws + WS_KROPE); u16* KSWA = (u16*)(p.ws + WS_KSWA);
  for (int it = blockIdx.x; it < NTOK / 16; it += gridDim.x) {
    const int m0 = it * 16;
    for (int tt = 0; tt < 2; ++tt) {
      const int ml = wid * 2 + tt, m = m0 + ml;
      u16* row = U0 + (size_t)m * L0C;
      const bool ctx = m < NCTX;
      const int pos = pos_of_tok(m), prow = pos >> 6, pcol = pos & 63, krow = krow_of_tok(m);
      {
        float lo[3], hi[3], ss = 0.f;
#pragma unroll
        for (int j = 0; j < 3; ++j) { const unsigned w = *(const unsigned*)(row + C0_CQ + 128 * j + 2 * lane); lo[j] = bf2f((u16)(w & 0xffffu)); hi[j] = bf2f((u16)(w >> 16)); ss += lo[j] * lo[j] + hi[j] * hi[j]; }
        ss = wave_sum(ss);
        const float rs = rsqrtf(ss * (1.f / 384.f) + EPS);
#pragma unroll
        for (int j = 0; j < 3; ++j) { const int c = 128 * j + 2 * lane; *(unsigned*)(row + C0_CQ + c) = pack2(lo[j] * rs * p.mla_q_norm[c], hi[j] * rs * p.mla_q_norm[c + 1]); }
      }
      {
        const u32x2 w = *(const u32x2*)(row + C0_CKV + 4 * lane);
        float x[4] = {bf2f((u16)(w[0] & 0xffffu)), bf2f((u16)(w[0] >> 16)), bf2f((u16)(w[1] & 0xffffu)), bf2f((u16)(w[1] >> 16))};
        float ss = x[0] * x[0] + x[1] * x[1] + x[2] * x[2] + x[3] * x[3];
        ss = wave_sum(ss);
        const float rs = rsqrtf(ss * (1.f / 256.f) + EPS);
        const float4 g = *(const float4*)(p.mla_kv_norm + 4 * lane);
        x[0] *= rs * g.x; x[1] *= rs * g.y; x[2] *= rs * g.z; x[3] *= rs * g.w;
        u32x2 o = {pack2(x[0], x[1]), pack2(x[2], x[3])};
        *(u32x2*)(CKVN + (size_t)krow * 256 + 4 * lane) = o;
        if (ctx) *(float4*)(p.out + O_CKV + (size_t)m * 256 + 4 * lane) = make_float4(x[0], x[1], x[2], x[3]);
      }
      {
        const float x = bf2f(row[C0_KR + (lane & 31)]);
        const float xp = __shfl_xor(x, 8);
        float val = x;
        if (!ctx) {
          const int half = (lane >> 4) & 1, within = lane & 15, fi = lane & 7;
          const float2 cs = tabM[(half ? pcol : prow) * 8 + fi];
          val = within < 8 ? (x * cs.x - xp * cs.y) : (x * cs.x + xp * cs.y);
        }
        if (lane < 32) {
          KROPE[(size_t)krow * 32 + lane] = f2bf(val);
          if (ctx) p.out[O_KROPE + (size_t)m * 32 + lane] = x;
        }
      }
      if (!ctx) {
        float x[8], xp[8];
        unpack8(*(const u32x4*)(row + C0_QB + lane * 8), x);
        shfl8(x, xp, 2);
        const int b16 = (lane & 7) >> 1;
        rope8(x, xp, tabS, 16, (b16 >= 2) ? pcol : prow, (lane & 1) * 8, (b16 & 1) != 0);
        *(u32x4*)(row + C0_QB + lane * 8) = pack8f(x);
      }
      {
        float x[8], xp[8];
        unpack8(*(const u32x4*)(row + C0_KB + (lane & 15) * 8), x);
        if (ctx && lane < 16) {
          *(float4*)(p.out + O_SWAK + (size_t)m * 128 + lane * 8) = make_float4(x[0], x[1], x[2], x[3]);
          *(float4*)(p.out + O_SWAK + (size_t)m * 128 + lane * 8 + 4) = make_float4(x[4], x[5], x[6], x[7]);
        }
        shfl8(x, xp, 2);
        if (!ctx) {
          const int b16 = (lane & 7) >> 1;
          rope8(x, xp, tabS, 16, (b16 >= 2) ? pcol : prow, (lane & 1) * 8, (b16 & 1) != 0);
        }
        if (lane < 16) *(u32x4*)(KSWA + (size_t)krow * 128 + lane * 8) = pack8f(x);
        if (lane < 16) {
          const u32x4 vw = *(const u32x4*)(row + C0_VB + lane * 8);
          *(u32x4*)(sv + ml * 136 + lane * 8) = vw;
          if (ctx) {
            float v[8]; unpack8(vw, v);
            *(float4*)(p.out + O_SWAV + (size_t)m * 128 + lane * 8) = make_float4(v[0], v[1], v[2], v[3]);
            *(float4*)(p.out + O_SWAV + (size_t)m * 128 + lane * 8 + 4) = make_float4(v[4], v[5], v[6], v[7]);
          }
        }
      }
    }
    __syncthreads();
    {
      const int s = seq_of_tok(m0);
      vt_store16(sv, 136, 128, (u16*)(p.ws + WS_VTSWA) + (size_t)krow0_of(s) * 128, cap_of(s), pos_of_tok(m0));
    }
    __syncthreads();
  }
}

template <int KIND>
DI void attn_item(const Params& p, int s, int hsel, int q0, char* lds) {
  constexpr int DQK = KIND == 0 ? 96 : (KIND == 1 ? 64 : 128);
  constexpr int DV = KIND == 2 ? 128 : 64;
  constexpr int KS = DQK + 8, VS = 72;
  constexpr int CPR = DQK / 8;
  constexpr int KCH = 64 * CPR, NKC = (KCH + 511) / 512;
  constexpr int VCH = DV * 8, NVC = VCH / 512;
  constexpr float SCALE = KIND == 0 ? 0.10206207261596577f : (KIND == 1 ? 0.125f : 0.08838834764831845f);
  constexpr float C = SCALE * LOG2E;
  const int tid = TIDX(), lane = tid & 63, wid = tid >> 6, r32 = lane & 31, h = lane >> 5;
  u16* sK = (u16*)lds; u16* sV = sK + 64 * KS;
  const int tok0 = tok0_of(s), kr0 = krow0_of(s), cap = cap_of(s), len = len_of(s);
  const bool smp = s >= 16;
  int hq, hkv, qrow0;
  if (KIND == 0) { hq = hsel; hkv = hsel; qrow0 = q0 + 32 * wid; }
  else if (KIND == 1) { hkv = hsel >> 1; hq = hkv * 4 + (hsel & 1) * 2 + (wid >> 2); qrow0 = q0 + 32 * (wid & 3); }
  else { hkv = hsel; hq = hkv * 2 + (wid >> 2); qrow0 = q0 + 32 * (wid & 3); }
  const int tok = tok0 + qrow0 + r32;
  const u16* U0 = (const u16*)(p.ws + WS_U);
  u16* U1B = (u16*)(p.ws + WS_U1B);
  const u16* qp;
  if (KIND == 0) qp = (const u16*)((const char*)p.out + YS_QMLA) + (size_t)tok * 768 + hq * 96 + h * 8;
  else if (KIND == 1) qp = U0 + (size_t)tok * L0C + C0_QB + hq * 64 + h * 8;
  else qp = U1B + (size_t)tok * U1B_LD + C1_QD + hq * 128 + h * 8;
  bf16x8 qf[DQK / 16];
#pragma unroll
  for (int d0 = 0; d0 < DQK / 16; ++d0) qf[d0] = *(const bf16x8*)(qp + d0 * 16);
  int nwin = 0, wlo = 0, nt = cap >> 6;
  if (KIND == 1 && smp) { wlo = q0 - 128 < 0 ? 0 : q0 - 128; const int whi = q0 + 256 > 2048 ? 2048 : q0 + 256; nwin = (whi - wlo) >> 6; nt = nwin + 8; }
  const u16* Kn = (const u16*)((const char*)p.out + YS_KN);
  const u16* KR = (const u16*)(p.ws + WS_KROPE);
  const u16* KSW = (const u16*)(p.ws + WS_KSWA);
  const u16* KCc = (const u16*)(p.ws + WS_KC);
  const u16* VT;
  if (KIND == 0) VT = (const u16*)((const char*)p.out + YS_VTMLA) + (size_t)kr0 * 512;
  else if (KIND == 1) VT = (const u16*)(p.ws + WS_VTSWA) + (size_t)kr0 * 128;
  else VT = (const u16*)(p.ws + WS_VTATT) + (size_t)kr0 * 256;
  bf16x8 rk[NKC], rv[NVC];
  int kkey[NKC], kd[NKC];
#pragma unroll
  for (int i = 0; i < NKC; ++i) { const int c = tid + 512 * i; kkey[i] = c / CPR; kd[i] = (c % CPR) * 8; }
  auto kt0_of = [&](int t) -> int { return (KIND == 1 && smp) ? (t < nwin ? wlo + 64 * t : 2048 + 64 * (t - nwin)) : 64 * t; };
  auto gload = [&](int t) {
    const int kt0 = kt0_of(t);
#pragma unroll
    for (int i = 0; i < NKC; ++i) {
      if (tid + 512 * i < KCH) {
        const int g = kt0 + kkey[i], d = kd[i];
        const u16* src;
        if (KIND == 0) src = d < 64 ? Kn + ((size_t)(kr0 + g) * 8 + hkv) * 64 + d : KR + (size_t)(kr0 + g) * 32 + (d - 64);
        else if (KIND == 1) src = KSW + ((size_t)(kr0 + g) * 2 + hkv) * 64 + d;
        else src = g < len ? U1B + (size_t)(tok0 + g) * U1B_LD + C1_KD + hkv * 128 + d : KCc + ((size_t)((s - 16) * 512 + g - 2048) * 2 + hkv) * 128 + d;
        rk[i] = *(const bf16x8*)src;
      }
    }
#pragma unroll
    for (int i = 0; i < NVC; ++i) {
      const int c = tid + 512 * i, dv = c >> 3, kc = c & 7;
      rv[i] = *(const bf16x8*)(VT + (size_t)(hkv * DV + dv) * cap + kt0 + kc * 8);
    }
  };
  auto swrite = [&]() {
#pragma unroll
    for (int i = 0; i < NKC; ++i) if (tid + 512 * i < KCH) *(bf16x8*)(sK + kkey[i] * KS + kd[i]) = rk[i];
#pragma unroll
    for (int i = 0; i < NVC; ++i) { const int c = tid + 512 * i; *(bf16x8*)(sV + (c >> 3) * VS + (c & 7) * 8) = rv[i]; }
  };
  f32x16 o[DV / 32];
#pragma unroll
  for (int db = 0; db < DV / 32; ++db)
#pragma unroll
    for (int r = 0; r < 16; ++r) o[db][r] = 0.f;
  float m = -1e30f, l = 0.f;
  gload(0);
  for (int t = 0; t < nt; ++t) {
    __syncthreads();
    swrite();
    __syncthreads();
    if (t + 1 < nt) gload(t + 1);
    f32x16 s0, s1;
#pragma unroll
    for (int r = 0; r < 16; ++r) { s0[r] = 0.f; s1[r] = 0.f; }
#pragma unroll
    for (int d0 = 0; d0 < DQK / 16; ++d0) {
      const bf16x8 k0 = *(const bf16x8*)(sK + r32 * KS + d0 * 16 + h * 8);
      const bf16x8 k1 = *(const bf16x8*)(sK + (32 + r32) * KS + d0 * 16 + h * 8);
      s0 = MFMA(k0, qf[d0], s0); s1 = MFMA(k1, qf[d0], s1);
    }
    if (KIND == 1 && smp && t < nwin) {
      const int kt0 = kt0_of(t), qi = qrow0 + r32;
#pragma unroll
      for (int r = 0; r < 16; ++r) {
        const int d0 = qi - (kt0 + crow(r, h)), d1 = d0 - 32;
        s0[r] = (d0 <= 128 && d0 >= -128) ? s0[r] : -INFINITY;
        s1[r] = (d1 <= 128 && d1 >= -128) ? s1[r] : -INFINITY;
      }
    }
    float mx = s0[0];
#pragma unroll
    for (int r = 1; r < 16; ++r) mx = fmaxf(mx, s0[r]);
#pragma unroll
    for (int r = 0; r < 16; ++r) mx = fmaxf(mx, s1[r]);
    mx = fmaxf(mx, __shfl_xor(mx, 32));
    const float mnew = fmaxf(m, mx * C);
    const float alpha = __builtin_amdgcn_exp2f(m - mnew);
    m = mnew;
    float ps = 0.f;
#pragma unroll
    for (int r = 0; r < 16; ++r) { s0[r] = __builtin_amdgcn_exp2f(s0[r] * C - mnew); ps += s0[r]; }
#pragma unroll
    for (int r = 0; r < 16; ++r) { s1[r] = __builtin_amdgcn_exp2f(s1[r] * C - mnew); ps += s1[r]; }
    l = l * alpha + ps;
#pragma unroll
    for (int db = 0; db < DV / 32; ++db)
#pragma unroll
      for (int r = 0; r < 16; ++r) o[db][r] *= alpha;
    const bf16x8 pf0 = pack8(s0, 0), pf1 = pack8(s0, 1), pf2 = pack8(s1, 0), pf3 = pack8(s1, 1);
#pragma unroll
    for (int db = 0; db < DV / 32; ++db) {
      const u16* vb = sV + (db * 32 + r32) * VS + h * 8;
      o[db] = MFMA(*(const bf16x8*)(vb), pf0, o[db]);
      o[db] = MFMA(*(const bf16x8*)(vb + 16), pf1, o[db]);
      o[db] = MFMA(*(const bf16x8*)(vb + 32), pf2, o[db]);
      o[db] = MFMA(*(const bf16x8*)(vb + 48), pf3, o[db]);
    }
  }
  float lt = l + __shfl_xor(l, 32);
  if (KIND == 1) lt += __builtin_amdgcn_exp2f(p.swa_sink[hq] * LOG2E - m);
  const float inv = 1.f / lt;
  const u16* zp; u16* op;
  if (KIND == 0) { zp = U0 + (size_t)tok * L0C + C0_ZA + hq * 64; op = (u16*)(p.ws + WS_H) + (size_t)tok * DM + hq * 64; }
  else if (KIND == 1) { zp = U0 + (size_t)tok * L0C + C0_ZB + hq * 64; op = (u16*)(p.ws + WS_H) + (size_t)tok * DM + 512 + hq * 64; }
  else { zp = U1B + (size_t)tok * U1B_LD + C1_ZD + hq * 128; op = (u16*)(p.ws + WS_H) + (size_t)tok * DM + 512 + hq * 128; }
#pragma unroll
  for (int db = 0; db < DV / 32; ++db)
#pragma unroll
    for (int g = 0; g < 4; ++g) {
      const int dv = db * 32 + 8 * g + 4 * h;
      const u32x2 zw = *(const u32x2*)(zp + dv);
      const float z0 = bf2f((u16)(zw[0] & 0xffffu)), z1 = bf2f((u16)(zw[0] >> 16)), z2 = bf2f((u16)(zw[1] & 0xffffu)), z3 = bf2f((u16)(zw[1] >> 16));
      u32x2 w = {pack2(o[db][4 * g] * inv * siluf(z0), o[db][4 * g + 1] * inv * siluf(z1)), pack2(o[db][4 * g + 2] * inv * siluf(z2), o[db][4 * g + 3] * inv * siluf(z3))};
      *(u32x2*)(op + dv) = w;
    }
  __syncthreads();
}

DI void phase_attn0(const Params& p, char* lds) {
  for (int it = blockIdx.x; it < 1280; it += gridDim.x) {
    if (it < 512) { const int s = 16 + (it >> 6), rem = it & 63; attn_item<0>(p, s, rem >> 3, (rem & 7) * 256, lds); }
    else if (it < 1024) { const int j = it - 512; const int s = 16 + (j >> 6), rem = j & 63; attn_item<1>(p, s, rem >> 4, (rem & 15) * 128, lds); }
    else if (it < 1152) { const int j = it - 1024; attn_item<0>(p, j >> 3, j & 7, 0, lds); }
    else { const int j = it - 1152; const int s = j >> 3, rem = j & 7; attn_item<1>(p, s, rem >> 1, (rem & 1) * 128, lds); }
  }
}
DI void phase_attn1(const Params& p, char* lds) {
  for (int it = blockIdx.x; it < 320; it += gridDim.x) {
    if (it < 256) { const int s = 16 + (it >> 5), rem = it & 31; attn_item<2>(p, s, rem >> 4, (rem & 15) * 128, lds); }
    else { const int j = it - 256; const int s = j >> 2, rem = j & 3; attn_item<2>(p, s, rem >> 1, (rem & 1) * 128, lds); }
  }
}

DI float group16_sum(float v) {
#pragma unroll
  for (int o = 8; o > 0; o >>= 1) v += __shfl_xor(v, o);
  return v;
}
DI void phase_l1prep(const Params& p, char* lds) {
  const int tid = TIDX(), lane = tid & 63, wid = tid >> 6;
  const u16* UA = (const u16*)(p.ws + WS_U1A);
  u16* UB = (u16*)(p.ws + WS_U1B);
  u16* QK = (u16*)(p.ws + WS_H);
  u16* VC = (u16*)(p.ws + WS_VC);
  float* GB = (float*)(p.ws + WS_GB);
  const float* AB = (const float*)(p.ws + WS_AB);
  const float2* tabA = (const float2*)(p.ws + WS_ROPE) + 1536;
  u16* sv = (u16*)lds;
  constexpr int N_TOK_ITEMS = NTOK / 16;
  constexpr int N_KC_ITEMS = 256;
  constexpr int N_VC_ITEMS = 256;
  for (int it = blockIdx.x; it < N_TOK_ITEMS + N_KC_ITEMS + N_VC_ITEMS; it += gridDim.x) {
    if (it >= N_TOK_ITEMS + N_KC_ITEMS) {
      const int t = it - N_TOK_ITEMS - N_KC_ITEMS; const int b = t >> 5, g = t & 31;
      {
        const int key = tid >> 5, c8 = (tid & 31) * 8;
        const float* src = p.c_attv + ((size_t)(b * 512 + g * 16 + key)) * 256 + c8;
        const float4 a = *(const float4*)src, b4 = *(const float4*)(src + 4);
        u32x4 w = {pack2(a.x, a.y), pack2(a.z, a.w), pack2(b4.x, b4.y), pack2(b4.z, b4.w)};
        *(u32x4*)(sv + key * 264 + c8) = w;
      }
      __syncthreads();
      vt_store16(sv, 264, 256, (u16*)(p.ws + WS_VTATT) + (size_t)krow0_of(16 + b) * 256, 2560, 2048 + g * 16);
      __syncthreads();
      continue;
    }
    if (it >= N_TOK_ITEMS) {
      const size_t i = (size_t)(it - N_TOK_ITEMS) * 4096 + tid * 8;
      const float4 a = *(const float4*)(p.c_attk + i), b4 = *(const float4*)(p.c_attk + i + 4);
      u32x4 w = {pack2(a.x, a.y), pack2(a.z, a.w), pack2(b4.x, b4.y), pack2(b4.z, b4.w)};
      *(u32x4*)((u16*)(p.ws + WS_KC) + i) = w;
      continue;
    }
    const int m0 = it * 16;
    for (int tt = 0; tt < 2; ++tt) {
      const int ml = wid * 2 + tt, m = m0 + ml;
      const bool ctx = m < NCTX;
      const int pos = pos_of_tok(m), prow = pos >> 6, pcol = pos & 63, len = ctx ? 256 : 2048;
      {
        const u16* r1 = UA + (size_t)m * U1A_LD;
#pragma unroll
        for (int j = 0; j < 3; ++j) {
          const int ch = j * 512 + lane * 8;
          float x0[8], x1[8], x2[8], y[8];
          unpack8(*(const u32x4*)(r1 + ch), x1);
          if (pos > 0) unpack8(*(const u32x4*)(r1 - U1A_LD + ch), x0); else {
#pragma unroll
            for (int e = 0; e < 8; ++e) x0[e] = 0.f; }
          if (pos < len - 1) unpack8(*(const u32x4*)(r1 + U1A_LD + ch), x2); else {
#pragma unroll
            for (int e = 0; e < 8; ++e) x2[e] = 0.f; }
          float ss = 0.f;
#pragma unroll
          for (int e = 0; e < 8; ++e) {
            const float a = p.gdn_conv[ch + e] * x0[e] + p.gdn_conv[1536 + ch + e] * x1[e] + p.gdn_conv[3072 + ch + e] * x2[e];
            y[e] = siluf(a); ss += y[e] * y[e];
          }
          if (j < 2) {
            ss = group16_sum(ss);
            const float rs = rsqrtf(ss + EPS) * (j == 0 ? 0.08838834764831845f : 1.f);
#pragma unroll
            for (int e = 0; e < 8; ++e) y[e] *= rs;
            *(u32x4*)(QK + (size_t)m * DM + j * 512 + lane * 8) = pack8f(y);
          } else {
            *(u32x4*)(VC + (size_t)m * 512 + lane * 8) = pack8f(y);
          }
        }
      }
      if (lane < 16) {
        const float a = AB[(size_t)m * 16 + lane];
        float r;
        if (lane < 8) { const float x = a + p.gdn_dt_bias[lane]; const float sp = x > 20.f ? x : log1pf(expf(x)); r = -expf(p.gdn_a_log[lane]) * sp; }
        else r = 1.f / (1.f + expf(-a));
        GB[(size_t)m * 16 + lane] = r;
      }
      {
        u16* qp = UB + (size_t)m * U1B_LD + C1_QD + lane * 8;
        float x[8], xp[8];
        unpack8(*(const u32x4*)qp, x);
        float ss = 0.f;
#pragma unroll
        for (int e = 0; e < 8; ++e) ss += x[e] * x[e];
        ss = group16_sum(ss);
        const float rs = rsqrtf(ss * (1.f / 128.f) + EPS);
        const int li = lane & 15;
#pragma unroll
        for (int e = 0; e < 8; ++e) x[e] *= rs * p.att_q_norm[li * 8 + e];
        shfl8(x, xp, 4);
        if (!ctx) { const int b32 = li >> 2; rope8(x, xp, tabA, 32, (b32 >= 2) ? pcol : prow, (li & 3) * 8, (b32 & 1) != 0); }
        *(u32x4*)qp = pack8f(x);
      }
      {
        u16* kp = UB + (size_t)m * U1B_LD + C1_KD + (lane & 31) * 8;
        float x[8], xp[8];
        unpack8(*(const u32x4*)kp, x);
        float ss = 0.f;
#pragma unroll
        for (int e = 0; e < 8; ++e) ss += x[e] * x[e];
        ss = group16_sum(ss);
        const float rs = rsqrtf(ss * (1.f / 128.f) + EPS);
        const int li = lane & 15;
#pragma unroll
        for (int e = 0; e < 8; ++e) x[e] *= rs * p.att_k_norm[li * 8 + e];
        if (ctx && lane < 32) {
          *(float4*)(p.out + O_ATTK + (size_t)m * 256 + lane * 8) = make_float4(x[0], x[1], x[2], x[3]);
          *(float4*)(p.out + O_ATTK + (size_t)m * 256 + lane * 8 + 4) = make_float4(x[4], x[5], x[6], x[7]);
        }
        shfl8(x, xp, 4);
        if (!ctx) { const int b32 = li >> 2; rope8(x, xp, tabA, 32, (b32 >= 2) ? pcol : prow, (li & 3) * 8, (b32 & 1) != 0); }
        if (lane < 32) {
          *(u32x4*)kp = pack8f(x);
          const u32x4 vw = *(const u32x4*)(UB + (size_t)m * U1B_LD + C1_VD + lane * 8);
          *(u32x4*)(sv + ml * 264 + lane * 8) = vw;
          if (ctx) {
            float v[8]; unpack8(vw, v);
            *(float4*)(p.out + O_ATTV + (size_t)m * 256 + lane * 8) = make_float4(v[0], v[1], v[2], v[3]);
            *(float4*)(p.out + O_ATTV + (size_t)m * 256 + lane * 8 + 4) = make_float4(v[4], v[5], v[6], v[7]);
          }
        }
      }
    }
    __syncthreads();
    {
      const int s = seq_of_tok(m0);
      vt_store16(sv, 264, 256, (u16*)(p.ws + WS_VTATT) + (size_t)krow0_of(s) * 256, cap_of(s), pos_of_tok(m0));
    }
    __syncthreads();
  }
}

DI void phase_gdnfinal(const Params& p) {
  const int tid_ = TIDX(), lane = tid_ & 63, wid = tid_ >> 6;
  const u16* OF = (const u16*)(p.ws + WS_OF); const u16* OBk = (const u16*)(p.ws + WS_OB);
  const u16* UB = (const u16*)(p.ws + WS_U1B);
  u16* H = (u16*)(p.ws + WS_H);
  for (int m = blockIdx.x * 8 + wid; m < NTOK; m += gridDim.x * 8) {
    float a[8], b[8], z[8];
    unpack8(*(const u32x4*)(OF + (size_t)m * 512 + lane * 8), a);
    unpack8(*(const u32x4*)(OBk + (size_t)m * 512 + lane * 8), b);
    unpack8(*(const u32x4*)(UB + (size_t)m * U1B_LD + C1_ZC + lane * 8), z);
    float ss = 0.f;
#pragma unroll
    for (int e = 0; e < 8; ++e) { a[e] += b[e]; ss += a[e] * a[e]; }
    ss = group16_sum(ss);
    const float rs = rsqrtf(ss * (1.f / 128.f) + EPS);
    const int li = lane & 15;
#pragma unroll
    for (int e = 0; e < 8; ++e) a[e] = a[e] * rs * p.gdn_norm[li * 8 + e] * siluf(z[e]);
    *(u32x4*)(H + (size_t)m * DM + lane * 8) = pack8f(a);
  }
}

DI float dbg_rel(const Params& p);
#ifndef DBG_CHECK
#define DBG_CHECK 0
#endif
#ifndef DBG_AMP
#define DBG_AMP 10.f
#endif
DI void phase_final(const Params& p) {
  const int tid_ = TIDX(), lane = tid_ & 63, wid = tid_ >> 6;
  float dscale = 1.f;
  if (DBG_CHECK) dscale = 1.f + DBG_AMP * dbg_rel(p);
  for (int m = blockIdx.x * 8 + wid; m < NTOK; m += gridDim.x * 8) {
    float* x = p.out + (size_t)m * DM;
    float4 v[4]; float ss = 0.f;
#pragma unroll
    for (int j = 0; j < 4; ++j) { v[j] = *(const float4*)(x + (j * 64 + lane) * 4); ss += v[j].x * v[j].x + v[j].y * v[j].y + v[j].z * v[j].z + v[j].w * v[j].w; }
    ss = wave_sum(ss);
    const float rs = rsqrtf(ss * (1.f / 1024.f) + EPS);
#pragma unroll
    for (int j = 0; j < 4; ++j) {
      const int c = (j * 64 + lane) * 4;
      const float4 g = *(const float4*)(p.ln_f + c);
      const float rr = (DBG_CHECK && m < NCTX) ? rs * dscale : rs;
      *(float4*)(x + c) = make_float4(v[j].x * rr * g.x, v[j].y * rr * g.y, v[j].z * rr * g.z, v[j].w * rr * g.w);
    }
  }
}

template <class F>
DI void ngemm(const GemmA A, const u16* __restrict__ Wt, int ldw, int K, int M, int N, char* lds, F f) {
  u16* sA = (u16*)lds;
  const int tid = TIDX();
  const int ncol = (N + 511) / 512;
  for (int it = blockIdx.x; it < (M / 8) * ncol; it += gridDim.x) {
    const int m0 = (it / ncol) * 8, n = (it % ncol) * 512 + tid;
    __syncthreads();
    for (int i = tid; i < 8 * (K / 8); i += NTHREADS) {
      const int r = i / (K / 8), k8 = (i % (K / 8)) * 8;
      const u16* src = k8 < A.ksplit ? A.p0 + (size_t)(m0 + r) * A.ld0 + k8 : A.p1 + (size_t)(m0 + r) * A.ld1 + (k8 - A.ksplit);
      *(u32x4*)(sA + r * K + k8) = *(const u32x4*)src;
    }
    __syncthreads();
    if (n < N) {
      float acc[8];
#pragma unroll
      for (int r = 0; r < 8; ++r) acc[r] = 0.f;
      for (int k8 = 0; k8 < K; k8 += 8) {
        float w[8]; unpack8(*(const u32x4*)(Wt + (size_t)n * ldw + k8), w);
#pragma unroll
        for (int r = 0; r < 8; ++r) {
          float a[8]; unpack8(*(const u32x4*)(sA + r * K + k8), a);
#pragma unroll
          for (int e = 0; e < 8; ++e) acc[r] += a[e] * w[e];
        }
      }
#pragma unroll
      for (int r = 0; r < 8; ++r) f(m0 + r, n, acc[r]);
    }
  }
}
DI void nphase_inproj0(const Params& p, char* lds) {
  u16* U = (u16*)(p.ws + WS_U); const u16* H = (const u16*)(p.ws + WS_H);
  ngemm(GemmA{H, DM, H, DM, 1 << 30}, (const u16*)(p.ws + WS_WT0), DM, DM, NTOK, L0C, lds, [=](int m, int n, float v) { U[(size_t)m * L0C + n] = f2bf(v); });
}
DI void nphase_l0gemms(const Params& p, char* lds) {
  const u16* U0 = (const u16*)(p.ws + WS_U); const u16* ck = (const u16*)(p.ws + WS_CKVN);
  u16* Kn = (u16*)((char*)p.out + YS_KN); u16* Vt = (u16*)((char*)p.out + YS_VTMLA); u16* Q = (u16*)((char*)p.out + YS_QMLA);
  ngemm(GemmA{ck, 256, ck, 256, 1 << 30}, (const u16*)(p.ws + WS_WUKV), 256, 256, NKROW, 1024, lds, [=](int kr, int n, float v) {
    const int head = n >> 7, within = n & 127;
    if (within < 64) Kn[((size_t)kr * 8 + head) * 64 + within] = f2bf(v);
    else {
      int seq, key;
      if (kr < NCTX) { seq = kr >> 8; key = kr & 255; } else { const int r = kr - NCTX; seq = 16 + r / 2560; key = r % 2560; }
      Vt[(size_t)krow0_of(seq) * 512 + (size_t)(head * 64 + within - 64) * cap_of(seq) + (key & ~15) + swz16(key & 15)] = f2bf(v);
    }
  });
  ngemm(GemmA{U0 + C0_CQ, L0C, U0 + C0_CQ, L0C, 1 << 30}, (const u16*)(p.ws + WS_WUQ), 384, 384, NTOK, 768, lds, [=](int m, int n, float v) { Q[(size_t)m * 768 + n] = f2bf(v); });
}
DI void nphase_qmla_rope(const Params& p) {
  u16* Q = (u16*)((char*)p.out + YS_QMLA);
  const float2* tab = (const float2*)(p.ws + WS_ROPE);
  for (size_t i = (size_t)blockIdx.x * NTHREADS + threadIdx.x; i < (size_t)(NTOK - NCTX) * 8 * 16; i += (size_t)gridDim.x * NTHREADS) {
    const int m = NCTX + (int)(i >> 7), head = (int)(i >> 4) & 7, j = (int)i & 15;
    const int pos = pos_of_tok(m), pp = (j >> 3) ? (pos & 63) : (pos >> 6);
    u16* q = Q + (size_t)m * 768 + head * 96 + 64 + (j >> 3) * 16 + (j & 7);
    const float x1 = bf2f(q[0]), x2 = bf2f(q[8]);
    const float2 cs = tab[pp * 8 + (j & 7)];
    q[0] = f2bf(x1 * cs.x - x2 * cs.y); q[8] = f2bf(x2 * cs.x + x1 * cs.y);
  }
}
DI void nphase_outproj(const Params& p, int layer, char* lds) {
  const u16* H = (const u16*)(p.ws + WS_H);
  const GemmA A{H, DM, H, DM, 1 << 30};
  const float* mod = (const float*)(p.ws + WS_MOD) + (size_t)layer * 9 * 3072 + 2048;
  const Params* pp = &p;
  ngemm(A, (const u16*)(p.ws + (layer ? WS_WO1 : WS_WO0)), DM, DM, NTOK, DM, lds, [=](int m, int n, float v) {
    const float gate = mod[(size_t)modidx_of_tok(m) * 3072 + n];
    const float xv = layer ? pp->out[(size_t)m * DM + n] : xrow(*pp, m)[n];
    pp->out[(size_t)m * DM + n] = xv + gate * v;
  });
}
DI void nphase_inproj1(const Params& p, char* lds) {
  u16* UA = (u16*)(p.ws + WS_U1A); u16* UB = (u16*)(p.ws + WS_U1B); float* AB = (float*)(p.ws + WS_AB);
  const u16* H = (const u16*)(p.ws + WS_H);
  ngemm(GemmA{H, DM, H, DM, 1 << 30}, (const u16*)(p.ws + WS_WT1), DM, DM, NTOK, L1C, lds, [=](int m, int n, float v) {
    if (n < 1536) UA[(size_t)m * U1A_LD + n] = f2bf(v);
    else if (n < 3584) UB[(size_t)m * U1B_LD + n - 1536] = f2bf(v);
    else AB[(size_t)m * 16 + n - 3584] = v;
  });
}

template <int KIND>
DI void nattn(const Params& p) {
  constexpr int DQK = KIND == 0 ? 96 : (KIND == 1 ? 64 : 128);
  constexpr int DV = KIND == 2 ? 128 : 64;
  constexpr int NH = KIND == 2 ? 4 : 8;
  constexpr float SCALE = KIND == 0 ? 0.10206207261596577f : (KIND == 1 ? 0.125f : 0.08838834764831845f);
  const int tid_ = TIDX(), lane = tid_ & 63, wid = tid_ >> 6;
  const u16* U0 = (const u16*)(p.ws + WS_U);
  u16* U1B = (u16*)(p.ws + WS_U1B);
  for (int it = blockIdx.x * 8 + wid; it < NTOK * NH; it += gridDim.x * 8) {
    const int tok = it / NH, hq = it % NH;
    const int s = seq_of_tok(tok), tok0 = tok0_of(s), kr0 = krow0_of(s), cap = cap_of(s), len = len_of(s), qi = tok - tok0;
    const bool smp = s >= 16;
    const int hkv = KIND == 0 ? hq : (KIND == 1 ? hq >> 2 : hq >> 1);
    const u16* qp; const u16* VT;
    if (KIND == 0) { qp = (const u16*)((const char*)p.out + YS_QMLA) + (size_t)tok * 768 + hq * 96; VT = (const u16*)((const char*)p.out + YS_VTMLA) + (size_t)kr0 * 512; }
    else if (KIND == 1) { qp = U0 + (size_t)tok * L0C + C0_QB + hq * 64; VT = (const u16*)(p.ws + WS_VTSWA) + (size_t)kr0 * 128; }
    else { qp = U1B + (size_t)tok * U1B_LD + C1_QD + hq * 128; VT = (const u16*)(p.ws + WS_VTATT) + (size_t)kr0 * 256; }
    const float q0 = bf2f(qp[lane]);
    const float q1 = (DQK > 64 && lane + 64 < DQK) ? bf2f(qp[lane + 64]) : 0.f;
    float m = -1e30f, l = 0.f, o0 = 0.f, o1 = 0.f;
    int glo = 0, ghi = cap >> 4;
    const int nseqg = len >> 4;
    for (int gidx = glo; gidx < ghi; ++gidx) {
      const int g0 = gidx * 16;
      if (KIND == 1 && smp && g0 < 2048) { if (g0 + 15 < qi - 128 || g0 > qi + 128) continue; }
      float sc[16];
#pragma unroll
      for (int j = 0; j < 16; ++j) {
        const int g = g0 + j;
        const u16* kp;
        float part;
        if (KIND == 0) {
          const u16* kn = (const u16*)((const char*)p.out + YS_KN) + ((size_t)(kr0 + g) * 8 + hkv) * 64;
          const u16* kr = (const u16*)(p.ws + WS_KROPE) + (size_t)(kr0 + g) * 32;
          part = q0 * bf2f(kn[lane]) + (lane < 32 ? q1 * bf2f(kr[lane]) : 0.f);
        } else if (KIND == 1) {
          kp = (const u16*)(p.ws + WS_KSWA) + ((size_t)(kr0 + g) * 2 + hkv) * 64;
          part = q0 * bf2f(kp[lane]);
        } else {
          kp = g < len ? U1B + (size_t)(tok0 + g) * U1B_LD + C1_KD + hkv * 128 : (const u16*)(p.ws + WS_KC) + ((size_t)((s - 16) * 512 + g - 2048) * 2 + hkv) * 128;
          part = q0 * bf2f(kp[lane]) + q1 * bf2f(kp[lane + 64]);
        }
        float sv_ = wave_sum(part) * SCALE;
        if (KIND == 1 && smp && g < 2048) { const int d = qi - g; if (d > 128 || d < -128) sv_ = -INFINITY; }
        sc[j] = sv_;
      }
      float mx = sc[0];
#pragma unroll
      for (int j = 1; j < 16; ++j) mx = fmaxf(mx, sc[j]);
      const float mnew = fmaxf(m, mx);
      const float alpha = __expf(m - mnew);
      m = mnew; l *= alpha; o0 *= alpha; o1 *= alpha;
      const u32x4 va = *(const u32x4*)(VT + (size_t)(hkv * DV + lane) * cap + g0), vb = *(const u32x4*)(VT + (size_t)(hkv * DV + lane) * cap + g0 + 8);
      float v0[16]; { float t8[8]; unpack8(va, t8); for (int e = 0; e < 8; ++e) v0[e] = t8[e]; unpack8(vb, t8); for (int e = 0; e < 8; ++e) v0[8 + e] = t8[e]; }
      float v1[16];
      if (DV > 64) {
        const u32x4 vc = *(const u32x4*)(VT + (size_t)(hkv * DV + 64 + lane) * cap + g0), vd = *(const u32x4*)(VT + (size_t)(hkv * DV + 64 + lane) * cap + g0 + 8);
        float t8[8]; unpack8(vc, t8); for (int e = 0; e < 8; ++e) v1[e] = t8[e]; unpack8(vd, t8); for (int e = 0; e < 8; ++e) v1[8 + e] = t8[e];
      }
#pragma unroll
      for (int j = 0; j < 16; ++j) {
        const float pj = __expf(sc[j] - mnew);
        l += pj;
        o0 += pj * v0[swz16(j)];
        if (DV > 64) o1 += pj * v1[swz16(j)];
      }
    }
    (void)nseqg; (void)glo;
    if (KIND == 1) l += __expf(p.swa_sink[hq] - m);
    const float inv = 1.f / l;
    if (KIND == 0) { const float z = bf2f(U0[(size_t)tok * L0C + C0_ZA + hq * 64 + lane]); ((u16*)(p.ws + WS_H))[(size_t)tok * DM + hq * 64 + lane] = f2bf(o0 * inv * siluf(z)); }
    else if (KIND == 1) { const float z = bf2f(U0[(size_t)tok * L0C + C0_ZB + hq * 64 + lane]); ((u16*)(p.ws + WS_H))[(size_t)tok * DM + 512 + hq * 64 + lane] = f2bf(o0 * inv * siluf(z)); }
    else {
      const float z0 = bf2f(U1B[(size_t)tok * U1B_LD + C1_ZD + hq * 128 + lane]), z1 = bf2f(U1B[(size_t)tok * U1B_LD + C1_ZD + hq * 128 + 64 + lane]);
      ((u16*)(p.ws + WS_H))[(size_t)tok * DM + 512 + hq * 128 + lane] = f2bf(o0 * inv * siluf(z0));
      ((u16*)(p.ws + WS_H))[(size_t)tok * DM + 512 + hq * 128 + 64 + lane] = f2bf(o1 * inv * siluf(z1));
    }
  }
}

DI void nphase_gdn(const Params& p, char* lds) {
  const int tid = TIDX();
  float* sq = (float*)lds; float* sk = sq + 128;
  const u16* QK = (const u16*)(p.ws + WS_H); const u16* VC = (const u16*)(p.ws + WS_VC); const float* GB = (const float*)(p.ws + WS_GB);
  for (int it = blockIdx.x; it < 192; it += gridDim.x) {
    int s, head, dir;
    if (it < 64) { s = 16 + (it >> 3); head = (it >> 1) & 3; dir = it & 1; } else { const int j = it - 64; s = j >> 3; head = (j >> 1) & 3; dir = j & 1; }
    const int tok0 = tok0_of(s), T = len_of(s);
    u16* O = (u16*)(p.ws + (dir ? WS_OB : WS_OF));
    float S[128];
    if (tid < 128) {
      if (s >= 16) {
        const float* st = p.c_state + ((size_t)(((s - 16) * 2 + dir) * 4 + head)) * 16384;
#pragma unroll
        for (int d = 0; d < 128; ++d) S[d] = st[d * 128 + tid];
      } else {
#pragma unroll
        for (int d = 0; d < 128; ++d) S[d] = 0.f;
      }
    }
    for (int tau = 0; tau < T; ++tau) {
      const int m = tok0 + (dir ? T - 1 - tau : tau);
      __syncthreads();
      if (tid < 128) { sq[tid] = bf2f(QK[(size_t)m * DM + head * 128 + tid]); sk[tid] = bf2f(QK[(size_t)m * DM + 512 + head * 128 + tid]); }
      __syncthreads();
      if (tid < 128) {
        const float g = GB[(size_t)m * 16 + dir * 4 + head], beta = GB[(size_t)m * 16 + 8 + dir * 4 + head];
        const float alpha = __expf(g);
        const float v = bf2f(VC[(size_t)m * 512 + head * 128 + tid]);
        float r = 0.f;
#pragma unroll
        for (int c = 0; c < 16; ++c) {
          const float4 ka = *(const float4*)(sk + c * 8), kb = *(const float4*)(sk + c * 8 + 4);
          r += ka.x * S[c * 8] + ka.y * S[c * 8 + 1] + ka.z * S[c * 8 + 2] + ka.w * S[c * 8 + 3] + kb.x * S[c * 8 + 4] + kb.y * S[c * 8 + 5] + kb.z * S[c * 8 + 6] + kb.w * S[c * 8 + 7];
          asm volatile("" ::: "memory");
        }
        const float dd = beta * (v - alpha * r);
        float o = 0.f;
#pragma unroll
        for (int c = 0; c < 16; ++c) {
          const float4 ka = *(const float4*)(sk + c * 8), kb = *(const float4*)(sk + c * 8 + 4);
          const float4 qa = *(const float4*)(sq + c * 8), qb = *(const float4*)(sq + c * 8 + 4);
          const float kk[8] = {ka.x, ka.y, ka.z, ka.w, kb.x, kb.y, kb.z, kb.w};
          const float qq[8] = {qa.x, qa.y, qa.z, qa.w, qb.x, qb.y, qb.z, qb.w};
#pragma unroll
          for (int e = 0; e < 8; ++e) { S[c * 8 + e] = alpha * S[c * 8 + e] + kk[e] * dd; o += qq[e] * S[c * 8 + e]; }
          asm volatile("" ::: "memory");
        }
        O[(size_t)m * 512 + head * 128 + tid] = f2bf(o);
      }
    }
    if (tid < 128 && s < 16) {
      float* st = p.out + O_STATE + ((size_t)((s * 2 + dir) * 4 + head)) * 16384;
#pragma unroll
      for (int d = 0; d < 128; ++d) st[d * 128 + tid] = S[d];
    }
    __syncthreads();
  }
}


DI bf16x8 afrag(const u16* base, int stride, int row, int kbase, int h) {
  const bf16x4 lo = *(const bf16x4*)(base + row * stride + kbase + 4 * h);
  const bf16x4 hi = *(const bf16x4*)(base + row * stride + kbase + 8 + 4 * h);
  return cat4(lo, hi);
}
DI void phase_chunkprep(const Params& p, char* lds) {
  const int tid = TIDX(), lane = tid & 63, wid = tid >> 6, r32 = lane & 31, h = lane >> 5;
  u16* sq = (u16*)lds; u16* sk = sq + 64 * 136;
  float* Lt = (float*)(sk + 64 * 136);
  float* gcd = Lt + 2 * 64 * 68;
  float* bet = gcd + 128;
  const u16* QK = (const u16*)(p.ws + WS_H); const float* GB = (const float*)(p.ws + WS_GB);
  const int dir = wid >> 2, wq = wid & 3;
  for (int it = blockIdx.x; it < 320 * 4; it += gridDim.x) {
    const int cgi = it >> 2, head = it & 3, tok0 = cgi * 64;
    const int oz = opaque_zero();
    const int tid = threadIdx.x + oz, lane = tid & 63, r32 = lane & 31, h = lane >> 5;
    __syncthreads();
#pragma unroll
    for (int i = 0; i < 4; ++i) {
      const int c = tid + 512 * i, which = c >> 10, cc = c & 1023, row = cc >> 4, d8 = (cc & 15) * 8;
      const u32x4 w = *(const u32x4*)(QK + (size_t)(tok0 + row) * DM + which * 512 + head * 128 + d8);
      *(u32x4*)((which ? sk : sq) + row * 136 + d8) = w;
    }
    if (wq == 0) {
      const float g = GB[(size_t)(tok0 + lane) * 16 + dir * 4 + head];
      float pre = g;
#pragma unroll
      for (int o = 1; o < 64; o <<= 1) { const float t = __shfl_up(pre, o); if (lane >= o) pre += t; }
      const float tot = __shfl(pre, 63);
      gcd[dir * 64 + lane] = dir ? (tot - pre + g) : pre;
      bet[dir * 64 + lane] = GB[(size_t)(tok0 + lane) * 16 + 8 + dir * 4 + head];
    }
    __syncthreads();
    const size_t tm = ((size_t)(cgi * 4 + head) * 2 + dir) * 4096;
    {
      const int ib = wq >> 1, jb = wq & 1;
      const bool skipL = dir ? (ib == 1 && jb == 0) : (ib == 0 && jb == 1);
      f32x16 kk, qk;
#pragma unroll
      for (int r = 0; r < 16; ++r) { kk[r] = 0.f; qk[r] = 0.f; }
#pragma unroll
      for (int s = 0; s < 8; ++s) {
        const bf16x8 ka = *(const bf16x8*)(sk + (32 * ib + r32) * 136 + 16 * s + 8 * h);
        const bf16x8 kb = *(const bf16x8*)(sk + (32 * jb + r32) * 136 + 16 * s + 8 * h);
        const bf16x8 qb = *(const bf16x8*)(sq + (32 * jb + r32) * 136 + 16 * s + 8 * h);
        kk = MFMA(ka, kb, kk);
        qk = MFMA(ka, qb, qk);
      }
      const float* gc = gcd + dir * 64; const float* be = bet + dir * 64;
      if (!skipL) {
        const int b = 32 * jb + r32; const float gb = gc[b];
        float* Ls = Lt + dir * 64 * 68;
#pragma unroll
        for (int r = 0; r < 16; ++r) {
          const int a = 32 * ib + crow(r, h);
          const bool valid = dir ? (b > a) : (b < a);
          const float v = valid ? be[a] * kk[r] * __expf(gc[a] - gb) : 0.f;
          if (dir == 0) Ls[a * 68 + b] = v; else Ls[(63 - a) * 68 + (63 - b)] = v;
        }
      }
      {
        u16* AM = (u16*)(p.ws + WS_AM) + tm;
        const int a = 32 * jb + r32; const float ga = gc[a];
#pragma unroll
        for (int g4 = 0; g4 < 4; ++g4) {
          const int b0 = 32 * ib + 8 * g4 + 4 * h;
          float v[4];
#pragma unroll
          for (int j = 0; j < 4; ++j) {
            const int b = b0 + j;
            const bool valid = dir ? (b >= a) : (b <= a);
            v[j] = valid ? qk[4 * g4 + j] * __expf(ga - gc[b]) : 0.f;
          }
          u32x2 w = {pack2(v[0], v[1]), pack2(v[2], v[3])};
          *(u32x2*)(AM + a * 64 + b0) = w;
        }
      }
    }
    __syncthreads();
    if (wq == 0) {
      const float* L = Lt + dir * 64 * 68;
      float T[64];
#pragma unroll
      for (int c = 0; c < 64; ++c) T[c] = (lane == c) ? 1.f : 0.f;
#pragma unroll
      for (int c = 63; c >= 1; --c) {
        const float tc = T[c];
#pragma unroll
        for (int c4 = 0; c4 < c; c4 += 4) {
          const float4 l4 = *(const float4*)(L + c * 68 + c4);
          T[c4] -= tc * l4.x;
          if (c4 + 1 < c) T[c4 + 1] -= tc * l4.y;
          if (c4 + 2 < c) T[c4 + 2] -= tc * l4.z;
          if (c4 + 3 < c) T[c4 + 3] -= tc * l4.w;
        }
        asm volatile("" ::: "memory");
      }
      u16* TB = (u16*)(p.ws + WS_TB) + tm;
      const int arow = dir ? 63 - lane : lane;
      const float* be = bet + dir * 64;
#pragma unroll
      for (int b8 = 0; b8 < 8; ++b8) {
        float o[8];
#pragma unroll
        for (int e = 0; e < 8; ++e) { const int b = b8 * 8 + e; o[e] = (dir ? T[63 - b] : T[b]) * be[b]; }
        *(u32x4*)(TB + arow * 64 + b8 * 8) = pack8f(o);
      }
    }
  }
}

DI void phase_scan(const Params& p, char* lds) {
  const int tid = TIDX(), lane = tid & 63, wid = tid >> 6, r32 = lane & 31, h = lane >> 5;
  u16* sq = (u16*)lds; u16* sk = sq + 64 * 136; u16* skT = sk + 64 * 136; u16* sv = skT + 128 * 72; u16* sTb = sv + 64 * 136; u16* sA = sTb + 64 * 72;
  float* vec = (float*)(sA + 64 * 72);
  const u16* QK = (const u16*)(p.ws + WS_H); const u16* VC = (const u16*)(p.ws + WS_VC); const float* GB = (const float*)(p.ws + WS_GB);
  for (int it = blockIdx.x; it < 192; it += gridDim.x) {
    int s, head, dir;
    if (it < 64) { s = 16 + (it >> 3); head = (it >> 1) & 3; dir = it & 1; } else { const int j = it - 64; s = j >> 3; head = (j >> 1) & 3; dir = j & 1; }
    const int tokS = tok0_of(s), nch = len_of(s) >> 6;
    u16* O = (u16*)(p.ws + (dir ? WS_OB : WS_OF));
    const int e0 = 32 * (wid & 3);
    f32x16 S[4];
    if (wid < 4) {
      if (s >= 16) {
        const float* st = p.c_state + ((size_t)(((s - 16) * 2 + dir) * 4 + head)) * 16384;
#pragma unroll
        for (int db = 0; db < 4; ++db)
#pragma unroll
          for (int r = 0; r < 16; ++r) S[db][r] = st[(32 * db + crow(r, h)) * 128 + e0 + r32];
      } else {
#pragma unroll
        for (int db = 0; db < 4; ++db)
#pragma unroll
          for (int r = 0; r < 16; ++r) S[db][r] = 0.f;
      }
    }
    u32x4 rg[8]; float r_egc = 0.f, r_dl = 0.f, r_eg = 0.f;
    auto prefetch = [&](int step) {
      const int tid = TIDX(), lane = tid & 63, wid = tid >> 6;
      const int ch = dir ? nch - 1 - step : step;
      const int tok0 = tokS + ch * 64;
      const size_t tm = ((size_t)((tok0 >> 6) * 4 + head) * 2 + dir) * 4096;
#pragma unroll
      for (int i = 0; i < 6; ++i) {
        const int c = tid + 512 * (i & 1), row = c >> 4, d8 = (c & 15) * 8;
        const u16* src = (i < 2) ? QK + (size_t)(tok0 + row) * DM + head * 128 + d8 : (i < 4) ? QK + (size_t)(tok0 + row) * DM + 512 + head * 128 + d8 : VC + (size_t)(tok0 + row) * 512 + head * 128 + d8;
        rg[i] = *(const u32x4*)src;
      }
      rg[6] = *(const u32x4*)((const u16*)(p.ws + WS_TB) + tm + (tid >> 3) * 64 + (tid & 7) * 8);
      rg[7] = *(const u32x4*)((const u16*)(p.ws + WS_AM) + tm + (tid >> 3) * 64 + (tid & 7) * 8);
      if (wid == 7) {
        const float g = GB[(size_t)(tok0 + lane) * 16 + dir * 4 + head];
        float pre = g;
#pragma unroll
        for (int o = 1; o < 64; o <<= 1) { const float t = __shfl_up(pre, o); if (lane >= o) pre += t; }
        const float tot = __shfl(pre, 63);
        const float gc = dir ? (tot - pre + g) : pre;
        r_egc = __expf(gc); r_dl = __expf(tot - gc); r_eg = __expf(tot);
      }
    };
    prefetch(0);
    for (int step = 0; step < nch; ++step) {
      const int ch = dir ? nch - 1 - step : step;
      const int tok0 = tokS + ch * 64;
      __syncthreads();
      {
      const int tid = TIDX(), lane = tid & 63, wid = tid >> 6;
#pragma unroll
      for (int i = 0; i < 6; ++i) {
        const int c = tid + 512 * (i & 1), row = c >> 4, d8 = (c & 15) * 8;
        u16* dst = (i < 2) ? sq : (i < 4) ? sk : sv;
        *(u32x4*)(dst + row * 136 + d8) = rg[i];
        if (i >= 2 && i < 4) {
#pragma unroll
          for (int e = 0; e < 4; ++e) { skT[(d8 + 2 * e) * 72 + row] = (u16)(rg[i][e] & 0xffffu); skT[(d8 + 2 * e + 1) * 72 + row] = (u16)(rg[i][e] >> 16); }
        }
      }
      *(u32x4*)(sTb + (tid >> 3) * 72 + (tid & 7) * 8) = rg[6];
      *(u32x4*)(sA + (tid >> 3) * 72 + (tid & 7) * 8) = rg[7];
      if (wid == 7) { vec[lane] = r_egc; vec[64 + lane] = r_dl; if (lane == 0) vec[128] = r_eg; }
      }
      __syncthreads();
      if (step + 1 < nch) prefetch(step + 1);
      if (wid < 4) {
        const int oz = opaque_zero();
        const int lane = (threadIdx.x + oz) & 63, r32 = lane & 31, h = lane >> 5;
        f32x16 VN[2];
        {
          f32x16 KS[2];
#pragma unroll
          for (int ib = 0; ib < 2; ++ib)
#pragma unroll
            for (int r = 0; r < 16; ++r) { KS[ib][r] = 0.f; VN[ib][r] = 0.f; }
#pragma unroll
          for (int db = 0; db < 4; ++db)
#pragma unroll
            for (int s2 = 0; s2 < 2; ++s2) {
              const bf16x8 sb = pack8(S[db], s2);
#pragma unroll
              for (int ib = 0; ib < 2; ++ib) KS[ib] = MFMA(afrag(sk, 136, 32 * ib + r32, 32 * db + 16 * s2, h), sb, KS[ib]);
            }
#pragma unroll
          for (int ib = 0; ib < 2; ++ib)
#pragma unroll
            for (int r = 0; r < 16; ++r) {
              const int i = 32 * ib + crow(r, h);
              KS[ib][r] = bf2f(sv[i * 136 + e0 + r32]) - vec[i] * KS[ib][r];
            }
#pragma unroll
          for (int ib = 0; ib < 2; ++ib)
#pragma unroll
            for (int s2 = 0; s2 < 2; ++s2) {
              const bf16x8 xb = pack8(KS[ib], s2);
#pragma unroll
              for (int i2 = 0; i2 < 2; ++i2) VN[i2] = MFMA(afrag(sTb, 72, 32 * i2 + r32, 32 * ib + 16 * s2, h), xb, VN[i2]);
            }
        }
        {
          f32x16 Oa[2];
#pragma unroll
          for (int ib = 0; ib < 2; ++ib)
#pragma unroll
            for (int r = 0; r < 16; ++r) Oa[ib][r] = 0.f;
#pragma unroll
          for (int db = 0; db < 4; ++db)
#pragma unroll
            for (int s2 = 0; s2 < 2; ++s2) {
              const bf16x8 sb = pack8(S[db], s2);
#pragma unroll
              for (int ib = 0; ib < 2; ++ib) Oa[ib] = MFMA(afrag(sq, 136, 32 * ib + r32, 32 * db + 16 * s2, h), sb, Oa[ib]);
            }
#pragma unroll
          for (int ib = 0; ib < 2; ++ib)
#pragma unroll
            for (int r = 0; r < 16; ++r) Oa[ib][r] *= vec[32 * ib + crow(r, h)];
#pragma unroll
          for (int ib = 0; ib < 2; ++ib)
#pragma unroll
            for (int s2 = 0; s2 < 2; ++s2) {
              const bf16x8 vb = pack8(VN[ib], s2);
#pragma unroll
              for (int i2 = 0; i2 < 2; ++i2) Oa[i2] = MFMA(afrag(sA, 72, 32 * i2 + r32, 32 * ib + 16 * s2, h), vb, Oa[i2]);
            }
#pragma unroll
          for (int ib = 0; ib < 2; ++ib)
#pragma unroll
            for (int r = 0; r < 16; ++r) O[(size_t)(tok0 + 32 * ib + crow(r, h)) * 512 + head * 128 + e0 + r32] = f2bf(Oa[ib][r]);
        }
        const float eg = vec[128];
#pragma unroll
        for (int db = 0; db < 4; ++db)
#pragma unroll
          for (int r = 0; r < 16; ++r) S[db][r] *= eg;
#pragma unroll
        for (int ib = 0; ib < 2; ++ib) {
#pragma unroll
          for (int r = 0; r < 16; ++r) VN[ib][r] *= vec[64 + 32 * ib + crow(r, h)];
#pragma unroll
          for (int s2 = 0; s2 < 2; ++s2) {
            const bf16x8 vb = pack8(VN[ib], s2);
#pragma unroll
            for (int db = 0; db < 4; ++db) S[db] = MFMA(afrag(skT, 72, 32 * db + r32, 32 * ib + 16 * s2, h), vb, S[db]);
          }
        }
      }
    }
    if (wid < 4 && s < 16) {
      float* st = p.out + O_STATE + ((size_t)((s * 2 + dir) * 4 + head)) * 16384;
#pragma unroll
      for (int db = 0; db < 4; ++db)
#pragma unroll
        for (int r = 0; r < 16; ++r) st[(32 * db + crow(r, h)) * 128 + e0 + r32] = S[db][r];
    }
    __syncthreads();
  }
}

#ifndef DBG_CHECK
#define DBG_CHECK 0
#endif
#ifndef DBG_AMP
#define DBG_AMP 10.f
#endif
constexpr size_t WS_DBG = WS_END + 16384;
DI void fingerprint(const Params& p, const void* buf, size_t n, bool isf32, int slot, char* lds) {
  float acc[9];
#pragma unroll
  for (int k = 0; k < 9; ++k) acc[k] = 0.f;
  for (size_t i = (size_t)blockIdx.x * NTHREADS + threadIdx.x; i < n; i += (size_t)gridDim.x * NTHREADS) {
    const float x = isf32 ? ((const float*)buf)[i] : bf2f(((const u16*)buf)[i]);
    unsigned hsh = (unsigned)i * 0x9E3779B1u; hsh ^= hsh >> 15; hsh *= 0x85EBCA77u; hsh ^= hsh >> 13;
#pragma unroll
    for (int k = 0; k < 8; ++k) acc[k] += ((hsh >> k) & 1u) ? x : -x;
    acc[8] += x * x;
  }
  float* red = (float*)lds;
  __syncthreads();
#pragma unroll
  for (int k = 0; k < 9; ++k) { const float v = wave_sum(acc[k]); if ((threadIdx.x & 63) == 0) red[(threadIdx.x >> 6) * 9 + k] = v; }
  __syncthreads();
  if (threadIdx.x < 9) {
    float v = 0.f;
    for (int w = 0; w < 8; ++w) v += red[w * 9 + threadIdx.x];
    ((float*)(p.ws + WS_DBG))[((size_t)slot * 256 + blockIdx.x) * 16 + threadIdx.x] = v;
  }
  __syncthreads();
}
DI float dbg_rel(const Params& p) {
  const float* d = (const float*)(p.ws + WS_DBG);
  float fn[9], ff[9];
#pragma unroll
  for (int k = 0; k < 9; ++k) { fn[k] = 0.f; ff[k] = 0.f; }
  for (int b = 0; b < (int)gridDim.x; ++b)
#pragma unroll
    for (int k = 0; k < 9; ++k) { fn[k] += d[((size_t)b) * 16 + k]; ff[k] += d[((size_t)256 + b) * 16 + k]; }
  float s = 0.f;
#pragma unroll
  for (int k = 0; k < 8; ++k) s += (ff[k] - fn[k]) * (ff[k] - fn[k]);
  return sqrtf(s * 0.125f / fn[8]);
}


#define XB_TMO      128
#define XB_XCNT(j)  (256  + 64 * (j))
#define XB_XSUB(j)  (1280 + 64 * (j))
#define XB_XGEN(j)  (2304 + 64 * (j))
#define XB_TOP      3328
#define XB_TOPGEN   3392
#define XCD_BAR_WORDS 3456
#define XB_SPIN_CAP (1u << 18)
#define LAS __attribute__((address_space(3)))
DI unsigned xb_ld(unsigned* p)              { return __hip_atomic_load(p, __ATOMIC_RELAXED, __HIP_MEMORY_SCOPE_AGENT); }
DI unsigned xb_add(unsigned* p, unsigned v) { return __hip_atomic_fetch_add(p, v, __ATOMIC_RELAXED, __HIP_MEMORY_SCOPE_AGENT); }
DI unsigned xb_xcc_id() { return (unsigned)__builtin_amdgcn_s_getreg((3 << 11) | 20) & 0xFu; }
#define XB_SPIN(cond, bar) do { unsigned _sp = 0; while (cond) { __builtin_amdgcn_s_sleep(1); \
    if ((++_sp & 255u) == 0u) { if (xb_ld(&(bar)[XB_TMO])) break; if (_sp > XB_SPIN_CAP) { atomicAdd(&(bar)[XB_TMO], 1u); break; } } } } while (0)
struct XcdBarrier { unsigned* bar; unsigned x; volatile LAS unsigned* st; };
DI XcdBarrier xcd_barrier_post(unsigned* bar, volatile LAS unsigned* st) {
  XcdBarrier b; b.bar = bar; b.x = xb_xcc_id(); b.st = st;
  if (threadIdx.x == 0) (void)xb_add(&bar[XB_XCNT(b.x)], 1u);
  return b;
}
DI void xcd_barrier_complete(unsigned* bar, unsigned x, unsigned& nloc, unsigned& nx) {
  const unsigned G = gridDim.x * gridDim.y * gridDim.z;
  unsigned sum, cnt, mine, sp = 0u;
  for (;;) {
    sum = 0u; cnt = 0u; mine = 0u;
#pragma unroll
    for (unsigned j = 0; j < 16; ++j) { const unsigned c = xb_ld(&bar[XB_XCNT(j)]); sum += c; cnt += (c > 0u) ? 1u : 0u; mine = (j == x) ? c : mine; }
    if (sum == G) break;
    __builtin_amdgcn_s_sleep(1);
    if ((++sp & 255u) == 0u) { if (xb_ld(&bar[XB_TMO])) break; if (sp > XB_SPIN_CAP) { atomicAdd(&bar[XB_TMO], 1u); break; } }
  }
  nloc = mine > 0u ? mine : 1u; nx = cnt > 0u ? cnt : 1u;
}
DI void xcd_barrier(const XcdBarrier& b) {
  asm volatile("s_waitcnt vmcnt(0)" ::: "memory");
  __syncthreads();
  if (threadIdx.x == 0) {
    unsigned* bar = b.bar;
    __builtin_amdgcn_s_waitcnt(0);
    unsigned nloc = b.st[0], nx = b.st[1];
    if (nloc == 0u) { xcd_barrier_complete(bar, b.x, nloc, nx); b.st[0] = nloc; b.st[1] = nx; }
    const unsigned old = xb_add(&bar[XB_XSUB(b.x)], 1u);
    const unsigned gen = old / nloc;
    if (old + 1u == (gen + 1u) * nloc) {
      __builtin_amdgcn_fence(__ATOMIC_RELEASE, "agent");
      asm volatile("s_waitcnt vmcnt(0)" ::: "memory");
      const unsigned og = xb_add(&bar[XB_TOP], 1u);
      const unsigned tg = og / nx;
      if (og + 1u == (tg + 1u) * nx) xb_add(&bar[XB_TOPGEN], 1u);
      else XB_SPIN(xb_ld(&bar[XB_TOPGEN]) == tg, bar);
      __builtin_amdgcn_fence(__ATOMIC_ACQUIRE, "agent");
      xb_add(&bar[XB_XGEN(b.x)], 1u);
      asm volatile("s_waitcnt vmcnt(0)" ::: "memory");
    } else {
      XB_SPIN(xb_ld(&bar[XB_XGEN(b.x)]) == gen, bar);
      __builtin_amdgcn_fence(__ATOMIC_ACQUIRE, "agent");
      asm volatile("s_waitcnt vmcnt(0)" ::: "memory");
    }
  }
  __syncthreads();
}

extern __shared__ __attribute__((aligned(16))) char smem[];
constexpr int LDS_BYTES = 98304;

#ifndef REPEAT
#define REPEAT 0
#endif
#ifndef FAST_MASK
#define FAST_MASK 255
#endif
#define GSYNC() xcd_barrier(xb)

__global__ void __launch_bounds__(NTHREADS) fwd_megakernel(Params p) {
  cg::grid_group grid = cg::this_grid();
  char* lds = smem;
  __shared__ uint4 xb_words;
  if (threadIdx.x == 0) xb_words = make_uint4(0u, 0u, 0u, 0u);
  __syncthreads();
  XcdBarrier xb = xcd_barrier_post((unsigned*)(p.ws + WS_BAR), (volatile LAS unsigned*)&xb_words);
  phase_prep(p, lds);
  grid.sync();
  if (REPEAT & 16) { phase_prep(p, lds); GSYNC(); }
  phase_adaln(p, 0);
  GSYNC();
  if (REPEAT & 16) { phase_adaln(p, 0); GSYNC(); }
  if (FAST_MASK & 1) phase_inproj0(p, lds); else nphase_inproj0(p, lds);
  GSYNC();
  if (REPEAT & 1) { phase_inproj0(p, lds); GSYNC(); }
  phase_l0prep(p, lds);
  GSYNC();
#if DBG_CHECK == 1
  nphase_l0gemms(p, lds); GSYNC(); nphase_qmla_rope(p); GSYNC();
  fingerprint(p, p.out, (YS_VTMLA + 25165824) / 2, false, 0, lds); GSYNC();
  phase_l0gemms(p, lds); GSYNC();
  fingerprint(p, p.out, (YS_VTMLA + 25165824) / 2, false, 1, lds);
#else
  if (FAST_MASK & 2) phase_l0gemms(p, lds); else { nphase_l0gemms(p, lds); GSYNC(); nphase_qmla_rope(p); }
#endif
  GSYNC();
  if (REPEAT & 1) { phase_l0gemms(p, lds); GSYNC(); }
#if DBG_CHECK == 2
  nattn<0>(p); nattn<1>(p); GSYNC();
  fingerprint(p, p.ws + WS_H, (size_t)NTOK * DM, false, 0, lds); GSYNC();
  phase_attn0(p, lds); GSYNC();
  fingerprint(p, p.ws + WS_H, (size_t)NTOK * DM, false, 1, lds);
#else
  if (FAST_MASK & 4) phase_attn0(p, lds); else { nattn<0>(p); nattn<1>(p); }
#endif
  GSYNC();
  if (REPEAT & 2) { phase_attn0(p, lds); GSYNC(); }
#if DBG_CHECK == 3
  nphase_outproj(p, 0, lds); GSYNC();
  fingerprint(p, p.out, (size_t)NTOK * DM, true, 0, lds); GSYNC();
  phase_outproj(p, 0, lds); GSYNC();
  fingerprint(p, p.out, (size_t)NTOK * DM, true, 1, lds);
#else
  if (FAST_MASK & 8) phase_outproj(p, 0, lds); else nphase_outproj(p, 0, lds);
#endif
  GSYNC();
  if (REPEAT & 1) { phase_outproj(p, 0, lds); GSYNC(); }
  phase_adaln(p, 1);
  GSYNC();
  if (FAST_MASK & 16) phase_inproj1(p, lds); else nphase_inproj1(p, lds);
  GSYNC();
  if (REPEAT & 1) { phase_inproj1(p, lds); GSYNC(); }
  phase_l1prep(p, lds);
  GSYNC();
#if DBG_CHECK == 5
  nphase_gdn(p, lds); GSYNC();
  fingerprint(p, p.ws + WS_OF, (size_t)NTOK * 512, false, 0, lds); GSYNC();
  phase_chunkprep(p, lds); GSYNC();
  phase_scan(p, lds); GSYNC();
  fingerprint(p, p.ws + WS_OF, (size_t)NTOK * 512, false, 1, lds);
#elif DBG_CHECK == 6
  nphase_gdn(p, lds); GSYNC();
  fingerprint(p, p.ws + WS_OB, (size_t)NTOK * 512, false, 0, lds); GSYNC();
  phase_chunkprep(p, lds); GSYNC();
  phase_scan(p, lds); GSYNC();
  fingerprint(p, p.ws + WS_OB, (size_t)NTOK * 512, false, 1, lds);
#else
  if (FAST_MASK & 32) { phase_chunkprep(p, lds); GSYNC(); if (REPEAT & 4) { phase_chunkprep(p, lds); GSYNC(); } phase_scan(p, lds); if (REPEAT & 8) { GSYNC(); phase_scan(p, lds); } } else nphase_gdn(p, lds);
#endif
  GSYNC();
  phase_gdnfinal(p);
#if DBG_CHECK == 4
  nattn<2>(p); GSYNC();
  fingerprint(p, p.ws + WS_H, (size_t)NTOK * DM, false, 0, lds); GSYNC();
  phase_attn1(p, lds); GSYNC();
  fingerprint(p, p.ws + WS_H, (size_t)NTOK * DM, false, 1, lds);
#else
  if (FAST_MASK & 64) phase_attn1(p, lds); else nattn<2>(p);
#endif
  GSYNC();
  if (REPEAT & 2) { phase_attn1(p, lds); GSYNC(); }
  if (FAST_MASK & 128) phase_outproj(p, 1, lds); else nphase_outproj(p, 1, lds);
  GSYNC();
  phase_final(p);
}

extern "C" void kernel_launch(void* const* d_in, const int* in_sizes, int n_in, void* d_out, int out_size, void* d_ws, size_t ws_size, hipStream_t stream) {
  static int grid_blocks = 0;
  if (!grid_blocks) {
    int dev = 0, cus = 0, per_cu = 0;
    (void)hipGetDevice(&dev);
    (void)hipDeviceGetAttribute(&cus, hipDeviceAttributeMultiprocessorCount, dev);
    (void)hipFuncSetAttribute((const void*)fwd_megakernel, hipFuncAttributeMaxDynamicSharedMemorySize, LDS_BYTES);
    (void)hipOccupancyMaxActiveBlocksPerMultiprocessor(&per_cu, fwd_megakernel, NTHREADS, LDS_BYTES);
    if (per_cu > 1) per_cu = 1;
    grid_blocks = cus * per_cu;
    if (grid_blocks <= 0) { fprintf(stderr, "occupancy query failed (cus %d per_cu %d)\n", cus, per_cu); grid_blocks = 0; return; }
  }
  if (n_in != 33 || ws_size < WS_END + 65536) { fprintf(stderr, "kernel_launch: unexpected n_in %d / ws %zu\n", n_in, ws_size); return; }
  Params p{};
  const float** pp = (const float**)&p;
  for (int i = 0; i < 33; ++i) pp[i] = (const float*)d_in[i];
  p.out = (float*)d_out;
  p.ws = (char*)d_ws;
  (void)hipMemsetAsync((char*)d_ws + WS_BAR, 0, 16384, stream);
  void* args[] = {&p};
  hipError_t e = hipLaunchCooperativeKernel((void*)fwd_megakernel, dim3(grid_blocks), dim3(NTHREADS), args, LDS_BYTES, stream);
  if (e != hipSuccess) fprintf(stderr, "cooperative launch failed: %s (grid %d)\n", hipGetErrorString(e), grid_blocks);
}
```

```cpp
#include <hip/hip_runtime.h>
#include <hip/hip_cooperative_groups.h>
#include <cstdio>
#include <cstdint>
namespace cg = cooperative_groups;

#define DI __device__ __forceinline__
typedef unsigned short u16;
using bf16x8 = __attribute__((ext_vector_type(8))) short;
using bf16x4 = __attribute__((ext_vector_type(4))) short;
using f32x16 = __attribute__((ext_vector_type(16))) float;
using f32x4  = __attribute__((ext_vector_type(4))) float;
using u32x4  = __attribute__((ext_vector_type(4))) unsigned;
using u32x2  = __attribute__((ext_vector_type(2))) unsigned;

#ifndef PHASE_LIMIT
#define PHASE_LIMIT 99
#endif

constexpr int NTHREADS = 512;
constexpr int DM = 1024, NTOK = 20480, NCTX = 4096, NKROW = 24576;
constexpr int L0C = 2464, L0CP = 2560, L1C = 3600, L1CP = 3840;
constexpr int U1A_LD = 1536, U1B_LD = 2048;
constexpr int C0_CQ = 0, C0_CKV = 384, C0_KR = 640, C0_ZA = 672, C0_QB = 1184, C0_KB = 1696, C0_VB = 1824, C0_ZB = 1952;
constexpr int C1_ZC = 0, C1_QD = 512, C1_KD = 1024, C1_VD = 1280, C1_ZD = 1536;
constexpr float EPS = 1e-6f;
constexpr float LOG2E = 1.4426950408889634f;

constexpr size_t O_Y = 0;
constexpr size_t O_CKV = 20971520, O_KROPE = 22020096, O_SWAK = 22151168, O_SWAV = 22675456, O_STATE = 23199744, O_ATTK = 25296896, O_ATTV = 26345472;

constexpr size_t WS_WO1 = 0;
constexpr size_t WS_MOD = WS_WO1 + 2097152;
constexpr size_t WS_ROPE = WS_MOD + 221184;
constexpr size_t WS_W2 = WS_ROPE + 32768;
constexpr size_t WS_WT0 = WS_W2;
constexpr size_t WS_WUQ = WS_WT0 + 5242880;
constexpr size_t WS_WUKV = WS_WUQ + 589824;
constexpr size_t WS_WO0 = WS_WUKV + 524288;
constexpr size_t WS_WT1 = WS_WO0 + 2097152;
constexpr size_t WS_W2_END = WS_WT1 + 7864320;
constexpr size_t WS_VTATT = WS_W2;
constexpr size_t WS_KC = WS_VTATT + 12582912;
constexpr size_t WS_GB = WS_KC + 2097152;
static_assert(WS_GB + 1310720 <= WS_W2_END, "layer-1 reuse overflow");
constexpr size_t WS_H = WS_W2_END;
constexpr size_t WS_U = WS_H + 41943040;
constexpr size_t WS_U0X = WS_U + (size_t)NTOK * L0C * 2;
constexpr size_t WS_KSWA = WS_U0X;
constexpr size_t WS_VTSWA = WS_KSWA + 6291456;
constexpr size_t WS_CKVN = WS_VTSWA + 6291456;
constexpr size_t WS_KROPE = WS_CKVN + 12582912;
static_assert(WS_KROPE + 1572864 <= WS_U + 147456000, "layer-0 extras overflow");
constexpr size_t WS_GY0 = WS_U;
constexpr size_t WS_U1A = WS_U;
constexpr size_t WS_U1B = WS_U + 62914560;
constexpr size_t WS_GY1 = WS_U1A;
constexpr size_t WS_TB = WS_U1A;
constexpr size_t WS_AM = WS_TB + 20971520;
constexpr size_t WS_OB = WS_AM + 20971520;
constexpr size_t WS_X = WS_U + 147456000;
constexpr size_t WS_VC = WS_X;
constexpr size_t WS_OF = WS_VC + 20971520;
constexpr size_t WS_AB = WS_OF + 20971520;
constexpr size_t WS_END = WS_AB + 1310720;
static_assert(WS_END <= 268435456ull, "ws overflow");
constexpr size_t WS_BAR = WS_END;
constexpr size_t YS_QMLA = 0;
constexpr size_t YS_KN = YS_QMLA + 31457280;
constexpr size_t YS_VTMLA = YS_KN + 25165824;
static_assert(YS_VTMLA + 25165824 <= (size_t)NTOK * DM * 4, "y scratch overflow");

struct Params {
  const float *x_prompt, *x_sample, *c_ckv, *c_krope, *c_swak, *c_swav, *c_state, *c_attk, *c_attv, *c, *c_ctx;
  const float *w_mod0, *b_mod0, *ln0, *w_in0, *mla_q_norm, *w_uq, *mla_kv_norm, *w_ukv, *swa_sink, *w_out0;
  const float *w_mod1, *b_mod1, *ln1, *w_in1, *gdn_conv, *gdn_a_log, *gdn_dt_bias, *gdn_norm, *att_q_norm, *att_k_norm, *w_out1, *ln_f;
  float* out;
  char* ws;
};

DI int opaque_zero() { int z = 0; asm volatile("" : "+v"(z)); return z; }
DI int opaque_tid() { int t = (int)threadIdx.x; asm volatile("" : "+v"(t)); return t; }
#define TIDX() opaque_tid()
DI void code_prefetch(unsigned long long code_end);
DI float bf2f(u16 b) { return __uint_as_float(((unsigned)b) << 16); }
typedef float ntf4 __attribute__((ext_vector_type(4)));
DI u32x4 ntload4u(const u16* q) { return __builtin_nontemporal_load((const u32x4*)q); }
DI u32x2 ntload2u(const u16* q) { return __builtin_nontemporal_load((const u32x2*)q); }
DI float4 ntload4(const float* q) { const ntf4 v = __builtin_nontemporal_load((const ntf4*)q); return make_float4(v[0], v[1], v[2], v[3]); }
DI u16 f2bf(float x) { unsigned u = __float_as_uint(x); u += 0x7fffu + ((u >> 16) & 1u); return (u16)(u >> 16); }
typedef __bf16 hwbf16x2_t __attribute__((ext_vector_type(2)));
typedef float hwf32x2_t __attribute__((ext_vector_type(2)));
DI unsigned pack2(float lo, float hi) { const hwf32x2_t v = {lo, hi}; return __builtin_bit_cast(unsigned, __builtin_convertvector(v, hwbf16x2_t)); }
DI int crow(int reg, int h) { return (reg & 3) + 8 * (reg >> 2) + 4 * h; }
DI int swz16(int k) { return (k & ~12) | ((k & 4) << 1) | ((k & 8) >> 1); }
DI float siluf(float x) { return x * __builtin_amdgcn_rcpf(1.f + __expf(-x)); }
DI int seq_of_tok(int m) { return m < NCTX ? (m >> 8) : 16 + ((m - NCTX) >> 11); }
DI int tok0_of(int s) { return s < 16 ? s * 256 : NCTX + (s - 16) * 2048; }
DI int krow0_of(int s) { return s < 16 ? s * 256 : NCTX + (s - 16) * 2560; }
DI int cap_of(int s) { return s < 16 ? 256 : 2560; }
DI int len_of(int s) { return s < 16 ? 256 : 2048; }
DI int modidx_of_tok(int m) { return m < NCTX ? 0 : 1 + ((m - NCTX) >> 11); }
DI int krow_of_tok(int m) { return m < NCTX ? m : NCTX + ((m - NCTX) >> 11) * 2560 + ((m - NCTX) & 2047); }
DI int pos_of_tok(int m) { return m < NCTX ? (m & 255) : ((m - NCTX) & 2047); }
DI const float* xrow(const Params& p, int m) { return m < NCTX ? p.x_prompt + (size_t)m * DM : p.x_sample + (size_t)(m - NCTX) * DM; }
DI float wave_sum(float v) {
#pragma unroll
  for (int o = 32; o > 0; o >>= 1) v += __shfl_xor(v, o);
  return v;
}
DI bf16x8 pack8(const f32x16& x, int s) {
  u32x4 w = {pack2(x[8 * s + 0], x[8 * s + 1]), pack2(x[8 * s + 2], x[8 * s + 3]), pack2(x[8 * s + 4], x[8 * s + 5]), pack2(x[8 * s + 6], x[8 * s + 7])};
  return __builtin_bit_cast(bf16x8, w);
}
DI bf16x8 cat4(bf16x4 lo, bf16x4 hi) { return __builtin_shufflevector(lo, hi, 0, 1, 2, 3, 4, 5, 6, 7); }
#define MFMA(a, b, c) __builtin_amdgcn_mfma_f32_32x32x16_bf16((a), (b), (c), 0, 0, 0)

DI void transpose_tile(const float* __restrict__ W, int ldw, int k0, int srccol0, int nvalid, u16* __restrict__ Wt, int ldt, int dstrow0, char* lds) {
  u16* t = (u16*)lds;
  const int tid = TIDX(), kr = tid >> 3, cc = (tid & 7) * 8;
  float v[8];
  if (cc < nvalid) {
    const float4 a = *(const float4*)(W + (size_t)(k0 + kr) * ldw + srccol0 + cc);
    const float4 b = *(const float4*)(W + (size_t)(k0 + kr) * ldw + srccol0 + cc + 4);
    v[0] = a.x; v[1] = a.y; v[2] = a.z; v[3] = a.w; v[4] = b.x; v[5] = b.y; v[6] = b.z; v[7] = b.w;
  } else {
#pragma unroll
    for (int e = 0; e < 8; ++e) v[e] = 0.f;
  }
#pragma unroll
  for (int e = 0; e < 8; ++e) t[(cc + e) * 72 + kr] = f2bf(v[e]);
  __syncthreads();
  const int n = tid >> 3, kc = (tid & 7) * 8;
  *(bf16x8*)(Wt + (size_t)(dstrow0 + n) * ldt + k0 + kc) = *(const bf16x8*)(t + n * 72 + kc);
  __syncthreads();
}

template <int MAT>
DI void transpose_tiles4(const Params& p, int t0, char* lds) {
  constexpr int NTN = MAT == 0 ? 40 : MAT == 1 ? 12 : MAT == 2 ? 16 : MAT == 4 ? 60 : 16;
  constexpr int NKT = MAT == 1 ? 6 : MAT == 2 ? 4 : 16;
  constexpr int LDW = MAT == 0 ? L0C : MAT == 1 ? 768 : MAT == 4 ? L1C : 1024;
  constexpr int LDT = MAT == 1 ? 384 : MAT == 2 ? 256 : 1024;
  const float* W = MAT == 0 ? p.w_in0 : MAT == 1 ? p.w_uq : MAT == 2 ? p.w_ukv : MAT == 3 ? p.w_out0 : MAT == 4 ? p.w_in1 : p.w_out1;
  u16* Wt = (u16*)(p.ws + (MAT == 0 ? WS_WT0 : MAT == 1 ? WS_WUQ : MAT == 2 ? WS_WUKV : MAT == 3 ? WS_WO0 : MAT == 4 ? WS_WT1 : WS_WO1));
  const int tid = TIDX(), kr = tid >> 3, cc = (tid & 7) * 8;
  float v[4][8];
#pragma unroll
  for (int q = 0; q < 4; ++q) {
    const int t = t0 + q;
#pragma unroll
    for (int e = 0; e < 8; ++e) v[q][e] = 0.f;
    if (t < NTN * NKT) {
      const int kt = t / NTN, nt = t % NTN, n0 = nt * 64;
      int src = n0, nv = 64;
      if (MAT == 0) { nv = L0C - n0; nv = nv < 0 ? 0 : (nv > 64 ? 64 : nv); }
      if (MAT == 2) src = nt < 8 ? nt * 128 : (nt - 8) * 128 + 64;
      if (MAT == 4) { if (n0 < 1536) { src = n0; } else if (n0 < 3584) { src = n0 + 16; } else if (n0 == 3584) { src = 1536; nv = 16; } else { src = 0; nv = 0; } }
      if (cc < nv) {
        const float4 a = ntload4(W + (size_t)(kt * 64 + kr) * LDW + src + cc);
        const float4 b = ntload4(W + (size_t)(kt * 64 + kr) * LDW + src + cc + 4);
        v[q][0] = a.x; v[q][1] = a.y; v[q][2] = a.z; v[q][3] = a.w; v[q][4] = b.x; v[q][5] = b.y; v[q][6] = b.z; v[q][7] = b.w;
      }
    }
  }
#pragma unroll
  for (int q = 0; q < 4; ++q) {
    u16* tl = (u16*)lds + q * 64 * 72;
#pragma unroll
    for (int e = 0; e < 8; ++e) tl[(cc + e) * 72 + (kr ^ cc)] = f2bf(v[q][e]);
  }
  __syncthreads();
  const int n = tid >> 3, kc = (tid & 7) * 8;
#pragma unroll
  for (int q = 0; q < 4; ++q) {
    const int t = t0 + q;
    if (t < NTN * NKT) {
      const int kt = t / NTN, nt = t % NTN;
      *(bf16x8*)(Wt + (size_t)(nt * 64 + n) * LDT + kt * 64 + kc) = *(const bf16x8*)((const u16*)lds + q * 64 * 72 + n * 72 + (kc ^ (n & 56)));
    }
  }
  __syncthreads();
}

DI void vt_store16(const u16* sv, int CS, int C, u16* __restrict__ vt, size_t cap, int key16base) {
  for (int i = TIDX(); i < C * 4; i += NTHREADS) {
    const int ch = i >> 2, q = i & 3;
    u16 e[4];
#pragma unroll
    for (int j = 0; j < 4; ++j) e[j] = sv[swz16(q * 4 + j) * CS + ch];
    u32x2 w = {(unsigned)e[0] | ((unsigned)e[1] << 16), (unsigned)e[2] | ((unsigned)e[3] << 16)};
    *(u32x2*)(vt + (size_t)ch * cap + key16base + q * 4) = w;
  }
}

DI void phase_prep(const Params& p, char* lds) {
  const int tid = TIDX();
  constexpr int N_MOD = 192;
  constexpr int T_IN0 = 16 * 40, T_UQ = 6 * 12, T_UKV = 4 * 16, T_O0 = 256, T_IN1 = 16 * 60, T_O1 = 256;
  constexpr int N_TR = T_IN0 + T_UQ + T_UKV + T_O0 + T_IN1 + T_O1;
  constexpr int N_CV = 256 + 32 + 128;
  constexpr int N_VT = 256;
  constexpr int N_TRQ = 562;
  constexpr int N_ITEMS = N_MOD + N_TRQ + N_CV + N_VT + 1;
  for (int it = blockIdx.x; it < N_ITEMS; it += gridDim.x) {
    if (it < N_MOD) {
      const int layer = it / 96, col0 = (it % 96) * 32;
      const float* Wm = layer ? p.w_mod1 : p.w_mod0;
      const float* bm = layer ? p.b_mod1 : p.b_mod0;
      float* sc = (float*)lds;
      float* red = sc + 9 * 1024;
      for (int i = tid; i < 9 * 1024; i += NTHREADS) {
        const int s = i >> 10, k = i & 1023;
        const float cv = s == 0 ? p.c_ctx[k] : p.c[(s - 1) * 1024 + k];
        sc[i] = siluf(cv);
      }
      __syncthreads();
      const int col = tid & 31, kg = tid >> 5;
      float acc[9];
#pragma unroll
      for (int s = 0; s < 9; ++s) acc[s] = 0.f;
      for (int kk = 0; kk < 64; ++kk) {
        const int k = kg * 64 + kk;
        const float w = __builtin_nontemporal_load(Wm + (size_t)k * 3072 + col0 + col);
#pragma unroll
        for (int s = 0; s < 9; ++s) acc[s] += sc[s * 1024 + k] * w;
      }
#pragma unroll
      for (int s = 0; s < 9; ++s) red[(kg * 9 + s) * 32 + col] = acc[s];
      __syncthreads();
      if (tid < 288) {
        const int s = tid >> 5, c2 = tid & 31;
        float a = bm[col0 + c2];
        for (int g = 0; g < 16; ++g) a += red[(g * 9 + s) * 32 + c2];
        ((float*)(p.ws + WS_MOD))[(size_t)(layer * 9 + s) * 3072 + col0 + c2] = a;
      }
      __syncthreads();
    } else if (it < N_MOD + N_TRQ) {
      int bq = it - N_MOD;
      if (bq < 160) transpose_tiles4<0>(p, bq * 4, lds);
      else if (bq < 178) transpose_tiles4<1>(p, (bq - 160) * 4, lds);
      else if (bq < 194) transpose_tiles4<2>(p, (bq - 178) * 4, lds);
      else if (bq < 258) transpose_tiles4<3>(p, (bq - 194) * 4, lds);
      else if (bq < 498) transpose_tiles4<4>(p, (bq - 258) * 4, lds);
      else transpose_tiles4<5>(p, (bq - 498) * 4, lds);
    } else if (it < N_MOD + N_TRQ + N_CV) {
      int t = it - N_MOD - N_TRQ;
      const int e0 = tid * 8;
      if (t < 256) {
        const size_t i = (size_t)t * 4096 + e0; const int b = (int)(i >> 17), rem = (int)(i & 131071), pp = rem >> 8, cc = rem & 255;
        const float4 a = ntload4(p.c_ckv + i), b4 = ntload4(p.c_ckv + i + 4);
        u32x4 w = {pack2(a.x, a.y), pack2(a.z, a.w), pack2(b4.x, b4.y), pack2(b4.z, b4.w)};
        *(u32x4*)((u16*)(p.ws + WS_CKVN) + (size_t)(NCTX + b * 2560 + 2048 + pp) * 256 + cc) = w;
      } else if (t < 288) {
        const size_t i = (size_t)(t - 256) * 4096 + e0; const int b = (int)(i >> 14), rem = (int)(i & 16383), pp = rem >> 5, cc = rem & 31;
        const float4 a = *(const float4*)(p.c_krope + i), b4 = *(const float4*)(p.c_krope + i + 4);
        u32x4 w = {pack2(a.x, a.y), pack2(a.z, a.w), pack2(b4.x, b4.y), pack2(b4.z, b4.w)};
        *(u32x4*)((u16*)(p.ws + WS_KROPE) + (size_t)(NCTX + b * 2560 + 2048 + pp) * 32 + cc) = w;
      } else {
        const size_t i = (size_t)(t - 288) * 4096 + e0; const int b = (int)(i >> 16), rem = (int)(i & 65535), pp = rem >> 7, cc = rem & 127;
        const float4 a = ntload4(p.c_swak + i), b4 = ntload4(p.c_swak + i + 4);
        u32x4 w = {pack2(a.x, a.y), pack2(a.z, a.w), pack2(b4.x, b4.y), pack2(b4.z, b4.w)};
        *(u32x4*)((u16*)(p.ws + WS_KSWA) + (size_t)(NCTX + b * 2560 + 2048 + pp) * 128 + cc) = w;
      }
    } else if (it < N_MOD + N_TRQ + N_CV + N_VT) {
      const int t = it - N_MOD - N_TRQ - N_CV; const int b = t >> 5, g = t & 31;
      u16* sv = (u16*)lds;
      {
        const int key = tid >> 5, c4 = (tid & 31) * 4;
        const float4 a = *(const float4*)(p.c_swav + ((size_t)(b * 512 + g * 16 + key)) * 128 + c4);
        u32x2 w = {pack2(a.x, a.y), pack2(a.z, a.w)};
        *(u32x2*)(sv + key * 136 + c4) = w;
      }
      __syncthreads();
      vt_store16(sv, 136, 128, (u16*)(p.ws + WS_VTSWA) + (size_t)krow0_of(16 + b) * 128, 2560, 2048 + g * 16);
      __syncthreads();
    } else {
      float2* tab = (float2*)(p.ws + WS_ROPE);
      for (int i = tid; i < 64 * 8 + 64 * 16 + 64 * 32; i += NTHREADS) {
        int q, pos, f, j = i;
        if (j < 512) { q = 8; } else if (j < 1536) { q = 16; j -= 512; } else { q = 32; j -= 1536; }
        pos = j / q; f = j % q;
        const float inv = __builtin_amdgcn_exp2f(-(float)f / (float)q * 13.287712379549449f);
        const float rev = (float)pos * inv * 0.15915494309189535f;
        tab[i] = make_float2(__builtin_amdgcn_cosf(rev), __builtin_amdgcn_sinf(rev));
      }
    }
  }
}

DI void phase_adaln(const Params& p, int layer) {
  const int tid_ = TIDX(), lane = tid_ & 63, wid = tid_ >> 6;
  const float* ln = layer ? p.ln1 : p.ln0;
  const float* mod = (const float*)(p.ws + WS_MOD) + (size_t)layer * 9 * 3072;
  u16* H = (u16*)(p.ws + WS_H);
  const u16* GY = (const u16*)(p.ws + WS_GY0);
  float4 g4[4];
#pragma unroll
  for (int j = 0; j < 4; ++j) g4[j] = *(const float4*)(ln + (j * 64 + lane) * 4);
  const int stride = gridDim.x * 8;
  int m = blockIdx.x * 8 + wid;
  float4 cur[4], nxt[4]; u32x2 cg[4], ng[4];
  if (m < NTOK) { const float* x = xrow(p, m);
#pragma unroll
    for (int j = 0; j < 4; ++j) { cur[j] = ntload4(x + (j * 64 + lane) * 4); if (layer) cg[j] = ntload2u(GY + (size_t)m * DM + (j * 64 + lane) * 4); } }
  for (; m < NTOK; m += stride) {
    const int mn = m + stride;
    if (mn < NTOK) { const float* xn = xrow(p, mn);
#pragma unroll
      for (int j = 0; j < 4; ++j) { nxt[j] = ntload4(xn + (j * 64 + lane) * 4); if (layer) ng[j] = ntload2u(GY + (size_t)mn * DM + (j * 64 + lane) * 4); } }
    const float* md = mod + (size_t)modidx_of_tok(m) * 3072;
    float4 sh[4], sc[4];
#pragma unroll
    for (int j = 0; j < 4; ++j) { sh[j] = *(const float4*)(md + (j * 64 + lane) * 4); sc[j] = *(const float4*)(md + 1024 + (j * 64 + lane) * 4); }
    if (layer) {
#pragma unroll
      for (int j = 0; j < 4; ++j) {
        cur[j].x += bf2f((u16)(cg[j][0] & 0xffffu)); cur[j].y += bf2f((u16)(cg[j][0] >> 16)); cur[j].z += bf2f((u16)(cg[j][1] & 0xffffu)); cur[j].w += bf2f((u16)(cg[j][1] >> 16));
        { typedef float nt4 __attribute__((ext_vector_type(4))); const nt4 xv = {cur[j].x, cur[j].y, cur[j].z, cur[j].w}; __builtin_nontemporal_store(xv, (nt4*)(p.out + (size_t)m * DM + (j * 64 + lane) * 4)); }
      }
    }
    float ss = 0.f;
#pragma unroll
    for (int j = 0; j < 4; ++j) ss += cur[j].x * cur[j].x + cur[j].y * cur[j].y + cur[j].z * cur[j].z + cur[j].w * cur[j].w;
    ss = wave_sum(ss);
    const float rs = rsqrtf(ss * (1.f / 1024.f) + EPS);
#pragma unroll
    for (int j = 0; j < 4; ++j) {
      const int c = (j * 64 + lane) * 4;
      const float a0 = cur[j].x * rs * g4[j].x * (1.f + sc[j].x) + sh[j].x, a1 = cur[j].y * rs * g4[j].y * (1.f + sc[j].y) + sh[j].y;
      const float a2 = cur[j].z * rs * g4[j].z * (1.f + sc[j].z) + sh[j].z, a3 = cur[j].w * rs * g4[j].w * (1.f + sc[j].w) + sh[j].w;
      u32x2 w = {pack2(a0, a1), pack2(a2, a3)};
      *(u32x2*)(H + (size_t)m * DM + c) = w;
    }
#pragma unroll
    for (int j = 0; j < 4; ++j) { cur[j] = nxt[j]; cg[j] = ng[j]; }
  }
}

struct GemmA { const u16* p0; int ld0; const u16* p1; int ld1; int ksplit; };
constexpr int G_LDS_A = 256 * 72 * 2;
template <class Epi>
DI void gemm_tile(const GemmA A, const u16* __restrict__ B, int ldb, int K, int m0, int n0, char* lds, Epi& epi) {
  u16* sA = (u16*)lds;
  const int tid = TIDX(), lane = tid & 63, wid = tid >> 6, r32 = lane & 31, h = lane >> 5;
  const int wm = wid >> 1, wn = wid & 1;
  const int lr = tid >> 3, lc = (tid & 7) * 8;
  f32x16 acc[2][2];
#pragma unroll
  for (int i = 0; i < 2; ++i)
#pragma unroll
    for (int j = 0; j < 2; ++j)
#pragma unroll
      for (int r = 0; r < 16; ++r) acc[i][j][r] = 0.f;
  bf16x8 ra0[4], rb0[2], ra1[4], rb1[2];
  const int nk = K >> 6;
  constexpr int GBUF = 256 * 72 + 128 * 72;
#define G_LOAD(RA, RB, KT) do { const int k0_ = (KT) * 64; const u16* ap_; int lda_, kk_; \
    if (k0_ < A.ksplit) { ap_ = A.p0; lda_ = A.ld0; kk_ = k0_; } else { ap_ = A.p1; lda_ = A.ld1; kk_ = k0_ - A.ksplit; } \
    _Pragma("unroll") for (int i_ = 0; i_ < 4; ++i_) RA[i_] = *(const bf16x8*)(ap_ + (size_t)(m0 + lr + 64 * i_) * lda_ + kk_ + lc); \
    _Pragma("unroll") for (int i_ = 0; i_ < 2; ++i_) RB[i_] = *(const bf16x8*)(B + (size_t)(n0 + lr + 64 * i_) * ldb + k0_ + lc); } while (0)
#define G_WRITE(RA, RB, BUF) do { u16* a_ = sA + (BUF) * GBUF; u16* b_ = a_ + 256 * 72; \
    _Pragma("unroll") for (int i_ = 0; i_ < 4; ++i_) *(bf16x8*)(a_ + (lr + 64 * i_) * 72 + lc) = RA[i_]; \
    _Pragma("unroll") for (int i_ = 0; i_ < 2; ++i_) *(bf16x8*)(b_ + (lr + 64 * i_) * 72 + lc) = RB[i_]; } while (0)
#define G_COMPUTE(BUF) do { const u16* a_ = sA + (BUF) * GBUF; const u16* b_ = a_ + 256 * 72; \
    _Pragma("unroll") for (int ks = 0; ks < 4; ++ks) { \
      bf16x8 a0 = *(const bf16x8*)(a_ + (wm * 64 + r32) * 72 + ks * 16 + h * 8); \
      bf16x8 a1 = *(const bf16x8*)(a_ + (wm * 64 + 32 + r32) * 72 + ks * 16 + h * 8); \
      bf16x8 b0 = *(const bf16x8*)(b_ + (wn * 64 + r32) * 72 + ks * 16 + h * 8); \
      bf16x8 b1 = *(const bf16x8*)(b_ + (wn * 64 + 32 + r32) * 72 + ks * 16 + h * 8); \
      acc[0][0] = MFMA(a0, b0, acc[0][0]); acc[0][1] = MFMA(a0, b1, acc[0][1]); \
      acc[1][0] = MFMA(a1, b0, acc[1][0]); acc[1][1] = MFMA(a1, b1, acc[1][1]); } } while (0)
  __syncthreads();
  G_LOAD(ra0, rb0, 0);
  if (nk > 1) G_LOAD(ra1, rb1, 1);
  G_WRITE(ra0, rb0, 0);
  __syncthreads();
  if (nk > 2) G_LOAD(ra0, rb0, 2);
#pragma unroll 1
  for (int kt = 0; kt < nk; kt += 2) {
    G_COMPUTE(0);
    if (kt + 1 < nk) {
      G_WRITE(ra1, rb1, 1);
      __syncthreads();
      if (kt + 3 < nk) G_LOAD(ra1, rb1, kt + 3);
      G_COMPUTE(1);
      if (kt + 2 < nk) {
        G_WRITE(ra0, rb0, 0);
        __syncthreads();
        if (kt + 4 < nk) G_LOAD(ra0, rb0, kt + 4);
      }
    }
  }
#undef G_LOAD
#undef G_WRITE
#undef G_COMPUTE
#pragma unroll
  for (int i = 0; i < 2; ++i)
#pragma unroll
    for (int j = 0; j < 2; ++j) epi(acc[i][j], m0 + wm * 64 + i * 32, n0 + wn * 64 + j * 32 + r32, h);
}

struct EpiU0 {
  u16* U;
  DI void operator()(const f32x16& a, int row0, int col, int h) const {
    if (col < L0C) {
#pragma unroll
      for (int r = 0; r < 16; ++r) U[(size_t)(row0 + crow(r, h)) * L0C + col] = f2bf(a[r]);
    }
  }
};
struct EpiQmla {
  u16* Q; const float2* tab;
  DI void operator()(const f32x16& a, int f0, int tok, int h) const {
    float v[16];
#pragma unroll
    for (int r = 0; r < 16; ++r) v[r] = a[r];
    if ((f0 % 96) == 64 && tok >= NCTX) {
      const int pos = pos_of_tok(tok), prow = pos >> 6, pcol = pos & 63;
#pragma unroll
      for (int j = 0; j < 4; ++j) {
        const int fi = 4 * h + j;
        const float2 cr = tab[prow * 8 + fi], cc = tab[pcol * 8 + fi];
        const float x1 = v[j], x2 = v[4 + j];
        v[j] = x1 * cr.x - x2 * cr.y; v[4 + j] = x2 * cr.x + x1 * cr.y;
        const float y1 = v[8 + j], y2 = v[12 + j];
        v[8 + j] = y1 * cc.x - y2 * cc.y; v[12 + j] = y2 * cc.x + y1 * cc.y;
      }
    }
#pragma unroll
    for (int g = 0; g < 4; ++g) {
      u32x2 w = {pack2(v[4 * g], v[4 * g + 1]), pack2(v[4 * g + 2], v[4 * g + 3])};
      *(u32x2*)(Q + (size_t)tok * 768 + f0 + 8 * g + 4 * h) = w;
    }
  }
};
struct EpiKvexp {
  u16* Kn; u16* Vt;
  DI void operator()(const f32x16& a, int kr0, int n, int h) const {
    const int head = n >> 7, within = n & 127;
    if (within < 64) {
#pragma unroll
      for (int r = 0; r < 16; ++r) Kn[((size_t)(kr0 + crow(r, h)) * 8 + head) * 64 + within] = f2bf(a[r]);
    } else {
      int seq, key0;
      if (kr0 < NCTX) { seq = kr0 >> 8; key0 = kr0 & 255; } else { const int r = kr0 - NCTX; seq = 16 + r / 2560; key0 = r % 2560; }
      const size_t cap = cap_of(seq);
      u16* base = Vt + (size_t)krow0_of(seq) * 512 + (size_t)(head * 64 + within - 64) * cap;
#pragma unroll
      for (int g = 0; g < 4; ++g) {
        const int pos = key0 + 16 * (g >> 1) + 8 * h + 4 * (g & 1);
        u32x2 w = {pack2(a[4 * g], a[4 * g + 1]), pack2(a[4 * g + 2], a[4 * g + 3])};
        *(u32x2*)(base + pos) = w;
      }
    }
  }
};
struct EpiOut {
  const Params* p; int layer;
  DI void operator()(const f32x16& a, int row0, int col, int h) const {
    const float* mod = (const float*)(p->ws + WS_MOD) + (size_t)(layer * 9 + modidx_of_tok(row0)) * 3072 + 2048;
    const float gate = mod[col];
#pragma unroll
    for (int r = 0; r < 16; ++r) {
      const int m = row0 + crow(r, h);
      const float xv = layer ? p->out[(size_t)m * DM + col] : xrow(*p, m)[col];
      p->out[(size_t)m * DM + col] = xv + gate * a[r];
    }
  }
};
struct EpiU1 {
  u16* UA; u16* UB; float* AB;
  DI void operator()(const f32x16& a, int row0, int col, int h) const {
    if (col < 1536) {
#pragma unroll
      for (int r = 0; r < 16; ++r) UA[(size_t)(row0 + crow(r, h)) * U1A_LD + col] = f2bf(a[r]);
    } else if (col < 3584) {
#pragma unroll
      for (int r = 0; r < 16; ++r) UB[(size_t)(row0 + crow(r, h)) * U1B_LD + col - 1536] = f2bf(a[r]);
    } else if (col < 3600) {
#pragma unroll
      for (int r = 0; r < 16; ++r) AB[(size_t)(row0 + crow(r, h)) * 16 + col - 3584] = a[r];
    }
  }
};


struct XcdIter {
  int xcd, lb, nlb, per, nmin, li;
  DI XcdIter(int nmaj, int nmin_) { xcd = blockIdx.x & 7; lb = blockIdx.x >> 3; nlb = gridDim.x >> 3; per = (nmaj >> 3) * nmin_; nmin = nmin_; li = lb; }
  DI bool valid() const { return li < per; }
  DI void next() { li += nlb; }
  DI int major() const { return xcd * (per / nmin) + li / nmin; }
  DI int minor() const { return li % nmin; }
};
DI void phase_inproj0(const Params& p, char* lds) {
  EpiU0 epi{(u16*)(p.ws + WS_U)};
  const u16* H = (const u16*)(p.ws + WS_H);
  const GemmA A{H, DM, H, DM, 1 << 30};
  for (XcdIter xi(80, 20); xi.valid(); xi.next())
    gemm_tile(A, (const u16*)(p.ws + WS_WT0), DM, DM, xi.major() * 256, xi.minor() * 128, lds, epi);
}
DI void phase_l0gemms(const Params& p, char* lds) {
  const u16* U0 = (const u16*)(p.ws + WS_U);
  EpiKvexp ek{(u16*)((char*)p.out + YS_KN), (u16*)((char*)p.out + YS_VTMLA)};
  EpiQmla eq{(u16*)((char*)p.out + YS_QMLA), (const float2*)(p.ws + WS_ROPE)};
  const u16* ck = (const u16*)(p.ws + WS_CKVN);
  const u16* wq = (const u16*)(p.ws + WS_WUQ);
  const GemmA Ak{ck, 256, ck, 256, 1 << 30};
  const GemmA Aq{wq, 384, wq, 384, 1 << 30};
  for (XcdIter xi(96, 8); xi.valid(); xi.next())
    gemm_tile(Ak, (const u16*)(p.ws + WS_WUKV), 256, 256, xi.major() * 256, xi.minor() * 128, lds, ek);
  for (XcdIter xi(160, 3); xi.valid(); xi.next())
    gemm_tile(Aq, U0 + C0_CQ, L0C, 384, xi.minor() * 256, xi.major() * 128, lds, eq);
}
DI void phase_outproj(const Params& p, int layer, char* lds) {
  EpiOut epi{&p, layer};
  const u16* H = (const u16*)(p.ws + WS_H);
  const GemmA A{H, DM, H, DM, 1 << 30};
  const u16* W = (const u16*)(p.ws + (layer ? WS_WO1 : WS_WO0));
  for (XcdIter xi(80, 8); xi.valid(); xi.next())
    gemm_tile(A, W, DM, DM, xi.major() * 256, xi.minor() * 128, lds, epi);
}
DI void phase_inproj1(const Params& p, char* lds) {
  EpiU1 epi{(u16*)(p.ws + WS_U1A), (u16*)(p.ws + WS_U1B), (float*)(p.ws + WS_AB)};
  const u16* H = (const u16*)(p.ws + WS_H);
  const GemmA A{H, DM, H, DM, 1 << 30};
  for (XcdIter xi(80, 29); xi.valid(); xi.next())
    gemm_tile(A, (const u16*)(p.ws + WS_WT1), DM, DM, xi.major() * 256, xi.minor() * 128, lds, epi);
}

DI void rope8(float (&x)[8], const float (&xp)[8], const float2* tab, int q, int pp, int fi0, bool is_x2) {
#pragma unroll
  for (int e = 0; e < 8; ++e) {
    const float2 cs = tab[pp * q + fi0 + e];
    x[e] = is_x2 ? (x[e] * cs.x + xp[e] * cs.y) : (x[e] * cs.x - xp[e] * cs.y);
  }
}
DI void unpack8(const u32x4 w, float (&x)[8]) {
#pragma unroll
  for (int i = 0; i < 4; ++i) { x[2 * i] = bf2f((u16)(w[i] & 0xffffu)); x[2 * i + 1] = bf2f((u16)(w[i] >> 16)); }
}
DI u32x4 pack8f(const float (&x)[8]) { u32x4 w = {pack2(x[0], x[1]), pack2(x[2], x[3]), pack2(x[4], x[5]), pack2(x[6], x[7])}; return w; }
DI void shfl8(const float (&x)[8], float (&xp)[8], int mask) {
#pragma unroll
  for (int e = 0; e < 8; ++e) xp[e] = __shfl_xor(x[e], mask);
}

DI void phase_l0prep(const Params& p, char* lds) {
  const int tid = TIDX(), lane = tid & 63, wid = tid >> 6;
  u16* U0 = (u16*)(p.ws + WS_U);
  u16* sv = (u16*)lds;
  const float2* tabM = (const float2*)(p.ws + WS_ROPE);
  const float2* tabS = tabM + 512;
  u16* CKVN = (u16*)(p.ws + WS_CKVN); u16* KROPE = (u16*)(p.ws + WS_KROPE); u16* KSWA = (u16*)(p.ws + WS_KSWA);
  float qn[6];
#pragma unroll
  for (int j = 0; j < 3; ++j) { const float2 t = *(const float2*)(p.mla_q_norm + 128 * j + 2 * lane); qn[2 * j] = t.x; qn[2 * j + 1] = t.y; }
  const float4 kvn = *(const float4*)(p.mla_kv_norm + 4 * lane);
  for (int it = blockIdx.x; it < NTOK / 16; it += gridDim.x) {
    const int m0 = it * 16;
    const bool ctx = m0 < NCTX;
    unsigned cqw[2][3]; u32x2 ckvw[2]; u16 krw[2]; u32x4 qbw[2], kbw[2], vbw[2]; float2 csm[2]; float2 css[2][8];
#pragma unroll
    for (int tt = 0; tt < 2; ++tt) {
      const int m = m0 + wid * 2 + tt;
      const u16* row = U0 + (size_t)m * L0C;
#pragma unroll
      for (int j = 0; j < 3; ++j) cqw[tt][j] = *(const unsigned*)(row + C0_CQ + 128 * j + 2 * lane);
      ckvw[tt] = ntload2u(row + C0_CKV + 4 * lane);
      krw[tt] = row[C0_KR + (lane & 31)];
      qbw[tt] = ntload4u(row + C0_QB + lane * 8);
      kbw[tt] = ntload4u(row + C0_KB + (lane & 15) * 8);
      vbw[tt] = ntload4u(row + C0_VB + (lane & 15) * 8);
      const int pos = pos_of_tok(m), prow = pos >> 6, pcol = pos & 63;
      csm[tt] = tabM[(((lane >> 4) & 1) ? pcol : prow) * 8 + (lane & 7)];
      const int b16 = (lane & 7) >> 1, pp = (b16 >= 2) ? pcol : prow, fi0 = (lane & 1) * 8;
#pragma unroll
      for (int e = 0; e < 8; ++e) css[tt][e] = tabS[pp * 16 + fi0 + e];
    }
#pragma unroll
    for (int tt = 0; tt < 2; ++tt) {
      const int ml = wid * 2 + tt, m = m0 + ml;
      u16* row = U0 + (size_t)m * L0C;
      const int krow = krow_of_tok(m);
      {
        float lo[3], hi[3], ss = 0.f;
#pragma unroll
        for (int j = 0; j < 3; ++j) { const unsigned w = cqw[tt][j]; lo[j] = bf2f((u16)(w & 0xffffu)); hi[j] = bf2f((u16)(w >> 16)); ss += lo[j] * lo[j] + hi[j] * hi[j]; }
        ss = wave_sum(ss);
        const float rs = rsqrtf(ss * (1.f / 384.f) + EPS);
#pragma unroll
        for (int j = 0; j < 3; ++j) *(unsigned*)(row + C0_CQ + 128 * j + 2 * lane) = pack2(lo[j] * rs * qn[2 * j], hi[j] * rs * qn[2 * j + 1]);
      }
      {
        const u32x2 w = ckvw[tt];
        float x[4] = {bf2f((u16)(w[0] & 0xffffu)), bf2f((u16)(w[0] >> 16)), bf2f((u16)(w[1] & 0xffffu)), bf2f((u16)(w[1] >> 16))};
        float ss = x[0] * x[0] + x[1] * x[1] + x[2] * x[2] + x[3] * x[3];
        ss = wave_sum(ss);
        const float rs = rsqrtf(ss * (1.f / 256.f) + EPS);
        x[0] *= rs * kvn.x; x[1] *= rs * kvn.y; x[2] *= rs * kvn.z; x[3] *= rs * kvn.w;
        u32x2 o = {pack2(x[0], x[1]), pack2(x[2], x[3])};
        *(u32x2*)(CKVN + (size_t)krow * 256 + 4 * lane) = o;
        if (ctx) *(float4*)(p.out + O_CKV + (size_t)m * 256 + 4 * lane) = make_float4(x[0], x[1], x[2], x[3]);
      }
      {
        const float x = bf2f(krw[tt]);
        const float xp = __shfl_xor(x, 8);
        float val = x;
        if (!ctx) { const float2 cs = csm[tt]; val = (lane & 15) < 8 ? (x * cs.x - xp * cs.y) : (x * cs.x + xp * cs.y); }
        if (lane < 32) {
          KROPE[(size_t)krow * 32 + lane] = f2bf(val);
          if (ctx) p.out[O_KROPE + (size_t)m * 32 + lane] = x;
        }
      }
      const bool is_x2 = (((lane & 7) >> 1) & 1) != 0;
      if (!ctx) {
        float x[8], xp[8];
        unpack8(qbw[tt], x);
        shfl8(x, xp, 2);
#pragma unroll
        for (int e = 0; e < 8; ++e) { const float2 cs = css[tt][e]; x[e] = is_x2 ? (x[e] * cs.x + xp[e] * cs.y) : (x[e] * cs.x - xp[e] * cs.y); }
        *(u32x4*)(row + C0_QB + lane * 8) = pack8f(x);
      }
      {
        float x[8], xp[8];
        unpack8(kbw[tt], x);
        if (ctx && lane < 16) {
          *(float4*)(p.out + O_SWAK + (size_t)m * 128 + lane * 8) = make_float4(x[0], x[1], x[2], x[3]);
          *(float4*)(p.out + O_SWAK + (size_t)m * 128 + lane * 8 + 4) = make_float4(x[4], x[5], x[6], x[7]);
        }
        shfl8(x, xp, 2);
        if (!ctx) {
#pragma unroll
          for (int e = 0; e < 8; ++e) { const float2 cs = css[tt][e]; x[e] = is_x2 ? (x[e] * cs.x + xp[e] * cs.y) : (x[e] * cs.x - xp[e] * cs.y); }
        }
        if (lane < 16) {
          *(u32x4*)(KSWA + (size_t)krow * 128 + lane * 8) = pack8f(x);
          const u32x4 vw = vbw[tt];
          *(u32x4*)(sv + ml * 136 + lane * 8) = vw;
          if (ctx) {
            float v[8]; unpack8(vw, v);
            *(float4*)(p.out + O_SWAV + (size_t)m * 128 + lane * 8) = make_float4(v[0], v[1], v[2], v[3]);
            *(float4*)(p.out + O_SWAV + (size_t)m * 128 + lane * 8 + 4) = make_float4(v[4], v[5], v[6], v[7]);
          }
        }
      }
    }
    __syncthreads();
    {
      const int s = seq_of_tok(m0);
      vt_store16(sv, 136, 128, (u16*)(p.ws + WS_VTSWA) + (size_t)krow0_of(s) * 128, cap_of(s), pos_of_tok(m0));
    }
    __syncthreads();
  }
}

namespace pg8 {
#define PG8_LAS __attribute__((address_space(3)))
typedef unsigned short bf16_t;
typedef short bf16x8 __attribute__((ext_vector_type(8)));
typedef float f32x4 __attribute__((ext_vector_type(4)));
typedef unsigned u32x4 __attribute__((ext_vector_type(4)));
constexpr int BM = 256, BK = 64, HALF = 128, HTB = HALF * BK * 2  , STAGE_BYTES = 8 * HTB, NXCD = 8, WGM = 8;

__host__ __device__ __forceinline__ int lds_byte(int r, int c) { const int st = (r >> 4) * 2 + (c >> 5), rr = r & 15, cc = c & 31, ob = rr * 64 + cc * 2; return st * 1024 + (ob ^ (((ob >> 9) & 1) << 5)); }
__host__ __device__ __forceinline__ void stage_rc(int b, int& R, int& C) { const int st = b / 1024, sb = b % 1024, swz = sb ^ (((sb >> 9) & 1) << 5); R = (st >> 1) * 16 + swz / 64; C = (st & 1) * 32 + (swz % 64) / 2; }
__host__ __device__ __forceinline__ int perm32(int rho) { const int n = rho >> 4, i = rho & 15; return 8 * (i >> 2) + 4 * n + (i & 3); }

struct Unit { int pm, pn; };
struct Gemm { const bf16_t* A; const bf16_t* Bt; int M, N, K, lda, ldb; };

struct StaticOrder {
    int nM, nN, nwg, G, c;
    __host__ __device__ void init(int M, int N, int G_, int c_) { nM = M / BM; nN = N / BM; nwg = nM * nN; G = G_; c = c_; }
    __host__ __device__ bool next(int i, Unit& u) const {
        const long L = (long)i * G + c; if (L >= nwg) return false;
        int wgid = (int)L; { const int q = nwg / NXCD, r = nwg % NXCD, xcd = wgid % NXCD, off = wgid / NXCD; wgid = (xcd < r ? xcd * (q + 1) : r * (q + 1) + (xcd - r) * q) + off; }
        const int nig = WGM * nN, gid = wgid / nig, fm = gid * WGM, gsz = (nM - fm) < WGM ? (nM - fm) : WGM;
        u.pm = fm + ((wgid % nig) % gsz); u.pn = (wgid % nig) / gsz; return true;
    }
    __device__ __forceinline__ void a_ready(const Unit&) const {}
    __device__ __forceinline__ void done(const Unit&) const {}
};
struct Ip0Order {
    StaticOrder S9; int rt0, nwg9, ntot, G, c;
    __device__ void init(int M, int Nmain, int rt0_, int G_, int c_) { S9.init(M, Nmain, G_, c_); rt0 = rt0_; nwg9 = S9.nwg; ntot = nwg9 + (M / BM - rt0_); G = G_; c = c_; }
    __device__ bool next(int i, Unit& u) const {
        const int L = i * G + c; if (L >= ntot) return false;
        if (L < nwg9) return S9.next(i, u);
        u.pm = rt0 + (L - nwg9); u.pn = S9.nN; return true;
    }
    __device__ __forceinline__ void a_ready(const Unit&) const {}
    __device__ __forceinline__ void done(const Unit&) const {}
};
template <class Epi, class Sched, bool STAMP = false>
__device__ __forceinline__ void gemm_phase(PG8_LAS unsigned char* lds, const Gemm g, const Sched& S, const Epi& E, unsigned long long* stamps) {
    const int tid = TIDX(), wid = __builtin_amdgcn_readfirstlane(tid >> 6), lane = tid & 63, wr = wid >> 2, wc = wid & 3, fr = lane & 15, fq = lane >> 4;
    const int K = g.K, nt = K / BK;
    int ts_lo = 0, ts_hi = 0, nts = 0; const unsigned long long rt_entry = STAMP ? (unsigned long long)wall_clock64() : 0ull;
#define PG8_STAMP() do { if (STAMP && wid == 0 && nts < 64) { const unsigned long long _c = (unsigned long long)clock64(); \
        ts_lo = (lane == nts) ? (int)(unsigned)_c : ts_lo; ts_hi = (lane == nts) ? (int)(unsigned)(_c >> 32) : ts_hi; ++nts; } } while (0)
    PG8_STAMP();
    unsigned voffA[2], voffB[2];
#pragma unroll
    for (int i = 0; i < 2; ++i) { int R, C; stage_rc(tid * 16 + i * 8192, R, C); const int Rb = Epi::PERM ? ((R & ~31) + perm32(R & 31)) : R;
        voffA[i] = (unsigned)(R * g.lda + C) * 2u; voffB[i] = (unsigned)(Rb * g.ldb + C) * 2u; }
    const size_t kstep = (size_t)(BK * 2);
    const size_t hstepA = (size_t)HALF * g.lda * 2, hstepB = (size_t)HALF * g.ldb * 2;
    const size_t tstepA = 2 * hstepA, tstepB = 2 * hstepB;
    const unsigned ldsw = (unsigned)wid * 1024u;
    const int aoff = lds_byte(wr * 64 + fr, fq * 8), boff = lds_byte(wc * 32 + fr, fq * 8);
#define PG8_SA(b, h) (((b) * 2 + (h)) * HTB)
#define PG8_SB(b, h) ((4 + (b) * 2 + (h)) * HTB)
#define PG8_STAGE(bufoff, gbase, voff) do { _Pragma("unroll") for (int _i = 0; _i < 2; ++_i) \
        __builtin_amdgcn_global_load_lds((const unsigned*)((const char*)(gbase) + (voff)[_i]), (PG8_LAS unsigned*)(lds + (bufoff) + ldsw + _i * 8192), 16, 0, 0); } while (0)
#define PG8_LDA(dst, b, h) do { _Pragma("unroll") for (int m = 0; m < 4; ++m) _Pragma("unroll") for (int k = 0; k < 2; ++k) dst[m][k] = *(const PG8_LAS bf16x8*)(lds + PG8_SA(b, h) + aoff + m * 2048 + k * 1024); } while (0)
#define PG8_LDB(dst, b, h) do { _Pragma("unroll") for (int n = 0; n < 2; ++n) _Pragma("unroll") for (int k = 0; k < 2; ++k) dst[n][k] = *(const PG8_LAS bf16x8*)(lds + PG8_SB(b, h) + boff + n * 2048 + k * 1024); } while (0)
#define PG8_MMA(ai, bj, At, Bt) do { __builtin_amdgcn_s_setprio(1); _Pragma("unroll") for (int m = 0; m < 4; ++m) _Pragma("unroll") for (int n = 0; n < 2; ++n) _Pragma("unroll") for (int k = 0; k < 2; ++k) \
        acc[ai][bj][m][n] = __builtin_amdgcn_mfma_f32_16x16x32_bf16(Bt[n][k], At[m][k], acc[ai][bj][m][n], 0, 0, 0); __builtin_amdgcn_s_setprio(0); } while (0)
#define PG8_WAIT_V(n) asm volatile("s_waitcnt vmcnt(" #n ")" ::: "memory")
#define PG8_WAIT_L(n) asm volatile("s_waitcnt lgkmcnt(" #n ")" ::: "memory")
#define PG8_BAR __builtin_amdgcn_s_barrier()
#define PG8_SCHED __builtin_amdgcn_sched_barrier(0)
    Unit cur, nxt; int ui = 0;
    if (!S.next(0, cur)) return;
    f32x4 acc[2][2][4][2];
#pragma unroll
    for (int a = 0; a < 2; ++a)
#pragma unroll
        for (int b = 0; b < 2; ++b)
#pragma unroll
            for (int m = 0; m < 4; ++m)
#pragma unroll
                for (int n = 0; n < 2; ++n) acc[a][b][m][n] = (f32x4){0.f, 0.f, 0.f, 0.f};
    bf16x8 At[4][2], B0[2][2], B1[2][2];
    const char* cA = (const char*)g.A + (size_t)cur.pm * tstepA; const char* cB = (const char*)g.Bt + (size_t)cur.pn * tstepB;
    S.a_ready(cur);
    PG8_STAGE(PG8_SB(0, 0), cB, voffB); PG8_STAGE(PG8_SA(0, 0), cA, voffA); PG8_STAGE(PG8_SB(0, 1), cB + hstepB, voffB); PG8_STAGE(PG8_SA(0, 1), cA + hstepA, voffA);
    if (wr == 1) PG8_BAR;
    PG8_WAIT_V(4); PG8_BAR;
    PG8_STAGE(PG8_SB(1, 0), cB + kstep, voffB); PG8_STAGE(PG8_SA(1, 0), cA + kstep, voffA); PG8_STAGE(PG8_SB(1, 1), cB + hstepB + kstep, voffB);
    PG8_WAIT_V(6); PG8_BAR;
    PG8_STAMP();
    for (;;) {
        const bool has_next = S.next(ui + 1, nxt);
        const char* nA = has_next ? (const char*)g.A + (size_t)nxt.pm * tstepA : cA; const char* nB = has_next ? (const char*)g.Bt + (size_t)nxt.pn * tstepB : cB;
#pragma unroll 1
        for (int t = 0; t < nt; t += 2) {
            const bool last = (t == nt - 2);
            const char* a1 = cA + (size_t)(t + 1) * kstep;
            const char* a2 = last ? nA : cA + (size_t)(t + 2) * kstep; const char* b2 = last ? nB : cB + (size_t)(t + 2) * kstep;
            const char* a3 = a2 + kstep; const char* b3 = b2 + kstep;
            if (last && has_next) S.a_ready(nxt);
            PG8_LDB(B0, 0, 0); PG8_SCHED; PG8_LDA(At, 0, 0); PG8_STAGE(PG8_SA(1, 1), a1 + hstepA, voffA);
            PG8_WAIT_L(8); PG8_BAR; PG8_WAIT_L(0); PG8_MMA(0, 0, At, B0); PG8_BAR; PG8_SCHED;
            PG8_LDB(B1, 0, 1); PG8_STAGE(PG8_SB(0, 0), b2, voffB);
            PG8_BAR; PG8_WAIT_L(0); PG8_MMA(0, 1, At, B1); PG8_BAR;
            PG8_LDA(At, 0, 1); PG8_STAGE(PG8_SA(0, 0), a2, voffA);
            PG8_BAR; PG8_WAIT_L(0); PG8_MMA(1, 0, At, B0); PG8_BAR; PG8_SCHED;
            PG8_STAGE(PG8_SB(0, 1), b2 + hstepB, voffB);
            PG8_WAIT_V(6); PG8_BAR; PG8_MMA(1, 1, At, B1); PG8_BAR;
            PG8_LDB(B0, 1, 0); PG8_SCHED; PG8_LDA(At, 1, 0); PG8_STAGE(PG8_SA(0, 1), a2 + hstepA, voffA);
            PG8_WAIT_L(8); PG8_BAR; PG8_WAIT_L(0); PG8_MMA(0, 0, At, B0); PG8_BAR; PG8_SCHED;
            PG8_LDB(B1, 1, 1); PG8_STAGE(PG8_SB(1, 0), b3, voffB);
            PG8_BAR; PG8_WAIT_L(0); PG8_MMA(0, 1, At, B1); PG8_BAR;
            PG8_LDA(At, 1, 1); PG8_STAGE(PG8_SA(1, 0), a3, voffA);
            PG8_BAR; PG8_WAIT_L(0); PG8_MMA(1, 0, At, B0); PG8_BAR; PG8_SCHED;
            PG8_STAGE(PG8_SB(1, 1), b3 + hstepB, voffB);
            PG8_WAIT_V(6); PG8_BAR; PG8_MMA(1, 1, At, B1); PG8_BAR;
        }
        PG8_STAMP();
        if constexpr (!Epi::AFTER_DRAIN) { E(acc, cur, wr, wc, fr, fq); S.done(cur); }
        PG8_STAMP();
        if (!has_next) break;
#pragma unroll
        for (int a = 0; a < 2; ++a)
#pragma unroll
            for (int b = 0; b < 2; ++b)
#pragma unroll
                for (int m = 0; m < 4; ++m)
#pragma unroll
                    for (int n = 0; n < 2; ++n) acc[a][b][m][n] = (f32x4){0.f, 0.f, 0.f, 0.f};
        cur = nxt; cA = nA; cB = nB; ++ui;
    }
    PG8_WAIT_V(0);
    if (wr == 0) PG8_BAR;
    PG8_BAR;
    if constexpr (Epi::AFTER_DRAIN) { E.fused(acc, cur, wr, wc, fr, fq, lds, wid, lane); S.done(cur); }
    PG8_STAMP();
    if (STAMP && wid == 0) { stamps[lane] = lane < nts ? (((unsigned long long)(unsigned)ts_hi << 32) | (unsigned)ts_lo) : 0ull;
        if (lane == 62) stamps[62] = rt_entry; if (lane == 63) stamps[63] = (unsigned long long)wall_clock64(); }
#undef PG8_STAMP
#undef PG8_SA
#undef PG8_SB
#undef PG8_STAGE
#undef PG8_LDA
#undef PG8_LDB
#undef PG8_MMA
#undef PG8_WAIT_V
#undef PG8_WAIT_L
#undef PG8_BAR
#undef PG8_SCHED
}
}

using pg8::Unit;
typedef pg8::f32x4 (acc8_t)[2][2][4][2];
DI u32x4 pk8(const pg8::f32x4& v0, const pg8::f32x4& v1) { u32x4 w = {pack2(v0[0], v0[1]), pack2(v0[2], v0[3]), pack2(v1[0], v1[1]), pack2(v1[2], v1[3])}; return w; }
struct E8U0 { static constexpr bool PERM = true, AFTER_DRAIN = false; u16* U; int pm0, pn0;
  DI void operator()(const acc8_t& acc, const Unit& u, int wr, int wc, int fr, int fq) const {
#pragma unroll
    for (int ai = 0; ai < 2; ++ai)
#pragma unroll
      for (int m = 0; m < 4; ++m) { const size_t row = (size_t)((u.pm + pm0) * 256 + wr * 64 + ai * 128 + m * 16 + fr);
#pragma unroll
        for (int bj = 0; bj < 2; ++bj) { const int col = (u.pn + pn0) * 256 + wc * 32 + bj * 128 + 8 * fq;
          if (col < L0C) *(u32x4*)(U + row * L0C + col) = pk8(acc[ai][bj][m][0], acc[ai][bj][m][1]); } }
  } };
struct E8U1 { static constexpr bool PERM = true, AFTER_DRAIN = false; u16* UA; u16* UB; float* AB;
  DI void operator()(const acc8_t& acc, const Unit& u, int wr, int wc, int fr, int fq) const {
#pragma unroll
    for (int ai = 0; ai < 2; ++ai)
#pragma unroll
      for (int m = 0; m < 4; ++m) { const size_t row = (size_t)(u.pm * 256 + wr * 64 + ai * 128 + m * 16 + fr);
#pragma unroll
        for (int bj = 0; bj < 2; ++bj) { const int col = u.pn * 256 + wc * 32 + bj * 128 + 8 * fq;
          if (col < 1536) *(u32x4*)(UA + row * U1A_LD + col) = pk8(acc[ai][bj][m][0], acc[ai][bj][m][1]);
          else if (col < 3584) *(u32x4*)(UB + row * U1B_LD + col - 1536) = pk8(acc[ai][bj][m][0], acc[ai][bj][m][1]);
          else if (col < 3600) { *(pg8::f32x4*)(AB + row * 16 + col - 3584) = acc[ai][bj][m][0]; *(pg8::f32x4*)(AB + row * 16 + col - 3584 + 4) = acc[ai][bj][m][1]; } } }
  } };
struct E8Gy { static constexpr bool PERM = true, AFTER_DRAIN = false; u16* GY; const float* mod;
  DI void operator()(const acc8_t& acc, const Unit& u, int wr, int wc, int fr, int fq) const {
    const float* gp = mod + (size_t)modidx_of_tok(u.pm * 256) * 3072 + 2048;
#pragma unroll
    for (int bj = 0; bj < 2; ++bj) { const int col = u.pn * 256 + wc * 32 + bj * 128 + 8 * fq;
      const pg8::f32x4 g0 = *(const pg8::f32x4*)(gp + col), g1 = *(const pg8::f32x4*)(gp + col + 4);
#pragma unroll
      for (int ai = 0; ai < 2; ++ai)
#pragma unroll
        for (int m = 0; m < 4; ++m) { const size_t row = (size_t)(u.pm * 256 + wr * 64 + ai * 128 + m * 16 + fr);
          *(u32x4*)(GY + row * DM + col) = pk8(acc[ai][bj][m][0] * g0, acc[ai][bj][m][1] * g1); } }
  } };
struct E8KV { static constexpr bool PERM = true, AFTER_DRAIN = false; u16* Kn; u16* Vt;
  DI void operator()(const acc8_t& acc, const Unit& u, int wr, int wc, int fr, int fq) const {
    if (u.pn < 2) {
#pragma unroll
      for (int ai = 0; ai < 2; ++ai)
#pragma unroll
        for (int m = 0; m < 4; ++m) { const size_t row = (size_t)(u.pm * 256 + wr * 64 + ai * 128 + m * 16 + fr);
#pragma unroll
          for (int bj = 0; bj < 2; ++bj) { const int col = u.pn * 256 + wc * 32 + bj * 128 + 8 * fq;
            *(u32x4*)(Kn + row * 512 + col) = pk8(acc[ai][bj][m][0], acc[ai][bj][m][1]); } }
    } else {
      const int krt = __builtin_amdgcn_readfirstlane(u.pm * 256);
      int seq, keyt;
      if (krt < NCTX) { seq = krt >> 8; keyt = 0; } else { const int r = krt - NCTX; seq = 16 + r / 2560; keyt = r - (seq - 16) * 2560; }
      const unsigned cap = (unsigned)cap_of(seq);
      u16* base = Vt + (size_t)krow0_of(seq) * 512 + keyt;
#pragma unroll
      for (int bj = 0; bj < 2; ++bj) {
        const unsigned f0 = (unsigned)((u.pn - 2) * 256 + wc * 32 + bj * 128 + 8 * fq);
        unsigned off = f0 * cap + (unsigned)(wr * 64 + swz16(fr));
#pragma unroll
        for (int ai = 0; ai < 2; ++ai) {
#pragma unroll
          for (int m = 0; m < 4; ++m) {
#pragma unroll
            for (int t = 0; t < 4; ++t) { base[off + t * cap] = f2bf(acc[ai][bj][m][0][t]); base[off + (4 + t) * cap] = f2bf(acc[ai][bj][m][1][t]); }
            off += 16;
            asm volatile("" ::: "memory"); }
          off += 64; } }
    }
  } };
struct E8Q { static constexpr bool PERM = true, AFTER_DRAIN = false; u16* Q;
  DI void operator()(const acc8_t& acc, const Unit& u, int wr, int wc, int fr, int fq) const {
#pragma unroll
    for (int ai = 0; ai < 2; ++ai)
#pragma unroll
      for (int m = 0; m < 4; ++m) { const size_t row = (size_t)(u.pm * 256 + wr * 64 + ai * 128 + m * 16 + fr);
#pragma unroll
        for (int bj = 0; bj < 2; ++bj) { const int col = u.pn * 256 + wc * 32 + bj * 128 + 8 * fq;
          *(u32x4*)(Q + row * 768 + col) = pk8(acc[ai][bj][m][0], acc[ai][bj][m][1]); } }
  } };
template <class Epi>
DI void gemm8_sub(const u16* A, int lda, const u16* Bt, int ldb, int M, int N, int K, char* lds, const Epi& E, int G, int c) {
  int Ko = K; asm volatile("" : "+s"(Ko));
  pg8::Gemm g{A, Bt, M, N, Ko, lda, ldb};
  pg8::StaticOrder S; S.init(M, N, G, c);
  __syncthreads();
  pg8::gemm_phase<Epi, pg8::StaticOrder, false>((PG8_LAS unsigned char*)lds, g, S, E, nullptr);
  __syncthreads();
}
template <class Epi>
DI void gemm8(const u16* A, int lda, const u16* Bt, int ldb, int M, int N, int K, char* lds, const Epi& E) { gemm8_sub(A, lda, Bt, ldb, M, N, K, lds, E, (int)gridDim.x, (int)blockIdx.x); }
struct E8Gen { static constexpr bool PERM = true, AFTER_DRAIN = false; int kv; u16* base; int ld, ncols, pm0, pn0; u16* Vt;
  DI void operator()(const acc8_t& acc, const Unit& u, int wr, int wc, int fr, int fq) const {
    if (kv && u.pn >= 2) {
      const int krt = __builtin_amdgcn_readfirstlane(u.pm * 256);
      int seq, keyt;
      if (krt < NCTX) { seq = krt >> 8; keyt = 0; } else { const int r = krt - NCTX; seq = 16 + r / 2560; keyt = r - (seq - 16) * 2560; }
      const unsigned cap = (unsigned)cap_of(seq);
      u16* vb = Vt + (size_t)krow0_of(seq) * 512 + keyt;
#pragma unroll
      for (int bj = 0; bj < 2; ++bj) {
        const unsigned f0 = (unsigned)((u.pn - 2) * 256 + wc * 32 + bj * 128 + 8 * fq);
        unsigned off = f0 * cap + (unsigned)(wr * 64 + swz16(fr));
#pragma unroll
        for (int ai = 0; ai < 2; ++ai) {
#pragma unroll
          for (int m = 0; m < 4; ++m) {
#pragma unroll
            for (int t = 0; t < 4; ++t) { vb[off + t * cap] = f2bf(acc[ai][bj][m][0][t]); vb[off + (4 + t) * cap] = f2bf(acc[ai][bj][m][1][t]); }
            off += 16;
            asm volatile("" ::: "memory"); }
          off += 64; } }
    } else {
#pragma unroll
      for (int ai = 0; ai < 2; ++ai)
#pragma unroll
        for (int m = 0; m < 4; ++m) { const size_t row = (size_t)((u.pm + pm0) * 256 + wr * 64 + ai * 128 + m * 16 + fr);
#pragma unroll
          for (int bj = 0; bj < 2; ++bj) { const int col = (u.pn + pn0) * 256 + wc * 32 + bj * 128 + 8 * fq;
            if (col < ncols) *(u32x4*)(base + row * ld + col) = pk8(acc[ai][bj][m][0], acc[ai][bj][m][1]); } }
    }
  } };
constexpr int IP0_DEFER_ROWT = 32;
template <class SyncF>
DI void phase8_layer0_gemms(const Params& p, char* lds, const SyncF& gsync) {
  const bool full = gridDim.x == 256;
  const int ng = 3 + opaque_zero();
#pragma unroll 1
  for (int g = 0; g < ng; ++g) {
    const u16* A; const u16* Bt; int lda, ldb, M, Nmain, K, rt0, G, c; E8Gen E;
    u16* U = (u16*)(p.ws + WS_U);
    if (g == 0) { A = (const u16*)(p.ws + WS_H); lda = DM; Bt = (const u16*)(p.ws + WS_WT0); ldb = DM; M = NTOK; K = DM; G = (int)gridDim.x; c = (int)blockIdx.x;
      Nmain = full ? 2304 : L0CP; rt0 = full ? IP0_DEFER_ROWT : NTOK / 256; E = E8Gen{0, U, L0C, L0C, 0, 0, nullptr}; }
    else if (g == 1) { A = (const u16*)(p.ws + WS_CKVN); lda = 256; Bt = (const u16*)(p.ws + WS_WUKV); ldb = 256; M = NKROW; Nmain = 1024; K = 256; rt0 = NKROW / 256; G = (int)gridDim.x; c = (int)blockIdx.x;
      E = E8Gen{1, (u16*)((char*)p.out + YS_KN), 512, 512, 0, 0, (u16*)((char*)p.out + YS_VTMLA)}; }
    else if (!full || blockIdx.x < 224) { A = U + C0_CQ; lda = L0C; Bt = (const u16*)(p.ws + WS_WUQ); ldb = 384; M = NTOK; Nmain = 768; K = 384; rt0 = NTOK / 256;
      G = full ? 224 : (int)gridDim.x; c = full ? ((int)blockIdx.x + 96) % 224 : (int)blockIdx.x; E = E8Gen{0, (u16*)((char*)p.out + YS_QMLA), 768, 768, 0, 0, nullptr}; }
    else { A = (const u16*)(p.ws + WS_H); lda = DM; Bt = (const u16*)(p.ws + WS_WT0) + (size_t)2304 * DM; ldb = DM; M = IP0_DEFER_ROWT * 256; Nmain = 256; K = DM; rt0 = IP0_DEFER_ROWT;
      G = 32; c = (int)blockIdx.x - 224; E = E8Gen{0, U, L0C, L0C, 0, 9, nullptr}; }
    {
      int Ko = K; asm volatile("" : "+s"(Ko));
      pg8::Gemm gm{A, Bt, M, Nmain, Ko, lda, ldb};
      pg8::Ip0Order S; S.init(M, Nmain, rt0, G, c);
      __syncthreads();
      pg8::gemm_phase<E8Gen, pg8::Ip0Order, false>((PG8_LAS unsigned char*)lds, gm, S, E, nullptr);
      __syncthreads();
    }
    if (g == 0) { gsync(); phase_l0prep(p, lds); gsync(); }
  }
}
DI void phase8_outproj(const Params& p, int layer, char* lds) {
  gemm8((const u16*)(p.ws + WS_H), DM, (const u16*)(p.ws + (layer ? WS_WO1 : WS_WO0)), DM, NTOK, DM, DM, lds,
        E8Gy{(u16*)(p.ws + (layer ? WS_GY1 : WS_GY0)), (const float*)(p.ws + WS_MOD) + (size_t)layer * 9 * 3072});
}
DI void phase8_inproj1(const Params& p, char* lds) {
  gemm8((const u16*)(p.ws + WS_H), DM, (const u16*)(p.ws + WS_WT1), DM, NTOK, L1CP, DM, lds, E8U1{(u16*)(p.ws + WS_U1A), (u16*)(p.ws + WS_U1B), (float*)(p.ws + WS_AB)});
}

template <int KIND, int DBGV = 0>
DI void attn_item(const Params& p, int s, int hsel, int q0, char* lds) {
  constexpr int DQK = KIND == 0 ? 96 : (KIND == 1 ? 64 : 128);
  constexpr int DV = KIND == 2 ? 128 : 64;
  constexpr int KT = KIND == 2 ? 64 : 128;
  constexpr int NKB = KT / 32;
  constexpr int KS = DQK + 8, VS = KT + 8;
  constexpr int CPR = DQK / 8;
  constexpr int VPR = KT / 8;
  constexpr int KCH = KT * CPR, NKC = (KCH + 511) / 512;
  constexpr int VCH = DV * VPR, NVC = VCH / 512;
  constexpr float SCALE = KIND == 0 ? 0.10206207261596577f : (KIND == 1 ? 0.125f : 0.08838834764831845f);
  constexpr float C = SCALE * LOG2E;
  const int tid = TIDX(), lane = tid & 63, wid = tid >> 6, r32 = lane & 31, h = lane >> 5;
  u16* sK0 = (u16*)lds;
  const int tok0 = tok0_of(s), kr0 = krow0_of(s), cap = cap_of(s), len = len_of(s);
  const bool smp = s >= 16;
  int hq, hkv, qrow0;
  if (KIND == 0) { hq = hsel; hkv = hsel; qrow0 = q0 + 32 * wid; }
  else if (KIND == 1) { hkv = hsel >> 1; hq = hkv * 4 + (hsel & 1) * 2 + (wid >> 2); qrow0 = q0 + 32 * (wid & 3); }
  else { hkv = hsel; hq = hkv * 2 + (wid >> 2); qrow0 = q0 + 32 * (wid & 3); }
  const int tok = tok0 + qrow0 + r32;
  const u16* U0 = (const u16*)(p.ws + WS_U);
  u16* U1B = (u16*)(p.ws + WS_U1B);
  const u16* qp;
  if (KIND == 0) qp = (const u16*)((const char*)p.out + YS_QMLA) + (size_t)tok * 768 + hq * 96 + h * 8;
  else if (KIND == 1) qp = U0 + (size_t)tok * L0C + C0_QB + hq * 64 + h * 8;
  else qp = U1B + (size_t)tok * U1B_LD + C1_QD + hq * 128 + h * 8;
  bf16x8 qf[DQK / 16];
#pragma unroll
  for (int d0 = 0; d0 < DQK / 16; ++d0) qf[d0] = *(const bf16x8*)(qp + d0 * 16);
  if (KIND == 0 && smp) {
    const float2* tabM = (const float2*)(p.ws + WS_ROPE);
    const int qpos = qrow0 + r32;
#pragma unroll
    for (int d0 = 4; d0 < 6; ++d0) {
      float x[8], xp[8];
      unpack8(__builtin_bit_cast(u32x4, qf[d0 < DQK / 16 ? d0 : 0]), x);
      shfl8(x, xp, 32);
      rope8(x, xp, tabM, 8, d0 == 4 ? (qpos >> 6) : (qpos & 63), 0, h != 0);
      if (d0 < DQK / 16) qf[d0 < DQK / 16 ? d0 : 0] = __builtin_bit_cast(bf16x8, pack8f(x));
    }
  }
  int nwin = 0, wlo = 0, nt = cap / KT;
  if (KIND == 1 && smp) { wlo = q0 - 128 < 0 ? 0 : q0 - 128; const int whi = q0 + 256 > 2048 ? 2048 : q0 + 256; nwin = (whi - wlo) / KT; nt = nwin + 512 / KT; }
  const u16* Kn = (const u16*)((const char*)p.out + YS_KN);
  const u16* KR = (const u16*)(p.ws + WS_KROPE);
  const u16* KSW = (const u16*)(p.ws + WS_KSWA);
  const u16* KCc = (const u16*)(p.ws + WS_KC);
  const u16* VT;
  if (KIND == 0) VT = (const u16*)((const char*)p.out + YS_VTMLA) + (size_t)kr0 * 512;
  else if (KIND == 1) VT = (const u16*)(p.ws + WS_VTSWA) + (size_t)kr0 * 128;
  else VT = (const u16*)(p.ws + WS_VTATT) + (size_t)kr0 * 256;
  bf16x8 rk[NKC], rv[NVC];
  int kkey[NKC], kd[NKC];
#pragma unroll
  for (int i = 0; i < NKC; ++i) { const int c = tid + 512 * i; kkey[i] = c / CPR; kd[i] = (c % CPR) * 8; }
  auto kt0_of = [&](int t) -> int { return (KIND == 1 && smp) ? (t < nwin ? wlo + KT * t : 2048 + KT * (t - nwin)) : KT * t; };
  auto gload = [&](int t) {
    const int kt0 = (DBGV == 2) ? 0 : kt0_of(t);
#pragma unroll
    for (int i = 0; i < NKC; ++i) {
      if (tid + 512 * i < KCH) {
        const int g = kt0 + kkey[i], d = kd[i];
        const u16* src;
        if (KIND == 0) src = d < 64 ? Kn + ((size_t)(kr0 + g) * 8 + hkv) * 64 + d : KR + (size_t)(kr0 + g) * 32 + (d - 64);
        else if (KIND == 1) src = KSW + ((size_t)(kr0 + g) * 2 + hkv) * 64 + d;
        else src = g < len ? U1B + (size_t)(tok0 + g) * U1B_LD + C1_KD + hkv * 128 + d : KCc + ((size_t)((s - 16) * 512 + g - 2048) * 2 + hkv) * 128 + d;
        rk[i] = *(const bf16x8*)src;
      }
    }
#pragma unroll
    for (int i = 0; i < NVC; ++i) {
      const int c = tid + 512 * i, dv = c / VPR, kc = c % VPR;
      rv[i] = *(const bf16x8*)(VT + (size_t)(hkv * DV + dv) * cap + kt0 + kc * 8);
    }
  };
  auto swrite = [&](int buf) {
    u16* sK = sK0 + buf * (KT * KS + DV * VS); u16* sV = sK + KT * KS;
#pragma unroll
    for (int i = 0; i < NKC; ++i) if (tid + 512 * i < KCH) *(bf16x8*)(sK + kkey[i] * KS + kd[i]) = rk[i];
#pragma unroll
    for (int i = 0; i < NVC; ++i) { const int c = tid + 512 * i; *(bf16x8*)(sV + (c / VPR) * VS + (c % VPR) * 8) = rv[i]; }
  };
  f32x16 o[DV / 32];
#pragma unroll
  for (int db = 0; db < DV / 32; ++db)
#pragma unroll
    for (int r = 0; r < 16; ++r) o[db][r] = 0.f;
  float m = -1e30f, l = 0.f;
  constexpr int ABUF = KT * KS + DV * VS;
  constexpr int ND = DQK / 16, NB = DV / 32;
#define SBAR() __builtin_amdgcn_sched_barrier(0)
  __syncthreads();
  gload(0); swrite(0);
  if (nt > 1) { gload(1); swrite(1); }
  __syncthreads();
  if (nt > 2) gload(2);
  int bcur = 0;
#pragma unroll 1
  for (int t = 0; t < nt; ++t) {
    const int bnxt = bcur == 2 ? 0 : bcur + 1, bnn = bnxt == 2 ? 0 : bnxt + 1;
    const u16* sK = sK0 + bcur * ABUF; const u16* sV = sK + KT * KS;
    f32x16 sc[NKB];
#pragma unroll
    for (int kb = 0; kb < NKB; ++kb)
#pragma unroll
      for (int r = 0; r < 16; ++r) sc[kb][r] = 0.f;
    constexpr int BS = NKB == 4 ? 1 : (ND <= 4 ? 2 : 3), NBK = (ND + BS - 1) / BS;
    bf16x8 kf[NBK][NKB * BS];
#pragma unroll
    for (int i = 0; i < BS; ++i)
#pragma unroll
      for (int kb = 0; kb < NKB; ++kb) kf[0][NKB * i + kb] = *(const bf16x8*)(sK + (32 * kb + r32) * KS + i * 16 + h * 8);
    SBAR();
    constexpr int NVG = NB * NKB / 2;
    bf16x8 vf[2][4];
#pragma unroll
    for (int bk = 0; bk < NBK; ++bk) {
      if (bk + 1 < NBK) {
#pragma unroll
        for (int i = 0; i < BS; ++i) { const int d0 = (bk + 1) * BS + i;
          if (d0 < ND) {
#pragma unroll
            for (int kb = 0; kb < NKB; ++kb) kf[bk + 1 < NBK ? bk + 1 : 0][NKB * i + kb] = *(const bf16x8*)(sK + (32 * kb + r32) * KS + d0 * 16 + h * 8); } }
      } else {
#pragma unroll
        for (int q = 0; q < 4; ++q) vf[0][q] = *(const bf16x8*)(sV + r32 * VS + h * 8 + 16 * q);
      }
      SBAR();
#pragma unroll
      for (int i = 0; i < BS; ++i) { const int d0 = bk * BS + i; if (d0 < ND) {
#pragma unroll
        for (int kb = 0; kb < NKB; ++kb) sc[kb] = MFMA(kf[bk][NKB * i + kb], qf[d0 < ND ? d0 : 0], sc[kb]); } }
      SBAR();
    }
    if (KIND == 1 && smp && t < nwin) {
      const int kt0 = kt0_of(t), qi = qrow0 + r32;
#pragma unroll
      for (int kb = 0; kb < NKB; ++kb)
#pragma unroll
        for (int r = 0; r < 16; ++r) { const int d0 = qi - (kt0 + 32 * kb + crow(r, h)); sc[kb][r] = (d0 <= 128 && d0 >= -128) ? sc[kb][r] : -INFINITY; }
    }
    float mx = sc[0][0];
#pragma unroll
    for (int kb = 0; kb < NKB; ++kb)
#pragma unroll
      for (int r = 0; r < 16; ++r) mx = fmaxf(mx, sc[kb][r]);
    { auto rr = __builtin_amdgcn_permlane32_swap(__float_as_uint(mx), __float_as_uint(mx), false, false);
      mx = fmaxf(__uint_as_float(rr[0]), __uint_as_float(rr[1])); }
    const float mnew = fmaxf(m, mx * C);
    const float alpha = __builtin_amdgcn_exp2f(m - mnew);
    m = mnew;
    float ps = 0.f;
#pragma unroll
    for (int kb = 0; kb < NKB; ++kb)
#pragma unroll
      for (int r = 0; r < 16; ++r) { sc[kb][r] = __builtin_amdgcn_exp2f(sc[kb][r] * C - mnew); ps += sc[kb][r]; }
    l = l * alpha + ps;
#pragma unroll
    for (int db = 0; db < NB; ++db)
#pragma unroll
      for (int r = 0; r < 16; ++r) o[db][r] *= alpha;
    bf16x8 pf[2 * NKB];
#pragma unroll
    for (int kb = 0; kb < NKB; ++kb) { pf[2 * kb] = pack8(sc[kb], 0); pf[2 * kb + 1] = pack8(sc[kb], 1); }
    SBAR();
#pragma unroll
    for (int g = 0; g < NVG; ++g) {
      if (g + 1 < NVG) {
        const int db1 = (g + 1) / (NKB / 2), kq1 = ((g + 1) % (NKB / 2)) * 4;
#pragma unroll
        for (int q = 0; q < 4; ++q) vf[(g + 1) & 1][q] = *(const bf16x8*)(sV + (db1 * 32 + r32) * VS + h * 8 + 16 * (kq1 + q));
      }
      SBAR();
      const int db = g / (NKB / 2), kq = (g % (NKB / 2)) * 4;
      o[db] = MFMA(vf[g & 1][0], pf[kq], o[db]); o[db] = MFMA(vf[g & 1][1], pf[kq + 1], o[db]); o[db] = MFMA(vf[g & 1][2], pf[kq + 2], o[db]); o[db] = MFMA(vf[g & 1][3], pf[kq + 3], o[db]);
      SBAR();
    }
    if (t + 2 < nt) {
      swrite(bnn);
      __syncthreads();
      if (t + 3 < nt) gload(t + 3);
    }
    bcur = bnxt;
  }
#undef SBAR
  float lt = l + __shfl_xor(l, 32);
  if (KIND == 1) lt += __builtin_amdgcn_exp2f(p.swa_sink[hq] * LOG2E - m);
  const float inv = 1.f / lt;
  const u16* zp; u16* op;
  if (KIND == 0) { zp = U0 + (size_t)tok * L0C + C0_ZA + hq * 64; op = (u16*)(p.ws + WS_H) + (size_t)tok * DM + hq * 64; }
  else if (KIND == 1) { zp = U0 + (size_t)tok * L0C + C0_ZB + hq * 64; op = (u16*)(p.ws + WS_H) + (size_t)tok * DM + 512 + hq * 64; }
  else { zp = U1B + (size_t)tok * U1B_LD + C1_ZD + hq * 128; op = (u16*)(p.ws + WS_H) + (size_t)tok * DM + 512 + hq * 128; }
#pragma unroll
  for (int db = 0; db < DV / 32; ++db)
#pragma unroll
    for (int g = 0; g < 4; ++g) {
      const int dv = db * 32 + 8 * g + 4 * h;
      const u32x2 zw = *(const u32x2*)(zp + dv);
      const float z0 = bf2f((u16)(zw[0] & 0xffffu)), z1 = bf2f((u16)(zw[0] >> 16)), z2 = bf2f((u16)(zw[1] & 0xffffu)), z3 = bf2f((u16)(zw[1] >> 16));
      u32x2 w = {pack2(o[db][4 * g] * inv * siluf(z0), o[db][4 * g + 1] * inv * siluf(z1)), pack2(o[db][4 * g + 2] * inv * siluf(z2), o[db][4 * g + 3] * inv * siluf(z3))};
      if (DBGV == 0) *(u32x2*)(op + dv) = w; else asm volatile("" :: "v"(w[0]), "v"(w[1]));
    }
  __syncthreads();
}

DI void phase_attn0(const Params& p, char* lds, unsigned long long code_end) {
#pragma unroll 1
  for (int it = blockIdx.x; it < 1280; it += gridDim.x) {
    const int x = it & 7;
    int kind, s, hs, q0;
    if (it < 512) { const int j = it >> 3; const int pr = (j & 7) * 8 + x, qb = j >> 3; kind = 0; s = 16 + (pr >> 3); hs = pr & 7; q0 = qb * 256; }
    else if (it < 1024) { const int j = (it - 512) >> 3; const int pr = (j & 1) * 8 + x, sub = j >> 1;
      kind = 1; s = 16 + (pr >> 1); hs = (pr & 1) * 2 + (sub & 1); q0 = (sub >> 1) * 128; }
    else if (it < 1152) { const int j = it - 1024; kind = 0; s = j >> 3; hs = j & 7; q0 = 0; }
    else { const int j = it - 1152; kind = 1; s = j >> 3; hs = (j & 7) >> 1; q0 = (j & 1) * 128; }
    if (it >= 512 && it < 768) code_prefetch(code_end);
    if (kind == 0) attn_item<0>(p, s, hs, q0, lds); else attn_item<1>(p, s, hs, q0, lds);
  }
}
template <int DBGV>
DI void phase_attn1_t(const Params& p, char* lds) {
#pragma unroll 1
  for (int it = blockIdx.x; it < 320; it += gridDim.x) {
    const int x = it & 7;
    int s, hs, q0;
    if (it < 256) { const int j = it >> 3; const int pr = (j & 1) * 8 + x, qb = j >> 1; s = 16 + (pr >> 1); hs = pr & 1; q0 = qb * 128; }
    else { const int j = it - 256; s = j >> 2; hs = (j & 3) >> 1; q0 = (j & 1) * 128; }
    attn_item<2, DBGV>(p, s, hs, q0, lds);
  }
}
DI void phase_attn1(const Params& p, char* lds) { phase_attn1_t<0>(p, lds); }

DI float group16_sum(float v) {
#pragma unroll
  for (int o = 8; o > 0; o >>= 1) v += __shfl_xor(v, o);
  return v;
}
template <bool GDN, bool ATT>
DI void l1prep_t(const Params& p, char* lds, int rank, int nblk) {
  const int tid = TIDX(), lane = tid & 63, wid = tid >> 6;
  const u16* UA = (const u16*)(p.ws + WS_U1A);
  u16* UB = (u16*)(p.ws + WS_U1B);
  u16* QK = (u16*)(p.ws + WS_H);
  u16* VC = (u16*)(p.ws + WS_VC);
  float* GB = (float*)(p.ws + WS_GB);
  const float* AB = (const float*)(p.ws + WS_AB);
  const float2* tabA = (const float2*)(p.ws + WS_ROPE) + 1536;
  u16* sv = (u16*)lds;
  float* sconv = (float*)(lds + 16384);
  if (GDN) { for (int i = tid; i < 1152; i += NTHREADS) *(float4*)(sconv + 4 * i) = *(const float4*)(p.gdn_conv + 4 * i); }
  __syncthreads();
  constexpr int N_TOK_ITEMS = NTOK / 16;
  constexpr int N_KC_ITEMS = 256;
  constexpr int N_VC_ITEMS = 256;
  for (int it = rank; it < (ATT ? N_TOK_ITEMS + N_KC_ITEMS + N_VC_ITEMS : N_TOK_ITEMS); it += nblk) {
    if (it >= N_TOK_ITEMS + N_KC_ITEMS) {
      const int t = it - N_TOK_ITEMS - N_KC_ITEMS; const int b = t >> 5, g = t & 31;
      {
        const int key = tid >> 5, c8 = (tid & 31) * 8;
        const float* src = p.c_attv + ((size_t)(b * 512 + g * 16 + key)) * 256 + c8;
        const float4 a = ntload4(src), b4 = ntload4(src + 4);
        u32x4 w = {pack2(a.x, a.y), pack2(a.z, a.w), pack2(b4.x, b4.y), pack2(b4.z, b4.w)};
        *(u32x4*)(sv + key * 264 + c8) = w;
      }
      __syncthreads();
      vt_store16(sv, 264, 256, (u16*)(p.ws + WS_VTATT) + (size_t)krow0_of(16 + b) * 256, 2560, 2048 + g * 16);
      __syncthreads();
      continue;
    }
    if (it >= N_TOK_ITEMS) {
      const size_t i = (size_t)(it - N_TOK_ITEMS) * 4096 + tid * 8;
      const float4 a = ntload4(p.c_attk + i), b4 = ntload4(p.c_attk + i + 4);
      u32x4 w = {pack2(a.x, a.y), pack2(a.z, a.w), pack2(b4.x, b4.y), pack2(b4.z, b4.w)};
      *(u32x4*)((u16*)(p.ws + WS_KC) + i) = w;
      continue;
    }
    const int m0 = it * 16;
    for (int tt = 0; tt < 2; ++tt) {
      const int ml = wid * 2 + tt, m = m0 + ml;
      const bool ctx = m < NCTX;
      const int pos = pos_of_tok(m), prow = pos >> 6, pcol = pos & 63, len = ctx ? 256 : 2048;
      const int li = lane & 15;
      const u16* r1 = UA + (size_t)m * U1A_LD;
      u32x4 xw[3][3]; float cw[3][3][8];
      if constexpr (GDN) {
#pragma unroll
      for (int j = 0; j < 3; ++j) {
        const int ch = j * 512 + lane * 8;
        xw[j][1] = *(const u32x4*)(r1 + ch);
        xw[j][0] = (pos > 0) ? *(const u32x4*)(r1 - U1A_LD + ch) : (u32x4){0u, 0u, 0u, 0u};
        xw[j][2] = (pos < len - 1) ? *(const u32x4*)(r1 + U1A_LD + ch) : (u32x4){0u, 0u, 0u, 0u};
#pragma unroll
        for (int kk = 0; kk < 3; ++kk) {
          const float4 wa = *(const float4*)(sconv + kk * 1536 + ch), wb = *(const float4*)(sconv + kk * 1536 + ch + 4);
          cw[j][kk][0] = wa.x; cw[j][kk][1] = wa.y; cw[j][kk][2] = wa.z; cw[j][kk][3] = wa.w; cw[j][kk][4] = wb.x; cw[j][kk][5] = wb.y; cw[j][kk][6] = wb.z; cw[j][kk][7] = wb.w;
        }
      }
      }
      u16* qp = UB + (size_t)m * U1B_LD + C1_QD + lane * 8;
      u16* kp = UB + (size_t)m * U1B_LD + C1_KD + (lane & 31) * 8;
      u32x4 qdw, kdw, vdw; float abv = 0.f;
      if constexpr (ATT) { qdw = ntload4u(qp); kdw = ntload4u(kp); vdw = ntload4u(UB + (size_t)m * U1B_LD + C1_VD + (lane & 31) * 8); }
      if constexpr (GDN) abv = AB[(size_t)m * 16 + (lane & 15)];
      float qn8[8], kn8[8]; float2 cs8[8];
      if constexpr (ATT) {
        const float4 a0 = *(const float4*)(p.att_q_norm + li * 8), a1 = *(const float4*)(p.att_q_norm + li * 8 + 4), b0 = *(const float4*)(p.att_k_norm + li * 8), b1 = *(const float4*)(p.att_k_norm + li * 8 + 4);
        qn8[0] = a0.x; qn8[1] = a0.y; qn8[2] = a0.z; qn8[3] = a0.w; qn8[4] = a1.x; qn8[5] = a1.y; qn8[6] = a1.z; qn8[7] = a1.w;
        kn8[0] = b0.x; kn8[1] = b0.y; kn8[2] = b0.z; kn8[3] = b0.w; kn8[4] = b1.x; kn8[5] = b1.y; kn8[6] = b1.z; kn8[7] = b1.w;
        const int b32 = li >> 2, pp = (b32 >= 2) ? pcol : prow;
#pragma unroll
        for (int e = 0; e < 8; ++e) cs8[e] = tabA[pp * 32 + (li & 3) * 8 + e];
      }
      const bool is_x2 = ((li >> 2) & 1) != 0;
      if constexpr (GDN) {
#pragma unroll
      for (int j = 0; j < 3; ++j) {
        float x0[8], x1[8], x2[8], y[8];
        unpack8(xw[j][0], x0); unpack8(xw[j][1], x1); unpack8(xw[j][2], x2);
        float ss = 0.f;
#pragma unroll
        for (int e = 0; e < 8; ++e) { const float a = cw[j][0][e] * x0[e] + cw[j][1][e] * x1[e] + cw[j][2][e] * x2[e]; y[e] = siluf(a); ss += y[e] * y[e]; }
        if (j < 2) {
          ss = group16_sum(ss);
          const float rs = rsqrtf(ss + EPS) * (j == 0 ? 0.08838834764831845f : 1.f);
#pragma unroll
          for (int e = 0; e < 8; ++e) y[e] *= rs;
          *(u32x4*)(QK + (size_t)m * DM + j * 512 + lane * 8) = pack8f(y);
        } else {
          *(u32x4*)(VC + (size_t)m * 512 + lane * 8) = pack8f(y);
        }
      }
      if (lane < 16) {
        float r;
        if (lane < 8) { const float x = abv + p.gdn_dt_bias[lane]; const float ex = __expf(x);
          const float sp = x > 20.f ? x : (ex < 0.03125f ? ex * (1.f - ex * (0.5f - ex * (0.33333333f - 0.25f * ex))) : __logf(1.f + ex));
          r = -__expf(p.gdn_a_log[lane]) * sp; }
        else r = __builtin_amdgcn_rcpf(1.f + __expf(-abv));
        GB[(size_t)m * 16 + lane] = r;
      }
      }
      if constexpr (ATT) {
        float x[8], xp[8];
        unpack8(qdw, x);
        float ss = 0.f;
#pragma unroll
        for (int e = 0; e < 8; ++e) ss += x[e] * x[e];
        ss = group16_sum(ss);
        const float rs = rsqrtf(ss * (1.f / 128.f) + EPS);
#pragma unroll
        for (int e = 0; e < 8; ++e) x[e] *= rs * qn8[e];
        shfl8(x, xp, 4);
        if (!ctx) {
#pragma unroll
          for (int e = 0; e < 8; ++e) x[e] = is_x2 ? (x[e] * cs8[e].x + xp[e] * cs8[e].y) : (x[e] * cs8[e].x - xp[e] * cs8[e].y);
        }
        *(u32x4*)qp = pack8f(x);
      }
      if constexpr (ATT) {
        float x[8], xp[8];
        unpack8(kdw, x);
        float ss = 0.f;
#pragma unroll
        for (int e = 0; e < 8; ++e) ss += x[e] * x[e];
        ss = group16_sum(ss);
        const float rs = rsqrtf(ss * (1.f / 128.f) + EPS);
#pragma unroll
        for (int e = 0; e < 8; ++e) x[e] *= rs * kn8[e];
        if (ctx && lane < 32) {
          *(float4*)(p.out + O_ATTK + (size_t)m * 256 + lane * 8) = make_float4(x[0], x[1], x[2], x[3]);
          *(float4*)(p.out + O_ATTK + (size_t)m * 256 + lane * 8 + 4) = make_float4(x[4], x[5], x[6], x[7]);
        }
        shfl8(x, xp, 4);
        if (!ctx) {
#pragma unroll
          for (int e = 0; e < 8; ++e) x[e] = is_x2 ? (x[e] * cs8[e].x + xp[e] * cs8[e].y) : (x[e] * cs8[e].x - xp[e] * cs8[e].y);
        }
        if (lane < 32) {
          *(u32x4*)kp = pack8f(x);
          *(u32x4*)(sv + ml * 264 + lane * 8) = vdw;
          if (ctx) {
            float v[8]; unpack8(vdw, v);
            *(float4*)(p.out + O_ATTV + (size_t)m * 256 + lane * 8) = make_float4(v[0], v[1], v[2], v[3]);
            *(float4*)(p.out + O_ATTV + (size_t)m * 256 + lane * 8 + 4) = make_float4(v[4], v[5], v[6], v[7]);
          }
        }
      }
    }
    if constexpr (ATT) {
      __syncthreads();
      {
        const int s = seq_of_tok(m0);
        vt_store16(sv, 264, 256, (u16*)(p.ws + WS_VTATT) + (size_t)krow0_of(s) * 256, cap_of(s), pos_of_tok(m0));
      }
      __syncthreads();
    }
  }
  __syncthreads();
}
DI int cp_main_chunk(int it) { if (it < 64) return it; const int j = it - 64, b = j / 24, cc = j % 24; return 64 + b * 32 + (cc < 12 ? cc : cc + 8); }
DI int cp_deferred_chunk(int it) { return 64 + (it >> 3) * 32 + 12 + (it & 7); }
DI void l1prep_gdn(const Params& p, int rank, int nblk) {
  const int tid = TIDX(), lane = tid & 63, wid = tid >> 6;
  const u16* UA = (const u16*)(p.ws + WS_U1A);
  u16* QK = (u16*)(p.ws + WS_H);
  u16* VC = (u16*)(p.ws + WS_VC);
  float* GB = (float*)(p.ws + WS_GB);
  const float* AB = (const float*)(p.ws + WS_AB);
  float cw[3][3][8];
#pragma unroll
  for (int j = 0; j < 3; ++j)
#pragma unroll
    for (int kk = 0; kk < 3; ++kk) {
      const float4 wa = *(const float4*)(p.gdn_conv + kk * 1536 + j * 512 + lane * 8), wb = *(const float4*)(p.gdn_conv + kk * 1536 + j * 512 + lane * 8 + 4);
      cw[j][kk][0] = wa.x; cw[j][kk][1] = wa.y; cw[j][kk][2] = wa.z; cw[j][kk][3] = wa.w; cw[j][kk][4] = wb.x; cw[j][kk][5] = wb.y; cw[j][kk][6] = wb.z; cw[j][kk][7] = wb.w;
    }
  const float dtb = p.gdn_dt_bias[lane & 7], nalog = -__expf(p.gdn_a_log[lane & 7]);
  constexpr int N_TOK_ITEMS = NTOK / 16;
  const int nit = rank < N_TOK_ITEMS ? (N_TOK_ITEMS - 1 - rank) / nblk + 1 : 0, nq = nit * 2;
  const bool own = nblk == 256;
  const int own_tok0 = cp_main_chunk(rank) * 64, def_tok0 = cp_deferred_chunk(rank >> 2) * 64 + (rank & 3) * 16;
#define L1G_TOK(q_) (own ? (((q_) >> 1) < 4 ? own_tok0 + ((q_) >> 1) * 16 : def_tok0) + wid * 2 + ((q_) & 1) : (rank + ((q_) >> 1) * nblk) * 16 + wid * 2 + ((q_) & 1))
#define L1G_LOAD(X_, A_, m_) do { const int pos_ = pos_of_tok(m_), len_ = (m_) < NCTX ? 256 : 2048; const u16* r1_ = UA + (size_t)(m_) * U1A_LD; \
    const u16* rp_ = pos_ > 0 ? r1_ - U1A_LD : r1_; const u16* rn_ = pos_ < len_ - 1 ? r1_ + U1A_LD : r1_; \
    _Pragma("unroll") for (int j = 0; j < 3; ++j) { const int ch_ = j * 512 + lane * 8; X_[j][0] = *(const u32x4*)(rp_ + ch_); X_[j][1] = *(const u32x4*)(r1_ + ch_); X_[j][2] = *(const u32x4*)(rn_ + ch_); } \
    A_ = AB[(size_t)(m_) * 16 + (lane & 15)]; } while (0)
  u32x4 xc[3][3], xn[3][3]; float abc = 0.f, abn = 0.f;
  if (nq > 0) { const int m0 = L1G_TOK(0); L1G_LOAD(xc, abc, m0); }
#pragma unroll 1
  for (int q = 0; q < nq; ++q) {
    const int m = L1G_TOK(q);
    if (q + 1 < nq) { const int mn = L1G_TOK(q + 1); L1G_LOAD(xn, abn, mn); }
    const int pos = pos_of_tok(m), len = m < NCTX ? 256 : 2048;
    const float e0 = pos > 0 ? 1.f : 0.f, e2 = pos < len - 1 ? 1.f : 0.f;
#pragma unroll
    for (int j = 0; j < 3; ++j) {
      float x0[8], x1[8], x2[8], y[8];
      unpack8(xc[j][0], x0); unpack8(xc[j][1], x1); unpack8(xc[j][2], x2);
      float ss = 0.f;
#pragma unroll
      for (int e = 0; e < 8; ++e) { const float a = cw[j][0][e] * (x0[e] * e0) + cw[j][1][e] * x1[e] + cw[j][2][e] * (x2[e] * e2); y[e] = siluf(a); ss += y[e] * y[e]; }
      if (j < 2) {
        ss = group16_sum(ss);
        const float rs = rsqrtf(ss + EPS) * (j == 0 ? 0.08838834764831845f : 1.f);
#pragma unroll
        for (int e = 0; e < 8; ++e) y[e] *= rs;
        *(u32x4*)(QK + (size_t)m * DM + j * 512 + lane * 8) = pack8f(y);
      } else {
        *(u32x4*)(VC + (size_t)m * 512 + lane * 8) = pack8f(y);
      }
    }
    if (lane < 16) {
      float r;
      if (lane < 8) { const float x = abc + dtb; const float ex = __expf(x);
        const float sp = x > 20.f ? x : (ex < 0.03125f ? ex * (1.f - ex * (0.5f - ex * (0.33333333f - 0.25f * ex))) : __logf(1.f + ex));
        r = nalog * sp; }
      else r = __builtin_amdgcn_rcpf(1.f + __expf(-abc));
      GB[(size_t)m * 16 + lane] = r;
    }
#pragma unroll
    for (int j = 0; j < 3; ++j)
#pragma unroll
      for (int kk = 0; kk < 3; ++kk) xc[j][kk] = xn[j][kk];
    abc = abn;
  }
#undef L1G_TOK
#undef L1G_LOAD
}
DI void phase_l1prep(const Params& p, char* lds) {
  l1prep_gdn(p, (int)blockIdx.x, (int)gridDim.x);
  if (gridDim.x != 256) l1prep_t<false, true>(p, lds, (int)blockIdx.x, (int)gridDim.x);
}


DI void phase_gdnfinal(const Params& p) {
  const int tid_ = TIDX(), lane = tid_ & 63, wid = tid_ >> 6;
  const u16* OF = (const u16*)(p.ws + WS_OF); const u16* OBk = (const u16*)(p.ws + WS_OB);
  const u16* UB = (const u16*)(p.ws + WS_U1B);
  u16* H = (u16*)(p.ws + WS_H);
  for (int m = blockIdx.x * 8 + wid; m < NTOK; m += gridDim.x * 8) {
    float a[8], b[8], z[8];
    unpack8(ntload4u(OF + (size_t)m * 512 + lane * 8), a);
    unpack8(ntload4u(OBk + (size_t)m * 512 + lane * 8), b);
    unpack8(ntload4u(UB + (size_t)m * U1B_LD + C1_ZC + lane * 8), z);
    float ss = 0.f;
#pragma unroll
    for (int e = 0; e < 8; ++e) { a[e] += b[e]; ss += a[e] * a[e]; }
    ss = group16_sum(ss);
    const float rs = rsqrtf(ss * (1.f / 128.f) + EPS);
    const int li = lane & 15;
#pragma unroll
    for (int e = 0; e < 8; ++e) a[e] = a[e] * rs * p.gdn_norm[li * 8 + e] * siluf(z[e]);
    *(u32x4*)(H + (size_t)m * DM + lane * 8) = pack8f(a);
  }
}

DI float dbg_rel(const Params& p);
#ifndef DBG_CHECK
#define DBG_CHECK 0
#endif
#ifndef DBG_AMP
#define DBG_AMP 10.f
#endif
DI void phase_final(const Params& p) {
  const int tid_ = TIDX(), lane = tid_ & 63, wid = tid_ >> 6;
  const u16* GY = (const u16*)(p.ws + WS_GY1);
  float4 g4[4];
#pragma unroll
  for (int j = 0; j < 4; ++j) g4[j] = *(const float4*)(p.ln_f + (j * 64 + lane) * 4);
  const int stride = gridDim.x * 8;
  int m = blockIdx.x * 8 + wid;
  float4 cur[4], nxt[4]; u32x2 cg[4], ng[4];
  if (m < NTOK) {
#pragma unroll
    for (int j = 0; j < 4; ++j) { cur[j] = ntload4(p.out + (size_t)m * DM + (j * 64 + lane) * 4); cg[j] = ntload2u(GY + (size_t)m * DM + (j * 64 + lane) * 4); } }
  for (; m < NTOK; m += stride) {
    const int mn = m + stride;
    if (mn < NTOK) {
#pragma unroll
      for (int j = 0; j < 4; ++j) { nxt[j] = ntload4(p.out + (size_t)mn * DM + (j * 64 + lane) * 4); ng[j] = ntload2u(GY + (size_t)mn * DM + (j * 64 + lane) * 4); } }
    float ss = 0.f;
#pragma unroll
    for (int j = 0; j < 4; ++j) {
      cur[j].x += bf2f((u16)(cg[j][0] & 0xffffu)); cur[j].y += bf2f((u16)(cg[j][0] >> 16)); cur[j].z += bf2f((u16)(cg[j][1] & 0xffffu)); cur[j].w += bf2f((u16)(cg[j][1] >> 16));
      ss += cur[j].x * cur[j].x + cur[j].y * cur[j].y + cur[j].z * cur[j].z + cur[j].w * cur[j].w;
    }
    ss = wave_sum(ss);
    const float rs = rsqrtf(ss * (1.f / 1024.f) + EPS);
#pragma unroll
    for (int j = 0; j < 4; ++j)
      { typedef float nt4 __attribute__((ext_vector_type(4))); const nt4 yv = {cur[j].x * rs * g4[j].x, cur[j].y * rs * g4[j].y, cur[j].z * rs * g4[j].z, cur[j].w * rs * g4[j].w};
        __builtin_nontemporal_store(yv, (nt4*)(p.out + (size_t)m * DM + (j * 64 + lane) * 4)); }
#pragma unroll
    for (int j = 0; j < 4; ++j) { cur[j] = nxt[j]; cg[j] = ng[j]; }
  }
}

template <class F>
DI void ngemm(const GemmA A, const u16* __restrict__ Wt, int ldw, int K, int M, int N, char* lds, F f) {
  u16* sA = (u16*)lds;
  const int tid = TIDX();
  const int ncol = (N + 511) / 512;
  for (int it = blockIdx.x; it < (M / 8) * ncol; it += gridDim.x) {
    const int m0 = (it / ncol) * 8, n = (it % ncol) * 512 + tid;
    __syncthreads();
    for (int i = tid; i < 8 * (K / 8); i += NTHREADS) {
      const int r = i / (K / 8), k8 = (i % (K / 8)) * 8;
      const u16* src = k8 < A.ksplit ? A.p0 + (size_t)(m0 + r) * A.ld0 + k8 : A.p1 + (size_t)(m0 + r) * A.ld1 + (k8 - A.ksplit);
      *(u32x4*)(sA + r * K + k8) = *(const u32x4*)src;
    }
    __syncthreads();
    if (n < N) {
      float acc[8];
#pragma unroll
      for (int r = 0; r < 8; ++r) acc[r] = 0.f;
      for (int k8 = 0; k8 < K; k8 += 8) {
        float w[8]; unpack8(*(const u32x4*)(Wt + (size_t)n * ldw + k8), w);
#pragma unroll
        for (int r = 0; r < 8; ++r) {
          float a[8]; unpack8(*(const u32x4*)(sA + r * K + k8), a);
#pragma unroll
          for (int e = 0; e < 8; ++e) acc[r] += a[e] * w[e];
        }
      }
#pragma unroll
      for (int r = 0; r < 8; ++r) f(m0 + r, n, acc[r]);
    }
  }
}
DI void nphase_inproj0(const Params& p, char* lds) {
  u16* U = (u16*)(p.ws + WS_U); const u16* H = (const u16*)(p.ws + WS_H);
  ngemm(GemmA{H, DM, H, DM, 1 << 30}, (const u16*)(p.ws + WS_WT0), DM, DM, NTOK, L0C, lds, [=](int m, int n, float v) { U[(size_t)m * L0C + n] = f2bf(v); });
}
DI void nphase_l0gemms(const Params& p, char* lds) {
  const u16* U0 = (const u16*)(p.ws + WS_U); const u16* ck = (const u16*)(p.ws + WS_CKVN);
  u16* Kn = (u16*)((char*)p.out + YS_KN); u16* Vt = (u16*)((char*)p.out + YS_VTMLA); u16* Q = (u16*)((char*)p.out + YS_QMLA);
  ngemm(GemmA{ck, 256, ck, 256, 1 << 30}, (const u16*)(p.ws + WS_WUKV), 256, 256, NKROW, 1024, lds, [=](int kr, int n, float v) {
    if (n < 512) Kn[(size_t)kr * 512 + n] = f2bf(v);
    else {
      int seq, key;
      if (kr < NCTX) { seq = kr >> 8; key = kr & 255; } else { const int r = kr - NCTX; seq = 16 + r / 2560; key = r % 2560; }
      Vt[(size_t)krow0_of(seq) * 512 + (size_t)(n - 512) * cap_of(seq) + (key & ~15) + swz16(key & 15)] = f2bf(v);
    }
  });
  ngemm(GemmA{U0 + C0_CQ, L0C, U0 + C0_CQ, L0C, 1 << 30}, (const u16*)(p.ws + WS_WUQ), 384, 384, NTOK, 768, lds, [=](int m, int n, float v) { Q[(size_t)m * 768 + n] = f2bf(v); });
}
DI void nphase_qmla_rope(const Params& p) {
  u16* Q = (u16*)((char*)p.out + YS_QMLA);
  const float2* tab = (const float2*)(p.ws + WS_ROPE);
  for (size_t i = (size_t)blockIdx.x * NTHREADS + threadIdx.x; i < (size_t)(NTOK - NCTX) * 8 * 16; i += (size_t)gridDim.x * NTHREADS) {
    const int m = NCTX + (int)(i >> 7), head = (int)(i >> 4) & 7, j = (int)i & 15;
    const int pos = pos_of_tok(m), pp = (j >> 3) ? (pos & 63) : (pos >> 6);
    u16* q = Q + (size_t)m * 768 + head * 96 + 64 + (j >> 3) * 16 + (j & 7);
    const float x1 = bf2f(q[0]), x2 = bf2f(q[8]);
    const float2 cs = tab[pp * 8 + (j & 7)];
    q[0] = f2bf(x1 * cs.x - x2 * cs.y); q[8] = f2bf(x2 * cs.x + x1 * cs.y);
  }
}
DI void nphase_outproj(const Params& p, int layer, char* lds) {
  const u16* H = (const u16*)(p.ws + WS_H);
  const GemmA A{H, DM, H, DM, 1 << 30};
  const float* mod = (const float*)(p.ws + WS_MOD) + (size_t)layer * 9 * 3072 + 2048;
  const Params* pp = &p;
  ngemm(A, (const u16*)(p.ws + (layer ? WS_WO1 : WS_WO0)), DM, DM, NTOK, DM, lds, [=](int m, int n, float v) {
    const float gate = mod[(size_t)modidx_of_tok(m) * 3072 + n];
    const float xv = layer ? pp->out[(size_t)m * DM + n] : xrow(*pp, m)[n];
    pp->out[(size_t)m * DM + n] = xv + gate * v;
  });
}
DI void nphase_inproj1(const Params& p, char* lds) {
  u16* UA = (u16*)(p.ws + WS_U1A); u16* UB = (u16*)(p.ws + WS_U1B); float* AB = (float*)(p.ws + WS_AB);
  const u16* H = (const u16*)(p.ws + WS_H);
  ngemm(GemmA{H, DM, H, DM, 1 << 30}, (const u16*)(p.ws + WS_WT1), DM, DM, NTOK, L1C, lds, [=](int m, int n, float v) {
    if (n < 1536) UA[(size_t)m * U1A_LD + n] = f2bf(v);
    else if (n < 3584) UB[(size_t)m * U1B_LD + n - 1536] = f2bf(v);
    else AB[(size_t)m * 16 + n - 3584] = v;
  });
}

template <int KIND>
DI void nattn(const Params& p) {
  constexpr int DQK = KIND == 0 ? 96 : (KIND == 1 ? 64 : 128);
  constexpr int DV = KIND == 2 ? 128 : 64;
  constexpr int NH = KIND == 2 ? 4 : 8;
  constexpr float SCALE = KIND == 0 ? 0.10206207261596577f : (KIND == 1 ? 0.125f : 0.08838834764831845f);
  const int tid_ = TIDX(), lane = tid_ & 63, wid = tid_ >> 6;
  const u16* U0 = (const u16*)(p.ws + WS_U);
  u16* U1B = (u16*)(p.ws + WS_U1B);
  for (int it = blockIdx.x * 8 + wid; it < NTOK * NH; it += gridDim.x * 8) {
    const int tok = it / NH, hq = it % NH;
    const int s = seq_of_tok(tok), tok0 = tok0_of(s), kr0 = krow0_of(s), cap = cap_of(s), len = len_of(s), qi = tok - tok0;
    const bool smp = s >= 16;
    const int hkv = KIND == 0 ? hq : (KIND == 1 ? hq >> 2 : hq >> 1);
    const u16* qp; const u16* VT;
    if (KIND == 0) { qp = (const u16*)((const char*)p.out + YS_QMLA) + (size_t)tok * 768 + hq * 96; VT = (const u16*)((const char*)p.out + YS_VTMLA) + (size_t)kr0 * 512; }
    else if (KIND == 1) { qp = U0 + (size_t)tok * L0C + C0_QB + hq * 64; VT = (const u16*)(p.ws + WS_VTSWA) + (size_t)kr0 * 128; }
    else { qp = U1B + (size_t)tok * U1B_LD + C1_QD + hq * 128; VT = (const u16*)(p.ws + WS_VTATT) + (size_t)kr0 * 256; }
    const float q0 = bf2f(qp[lane]);
    float q1 = (DQK > 64 && lane + 64 < DQK) ? bf2f(qp[lane + 64]) : 0.f;
    if (KIND == 0) {
      const float q1p = __shfl_xor(q1, 8);
      if (smp && lane < 32) {
        const float2 cs = ((const float2*)(p.ws + WS_ROPE))[((lane >> 4) ? (qi & 63) : (qi >> 6)) * 8 + (lane & 7)];
        q1 = (lane & 8) ? (q1 * cs.x + q1p * cs.y) : (q1 * cs.x - q1p * cs.y);
      }
    }
    float m = -1e30f, l = 0.f, o0 = 0.f, o1 = 0.f;
    int glo = 0, ghi = cap >> 4;
    const int nseqg = len >> 4;
    for (int gidx = glo; gidx < ghi; ++gidx) {
      const int g0 = gidx * 16;
      if (KIND == 1 && smp && g0 < 2048) { if (g0 + 15 < qi - 128 || g0 > qi + 128) continue; }
      float sc[16];
#pragma unroll
      for (int j = 0; j < 16; ++j) {
        const int g = g0 + j;
        const u16* kp;
        float part;
        if (KIND == 0) {
          const u16* kn = (const u16*)((const char*)p.out + YS_KN) + ((size_t)(kr0 + g) * 8 + hkv) * 64;
          const u16* kr = (const u16*)(p.ws + WS_KROPE) + (size_t)(kr0 + g) * 32;
          part = q0 * bf2f(kn[lane]) + (lane < 32 ? q1 * bf2f(kr[lane]) : 0.f);
        } else if (KIND == 1) {
          kp = (const u16*)(p.ws + WS_KSWA) + ((size_t)(kr0 + g) * 2 + hkv) * 64;
          part = q0 * bf2f(kp[lane]);
        } else {
          kp = g < len ? U1B + (size_t)(tok0 + g) * U1B_LD + C1_KD + hkv * 128 : (const u16*)(p.ws + WS_KC) + ((size_t)((s - 16) * 512 + g - 2048) * 2 + hkv) * 128;
          part = q0 * bf2f(kp[lane]) + q1 * bf2f(kp[lane + 64]);
        }
        float sv_ = wave_sum(part) * SCALE;
        if (KIND == 1 && smp && g < 2048) { const int d = qi - g; if (d > 128 || d < -128) sv_ = -INFINITY; }
        sc[j] = sv_;
      }
      float mx = sc[0];
#pragma unroll
      for (int j = 1; j < 16; ++j) mx = fmaxf(mx, sc[j]);
      const float mnew = fmaxf(m, mx);
      const float alpha = __expf(m - mnew);
      m = mnew; l *= alpha; o0 *= alpha; o1 *= alpha;
      const u32x4 va = *(const u32x4*)(VT + (size_t)(hkv * DV + lane) * cap + g0), vb = *(const u32x4*)(VT + (size_t)(hkv * DV + lane) * cap + g0 + 8);
      float v0[16]; { float t8[8]; unpack8(va, t8); for (int e = 0; e < 8; ++e) v0[e] = t8[e]; unpack8(vb, t8); for (int e = 0; e < 8; ++e) v0[8 + e] = t8[e]; }
      float v1[16];
      if (DV > 64) {
        const u32x4 vc = *(const u32x4*)(VT + (size_t)(hkv * DV + 64 + lane) * cap + g0), vd = *(const u32x4*)(VT + (size_t)(hkv * DV + 64 + lane) * cap + g0 + 8);
        float t8[8]; unpack8(vc, t8); for (int e = 0; e < 8; ++e) v1[e] = t8[e]; unpack8(vd, t8); for (int e = 0; e < 8; ++e) v1[8 + e] = t8[e];
      }
#pragma unroll
      for (int j = 0; j < 16; ++j) {
        const float pj = __expf(sc[j] - mnew);
        l += pj;
        o0 += pj * v0[swz16(j)];
        if (DV > 64) o1 += pj * v1[swz16(j)];
      }
    }
    (void)nseqg; (void)glo;
    if (KIND == 1) l += __expf(p.swa_sink[hq] - m);
    const float inv = 1.f / l;
    if (KIND == 0) { const float z = bf2f(U0[(size_t)tok * L0C + C0_ZA + hq * 64 + lane]); ((u16*)(p.ws + WS_H))[(size_t)tok * DM + hq * 64 + lane] = f2bf(o0 * inv * siluf(z)); }
    else if (KIND == 1) { const float z = bf2f(U0[(size_t)tok * L0C + C0_ZB + hq * 64 + lane]); ((u16*)(p.ws + WS_H))[(size_t)tok * DM + 512 + hq * 64 + lane] = f2bf(o0 * inv * siluf(z)); }
    else {
      const float z0 = bf2f(U1B[(size_t)tok * U1B_LD + C1_ZD + hq * 128 + lane]), z1 = bf2f(U1B[(size_t)tok * U1B_LD + C1_ZD + hq * 128 + 64 + lane]);
      ((u16*)(p.ws + WS_H))[(size_t)tok * DM + 512 + hq * 128 + lane] = f2bf(o0 * inv * siluf(z0));
      ((u16*)(p.ws + WS_H))[(size_t)tok * DM + 512 + hq * 128 + 64 + lane] = f2bf(o1 * inv * siluf(z1));
    }
  }
}

DI void nphase_gdn(const Params& p, char* lds) {
  const int tid = TIDX();
  float* sq = (float*)lds; float* sk = sq + 128;
  const u16* QK = (const u16*)(p.ws + WS_H); const u16* VC = (const u16*)(p.ws + WS_VC); const float* GB = (const float*)(p.ws + WS_GB);
  for (int it = blockIdx.x; it < 192; it += gridDim.x) {
    int s, head, dir;
    if (it < 64) { s = 16 + (it >> 3); head = (it >> 1) & 3; dir = it & 1; } else { const int j = it - 64; s = j >> 3; head = (j >> 1) & 3; dir = j & 1; }
    const int tok0 = tok0_of(s), T = len_of(s);
    u16* O = (u16*)(p.ws + (dir ? WS_OB : WS_OF));
    float S[128];
    if (tid < 128) {
      if (s >= 16) {
        const float* st = p.c_state + ((size_t)(((s - 16) * 2 + dir) * 4 + head)) * 16384;
#pragma unroll
        for (int d = 0; d < 128; ++d) S[d] = st[d * 128 + tid];
      } else {
#pragma unroll
        for (int d = 0; d < 128; ++d) S[d] = 0.f;
      }
    }
    for (int tau = 0; tau < T; ++tau) {
      const int m = tok0 + (dir ? T - 1 - tau : tau);
      __syncthreads();
      if (tid < 128) { sq[tid] = bf2f(QK[(size_t)m * DM + head * 128 + tid]); sk[tid] = bf2f(QK[(size_t)m * DM + 512 + head * 128 + tid]); }
      __syncthreads();
      if (tid < 128) {
        const float g = GB[(size_t)m * 16 + dir * 4 + head], beta = GB[(size_t)m * 16 + 8 + dir * 4 + head];
        const float alpha = __expf(g);
        const float v = bf2f(VC[(size_t)m * 512 + head * 128 + tid]);
        float r = 0.f;
#pragma unroll
        for (int c = 0; c < 16; ++c) {
          const float4 ka = *(const float4*)(sk + c * 8), kb = *(const float4*)(sk + c * 8 + 4);
          r += ka.x * S[c * 8] + ka.y * S[c * 8 + 1] + ka.z * S[c * 8 + 2] + ka.w * S[c * 8 + 3] + kb.x * S[c * 8 + 4] + kb.y * S[c * 8 + 5] + kb.z * S[c * 8 + 6] + kb.w * S[c * 8 + 7];
          asm volatile("" ::: "memory");
        }
        const float dd = beta * (v - alpha * r);
        float o = 0.f;
#pragma unroll
        for (int c = 0; c < 16; ++c) {
          const float4 ka = *(const float4*)(sk + c * 8), kb = *(const float4*)(sk + c * 8 + 4);
          const float4 qa = *(const float4*)(sq + c * 8), qb = *(const float4*)(sq + c * 8 + 4);
          const float kk[8] = {ka.x, ka.y, ka.z, ka.w, kb.x, kb.y, kb.z, kb.w};
          const float qq[8] = {qa.x, qa.y, qa.z, qa.w, qb.x, qb.y, qb.z, qb.w};
#pragma unroll
          for (int e = 0; e < 8; ++e) { S[c * 8 + e] = alpha * S[c * 8 + e] + kk[e] * dd; o += qq[e] * S[c * 8 + e]; }
          asm volatile("" ::: "memory");
        }
        O[(size_t)m * 512 + head * 128 + tid] = f2bf(o);
      }
    }
    if (tid < 128 && s < 16) {
      float* st = p.out + O_STATE + ((size_t)((s * 2 + dir) * 4 + head)) * 16384;
#pragma unroll
      for (int d = 0; d < 128; ++d) st[d * 128 + tid] = S[d];
    }
    __syncthreads();
  }
}


DI bf16x8 afrag(const u16* base, int stride, int row, int kbase, int h) {
  const bf16x4 lo = *(const bf16x4*)(base + row * stride + kbase + 4 * h);
  const bf16x4 hi = *(const bf16x4*)(base + row * stride + kbase + 8 + 4 * h);
  return cat4(lo, hi);
}
DI void chunkprep_item(const Params& p, int cgi, char* lds) {
  const int tid0 = TIDX(), wid = tid0 >> 6, head = wid >> 1, dir = wid & 1;
  u16* tiles = (u16*)lds;
  float* vecs = (float*)(lds + 4 * 34816) + wid * 128;
  const u16* QK = (const u16*)(p.ws + WS_H); const float* GB = (const float*)(p.ws + WS_GB);
  {
    const int tok0 = cgi * 64;
    const int oz = opaque_zero();
    const int tid = TIDX() + oz, lane = tid & 63, r32 = lane & 31, h = lane >> 5;
    __syncthreads();
#pragma unroll
    for (int i = 0; i < 16; ++i) {
      const int c = tid + 512 * i, row = c >> 7, col8 = (c & 127) * 8, which = col8 >> 9, hh = (col8 >> 7) & 3, d8 = col8 & 127;
      *(u32x4*)(tiles + hh * 17408 + which * 8704 + row * 136 + d8) = *(const u32x4*)(QK + (size_t)(tok0 + row) * DM + col8);
    }
    {
      const float g = GB[(size_t)(tok0 + lane) * 16 + dir * 4 + head];
      float pre = g;
#pragma unroll
      for (int o = 1; o < 64; o <<= 1) { const float t = __shfl_up(pre, o); if (lane >= o) pre += t; }
      const float tot = __shfl(pre, 63);
      vecs[lane] = dir ? (tot - pre + g) : pre;
      vecs[64 + lane] = GB[(size_t)(tok0 + lane) * 16 + 8 + dir * 4 + head];
    }
    __syncthreads();
    const u16* sq = tiles + head * 17408; const u16* sk = sq + 8704;
    const float* gc = vecs; const float* be = vecs + 64;
    const size_t tm = ((size_t)(cgi * 4 + head) * 2 + dir) * 4096;
    u16* AM = (u16*)(p.ws + WS_AM) + tm;
    f32x16 P[2][2];
#pragma unroll 1
    for (int q4 = 0; q4 < 4; ++q4) {
      const int ib = q4 >> 1, jb = q4 & 1;
      f32x16 kk, qk, pt;
#pragma unroll
      for (int r = 0; r < 16; ++r) { kk[r] = 0.f; qk[r] = 0.f; }
#pragma unroll
      for (int s2 = 0; s2 < 8; ++s2) {
        const bf16x8 ka = *(const bf16x8*)(sk + (32 * ib + r32) * 136 + 16 * s2 + 8 * h);
        const bf16x8 kb = *(const bf16x8*)(sk + (32 * jb + r32) * 136 + 16 * s2 + 8 * h);
        const bf16x8 qb = *(const bf16x8*)(sq + (32 * jb + r32) * 136 + 16 * s2 + 8 * h);
        kk = MFMA(ka, kb, kk);
        qk = MFMA(ka, qb, qk);
      }
      const int cidx = 32 * jb + r32; const float gcol = gc[cidx], bcol = be[cidx];
#pragma unroll
      for (int g4 = 0; g4 < 4; ++g4) {
        const int b0 = 32 * ib + 8 * g4 + 4 * h;
        const float4 gv = *(const float4*)(gc + b0);
        const float gq[4] = {gv.x, gv.y, gv.z, gv.w};
        float v[4];
#pragma unroll
        for (int j = 0; j < 4; ++j) {
          const int rr = b0 + j;
          const float ea = __expf(fminf(gcol - gq[j], 0.f));
          const bool va = dir ? (rr >= cidx) : (rr <= cidx);
          const bool vs = dir ? (rr > cidx) : (rr < cidx);
          v[j] = va ? qk[4 * g4 + j] * ea : 0.f;
          pt[4 * g4 + j] = vs ? bcol * kk[4 * g4 + j] * ea : 0.f;
        }
        u32x2 w = {pack2(v[0], v[1]), pack2(v[2], v[3])};
        *(u32x2*)(AM + cidx * 64 + b0) = w;
      }
      if (q4 == 0) P[0][0] = pt; else if (q4 == 1) P[0][1] = pt; else if (q4 == 2) P[1][0] = pt; else P[1][1] = pt;
      asm volatile("" ::: "memory");
    }
    __syncthreads();
    u16* img = tiles + head * 17408 + dir * 8704;
    const int pcol = (r32 & ~15) | swz16(r32 & 15);
    f32x16 R[2][2];
#pragma unroll
    for (int I = 0; I < 2; ++I)
#pragma unroll
      for (int J = 0; J < 2; ++J)
#pragma unroll
        for (int r = 0; r < 16; ++r) R[I][J][r] = ((I == J && crow(r, h) == r32) ? 1.f : 0.f) - P[I][J][r];
#define CP_ZERO(a_, b_) (dir ? ((a_) == 0 && (b_) == 1) : ((a_) == 1 && (b_) == 0))
#define CP_IMG(T_) do { _Pragma("unroll") for (int I_ = 0; I_ < 2; ++I_) _Pragma("unroll") for (int J_ = 0; J_ < 2; ++J_) if (!CP_ZERO(I_, J_)) { \
      _Pragma("unroll") for (int r_ = 0; r_ < 16; r_ += 2) { const unsigned w_ = pack2(T_[I_][J_][r_], T_[I_][J_][r_ + 1]); \
        img[(32 * I_ + crow(r_, h)) * 72 + 32 * J_ + pcol] = (u16)(w_ & 0xffffu); img[(32 * I_ + crow(r_ + 1, h)) * 72 + 32 * J_ + pcol] = (u16)(w_ >> 16); } } } while (0)
    {
      const int zi = dir ? 0 : 1, zj = dir ? 1 : 0;
#pragma unroll
      for (int r = 0; r < 16; ++r) img[(32 * zi + crow(r, h)) * 72 + 32 * zj + pcol] = 0;
    }
    CP_IMG(P);
#pragma unroll 1
    for (int itn = 0; itn < 5; ++itn) {
#pragma unroll
      for (int J = 0; J < 2; ++J) {
        f32x16 n0, n1;
#pragma unroll
        for (int r = 0; r < 16; ++r) { n0[r] = 0.f; n1[r] = 0.f; }
#pragma unroll
        for (int K = 0; K < 2; ++K) if (!CP_ZERO(K, J)) {
#pragma unroll
          for (int s2 = 0; s2 < 2; ++s2) {
            const bf16x8 bfr = pack8(P[K][J], s2);
            if (!CP_ZERO(0, K) && !CP_ZERO(0, J)) n0 = MFMA(*(const bf16x8*)(img + r32 * 72 + 32 * K + 16 * s2 + 8 * h), bfr, n0);
            if (!CP_ZERO(1, K) && !CP_ZERO(1, J)) n1 = MFMA(*(const bf16x8*)(img + (32 + r32) * 72 + 32 * K + 16 * s2 + 8 * h), bfr, n1);
          }
        }
        P[0][J] = n0; P[1][J] = n1;
      }
      CP_IMG(P);
#pragma unroll
      for (int J = 0; J < 2; ++J) {
        f32x16 n0 = R[0][J], n1 = R[1][J];
#pragma unroll
        for (int K = 0; K < 2; ++K) if (!CP_ZERO(K, J)) {
#pragma unroll
          for (int s2 = 0; s2 < 2; ++s2) {
            const bf16x8 bfr = pack8(R[K][J], s2);
            if (!CP_ZERO(0, K) && !CP_ZERO(0, J)) n0 = MFMA(*(const bf16x8*)(img + r32 * 72 + 32 * K + 16 * s2 + 8 * h), bfr, n0);
            if (!CP_ZERO(1, K) && !CP_ZERO(1, J)) n1 = MFMA(*(const bf16x8*)(img + (32 + r32) * 72 + 32 * K + 16 * s2 + 8 * h), bfr, n1);
          }
        }
        R[0][J] = n0; R[1][J] = n1;
      }
    }
#undef CP_ZERO
#undef CP_IMG
    {
      u16* TB = (u16*)(p.ws + WS_TB) + tm;
#pragma unroll
      for (int I = 0; I < 2; ++I)
#pragma unroll
        for (int J = 0; J < 2; ++J)
#pragma unroll
          for (int g4 = 0; g4 < 4; ++g4) {
            const int b0 = 32 * I + 8 * g4 + 4 * h;
            const float4 bv = *(const float4*)(be + b0);
            u32x2 w = {pack2(R[I][J][4 * g4] * bv.x, R[I][J][4 * g4 + 1] * bv.y), pack2(R[I][J][4 * g4 + 2] * bv.z, R[I][J][4 * g4 + 3] * bv.w)};
            *(u32x2*)(TB + (32 * J + r32) * 64 + b0) = w;
          }
    }
  }
}

constexpr int CP_CNT_WORD = 4000;
DI void phase_chunkprep(const Params& p, char* lds) {
  for (int it = blockIdx.x; it < 256; it += gridDim.x) chunkprep_item(p, cp_main_chunk(it), lds);
  __syncthreads();
}
DI void chunkprep_deferred(const Params& p, char* lds) {
  const int it = (int)blockIdx.x - 64;
  if (it < 0 || it >= 64) return;
  chunkprep_item(p, cp_deferred_chunk(it), lds);
  asm volatile("s_waitcnt vmcnt(0)" ::: "memory");
  __syncthreads();
  if (threadIdx.x == 0) {
    __builtin_amdgcn_fence(__ATOMIC_RELEASE, "agent");
    asm volatile("s_waitcnt vmcnt(0)" ::: "memory");
    __hip_atomic_fetch_add((unsigned*)(p.ws + WS_BAR) + CP_CNT_WORD, 1u, __ATOMIC_RELAXED, __HIP_MEMORY_SCOPE_AGENT);
  }
  __syncthreads();
}
DI void chunkprep_wait_deferred(const Params& p, int lane) {
  unsigned* cnt = (unsigned*)(p.ws + WS_BAR) + CP_CNT_WORD;
  if (lane == 0) {
    unsigned spins = 0;
    while (__hip_atomic_load(cnt, __ATOMIC_RELAXED, __HIP_MEMORY_SCOPE_AGENT) < 64u) { __builtin_amdgcn_s_sleep(2); if (++spins > (1u << 22)) break; }
  }
  __builtin_amdgcn_fence(__ATOMIC_ACQUIRE, "agent");
  asm volatile("s_waitcnt vmcnt(0)" ::: "memory");
}
DI void phase_scan(const Params& p, char* lds) {
  const int tid0 = TIDX(), wid = tid0 >> 6;
  u16* sq = (u16*)lds; u16* sk = sq + 64 * 136; u16* skT = sk + 64 * 136; u16* sv = skT + 128 * 72; u16* sTb = sv + 64 * 136; u16* sA = sTb + 64 * 72;
  float* vec0 = (float*)(sA + 64 * 72);
  const u16* QK = (const u16*)(p.ws + WS_H); const u16* VC = (const u16*)(p.ws + WS_VC); const float* GB = (const float*)(p.ws + WS_GB);
  chunkprep_deferred(p, lds);
  for (int it = blockIdx.x; it < 192; it += gridDim.x) {
    int s, head, dir;
    if (it < 64) { s = 16 + (it >> 3); head = (it >> 1) & 3; dir = it & 1; } else { const int j = it - 64; s = j >> 3; head = (j >> 1) & 3; dir = j & 1; }
    const int tokS = tok0_of(s), nch = len_of(s) >> 6;
    __syncthreads();
    if (wid >= 4) {
      const int t2 = TIDX() - 256, lane = t2 & 63, lw = t2 >> 6;
      u32x4 R0[20], R1[20]; float g0 = 0.f, g1 = 0.f;
#define SC_LOAD(R, G, STEP) do { const int ch_ = dir ? nch - 1 - (STEP) : (STEP); const int tok0_ = tokS + ch_ * 64; \
        const size_t tm_ = ((size_t)((tok0_ >> 6) * 4 + head) * 2 + dir) * 4096; \
        _Pragma("unroll") for (int j_ = 0; j_ < 4; ++j_) { const int c_ = t2 + 256 * j_, row_ = c_ >> 4, d8_ = (c_ & 15) * 8; \
          R[j_]      = *(const u32x4*)(QK + (size_t)(tok0_ + row_) * DM + head * 128 + d8_); \
          R[4 + j_]  = *(const u32x4*)(QK + (size_t)(tok0_ + row_) * DM + 512 + head * 128 + d8_); \
          R[8 + j_]  = *(const u32x4*)(QK + (size_t)(tok0_ + lane) * DM + 512 + head * 128 + (lw * 4 + j_) * 8); \
          R[12 + j_] = *(const u32x4*)(VC + (size_t)(tok0_ + row_) * 512 + head * 128 + d8_); } \
        _Pragma("unroll") for (int j_ = 0; j_ < 2; ++j_) { const int c_ = t2 + 256 * j_; \
          R[16 + j_] = *(const u32x4*)((const u16*)(p.ws + WS_TB) + tm_ + (c_ >> 3) * 64 + (c_ & 7) * 8); \
          R[18 + j_] = *(const u32x4*)((const u16*)(p.ws + WS_AM) + tm_ + (c_ >> 3) * 64 + (c_ & 7) * 8); } \
        if (lw == 3) G = GB[(size_t)(tok0_ + lane) * 16 + dir * 4 + head]; } while (0)
#define SC_W2(BASE, STRIDE, ROW, C0, W) do { const int a_ = ((C0) >> 3) & 1, g_ = (C0) & ~15; \
        u32x2 lo_ = {(W)[0], (W)[1]}, hi_ = {(W)[2], (W)[3]}; \
        *(u32x2*)((BASE) + (ROW) * (STRIDE) + g_ + 4 * a_) = lo_; *(u32x2*)((BASE) + (ROW) * (STRIDE) + g_ + 8 + 4 * a_) = hi_; } while (0)
#define SC_WRITE1(R) do { \
        _Pragma("unroll") for (int j_ = 0; j_ < 4; ++j_) { const int c_ = t2 + 256 * j_, row_ = c_ >> 4, d8_ = (c_ & 15) * 8; \
          SC_W2(sq, 136, row_, d8_, R[j_]); SC_W2(sk, 136, row_, d8_, R[4 + j_]); \
          *(u32x4*)(sv + row_ * 136 + d8_) = R[12 + j_]; } \
        _Pragma("unroll") for (int j_ = 0; j_ < 2; ++j_) { const int c_ = t2 + 256 * j_; \
          SC_W2(sTb, 72, c_ >> 3, (c_ & 7) * 8, R[16 + j_]); SC_W2(sA, 72, c_ >> 3, (c_ & 7) * 8, R[18 + j_]); } } while (0)
#define SC_WKT(R) do { \
        _Pragma("unroll") for (int j_ = 0; j_ < 4; ++j_) { \
          { const int dd_ = (lw * 4 + j_) * 8, pos_ = (lane & ~15) + swz16(lane & 15); \
            _Pragma("unroll") for (int e_ = 0; e_ < 4; ++e_) { skT[(dd_ + 2 * e_) * 72 + pos_] = (u16)(R[8 + j_][e_] & 0xffffu); skT[(dd_ + 2 * e_ + 1) * 72 + pos_] = (u16)(R[8 + j_][e_] >> 16); } } } } while (0)
#define SC_VEC(G, PAR) do { \
        if (lw == 3) { float* vw_ = vec0 + (PAR) * 132; float pre_ = G; \
          _Pragma("unroll") for (int o_ = 1; o_ < 64; o_ <<= 1) { const float t_ = __shfl_up(pre_, o_); if (lane >= o_) pre_ += t_; } \
          const float tot_ = __shfl(pre_, 63); const float gc_ = dir ? (tot_ - pre_ + G) : pre_; \
          vw_[lane] = __expf(gc_); vw_[64 + lane] = __expf(tot_ - gc_); if (lane == 0) vw_[128] = __expf(tot_); } } while (0)
      SC_LOAD(R0, g0, 0);
      if (nch > 1) SC_LOAD(R1, g1, 1);
      SC_WRITE1(R0); SC_VEC(g0, 0);
#pragma unroll 1
      for (int step = 0; step < nch; step += 2) {
        __syncthreads();
        SC_WKT(R0);
        if (s >= 16 && step + 2 == 12) chunkprep_wait_deferred(p, lane);
        float g0n = g0;
        if (step + 2 < nch) SC_LOAD(R0, g0n, step + 2);
        __syncthreads();
        SC_WRITE1(R1); SC_VEC(g1, 1);
        __syncthreads();
        SC_WKT(R1);
        if (step + 3 < nch) SC_LOAD(R1, g1, step + 3);
        __syncthreads();
        g0 = g0n;
        if (step + 2 < nch) { SC_WRITE1(R0); SC_VEC(g0, 0); }
      }
#undef SC_LOAD
#undef SC_W2
#undef SC_WRITE1
#undef SC_WKT
#undef SC_VEC
    } else {
      const int lane = TIDX() & 63, r32 = lane & 31, h = lane >> 5;
      u16* O = (u16*)(p.ws + (dir ? WS_OB : WS_OF));
      const int e0 = 32 * wid;
      f32x16 S[4];
      if (s >= 16) {
        const float* st = p.c_state + ((size_t)(((s - 16) * 2 + dir) * 4 + head)) * 16384;
#pragma unroll
        for (int db = 0; db < 4; ++db)
#pragma unroll
          for (int r = 0; r < 16; ++r) S[db][r] = st[(32 * db + crow(r, h)) * 128 + e0 + r32];
      } else {
#pragma unroll
        for (int db = 0; db < 4; ++db)
#pragma unroll
          for (int r = 0; r < 16; ++r) S[db][r] = 0.f;
      }
#define SC_AF(BASE, STRIDE, ROW, KB) (*(const bf16x8*)((BASE) + (ROW) * (STRIDE) + (KB) + 8 * h))
#pragma unroll 1
      for (int step = 0; step < nch; ++step) {
        const int ch = dir ? nch - 1 - step : step;
        const int tok0 = tokS + ch * 64;
        const float* vec = vec0 + (step & 1) * 132;
        __syncthreads();
        f32x16 VN[2], Oa[2];
        {
          f32x16 KS[2];
#pragma unroll
          for (int ib = 0; ib < 2; ++ib)
#pragma unroll
            for (int r = 0; r < 16; ++r) { KS[ib][r] = 0.f; VN[ib][r] = 0.f; Oa[ib][r] = 0.f; }
#pragma unroll
          for (int db = 0; db < 4; ++db)
#pragma unroll
            for (int s2 = 0; s2 < 2; ++s2) {
              const bf16x8 sb = pack8(S[db], s2);
#pragma unroll
              for (int ib = 0; ib < 2; ++ib) KS[ib] = MFMA(SC_AF(sk, 136, 32 * ib + r32, 32 * db + 16 * s2), sb, KS[ib]);
#pragma unroll
              for (int ib = 0; ib < 2; ++ib) Oa[ib] = MFMA(SC_AF(sq, 136, 32 * ib + r32, 32 * db + 16 * s2), sb, Oa[ib]);
            }
#pragma unroll
          for (int ib = 0; ib < 2; ++ib)
#pragma unroll
            for (int r = 0; r < 16; ++r) {
              const int i = 32 * ib + crow(r, h);
              KS[ib][r] = bf2f(sv[i * 136 + e0 + r32]) - vec[i] * KS[ib][r];
            }
#pragma unroll
          for (int ib = 0; ib < 2; ++ib)
#pragma unroll
            for (int s2 = 0; s2 < 2; ++s2) {
              const bf16x8 xb = pack8(KS[ib], s2);
#pragma unroll
              for (int i2 = 0; i2 < 2; ++i2) VN[i2] = MFMA(SC_AF(sTb, 72, 32 * i2 + r32, 32 * ib + 16 * s2), xb, VN[i2]);
            }
        }
        {
#pragma unroll
          for (int ib = 0; ib < 2; ++ib)
#pragma unroll
            for (int r = 0; r < 16; ++r) Oa[ib][r] *= vec[32 * ib + crow(r, h)];
#pragma unroll
          for (int ib = 0; ib < 2; ++ib)
#pragma unroll
            for (int s2 = 0; s2 < 2; ++s2) {
              const bf16x8 vb = pack8(VN[ib], s2);
#pragma unroll
              for (int i2 = 0; i2 < 2; ++i2) Oa[i2] = MFMA(SC_AF(sA, 72, 32 * i2 + r32, 32 * ib + 16 * s2), vb, Oa[i2]);
            }
          __syncthreads();
#pragma unroll
          for (int ib = 0; ib < 2; ++ib) {
            u16* op_ = O + (size_t)(tok0 + 32 * ib + 4 * h) * 512 + head * 128 + e0 + r32;
#pragma unroll
            for (int r = 0; r < 16; r += 2) { const unsigned w_ = pack2(Oa[ib][r], Oa[ib][r + 1]);
              op_[(size_t)((r & 3) + 8 * (r >> 2)) * 512] = (u16)(w_ & 0xffffu); op_[(size_t)((r & 3) + 8 * (r >> 2) + 1) * 512] = (u16)(w_ >> 16); }
          }
        }
        const float eg = vec[128];
#pragma unroll
        for (int db = 0; db < 4; ++db)
#pragma unroll
          for (int r = 0; r < 16; ++r) S[db][r] *= eg;
#pragma unroll
        for (int ib = 0; ib < 2; ++ib) {
#pragma unroll
          for (int r = 0; r < 16; ++r) VN[ib][r] *= vec[64 + 32 * ib + crow(r, h)];
#pragma unroll
          for (int s2 = 0; s2 < 2; ++s2) {
            const bf16x8 vb = pack8(VN[ib], s2);
#pragma unroll
            for (int db = 0; db < 4; ++db) S[db] = MFMA(SC_AF(skT, 72, 32 * db + r32, 32 * ib + 16 * s2), vb, S[db]);
          }
        }
      }
#undef SC_AF
      if (s < 16) {
        float* st = p.out + O_STATE + ((size_t)((s * 2 + dir) * 4 + head)) * 16384;
#pragma unroll
        for (int db = 0; db < 4; ++db)
#pragma unroll
          for (int r = 0; r < 16; ++r) st[(32 * db + crow(r, h)) * 128 + e0 + r32] = S[db][r];
      }
    }
  }
  __syncthreads();
  if (gridDim.x == 256 && blockIdx.x >= 64) l1prep_t<false, true>(p, lds, (int)blockIdx.x - 64, 192);
}

#ifndef DBG_CHECK
#define DBG_CHECK 0
#endif
#ifndef DBG_AMP
#define DBG_AMP 10.f
#endif
constexpr size_t WS_DBG = WS_END + 16384;
DI void fingerprint(const Params& p, const void* buf, size_t n, bool isf32, int slot, char* lds) {
  float acc[9];
#pragma unroll
  for (int k = 0; k < 9; ++k) acc[k] = 0.f;
  for (size_t i = (size_t)blockIdx.x * NTHREADS + threadIdx.x; i < n; i += (size_t)gridDim.x * NTHREADS) {
    const float x = isf32 ? ((const float*)buf)[i] : bf2f(((const u16*)buf)[i]);
    unsigned hsh = (unsigned)i * 0x9E3779B1u; hsh ^= hsh >> 15; hsh *= 0x85EBCA77u; hsh ^= hsh >> 13;
#pragma unroll
    for (int k = 0; k < 8; ++k) acc[k] += ((hsh >> k) & 1u) ? x : -x;
    acc[8] += x * x;
  }
  float* red = (float*)lds;
  __syncthreads();
#pragma unroll
  for (int k = 0; k < 9; ++k) { const float v = wave_sum(acc[k]); if ((threadIdx.x & 63) == 0) red[(threadIdx.x >> 6) * 9 + k] = v; }
  __syncthreads();
  if (threadIdx.x < 9) {
    float v = 0.f;
    for (int w = 0; w < 8; ++w) v += red[w * 9 + threadIdx.x];
    ((float*)(p.ws + WS_DBG))[((size_t)slot * 256 + blockIdx.x) * 16 + threadIdx.x] = v;
  }
  __syncthreads();
}
DI float dbg_rel(const Params& p) {
  const float* d = (const float*)(p.ws + WS_DBG);
  float fn[9], ff[9];
#pragma unroll
  for (int k = 0; k < 9; ++k) { fn[k] = 0.f; ff[k] = 0.f; }
  for (int b = 0; b < (int)gridDim.x; ++b)
#pragma unroll
    for (int k = 0; k < 9; ++k) { fn[k] += d[((size_t)b) * 16 + k]; ff[k] += d[((size_t)256 + b) * 16 + k]; }
  float s = 0.f;
#pragma unroll
  for (int k = 0; k < 8; ++k) s += (ff[k] - fn[k]) * (ff[k] - fn[k]);
  return sqrtf(s * 0.125f / fn[8]);
}


#define XB_TMO      128
#define XB_XCNT(j)  (256  + 64 * (j))
#define XB_XSUB(j)  (1280 + 64 * (j))
#define XB_XGEN(j)  (2304 + 64 * (j))
#define XB_TOP      3328
#define XB_TOPGEN   3392
#define XCD_BAR_WORDS 3456
#define XB_SPIN_CAP (1u << 18)
#define LAS __attribute__((address_space(3)))
DI unsigned xb_ld(unsigned* p)              { return __hip_atomic_load(p, __ATOMIC_RELAXED, __HIP_MEMORY_SCOPE_AGENT); }
DI unsigned xb_add(unsigned* p, unsigned v) { return __hip_atomic_fetch_add(p, v, __ATOMIC_RELAXED, __HIP_MEMORY_SCOPE_AGENT); }
DI unsigned xb_xcc_id() { return (unsigned)__builtin_amdgcn_s_getreg((3 << 11) | 20) & 0xFu; }
#define XB_SPIN(cond, bar) do { unsigned _sp = 0; while (cond) { __builtin_amdgcn_s_sleep(1); \
    if ((++_sp & 255u) == 0u) { if (xb_ld(&(bar)[XB_TMO])) break; if (_sp > XB_SPIN_CAP) { atomicAdd(&(bar)[XB_TMO], 1u); break; } } } } while (0)
struct XcdBarrier { unsigned* bar; unsigned x; volatile LAS unsigned* st; };
DI XcdBarrier xcd_barrier_post(unsigned* bar, volatile LAS unsigned* st) {
  XcdBarrier b; b.bar = bar; b.x = xb_xcc_id(); b.st = st;
  if (threadIdx.x == 0) (void)xb_add(&bar[XB_XCNT(b.x)], 1u);
  return b;
}
DI void xcd_barrier_complete(unsigned* bar, unsigned x, unsigned& nloc, unsigned& nx) {
  const unsigned G = gridDim.x * gridDim.y * gridDim.z;
  unsigned sum, cnt, mine, sp = 0u;
  for (;;) {
    sum = 0u; cnt = 0u; mine = 0u;
#pragma unroll
    for (unsigned j = 0; j < 16; ++j) { const unsigned c = xb_ld(&bar[XB_XCNT(j)]); sum += c; cnt += (c > 0u) ? 1u : 0u; mine = (j == x) ? c : mine; }
    if (sum == G) break;
    __builtin_amdgcn_s_sleep(1);
    if ((++sp & 255u) == 0u) { if (xb_ld(&bar[XB_TMO])) break; if (sp > XB_SPIN_CAP) { atomicAdd(&bar[XB_TMO], 1u); break; } }
  }
  nloc = mine > 0u ? mine : 1u; nx = cnt > 0u ? cnt : 1u;
}
DI void xcd_barrier(const XcdBarrier& b) {
  asm volatile("s_waitcnt vmcnt(0)" ::: "memory");
  __syncthreads();
  if (threadIdx.x == 0) {
    unsigned* bar = b.bar;
    __builtin_amdgcn_s_waitcnt(0);
    unsigned nloc = b.st[0], nx = b.st[1];
    if (nloc == 0u) { xcd_barrier_complete(bar, b.x, nloc, nx); b.st[0] = nloc; b.st[1] = nx; }
    const unsigned old = xb_add(&bar[XB_XSUB(b.x)], 1u);
    const unsigned gen = old / nloc;
    if (old + 1u == (gen + 1u) * nloc) {
      __builtin_amdgcn_fence(__ATOMIC_RELEASE, "agent");
      asm volatile("s_waitcnt vmcnt(0)" ::: "memory");
      const unsigned og = xb_add(&bar[XB_TOP], 1u);
      const unsigned tg = og / nx;
      if (og + 1u == (tg + 1u) * nx) xb_add(&bar[XB_TOPGEN], 1u);
      else XB_SPIN(xb_ld(&bar[XB_TOPGEN]) == tg, bar);
      __builtin_amdgcn_fence(__ATOMIC_ACQUIRE, "agent");
      xb_add(&bar[XB_XGEN(b.x)], 1u);
      asm volatile("s_waitcnt vmcnt(0)" ::: "memory");
    } else {
      XB_SPIN(xb_ld(&bar[XB_XGEN(b.x)]) == gen, bar);
      __builtin_amdgcn_fence(__ATOMIC_ACQUIRE, "agent");
      asm volatile("s_waitcnt vmcnt(0)" ::: "memory");
    }
  }
  __syncthreads();
}

extern __shared__ __attribute__((aligned(16))) char smem[];
constexpr int LDS_BYTES = 147456;

#ifndef REPEAT
#define REPEAT 0
#endif
#ifndef FAST_MASK
#define FAST_MASK 255
#endif
DI void code_prefetch(unsigned long long code_end) {
  unsigned long long pc;
  asm volatile("s_getpc_b64 %0" : "=s"(pc));
  pc &= ~63ull;
  const unsigned rem = code_end > pc ? (unsigned)(code_end - pc) : 0u;
  const unsigned o0 = threadIdx.x * 64u, o1 = o0 + 32768u;
  const char* base = (const char*)pc;
  const int v0 = *(const volatile int*)(base + (o0 < rem ? o0 : rem));
  const int v1 = *(const volatile int*)(base + (o1 < rem ? o1 : rem));
  asm volatile("" :: "v"(v0), "v"(v1));
}
#define GSYNC() do { code_prefetch(code_end); xcd_barrier(xb); } while (0)
#define GSYNC_KB(kb) GSYNC()

#ifndef DBG_TIME
#define DBG_TIME -1
#endif
#if DBG_TIME >= 0
#define TSTAMP(i) do { if (blockIdx.x == 0 && threadIdx.x == 0) ((volatile unsigned long long*)(smem + LDS_BYTES - 512))[i] = __builtin_amdgcn_s_memrealtime(); } while (0)
#else
#define TSTAMP(i) do {} while (0)
#endif
__global__ void __launch_bounds__(NTHREADS) fwd_megakernel(Params p) {
  unsigned long long code_end; unsigned code_len;
  asm volatile("s_getpc_b64 %0\n.Lcp_base:\n\ts_mov_b32 %1, .Lcp_end-.Lcp_base" : "=s"(code_end), "=s"(code_len));
  code_end = (code_end + code_len) & ~63ull;
  cg::grid_group grid = cg::this_grid();
  char* lds = smem;
  __shared__ uint4 xb_words;
  if (threadIdx.x == 0) xb_words = make_uint4(0u, 0u, 0u, 0u);
  __syncthreads();
  XcdBarrier xb = xcd_barrier_post((unsigned*)(p.ws + WS_BAR), (volatile LAS unsigned*)&xb_words);
  TSTAMP(0);
  phase_prep(p, lds);            GSYNC(); TSTAMP(1);
  if (p.ws == nullptr) grid.sync();
  phase_adaln(p, 0);             GSYNC(); TSTAMP(2);
  phase8_layer0_gemms(p, lds, [&]() { GSYNC(); });   GSYNC(); TSTAMP(5);
  phase_attn0(p, lds, code_end); GSYNC(); TSTAMP(6);
  phase8_outproj(p, 0, lds);     GSYNC(); TSTAMP(7);
  phase_adaln(p, 1);             GSYNC(); TSTAMP(8);
  phase8_inproj1(p, lds);        GSYNC(); TSTAMP(9);
  phase_l1prep(p, lds);
  if (gridDim.x == 256) { asm volatile("s_waitcnt vmcnt(0)" ::: "memory"); __syncthreads(); }
  else GSYNC();
  TSTAMP(10);
  phase_chunkprep(p, lds);       GSYNC_KB(32); TSTAMP(11);
  phase_scan(p, lds);            GSYNC_KB(24); TSTAMP(12);
  phase_gdnfinal(p);
  code_prefetch(code_end);
  phase_attn1(p, lds);           GSYNC_KB(12); TSTAMP(13);
  phase8_outproj(p, 1, lds);     GSYNC_KB(3); TSTAMP(14);
  phase_final(p);
#if DBG_TIME >= 0
  GSYNC(); TSTAMP(15);
  if (blockIdx.x == 0) {
    __syncthreads();
    const size_t offs[7] = {O_CKV, O_KROPE, O_SWAK, O_SWAV, O_STATE, O_ATTK, O_ATTV};
    volatile unsigned long long* tb = (volatile unsigned long long*)(smem + LDS_BYTES - 512);
    for (int k = 0; k < 7; ++k) {
      const int i0 = DBG_TIME + k;
      if (i0 + 1 > 15) break;
      const unsigned long long dt = tb[i0 + 1] - tb[i0];
      const int n = (int)(dt / 100ull);
      for (int e = threadIdx.x; e < n; e += NTHREADS) ((unsigned*)p.out)[offs[k] + e] = 0xAAAAAAAAu;
    }
  }
#endif
  asm volatile(".Lcp_end:");
}

extern "C" void kernel_launch(void* const* d_in, const int* in_sizes, int n_in, void* d_out, int out_size, void* d_ws, size_t ws_size, hipStream_t stream) {
  static int grid_blocks = 0;
  if (!grid_blocks) {
    int dev = 0, cus = 0, per_cu = 0;
    (void)hipGetDevice(&dev);
    (void)hipDeviceGetAttribute(&cus, hipDeviceAttributeMultiprocessorCount, dev);
    (void)hipFuncSetAttribute((const void*)fwd_megakernel, hipFuncAttributeMaxDynamicSharedMemorySize, LDS_BYTES);
    (void)hipOccupancyMaxActiveBlocksPerMultiprocessor(&per_cu, fwd_megakernel, NTHREADS, LDS_BYTES);
    if (per_cu > 1) per_cu = 1;
    grid_blocks = (cus * per_cu) & ~7;
    if (grid_blocks <= 0) { fprintf(stderr, "occupancy query failed (cus %d per_cu %d)\n", cus, per_cu); grid_blocks = 0; return; }
  }
  if (n_in != 33 || ws_size < WS_END + 65536) { fprintf(stderr, "kernel_launch: unexpected n_in %d / ws %zu\n", n_in, ws_size); return; }
  Params p{};
  const float** pp = (const float**)&p;
  for (int i = 0; i < 33; ++i) pp[i] = (const float*)d_in[i];
  p.out = (float*)d_out;
  p.ws = (char*)d_ws;
  (void)hipMemsetAsync((char*)d_ws + WS_BAR, 0, 16384, stream);
  void* args[] = {&p};
  hipError_t e = hipLaunchCooperativeKernel((void*)fwd_megakernel, dim3(grid_blocks), dim3(NTHREADS), args, LDS_BYTES, stream);
  if (e != hipSuccess) fprintf(stderr, "cooperative launch failed: %s (grid %d)\n", hipGetErrorString(e), grid_blocks);
}
```

```cpp
#include <hip/hip_runtime.h>
#include <hip/hip_cooperative_groups.h>
#include <cstdio>
#include <cstdint>
namespace cg = cooperative_groups;

#define DI __device__ __forceinline__
typedef unsigned short u16;
using bf16x8 = __attribute__((ext_vector_type(8))) short;
using bf16x4 = __attribute__((ext_vector_type(4))) short;
using f32x16 = __attribute__((ext_vector_type(16))) float;
using f32x4  = __attribute__((ext_vector_type(4))) float;
using u32x4  = __attribute__((ext_vector_type(4))) unsigned;
using u32x2  = __attribute__((ext_vector_type(2))) unsigned;

#ifndef PHASE_LIMIT
#define PHASE_LIMIT 99
#endif

constexpr int NTHREADS = 512;
constexpr int DM = 1024, NTOK = 20480, NCTX = 4096, NKROW = 24576;
constexpr int L0C = 2464, L0CP = 2560, L1C = 3600, L1CP = 3840;
constexpr int U1A_LD = 1536, U1B_LD = 2048;
constexpr int C0_CQ = 0, C0_CKV = 384, C0_KR = 640, C0_ZA = 672, C0_QB = 1184, C0_KB = 1696, C0_VB = 1824, C0_ZB = 1952;
constexpr int C1_ZC = 0, C1_QD = 512, C1_KD = 1024, C1_VD = 1280, C1_ZD = 1536;
constexpr float EPS = 1e-6f;
constexpr float LOG2E = 1.4426950408889634f;

constexpr size_t O_Y = 0;
constexpr size_t O_CKV = 20971520, O_KROPE = 22020096, O_SWAK = 22151168, O_SWAV = 22675456, O_STATE = 23199744, O_ATTK = 25296896, O_ATTV = 26345472;

constexpr size_t WS_WO1 = 0;
constexpr size_t WS_MOD = WS_WO1 + 2097152;
constexpr size_t WS_ROPE = WS_MOD + 221184;
constexpr size_t WS_W2 = WS_ROPE + 32768;
constexpr size_t WS_WT0 = WS_W2;
constexpr size_t WS_WUQ = WS_WT0 + 5242880;
constexpr size_t WS_WUKV = WS_WUQ + 589824;
constexpr size_t WS_WO0 = WS_WUKV + 524288;
constexpr size_t WS_WT1 = WS_WO0 + 2097152;
constexpr size_t WS_W2_END = WS_WT1 + 7864320;
constexpr size_t WS_VTATT = WS_W2;
constexpr size_t WS_KC = WS_VTATT + 12582912;
constexpr size_t WS_GB = WS_KC + 2097152;
static_assert(WS_GB + 1310720 <= WS_W2_END, "layer-1 reuse overflow");
constexpr size_t WS_H = WS_W2_END;
constexpr size_t WS_U = WS_H + 41943040;
constexpr size_t WS_U0X = WS_U + (size_t)NTOK * L0C * 2;
constexpr size_t WS_KSWA = WS_U0X;
constexpr size_t WS_VTSWA = WS_KSWA + 6291456;
constexpr size_t WS_CKVN = WS_VTSWA + 6291456;
constexpr size_t WS_KROPE = WS_CKVN + 12582912;
static_assert(WS_KROPE + 1572864 <= WS_U + 147456000, "layer-0 extras overflow");
constexpr size_t WS_GY0 = WS_U;
constexpr size_t WS_U1A = WS_U;
constexpr size_t WS_U1B = WS_U + 62914560;
constexpr size_t WS_GY1 = WS_U1A;
constexpr size_t WS_TB = WS_U1A;
constexpr size_t WS_AM = WS_TB + 20971520;
constexpr size_t WS_OB = WS_AM + 20971520;
constexpr size_t WS_X = WS_U + 147456000;
constexpr size_t WS_VC = WS_X;
constexpr size_t WS_OF = WS_VC + 20971520;
constexpr size_t WS_AB = WS_OF + 20971520;
constexpr size_t WS_END = WS_AB + 1310720;
static_assert(WS_END <= 268435456ull, "ws overflow");
constexpr size_t WS_BAR = WS_END;
constexpr size_t YS_QMLA = 0;
constexpr size_t YS_KN = YS_QMLA + 31457280;
constexpr size_t YS_VTMLA = YS_KN + 25165824;
static_assert(YS_VTMLA + 25165824 <= (size_t)NTOK * DM * 4, "y scratch overflow");

struct Params {
  const float *x_prompt, *x_sample, *c_ckv, *c_krope, *c_swak, *c_swav, *c_state, *c_attk, *c_attv, *c, *c_ctx;
  const float *w_mod0, *b_mod0, *ln0, *w_in0, *mla_q_norm, *w_uq, *mla_kv_norm, *w_ukv, *swa_sink, *w_out0;
  const float *w_mod1, *b_mod1, *ln1, *w_in1, *gdn_conv, *gdn_a_log, *gdn_dt_bias, *gdn_norm, *att_q_norm, *att_k_norm, *w_out1, *ln_f;
  float* out;
  char* ws;
};

DI int opaque_zero() { int z = 0; asm volatile("" : "+v"(z)); return z; }
DI int opaque_tid() { int t = (int)threadIdx.x; asm volatile("" : "+v"(t)); return t; }
#define TIDX() opaque_tid()
DI void code_prefetch(unsigned long long code_end);
DI float bf2f(u16 b) { return __uint_as_float(((unsigned)b) << 16); }
typedef float ntf4 __attribute__((ext_vector_type(4)));
DI u32x4 ntload4u(const u16* q) { return __builtin_nontemporal_load((const u32x4*)q); }
DI u32x2 ntload2u(const u16* q) { return __builtin_nontemporal_load((const u32x2*)q); }
DI float4 ntload4(const float* q) { const ntf4 v = __builtin_nontemporal_load((const ntf4*)q); return make_float4(v[0], v[1], v[2], v[3]); }
DI u16 f2bf(float x) { unsigned u = __float_as_uint(x); u += 0x7fffu + ((u >> 16) & 1u); return (u16)(u >> 16); }
typedef __bf16 hwbf16x2_t __attribute__((ext_vector_type(2)));
typedef float hwf32x2_t __attribute__((ext_vector_type(2)));
DI unsigned pack2(float lo, float hi) { const hwf32x2_t v = {lo, hi}; return __builtin_bit_cast(unsigned, __builtin_convertvector(v, hwbf16x2_t)); }
DI int crow(int reg, int h) { return (reg & 3) + 8 * (reg >> 2) + 4 * h; }
DI int swz16(int k) { return (k & ~12) | ((k & 4) << 1) | ((k & 8) >> 1); }
DI float siluf(float x) { return x * __builtin_amdgcn_rcpf(1.f + __expf(-x)); }
DI int seq_of_tok(int m) { return m < NCTX ? (m >> 8) : 16 + ((m - NCTX) >> 11); }
DI int tok0_of(int s) { return s < 16 ? s * 256 : NCTX + (s - 16) * 2048; }
DI int krow0_of(int s) { return s < 16 ? s * 256 : NCTX + (s - 16) * 2560; }
DI int cap_of(int s) { return s < 16 ? 256 : 2560; }
DI int len_of(int s) { return s < 16 ? 256 : 2048; }
DI int modidx_of_tok(int m) { return m < NCTX ? 0 : 1 + ((m - NCTX) >> 11); }
DI int krow_of_tok(int m) { return m < NCTX ? m : NCTX + ((m - NCTX) >> 11) * 2560 + ((m - NCTX) & 2047); }
DI int pos_of_tok(int m) { return m < NCTX ? (m & 255) : ((m - NCTX) & 2047); }
DI const float* xrow(const Params& p, int m) { return m < NCTX ? p.x_prompt + (size_t)m * DM : p.x_sample + (size_t)(m - NCTX) * DM; }
DI float wave_sum(float v) {
#pragma unroll
  for (int o = 32; o > 0; o >>= 1) v += __shfl_xor(v, o);
  return v;
}
DI bf16x8 pack8(const f32x16& x, int s) {
  u32x4 w = {pack2(x[8 * s + 0], x[8 * s + 1]), pack2(x[8 * s + 2], x[8 * s + 3]), pack2(x[8 * s + 4], x[8 * s + 5]), pack2(x[8 * s + 6], x[8 * s + 7])};
  return __builtin_bit_cast(bf16x8, w);
}
DI bf16x8 cat4(bf16x4 lo, bf16x4 hi) { return __builtin_shufflevector(lo, hi, 0, 1, 2, 3, 4, 5, 6, 7); }
#define MFMA(a, b, c) __builtin_amdgcn_mfma_f32_32x32x16_bf16((a), (b), (c), 0, 0, 0)

DI void transpose_tile(const float* __restrict__ W, int ldw, int k0, int srccol0, int nvalid, u16* __restrict__ Wt, int ldt, int dstrow0, char* lds) {
  u16* t = (u16*)lds;
  const int tid = TIDX(), kr = tid >> 3, cc = (tid & 7) * 8;
  float v[8];
  if (cc < nvalid) {
    const float4 a = *(const float4*)(W + (size_t)(k0 + kr) * ldw + srccol0 + cc);
    const float4 b = *(const float4*)(W + (size_t)(k0 + kr) * ldw + srccol0 + cc + 4);
    v[0] = a.x; v[1] = a.y; v[2] = a.z; v[3] = a.w; v[4] = b.x; v[5] = b.y; v[6] = b.z; v[7] = b.w;
  } else {
#pragma unroll
    for (int e = 0; e < 8; ++e) v[e] = 0.f;
  }
#pragma unroll
  for (int e = 0; e < 8; ++e) t[(cc + e) * 72 + kr] = f2bf(v[e]);
  __syncthreads();
  const int n = tid >> 3, kc = (tid & 7) * 8;
  *(bf16x8*)(Wt + (size_t)(dstrow0 + n) * ldt + k0 + kc) = *(const bf16x8*)(t + n * 72 + kc);
  __syncthreads();
}

template <int MAT>
DI void transpose_tiles4(const Params& p, int t0, char* lds) {
  constexpr int NTN = MAT == 0 ? 40 : MAT == 1 ? 12 : MAT == 2 ? 16 : MAT == 4 ? 60 : 16;
  constexpr int NKT = MAT == 1 ? 6 : MAT == 2 ? 4 : 16;
  constexpr int LDW = MAT == 0 ? L0C : MAT == 1 ? 768 : MAT == 4 ? L1C : 1024;
  constexpr int LDT = MAT == 1 ? 384 : MAT == 2 ? 256 : 1024;
  const float* W = MAT == 0 ? p.w_in0 : MAT == 1 ? p.w_uq : MAT == 2 ? p.w_ukv : MAT == 3 ? p.w_out0 : MAT == 4 ? p.w_in1 : p.w_out1;
  u16* Wt = (u16*)(p.ws + (MAT == 0 ? WS_WT0 : MAT == 1 ? WS_WUQ : MAT == 2 ? WS_WUKV : MAT == 3 ? WS_WO0 : MAT == 4 ? WS_WT1 : WS_WO1));
  const int tid = TIDX(), kr = tid >> 3, cc = (tid & 7) * 8;
  float v[4][8];
#pragma unroll
  for (int q = 0; q < 4; ++q) {
    const int t = t0 + q;
#pragma unroll
    for (int e = 0; e < 8; ++e) v[q][e] = 0.f;
    if (t < NTN * NKT) {
      const int kt = t / NTN, nt = t % NTN, n0 = nt * 64;
      int src = n0, nv = 64;
      if (MAT == 0) { nv = L0C - n0; nv = nv < 0 ? 0 : (nv > 64 ? 64 : nv); }
      if (MAT == 2) src = nt < 8 ? nt * 128 : (nt - 8) * 128 + 64;
      if (MAT == 4) { if (n0 < 1536) { src = n0; } else if (n0 < 3584) { src = n0 + 16; } else if (n0 == 3584) { src = 1536; nv = 16; } else { src = 0; nv = 0; } }
      if (cc < nv) {
        const float4 a = ntload4(W + (size_t)(kt * 64 + kr) * LDW + src + cc);
        const float4 b = ntload4(W + (size_t)(kt * 64 + kr) * LDW + src + cc + 4);
        v[q][0] = a.x; v[q][1] = a.y; v[q][2] = a.z; v[q][3] = a.w; v[q][4] = b.x; v[q][5] = b.y; v[q][6] = b.z; v[q][7] = b.w;
      }
    }
  }
#pragma unroll
  for (int q = 0; q < 4; ++q) {
    u16* tl = (u16*)lds + q * 64 * 72;
#pragma unroll
    for (int e = 0; e < 8; ++e) tl[(cc + e) * 72 + (kr ^ cc)] = f2bf(v[q][e]);
  }
  __syncthreads();
  const int n = tid >> 3, kc = (tid & 7) * 8;
#pragma unroll
  for (int q = 0; q < 4; ++q) {
    const int t = t0 + q;
    if (t < NTN * NKT) {
      const int kt = t / NTN, nt = t % NTN;
      *(bf16x8*)(Wt + (size_t)(nt * 64 + n) * LDT + kt * 64 + kc) = *(const bf16x8*)((const u16*)lds + q * 64 * 72 + n * 72 + (kc ^ (n & 56)));
    }
  }
  __syncthreads();
}

DI void vt_store16(const u16* sv, int CS, int C, u16* __restrict__ vt, size_t cap, int key16base) {
  for (int i = TIDX(); i < C * 4; i += NTHREADS) {
    const int ch = i >> 2, q = i & 3;
    u16 e[4];
#pragma unroll
    for (int j = 0; j < 4; ++j) e[j] = sv[swz16(q * 4 + j) * CS + ch];
    u32x2 w = {(unsigned)e[0] | ((unsigned)e[1] << 16), (unsigned)e[2] | ((unsigned)e[3] << 16)};
    *(u32x2*)(vt + (size_t)ch * cap + key16base + q * 4) = w;
  }
}

DI void phase_prep(const Params& p, char* lds) {
  const int tid = TIDX();
  constexpr int N_MOD = 192;
  constexpr int T_IN0 = 16 * 40, T_UQ = 6 * 12, T_UKV = 4 * 16, T_O0 = 256, T_IN1 = 16 * 60, T_O1 = 256;
  constexpr int N_TR = T_IN0 + T_UQ + T_UKV + T_O0 + T_IN1 + T_O1;
  constexpr int N_CV = 256 + 32 + 128;
  constexpr int N_VT = 256;
  const int N_TRQ = gridDim.x == 256 ? 258 : 562;
  const int N_ITEMS = N_MOD + N_TRQ + N_CV + N_VT + 1;
  for (int it = blockIdx.x; it < N_ITEMS; it += gridDim.x) {
    if (it < N_MOD) {
      const int layer = it / 96, col0 = (it % 96) * 32;
      const float* Wm = layer ? p.w_mod1 : p.w_mod0;
      const float* bm = layer ? p.b_mod1 : p.b_mod0;
      float* sc = (float*)lds;
      float* red = sc + 9 * 1024;
      for (int i = tid; i < 9 * 1024; i += NTHREADS) {
        const int s = i >> 10, k = i & 1023;
        const float cv = s == 0 ? p.c_ctx[k] : p.c[(s - 1) * 1024 + k];
        sc[i] = siluf(cv);
      }
      __syncthreads();
      const int col = tid & 31, kg = tid >> 5;
      float acc[9];
#pragma unroll
      for (int s = 0; s < 9; ++s) acc[s] = 0.f;
      for (int kk = 0; kk < 64; ++kk) {
        const int k = kg * 64 + kk;
        const float w = __builtin_nontemporal_load(Wm + (size_t)k * 3072 + col0 + col);
#pragma unroll
        for (int s = 0; s < 9; ++s) acc[s] += sc[s * 1024 + k] * w;
      }
#pragma unroll
      for (int s = 0; s < 9; ++s) red[(kg * 9 + s) * 32 + col] = acc[s];
      __syncthreads();
      if (tid < 288) {
        const int s = tid >> 5, c2 = tid & 31;
        float a = bm[col0 + c2];
        for (int g = 0; g < 16; ++g) a += red[(g * 9 + s) * 32 + c2];
        ((float*)(p.ws + WS_MOD))[(size_t)(layer * 9 + s) * 3072 + col0 + c2] = a;
      }
      __syncthreads();
    } else if (it < N_MOD + N_TRQ) {
      int bq = it - N_MOD;
      if (bq < 160) transpose_tiles4<0>(p, bq * 4, lds);
      else if (bq < 178) transpose_tiles4<1>(p, (bq - 160) * 4, lds);
      else if (bq < 194) transpose_tiles4<2>(p, (bq - 178) * 4, lds);
      else if (bq < 258) transpose_tiles4<3>(p, (bq - 194) * 4, lds);
      else if (bq < 498) transpose_tiles4<4>(p, (bq - 258) * 4, lds);
      else transpose_tiles4<5>(p, (bq - 498) * 4, lds);
    } else if (it < N_MOD + N_TRQ + N_CV) {
      int t = it - N_MOD - N_TRQ;
      const int e0 = tid * 8;
      if (t < 256) {
        const size_t i = (size_t)t * 4096 + e0; const int b = (int)(i >> 17), rem = (int)(i & 131071), pp = rem >> 8, cc = rem & 255;
        const float4 a = ntload4(p.c_ckv + i), b4 = ntload4(p.c_ckv + i + 4);
        u32x4 w = {pack2(a.x, a.y), pack2(a.z, a.w), pack2(b4.x, b4.y), pack2(b4.z, b4.w)};
        *(u32x4*)((u16*)(p.ws + WS_CKVN) + (size_t)(NCTX + b * 2560 + 2048 + pp) * 256 + cc) = w;
      } else if (t < 288) {
        const size_t i = (size_t)(t - 256) * 4096 + e0; const int b = (int)(i >> 14), rem = (int)(i & 16383), pp = rem >> 5, cc = rem & 31;
        const float4 a = *(const float4*)(p.c_krope + i), b4 = *(const float4*)(p.c_krope + i + 4);
        u32x4 w = {pack2(a.x, a.y), pack2(a.z, a.w), pack2(b4.x, b4.y), pack2(b4.z, b4.w)};
        *(u32x4*)((u16*)(p.ws + WS_KROPE) + (size_t)(NCTX + b * 2560 + 2048 + pp) * 32 + cc) = w;
      } else {
        const size_t i = (size_t)(t - 288) * 4096 + e0; const int b = (int)(i >> 16), rem = (int)(i & 65535), pp = rem >> 7, cc = rem & 127;
        const float4 a = ntload4(p.c_swak + i), b4 = ntload4(p.c_swak + i + 4);
        u32x4 w = {pack2(a.x, a.y), pack2(a.z, a.w), pack2(b4.x, b4.y), pack2(b4.z, b4.w)};
        *(u32x4*)((u16*)(p.ws + WS_KSWA) + (size_t)(NCTX + b * 2560 + 2048 + pp) * 128 + cc) = w;
      }
    } else if (it < N_MOD + N_TRQ + N_CV + N_VT) {
      const int t = it - N_MOD - N_TRQ - N_CV; const int b = t >> 5, g = t & 31;
      u16* sv = (u16*)lds;
      {
        const int key = tid >> 5, c4 = (tid & 31) * 4;
        const float4 a = *(const float4*)(p.c_swav + ((size_t)(b * 512 + g * 16 + key)) * 128 + c4);
        u32x2 w = {pack2(a.x, a.y), pack2(a.z, a.w)};
        *(u32x2*)(sv + key * 136 + c4) = w;
      }
      __syncthreads();
      vt_store16(sv, 136, 128, (u16*)(p.ws + WS_VTSWA) + (size_t)krow0_of(16 + b) * 128, 2560, 2048 + g * 16);
      __syncthreads();
    } else {
      float2* tab = (float2*)(p.ws + WS_ROPE);
      for (int i = tid; i < 64 * 8 + 64 * 16 + 64 * 32; i += NTHREADS) {
        int q, pos, f, j = i;
        if (j < 512) { q = 8; } else if (j < 1536) { q = 16; j -= 512; } else { q = 32; j -= 1536; }
        pos = j / q; f = j % q;
        const float inv = __builtin_amdgcn_exp2f(-(float)f / (float)q * 13.287712379549449f);
        const float rev = (float)pos * inv * 0.15915494309189535f;
        tab[i] = make_float2(__builtin_amdgcn_cosf(rev), __builtin_amdgcn_sinf(rev));
      }
    }
  }
}

DI void phase_adaln(const Params& p, int layer) {
  const int tid_ = TIDX(), lane = tid_ & 63, wid = tid_ >> 6;
  const float* ln = layer ? p.ln1 : p.ln0;
  const float* mod = (const float*)(p.ws + WS_MOD) + (size_t)layer * 9 * 3072;
  u16* H = (u16*)(p.ws + WS_H);
  const u16* GY = (const u16*)(p.ws + WS_GY0);
  float4 g4[4];
#pragma unroll
  for (int j = 0; j < 4; ++j) g4[j] = *(const float4*)(ln + (j * 64 + lane) * 4);
  const int stride = gridDim.x * 8;
  int m = blockIdx.x * 8 + wid;
  float4 cur[4], nxt[4]; u32x2 cg[4], ng[4];
  if (m < NTOK) { const float* x = xrow(p, m);
#pragma unroll
    for (int j = 0; j < 4; ++j) { cur[j] = ntload4(x + (j * 64 + lane) * 4); if (layer) cg[j] = ntload2u(GY + (size_t)m * DM + (j * 64 + lane) * 4); } }
  for (; m < NTOK; m += stride) {
    const int mn = m + stride;
    if (mn < NTOK) { const float* xn = xrow(p, mn);
#pragma unroll
      for (int j = 0; j < 4; ++j) { nxt[j] = ntload4(xn + (j * 64 + lane) * 4); if (layer) ng[j] = ntload2u(GY + (size_t)mn * DM + (j * 64 + lane) * 4); } }
    const float* md = mod + (size_t)modidx_of_tok(m) * 3072;
    float4 sh[4], sc[4];
#pragma unroll
    for (int j = 0; j < 4; ++j) { sh[j] = *(const float4*)(md + (j * 64 + lane) * 4); sc[j] = *(const float4*)(md + 1024 + (j * 64 + lane) * 4); }
    if (layer) {
#pragma unroll
      for (int j = 0; j < 4; ++j) {
        cur[j].x += bf2f((u16)(cg[j][0] & 0xffffu)); cur[j].y += bf2f((u16)(cg[j][0] >> 16)); cur[j].z += bf2f((u16)(cg[j][1] & 0xffffu)); cur[j].w += bf2f((u16)(cg[j][1] >> 16));
        { typedef float nt4 __attribute__((ext_vector_type(4))); const nt4 xv = {cur[j].x, cur[j].y, cur[j].z, cur[j].w}; __builtin_nontemporal_store(xv, (nt4*)(p.out + (size_t)m * DM + (j * 64 + lane) * 4)); }
      }
    }
    float ss = 0.f;
#pragma unroll
    for (int j = 0; j < 4; ++j) ss += cur[j].x * cur[j].x + cur[j].y * cur[j].y + cur[j].z * cur[j].z + cur[j].w * cur[j].w;
    ss = wave_sum(ss);
    const float rs = rsqrtf(ss * (1.f / 1024.f) + EPS);
#pragma unroll
    for (int j = 0; j < 4; ++j) {
      const int c = (j * 64 + lane) * 4;
      const float a0 = cur[j].x * rs * g4[j].x * (1.f + sc[j].x) + sh[j].x, a1 = cur[j].y * rs * g4[j].y * (1.f + sc[j].y) + sh[j].y;
      const float a2 = cur[j].z * rs * g4[j].z * (1.f + sc[j].z) + sh[j].z, a3 = cur[j].w * rs * g4[j].w * (1.f + sc[j].w) + sh[j].w;
      u32x2 w = {pack2(a0, a1), pack2(a2, a3)};
      *(u32x2*)(H + (size_t)m * DM + c) = w;
    }
#pragma unroll
    for (int j = 0; j < 4; ++j) { cur[j] = nxt[j]; cg[j] = ng[j]; }
  }
}

struct GemmA { const u16* p0; int ld0; const u16* p1; int ld1; int ksplit; };
constexpr int G_LDS_A = 256 * 72 * 2;
template <class Epi>
DI void gemm_tile(const GemmA A, const u16* __restrict__ B, int ldb, int K, int m0, int n0, char* lds, Epi& epi) {
  u16* sA = (u16*)lds;
  const int tid = TIDX(), lane = tid & 63, wid = tid >> 6, r32 = lane & 31, h = lane >> 5;
  const int wm = wid >> 1, wn = wid & 1;
  const int lr = tid >> 3, lc = (tid & 7) * 8;
  f32x16 acc[2][2];
#pragma unroll
  for (int i = 0; i < 2; ++i)
#pragma unroll
    for (int j = 0; j < 2; ++j)
#pragma unroll
      for (int r = 0; r < 16; ++r) acc[i][j][r] = 0.f;
  bf16x8 ra0[4], rb0[2], ra1[4], rb1[2];
  const int nk = K >> 6;
  constexpr int GBUF = 256 * 72 + 128 * 72;
#define G_LOAD(RA, RB, KT) do { const int k0_ = (KT) * 64; const u16* ap_; int lda_, kk_; \
    if (k0_ < A.ksplit) { ap_ = A.p0; lda_ = A.ld0; kk_ = k0_; } else { ap_ = A.p1; lda_ = A.ld1; kk_ = k0_ - A.ksplit; } \
    _Pragma("unroll") for (int i_ = 0; i_ < 4; ++i_) RA[i_] = *(const bf16x8*)(ap_ + (size_t)(m0 + lr + 64 * i_) * lda_ + kk_ + lc); \
    _Pragma("unroll") for (int i_ = 0; i_ < 2; ++i_) RB[i_] = *(const bf16x8*)(B + (size_t)(n0 + lr + 64 * i_) * ldb + k0_ + lc); } while (0)
#define G_WRITE(RA, RB, BUF) do { u16* a_ = sA + (BUF) * GBUF; u16* b_ = a_ + 256 * 72; \
    _Pragma("unroll") for (int i_ = 0; i_ < 4; ++i_) *(bf16x8*)(a_ + (lr + 64 * i_) * 72 + lc) = RA[i_]; \
    _Pragma("unroll") for (int i_ = 0; i_ < 2; ++i_) *(bf16x8*)(b_ + (lr + 64 * i_) * 72 + lc) = RB[i_]; } while (0)
#define G_COMPUTE(BUF) do { const u16* a_ = sA + (BUF) * GBUF; const u16* b_ = a_ + 256 * 72; \
    _Pragma("unroll") for (int ks = 0; ks < 4; ++ks) { \
      bf16x8 a0 = *(const bf16x8*)(a_ + (wm * 64 + r32) * 72 + ks * 16 + h * 8); \
      bf16x8 a1 = *(const bf16x8*)(a_ + (wm * 64 + 32 + r32) * 72 + ks * 16 + h * 8); \
      bf16x8 b0 = *(const bf16x8*)(b_ + (wn * 64 + r32) * 72 + ks * 16 + h * 8); \
      bf16x8 b1 = *(const bf16x8*)(b_ + (wn * 64 + 32 + r32) * 72 + ks * 16 + h * 8); \
      acc[0][0] = MFMA(a0, b0, acc[0][0]); acc[0][1] = MFMA(a0, b1, acc[0][1]); \
      acc[1][0] = MFMA(a1, b0, acc[1][0]); acc[1][1] = MFMA(a1, b1, acc[1][1]); } } while (0)
  __syncthreads();
  G_LOAD(ra0, rb0, 0);
  if (nk > 1) G_LOAD(ra1, rb1, 1);
  G_WRITE(ra0, rb0, 0);
  __syncthreads();
  if (nk > 2) G_LOAD(ra0, rb0, 2);
#pragma unroll 1
  for (int kt = 0; kt < nk; kt += 2) {
    G_COMPUTE(0);
    if (kt + 1 < nk) {
      G_WRITE(ra1, rb1, 1);
      __syncthreads();
      if (kt + 3 < nk) G_LOAD(ra1, rb1, kt + 3);
      G_COMPUTE(1);
      if (kt + 2 < nk) {
        G_WRITE(ra0, rb0, 0);
        __syncthreads();
        if (kt + 4 < nk) G_LOAD(ra0, rb0, kt + 4);
      }
    }
  }
#undef G_LOAD
#undef G_WRITE
#undef G_COMPUTE
#pragma unroll
  for (int i = 0; i < 2; ++i)
#pragma unroll
    for (int j = 0; j < 2; ++j) epi(acc[i][j], m0 + wm * 64 + i * 32, n0 + wn * 64 + j * 32 + r32, h);
}

struct EpiU0 {
  u16* U;
  DI void operator()(const f32x16& a, int row0, int col, int h) const {
    if (col < L0C) {
#pragma unroll
      for (int r = 0; r < 16; ++r) U[(size_t)(row0 + crow(r, h)) * L0C + col] = f2bf(a[r]);
    }
  }
};
struct EpiQmla {
  u16* Q; const float2* tab;
  DI void operator()(const f32x16& a, int f0, int tok, int h) const {
    float v[16];
#pragma unroll
    for (int r = 0; r < 16; ++r) v[r] = a[r];
    if ((f0 % 96) == 64 && tok >= NCTX) {
      const int pos = pos_of_tok(tok), prow = pos >> 6, pcol = pos & 63;
#pragma unroll
      for (int j = 0; j < 4; ++j) {
        const int fi = 4 * h + j;
        const float2 cr = tab[prow * 8 + fi], cc = tab[pcol * 8 + fi];
        const float x1 = v[j], x2 = v[4 + j];
        v[j] = x1 * cr.x - x2 * cr.y; v[4 + j] = x2 * cr.x + x1 * cr.y;
        const float y1 = v[8 + j], y2 = v[12 + j];
        v[8 + j] = y1 * cc.x - y2 * cc.y; v[12 + j] = y2 * cc.x + y1 * cc.y;
      }
    }
#pragma unroll
    for (int g = 0; g < 4; ++g) {
      u32x2 w = {pack2(v[4 * g], v[4 * g + 1]), pack2(v[4 * g + 2], v[4 * g + 3])};
      *(u32x2*)(Q + (size_t)tok * 768 + f0 + 8 * g + 4 * h) = w;
    }
  }
};
struct EpiKvexp {
  u16* Kn; u16* Vt;
  DI void operator()(const f32x16& a, int kr0, int n, int h) const {
    const int head = n >> 7, within = n & 127;
    if (within < 64) {
#pragma unroll
      for (int r = 0; r < 16; ++r) Kn[((size_t)(kr0 + crow(r, h)) * 8 + head) * 64 + within] = f2bf(a[r]);
    } else {
      int seq, key0;
      if (kr0 < NCTX) { seq = kr0 >> 8; key0 = kr0 & 255; } else { const int r = kr0 - NCTX; seq = 16 + r / 2560; key0 = r % 2560; }
      const size_t cap = cap_of(seq);
      u16* base = Vt + (size_t)krow0_of(seq) * 512 + (size_t)(head * 64 + within - 64) * cap;
#pragma unroll
      for (int g = 0; g < 4; ++g) {
        const int pos = key0 + 16 * (g >> 1) + 8 * h + 4 * (g & 1);
        u32x2 w = {pack2(a[4 * g], a[4 * g + 1]), pack2(a[4 * g + 2], a[4 * g + 3])};
        *(u32x2*)(base + pos) = w;
      }
    }
  }
};
struct EpiOut {
  const Params* p; int layer;
  DI void operator()(const f32x16& a, int row0, int col, int h) const {
    const float* mod = (const float*)(p->ws + WS_MOD) + (size_t)(layer * 9 + modidx_of_tok(row0)) * 3072 + 2048;
    const float gate = mod[col];
#pragma unroll
    for (int r = 0; r < 16; ++r) {
      const int m = row0 + crow(r, h);
      const float xv = layer ? p->out[(size_t)m * DM + col] : xrow(*p, m)[col];
      p->out[(size_t)m * DM + col] = xv + gate * a[r];
    }
  }
};
struct EpiU1 {
  u16* UA; u16* UB; float* AB;
  DI void operator()(const f32x16& a, int row0, int col, int h) const {
    if (col < 1536) {
#pragma unroll
      for (int r = 0; r < 16; ++r) UA[(size_t)(row0 + crow(r, h)) * U1A_LD + col] = f2bf(a[r]);
    } else if (col < 3584) {
#pragma unroll
      for (int r = 0; r < 16; ++r) UB[(size_t)(row0 + crow(r, h)) * U1B_LD + col - 1536] = f2bf(a[r]);
    } else if (col < 3600) {
#pragma unroll
      for (int r = 0; r < 16; ++r) AB[(size_t)(row0 + crow(r, h)) * 16 + col - 3584] = a[r];
    }
  }
};


struct XcdIter {
  int xcd, lb, nlb, per, nmin, li;
  DI XcdIter(int nmaj, int nmin_) { xcd = blockIdx.x & 7; lb = blockIdx.x >> 3; nlb = gridDim.x >> 3; per = (nmaj >> 3) * nmin_; nmin = nmin_; li = lb; }
  DI bool valid() const { return li < per; }
  DI void next() { li += nlb; }
  DI int major() const { return xcd * (per / nmin) + li / nmin; }
  DI int minor() const { return li % nmin; }
};
DI void phase_inproj0(const Params& p, char* lds) {
  EpiU0 epi{(u16*)(p.ws + WS_U)};
  const u16* H = (const u16*)(p.ws + WS_H);
  const GemmA A{H, DM, H, DM, 1 << 30};
  for (XcdIter xi(80, 20); xi.valid(); xi.next())
    gemm_tile(A, (const u16*)(p.ws + WS_WT0), DM, DM, xi.major() * 256, xi.minor() * 128, lds, epi);
}
DI void phase_l0gemms(const Params& p, char* lds) {
  const u16* U0 = (const u16*)(p.ws + WS_U);
  EpiKvexp ek{(u16*)((char*)p.out + YS_KN), (u16*)((char*)p.out + YS_VTMLA)};
  EpiQmla eq{(u16*)((char*)p.out + YS_QMLA), (const float2*)(p.ws + WS_ROPE)};
  const u16* ck = (const u16*)(p.ws + WS_CKVN);
  const u16* wq = (const u16*)(p.ws + WS_WUQ);
  const GemmA Ak{ck, 256, ck, 256, 1 << 30};
  const GemmA Aq{wq, 384, wq, 384, 1 << 30};
  for (XcdIter xi(96, 8); xi.valid(); xi.next())
    gemm_tile(Ak, (const u16*)(p.ws + WS_WUKV), 256, 256, xi.major() * 256, xi.minor() * 128, lds, ek);
  for (XcdIter xi(160, 3); xi.valid(); xi.next())
    gemm_tile(Aq, U0 + C0_CQ, L0C, 384, xi.minor() * 256, xi.major() * 128, lds, eq);
}
DI void phase_outproj(const Params& p, int layer, char* lds) {
  EpiOut epi{&p, layer};
  const u16* H = (const u16*)(p.ws + WS_H);
  const GemmA A{H, DM, H, DM, 1 << 30};
  const u16* W = (const u16*)(p.ws + (layer ? WS_WO1 : WS_WO0));
  for (XcdIter xi(80, 8); xi.valid(); xi.next())
    gemm_tile(A, W, DM, DM, xi.major() * 256, xi.minor() * 128, lds, epi);
}
DI void phase_inproj1(const Params& p, char* lds) {
  EpiU1 epi{(u16*)(p.ws + WS_U1A), (u16*)(p.ws + WS_U1B), (float*)(p.ws + WS_AB)};
  const u16* H = (const u16*)(p.ws + WS_H);
  const GemmA A{H, DM, H, DM, 1 << 30};
  for (XcdIter xi(80, 29); xi.valid(); xi.next())
    gemm_tile(A, (const u16*)(p.ws + WS_WT1), DM, DM, xi.major() * 256, xi.minor() * 128, lds, epi);
}

DI void rope8(float (&x)[8], const float (&xp)[8], const float2* tab, int q, int pp, int fi0, bool is_x2) {
#pragma unroll
  for (int e = 0; e < 8; ++e) {
    const float2 cs = tab[pp * q + fi0 + e];
    x[e] = is_x2 ? (x[e] * cs.x + xp[e] * cs.y) : (x[e] * cs.x - xp[e] * cs.y);
  }
}
DI void unpack8(const u32x4 w, float (&x)[8]) {
#pragma unroll
  for (int i = 0; i < 4; ++i) { x[2 * i] = bf2f((u16)(w[i] & 0xffffu)); x[2 * i + 1] = bf2f((u16)(w[i] >> 16)); }
}
DI u32x4 pack8f(const float (&x)[8]) { u32x4 w = {pack2(x[0], x[1]), pack2(x[2], x[3]), pack2(x[4], x[5]), pack2(x[6], x[7])}; return w; }
DI void shfl8(const float (&x)[8], float (&xp)[8], int mask) {
#pragma unroll
  for (int e = 0; e < 8; ++e) xp[e] = __shfl_xor(x[e], mask);
}

DI void phase_l0prep(const Params& p, char* lds) {
  const int tid = TIDX(), lane = tid & 63, wid = tid >> 6;
  u16* U0 = (u16*)(p.ws + WS_U);
  u16* sv = (u16*)lds;
  const float2* tabM = (const float2*)(p.ws + WS_ROPE);
  const float2* tabS = tabM + 512;
  u16* CKVN = (u16*)(p.ws + WS_CKVN); u16* KROPE = (u16*)(p.ws + WS_KROPE); u16* KSWA = (u16*)(p.ws + WS_KSWA);
  float qn[6];
#pragma unroll
  for (int j = 0; j < 3; ++j) { const float2 t = *(const float2*)(p.mla_q_norm + 128 * j + 2 * lane); qn[2 * j] = t.x; qn[2 * j + 1] = t.y; }
  const float4 kvn = *(const float4*)(p.mla_kv_norm + 4 * lane);
  for (int it = blockIdx.x; it < NTOK / 16; it += gridDim.x) {
    const int m0 = it * 16;
    const bool ctx = m0 < NCTX;
    unsigned cqw[2][3]; u32x2 ckvw[2]; u16 krw[2]; u32x4 qbw[2], kbw[2], vbw[2]; float2 csm[2]; float2 css[2][8];
#pragma unroll
    for (int tt = 0; tt < 2; ++tt) {
      const int m = m0 + wid * 2 + tt;
      const u16* row = U0 + (size_t)m * L0C;
#pragma unroll
      for (int j = 0; j < 3; ++j) cqw[tt][j] = *(const unsigned*)(row + C0_CQ + 128 * j + 2 * lane);
      ckvw[tt] = ntload2u(row + C0_CKV + 4 * lane);
      krw[tt] = row[C0_KR + (lane & 31)];
      qbw[tt] = ntload4u(row + C0_QB + lane * 8);
      kbw[tt] = ntload4u(row + C0_KB + (lane & 15) * 8);
      vbw[tt] = ntload4u(row + C0_VB + (lane & 15) * 8);
      const int pos = pos_of_tok(m), prow = pos >> 6, pcol = pos & 63;
      csm[tt] = tabM[(((lane >> 4) & 1) ? pcol : prow) * 8 + (lane & 7)];
      const int b16 = (lane & 7) >> 1, pp = (b16 >= 2) ? pcol : prow, fi0 = (lane & 1) * 8;
#pragma unroll
      for (int e = 0; e < 8; ++e) css[tt][e] = tabS[pp * 16 + fi0 + e];
    }
#pragma unroll
    for (int tt = 0; tt < 2; ++tt) {
      const int ml = wid * 2 + tt, m = m0 + ml;
      u16* row = U0 + (size_t)m * L0C;
      const int krow = krow_of_tok(m);
      {
        float lo[3], hi[3], ss = 0.f;
#pragma unroll
        for (int j = 0; j < 3; ++j) { const unsigned w = cqw[tt][j]; lo[j] = bf2f((u16)(w & 0xffffu)); hi[j] = bf2f((u16)(w >> 16)); ss += lo[j] * lo[j] + hi[j] * hi[j]; }
        ss = wave_sum(ss);
        const float rs = rsqrtf(ss * (1.f / 384.f) + EPS);
#pragma unroll
        for (int j = 0; j < 3; ++j) *(unsigned*)(row + C0_CQ + 128 * j + 2 * lane) = pack2(lo[j] * rs * qn[2 * j], hi[j] * rs * qn[2 * j + 1]);
      }
      {
        const u32x2 w = ckvw[tt];
        float x[4] = {bf2f((u16)(w[0] & 0xffffu)), bf2f((u16)(w[0] >> 16)), bf2f((u16)(w[1] & 0xffffu)), bf2f((u16)(w[1] >> 16))};
        float ss = x[0] * x[0] + x[1] * x[1] + x[2] * x[2] + x[3] * x[3];
        ss = wave_sum(ss);
        const float rs = rsqrtf(ss * (1.f / 256.f) + EPS);
        x[0] *= rs * kvn.x; x[1] *= rs * kvn.y; x[2] *= rs * kvn.z; x[3] *= rs * kvn.w;
        u32x2 o = {pack2(x[0], x[1]), pack2(x[2], x[3])};
        *(u32x2*)(CKVN + (size_t)krow * 256 + 4 * lane) = o;
        if (ctx) *(float4*)(p.out + O_CKV + (size_t)m * 256 + 4 * lane) = make_float4(x[0], x[1], x[2], x[3]);
      }
      {
        const float x = bf2f(krw[tt]);
        const float xp = __shfl_xor(x, 8);
        float val = x;
        if (!ctx) { const float2 cs = csm[tt]; val = (lane & 15) < 8 ? (x * cs.x - xp * cs.y) : (x * cs.x + xp * cs.y); }
        if (lane < 32) {
          KROPE[(size_t)krow * 32 + lane] = f2bf(val);
          if (ctx) p.out[O_KROPE + (size_t)m * 32 + lane] = x;
        }
      }
      const bool is_x2 = (((lane & 7) >> 1) & 1) != 0;
      if (!ctx) {
        float x[8], xp[8];
        unpack8(qbw[tt], x);
        shfl8(x, xp, 2);
#pragma unroll
        for (int e = 0; e < 8; ++e) { const float2 cs = css[tt][e]; x[e] = is_x2 ? (x[e] * cs.x + xp[e] * cs.y) : (x[e] * cs.x - xp[e] * cs.y); }
        *(u32x4*)(row + C0_QB + lane * 8) = pack8f(x);
      }
      {
        float x[8], xp[8];
        unpack8(kbw[tt], x);
        if (ctx && lane < 16) {
          *(float4*)(p.out + O_SWAK + (size_t)m * 128 + lane * 8) = make_float4(x[0], x[1], x[2], x[3]);
          *(float4*)(p.out + O_SWAK + (size_t)m * 128 + lane * 8 + 4) = make_float4(x[4], x[5], x[6], x[7]);
        }
        shfl8(x, xp, 2);
        if (!ctx) {
#pragma unroll
          for (int e = 0; e < 8; ++e) { const float2 cs = css[tt][e]; x[e] = is_x2 ? (x[e] * cs.x + xp[e] * cs.y) : (x[e] * cs.x - xp[e] * cs.y); }
        }
        if (lane < 16) {
          *(u32x4*)(KSWA + (size_t)krow * 128 + lane * 8) = pack8f(x);
          const u32x4 vw = vbw[tt];
          *(u32x4*)(sv + ml * 136 + lane * 8) = vw;
          if (ctx) {
            float v[8]; unpack8(vw, v);
            *(float4*)(p.out + O_SWAV + (size_t)m * 128 + lane * 8) = make_float4(v[0], v[1], v[2], v[3]);
            *(float4*)(p.out + O_SWAV + (size_t)m * 128 + lane * 8 + 4) = make_float4(v[4], v[5], v[6], v[7]);
          }
        }
      }
    }
    __syncthreads();
    {
      const int s = seq_of_tok(m0);
      vt_store16(sv, 136, 128, (u16*)(p.ws + WS_VTSWA) + (size_t)krow0_of(s) * 128, cap_of(s), pos_of_tok(m0));
    }
    __syncthreads();
  }
}

namespace pg8 {
#define PG8_LAS __attribute__((address_space(3)))
typedef unsigned short bf16_t;
typedef short bf16x8 __attribute__((ext_vector_type(8)));
typedef float f32x4 __attribute__((ext_vector_type(4)));
typedef unsigned u32x4 __attribute__((ext_vector_type(4)));
constexpr int BM = 256, BK = 64, HALF = 128, HTB = HALF * BK * 2  , STAGE_BYTES = 8 * HTB, NXCD = 8, WGM = 8;

__host__ __device__ __forceinline__ int lds_byte(int r, int c) { const int st = (r >> 4) * 2 + (c >> 5), rr = r & 15, cc = c & 31, ob = rr * 64 + cc * 2; return st * 1024 + (ob ^ (((ob >> 9) & 1) << 5)); }
__host__ __device__ __forceinline__ void stage_rc(int b, int& R, int& C) { const int st = b / 1024, sb = b % 1024, swz = sb ^ (((sb >> 9) & 1) << 5); R = (st >> 1) * 16 + swz / 64; C = (st & 1) * 32 + (swz % 64) / 2; }
__host__ __device__ __forceinline__ int perm32(int rho) { const int n = rho >> 4, i = rho & 15; return 8 * (i >> 2) + 4 * n + (i & 3); }

struct Unit { int pm, pn; };
struct Gemm { const bf16_t* A; const bf16_t* Bt; int M, N, K, lda, ldb; };

struct StaticOrder {
    int nM, nN, nwg, G, c;
    __host__ __device__ void init(int M, int N, int G_, int c_) { nM = M / BM; nN = N / BM; nwg = nM * nN; G = G_; c = c_; }
    __host__ __device__ bool next(int i, Unit& u) const {
        const long L = (long)i * G + c; if (L >= nwg) return false;
        int wgid = (int)L; { const int q = nwg / NXCD, r = nwg % NXCD, xcd = wgid % NXCD, off = wgid / NXCD; wgid = (xcd < r ? xcd * (q + 1) : r * (q + 1) + (xcd - r) * q) + off; }
        const int nig = WGM * nN, gid = wgid / nig, fm = gid * WGM, gsz = (nM - fm) < WGM ? (nM - fm) : WGM;
        u.pm = fm + ((wgid % nig) % gsz); u.pn = (wgid % nig) / gsz; return true;
    }
    __device__ __forceinline__ void a_ready(const Unit&) const {}
    __device__ __forceinline__ void done(const Unit&) const {}
};
struct Ip0Order {
    StaticOrder S9; int rt0, nwg9, ntot, G, c;
    __device__ void init(int M, int Nmain, int rt0_, int G_, int c_) { S9.init(M, Nmain, G_, c_); rt0 = rt0_; nwg9 = S9.nwg; ntot = nwg9 + (M / BM - rt0_); G = G_; c = c_; }
    __device__ bool next(int i, Unit& u) const {
        const int L = i * G + c; if (L >= ntot) return false;
        if (L < nwg9) return S9.next(i, u);
        u.pm = rt0 + (L - nwg9); u.pn = S9.nN; return true;
    }
    __device__ __forceinline__ void a_ready(const Unit&) const {}
    __device__ __forceinline__ void done(const Unit&) const {}
};
template <class Epi, class Sched, bool STAMP = false>
__device__ __forceinline__ void gemm_phase(PG8_LAS unsigned char* lds, const Gemm g, const Sched& S, const Epi& E, unsigned long long* stamps) {
    const int tid = TIDX(), wid = __builtin_amdgcn_readfirstlane(tid >> 6), lane = tid & 63, wr = wid >> 2, wc = wid & 3, fr = lane & 15, fq = lane >> 4;
    const int K = g.K, nt = K / BK;
    int ts_lo = 0, ts_hi = 0, nts = 0; const unsigned long long rt_entry = STAMP ? (unsigned long long)wall_clock64() : 0ull;
#define PG8_STAMP() do { if (STAMP && wid == 0 && nts < 64) { const unsigned long long _c = (unsigned long long)clock64(); \
        ts_lo = (lane == nts) ? (int)(unsigned)_c : ts_lo; ts_hi = (lane == nts) ? (int)(unsigned)(_c >> 32) : ts_hi; ++nts; } } while (0)
    PG8_STAMP();
    unsigned voffA[2], voffB[2];
#pragma unroll
    for (int i = 0; i < 2; ++i) { int R, C; stage_rc(tid * 16 + i * 8192, R, C); const int Rb = Epi::PERM ? ((R & ~31) + perm32(R & 31)) : R;
        voffA[i] = (unsigned)(R * g.lda + C) * 2u; voffB[i] = (unsigned)(Rb * g.ldb + C) * 2u; }
    const size_t kstep = (size_t)(BK * 2);
    const size_t hstepA = (size_t)HALF * g.lda * 2, hstepB = (size_t)HALF * g.ldb * 2;
    const size_t tstepA = 2 * hstepA, tstepB = 2 * hstepB;
    const unsigned ldsw = (unsigned)wid * 1024u;
    const int aoff = lds_byte(wr * 64 + fr, fq * 8), boff = lds_byte(wc * 32 + fr, fq * 8);
#define PG8_SA(b, h) (((b) * 2 + (h)) * HTB)
#define PG8_SB(b, h) ((4 + (b) * 2 + (h)) * HTB)
#define PG8_STAGE(bufoff, gbase, voff) do { _Pragma("unroll") for (int _i = 0; _i < 2; ++_i) \
        __builtin_amdgcn_global_load_lds((const unsigned*)((const char*)(gbase) + (voff)[_i]), (PG8_LAS unsigned*)(lds + (bufoff) + ldsw + _i * 8192), 16, 0, 0); } while (0)
#define PG8_LDA(dst, b, h) do { _Pragma("unroll") for (int m = 0; m < 4; ++m) _Pragma("unroll") for (int k = 0; k < 2; ++k) dst[m][k] = *(const PG8_LAS bf16x8*)(lds + PG8_SA(b, h) + aoff + m * 2048 + k * 1024); } while (0)
#define PG8_LDB(dst, b, h) do { _Pragma("unroll") for (int n = 0; n < 2; ++n) _Pragma("unroll") for (int k = 0; k < 2; ++k) dst[n][k] = *(const PG8_LAS bf16x8*)(lds + PG8_SB(b, h) + boff + n * 2048 + k * 1024); } while (0)
#define PG8_MMA(ai, bj, At, Bt) do { __builtin_amdgcn_s_setprio(1); _Pragma("unroll") for (int m = 0; m < 4; ++m) _Pragma("unroll") for (int n = 0; n < 2; ++n) _Pragma("unroll") for (int k = 0; k < 2; ++k) \
        acc[ai][bj][m][n] = __builtin_amdgcn_mfma_f32_16x16x32_bf16(Bt[n][k], At[m][k], acc[ai][bj][m][n], 0, 0, 0); __builtin_amdgcn_s_setprio(0); } while (0)
#define PG8_WAIT_V(n) asm volatile("s_waitcnt vmcnt(" #n ")" ::: "memory")
#define PG8_WAIT_L(n) asm volatile("s_waitcnt lgkmcnt(" #n ")" ::: "memory")
#define PG8_BAR __builtin_amdgcn_s_barrier()
#define PG8_SCHED __builtin_amdgcn_sched_barrier(0)
    Unit cur, nxt; int ui = 0;
    if (!S.next(0, cur)) return;
    f32x4 acc[2][2][4][2];
#pragma unroll
    for (int a = 0; a < 2; ++a)
#pragma unroll
        for (int b = 0; b < 2; ++b)
#pragma unroll
            for (int m = 0; m < 4; ++m)
#pragma unroll
                for (int n = 0; n < 2; ++n) acc[a][b][m][n] = (f32x4){0.f, 0.f, 0.f, 0.f};
    bf16x8 At[4][2], B0[2][2], B1[2][2];
    const char* cA = (const char*)g.A + (size_t)cur.pm * tstepA; const char* cB = (const char*)g.Bt + (size_t)cur.pn * tstepB;
    S.a_ready(cur);
    PG8_STAGE(PG8_SB(0, 0), cB, voffB); PG8_STAGE(PG8_SA(0, 0), cA, voffA); PG8_STAGE(PG8_SB(0, 1), cB + hstepB, voffB); PG8_STAGE(PG8_SA(0, 1), cA + hstepA, voffA);
    if (wr == 1) PG8_BAR;
    PG8_WAIT_V(4); PG8_BAR;
    PG8_STAGE(PG8_SB(1, 0), cB + kstep, voffB); PG8_STAGE(PG8_SA(1, 0), cA + kstep, voffA); PG8_STAGE(PG8_SB(1, 1), cB + hstepB + kstep, voffB);
    PG8_WAIT_V(6); PG8_BAR;
    PG8_STAMP();
    for (;;) {
        const bool has_next = S.next(ui + 1, nxt);
        const char* nA = has_next ? (const char*)g.A + (size_t)nxt.pm * tstepA : cA; const char* nB = has_next ? (const char*)g.Bt + (size_t)nxt.pn * tstepB : cB;
#pragma unroll 1
        for (int t = 0; t < nt; t += 2) {
            const bool last = (t == nt - 2);
            const char* a1 = cA + (size_t)(t + 1) * kstep;
            const char* a2 = last ? nA : cA + (size_t)(t + 2) * kstep; const char* b2 = last ? nB : cB + (size_t)(t + 2) * kstep;
            const char* a3 = a2 + kstep; const char* b3 = b2 + kstep;
            if (last && has_next) S.a_ready(nxt);
            PG8_LDB(B0, 0, 0); PG8_SCHED; PG8_LDA(At, 0, 0); PG8_STAGE(PG8_SA(1, 1), a1 + hstepA, voffA);
            PG8_WAIT_L(8); PG8_BAR; PG8_WAIT_L(0); PG8_MMA(0, 0, At, B0); PG8_BAR; PG8_SCHED;
            PG8_LDB(B1, 0, 1); PG8_STAGE(PG8_SB(0, 0), b2, voffB);
            PG8_BAR; PG8_WAIT_L(0); PG8_MMA(0, 1, At, B1); PG8_BAR;
            PG8_LDA(At, 0, 1); PG8_STAGE(PG8_SA(0, 0), a2, voffA);
            PG8_BAR; PG8_WAIT_L(0); PG8_MMA(1, 0, At, B0); PG8_BAR; PG8_SCHED;
            PG8_STAGE(PG8_SB(0, 1), b2 + hstepB, voffB);
            PG8_WAIT_V(6); PG8_BAR; PG8_MMA(1, 1, At, B1); PG8_BAR;
            PG8_LDB(B0, 1, 0); PG8_SCHED; PG8_LDA(At, 1, 0); PG8_STAGE(PG8_SA(0, 1), a2 + hstepA, voffA);
            PG8_WAIT_L(8); PG8_BAR; PG8_WAIT_L(0); PG8_MMA(0, 0, At, B0); PG8_BAR; PG8_SCHED;
            PG8_LDB(B1, 1, 1); PG8_STAGE(PG8_SB(1, 0), b3, voffB);
            PG8_BAR; PG8_WAIT_L(0); PG8_MMA(0, 1, At, B1); PG8_BAR;
            PG8_LDA(At, 1, 1); PG8_STAGE(PG8_SA(1, 0), a3, voffA);
            PG8_BAR; PG8_WAIT_L(0); PG8_MMA(1, 0, At, B0); PG8_BAR; PG8_SCHED;
            PG8_STAGE(PG8_SB(1, 1), b3 + hstepB, voffB);
            PG8_WAIT_V(6); PG8_BAR; PG8_MMA(1, 1, At, B1); PG8_BAR;
        }
        PG8_STAMP();
        if constexpr (!Epi::AFTER_DRAIN) { E(acc, cur, wr, wc, fr, fq); S.done(cur); }
        PG8_STAMP();
        if (!has_next) break;
#pragma unroll
        for (int a = 0; a < 2; ++a)
#pragma unroll
            for (int b = 0; b < 2; ++b)
#pragma unroll
                for (int m = 0; m < 4; ++m)
#pragma unroll
                    for (int n = 0; n < 2; ++n) acc[a][b][m][n] = (f32x4){0.f, 0.f, 0.f, 0.f};
        cur = nxt; cA = nA; cB = nB; ++ui;
    }
    PG8_WAIT_V(0);
    if (wr == 0) PG8_BAR;
    PG8_BAR;
    if constexpr (Epi::AFTER_DRAIN) { E.fused(acc, cur, wr, wc, fr, fq, lds, wid, lane); S.done(cur); }
    PG8_STAMP();
    if (STAMP && wid == 0) { stamps[lane] = lane < nts ? (((unsigned long long)(unsigned)ts_hi << 32) | (unsigned)ts_lo) : 0ull;
        if (lane == 62) stamps[62] = rt_entry; if (lane == 63) stamps[63] = (unsigned long long)wall_clock64(); }
#undef PG8_STAMP
#undef PG8_SA
#undef PG8_SB
#undef PG8_STAGE
#undef PG8_LDA
#undef PG8_LDB
#undef PG8_MMA
#undef PG8_WAIT_V
#undef PG8_WAIT_L
#undef PG8_BAR
#undef PG8_SCHED
}
}

using pg8::Unit;
typedef pg8::f32x4 (acc8_t)[2][2][4][2];
DI u32x4 pk8(const pg8::f32x4& v0, const pg8::f32x4& v1) { u32x4 w = {pack2(v0[0], v0[1]), pack2(v0[2], v0[3]), pack2(v1[0], v1[1]), pack2(v1[2], v1[3])}; return w; }
struct E8U0 { static constexpr bool PERM = true, AFTER_DRAIN = false; u16* U; int pm0, pn0;
  DI void operator()(const acc8_t& acc, const Unit& u, int wr, int wc, int fr, int fq) const {
#pragma unroll
    for (int ai = 0; ai < 2; ++ai)
#pragma unroll
      for (int m = 0; m < 4; ++m) { const size_t row = (size_t)((u.pm + pm0) * 256 + wr * 64 + ai * 128 + m * 16 + fr);
#pragma unroll
        for (int bj = 0; bj < 2; ++bj) { const int col = (u.pn + pn0) * 256 + wc * 32 + bj * 128 + 8 * fq;
          if (col < L0C) *(u32x4*)(U + row * L0C + col) = pk8(acc[ai][bj][m][0], acc[ai][bj][m][1]); } }
  } };
struct E8U1 { static constexpr bool PERM = true, AFTER_DRAIN = false; u16* UA; u16* UB; float* AB;
  DI void operator()(const acc8_t& acc, const Unit& u, int wr, int wc, int fr, int fq) const {
#pragma unroll
    for (int ai = 0; ai < 2; ++ai)
#pragma unroll
      for (int m = 0; m < 4; ++m) { const size_t row = (size_t)(u.pm * 256 + wr * 64 + ai * 128 + m * 16 + fr);
#pragma unroll
        for (int bj = 0; bj < 2; ++bj) { const int col = u.pn * 256 + wc * 32 + bj * 128 + 8 * fq;
          if (col < 1536) *(u32x4*)(UA + row * U1A_LD + col) = pk8(acc[ai][bj][m][0], acc[ai][bj][m][1]);
          else if (col < 3584) *(u32x4*)(UB + row * U1B_LD + col - 1536) = pk8(acc[ai][bj][m][0], acc[ai][bj][m][1]);
          else if (col < 3600) { *(pg8::f32x4*)(AB + row * 16 + col - 3584) = acc[ai][bj][m][0]; *(pg8::f32x4*)(AB + row * 16 + col - 3584 + 4) = acc[ai][bj][m][1]; } } }
  } };
struct E8Gy { static constexpr bool PERM = true, AFTER_DRAIN = false; u16* GY; const float* mod;
  DI void operator()(const acc8_t& acc, const Unit& u, int wr, int wc, int fr, int fq) const {
    const float* gp = mod + (size_t)modidx_of_tok(u.pm * 256) * 3072 + 2048;
#pragma unroll
    for (int bj = 0; bj < 2; ++bj) { const int col = u.pn * 256 + wc * 32 + bj * 128 + 8 * fq;
      const pg8::f32x4 g0 = *(const pg8::f32x4*)(gp + col), g1 = *(const pg8::f32x4*)(gp + col + 4);
#pragma unroll
      for (int ai = 0; ai < 2; ++ai)
#pragma unroll
        for (int m = 0; m < 4; ++m) { const size_t row = (size_t)(u.pm * 256 + wr * 64 + ai * 128 + m * 16 + fr);
          *(u32x4*)(GY + row * DM + col) = pk8(acc[ai][bj][m][0] * g0, acc[ai][bj][m][1] * g1); } }
  } };
struct E8KV { static constexpr bool PERM = true, AFTER_DRAIN = false; u16* Kn; u16* Vt;
  DI void operator()(const acc8_t& acc, const Unit& u, int wr, int wc, int fr, int fq) const {
    if (u.pn < 2) {
#pragma unroll
      for (int ai = 0; ai < 2; ++ai)
#pragma unroll
        for (int m = 0; m < 4; ++m) { const size_t row = (size_t)(u.pm * 256 + wr * 64 + ai * 128 + m * 16 + fr);
#pragma unroll
          for (int bj = 0; bj < 2; ++bj) { const int col = u.pn * 256 + wc * 32 + bj * 128 + 8 * fq;
            *(u32x4*)(Kn + row * 512 + col) = pk8(acc[ai][bj][m][0], acc[ai][bj][m][1]); } }
    } else {
      const int krt = __builtin_amdgcn_readfirstlane(u.pm * 256);
      int seq, keyt;
      if (krt < NCTX) { seq = krt >> 8; keyt = 0; } else { const int r = krt - NCTX; seq = 16 + r / 2560; keyt = r - (seq - 16) * 2560; }
      const unsigned cap = (unsigned)cap_of(seq);
      u16* base = Vt + (size_t)krow0_of(seq) * 512 + keyt;
#pragma unroll
      for (int bj = 0; bj < 2; ++bj) {
        const unsigned f0 = (unsigned)((u.pn - 2) * 256 + wc * 32 + bj * 128 + 8 * fq);
        unsigned off = f0 * cap + (unsigned)(wr * 64 + swz16(fr));
#pragma unroll
        for (int ai = 0; ai < 2; ++ai) {
#pragma unroll
          for (int m = 0; m < 4; ++m) {
#pragma unroll
            for (int t = 0; t < 4; ++t) { base[off + t * cap] = f2bf(acc[ai][bj][m][0][t]); base[off + (4 + t) * cap] = f2bf(acc[ai][bj][m][1][t]); }
            off += 16;
            asm volatile("" ::: "memory"); }
          off += 64; } }
    }
  } };
struct E8Q { static constexpr bool PERM = true, AFTER_DRAIN = false; u16* Q;
  DI void operator()(const acc8_t& acc, const Unit& u, int wr, int wc, int fr, int fq) const {
#pragma unroll
    for (int ai = 0; ai < 2; ++ai)
#pragma unroll
      for (int m = 0; m < 4; ++m) { const size_t row = (size_t)(u.pm * 256 + wr * 64 + ai * 128 + m * 16 + fr);
#pragma unroll
        for (int bj = 0; bj < 2; ++bj) { const int col = u.pn * 256 + wc * 32 + bj * 128 + 8 * fq;
          *(u32x4*)(Q + row * 768 + col) = pk8(acc[ai][bj][m][0], acc[ai][bj][m][1]); } }
  } };
template <class Epi>
DI void gemm8_sub(const u16* A, int lda, const u16* Bt, int ldb, int M, int N, int K, char* lds, const Epi& E, int G, int c) {
  int Ko = K; asm volatile("" : "+s"(Ko));
  pg8::Gemm g{A, Bt, M, N, Ko, lda, ldb};
  pg8::StaticOrder S; S.init(M, N, G, c);
  __syncthreads();
  pg8::gemm_phase<Epi, pg8::StaticOrder, false>((PG8_LAS unsigned char*)lds, g, S, E, nullptr);
  __syncthreads();
}
template <class Epi>
DI void gemm8(const u16* A, int lda, const u16* Bt, int ldb, int M, int N, int K, char* lds, const Epi& E) { gemm8_sub(A, lda, Bt, ldb, M, N, K, lds, E, (int)gridDim.x, (int)blockIdx.x); }
struct E8Gen { static constexpr bool PERM = true, AFTER_DRAIN = false; int kv; u16* base; int ld, ncols, pm0, pn0; u16* Vt;
  DI void operator()(const acc8_t& acc, const Unit& u, int wr, int wc, int fr, int fq) const {
    if (kv && u.pn >= 2) {
      const int krt = __builtin_amdgcn_readfirstlane(u.pm * 256);
      int seq, keyt;
      if (krt < NCTX) { seq = krt >> 8; keyt = 0; } else { const int r = krt - NCTX; seq = 16 + r / 2560; keyt = r - (seq - 16) * 2560; }
      const unsigned cap = (unsigned)cap_of(seq);
      u16* vb = Vt + (size_t)krow0_of(seq) * 512 + keyt;
#pragma unroll
      for (int bj = 0; bj < 2; ++bj) {
        const unsigned f0 = (unsigned)((u.pn - 2) * 256 + wc * 32 + bj * 128 + 8 * fq);
        unsigned off = f0 * cap + (unsigned)(wr * 64 + swz16(fr));
#pragma unroll
        for (int ai = 0; ai < 2; ++ai) {
#pragma unroll
          for (int m = 0; m < 4; ++m) {
#pragma unroll
            for (int t = 0; t < 4; ++t) { vb[off + t * cap] = f2bf(acc[ai][bj][m][0][t]); vb[off + (4 + t) * cap] = f2bf(acc[ai][bj][m][1][t]); }
            off += 16;
            asm volatile("" ::: "memory"); }
          off += 64; } }
    } else {
#pragma unroll
      for (int ai = 0; ai < 2; ++ai)
#pragma unroll
        for (int m = 0; m < 4; ++m) { const size_t row = (size_t)((u.pm + pm0) * 256 + wr * 64 + ai * 128 + m * 16 + fr);
#pragma unroll
          for (int bj = 0; bj < 2; ++bj) { const int col = (u.pn + pn0) * 256 + wc * 32 + bj * 128 + 8 * fq;
            if (col < ncols) *(u32x4*)(base + row * ld + col) = pk8(acc[ai][bj][m][0], acc[ai][bj][m][1]); } }
    }
  } };
constexpr int IP0_DEFER_ROWT = 32;
template <class SyncF>
DI void phase8_layer0_gemms(const Params& p, char* lds, const SyncF& gsync) {
  const bool full = gridDim.x == 256;
  const int ng = 3 + opaque_zero();
#pragma unroll 1
  for (int g = 0; g < ng; ++g) {
    const u16* A; const u16* Bt; int lda, ldb, M, Nmain, K, rt0, G, c; E8Gen E;
    u16* U = (u16*)(p.ws + WS_U);
    if (g == 0) { A = (const u16*)(p.ws + WS_H); lda = DM; Bt = (const u16*)(p.ws + WS_WT0); ldb = DM; M = NTOK; K = DM; G = (int)gridDim.x; c = (int)blockIdx.x;
      Nmain = full ? 2304 : L0CP; rt0 = full ? IP0_DEFER_ROWT : NTOK / 256; E = E8Gen{0, U, L0C, L0C, 0, 0, nullptr}; }
    else if (g == 1) { A = (const u16*)(p.ws + WS_CKVN); lda = 256; Bt = (const u16*)(p.ws + WS_WUKV); ldb = 256; M = NKROW; Nmain = 1024; K = 256; rt0 = NKROW / 256; G = (int)gridDim.x; c = (int)blockIdx.x;
      E = E8Gen{1, (u16*)((char*)p.out + YS_KN), 512, 512, 0, 0, (u16*)((char*)p.out + YS_VTMLA)}; }
    else if (!full || blockIdx.x < 224) { A = U + C0_CQ; lda = L0C; Bt = (const u16*)(p.ws + WS_WUQ); ldb = 384; M = NTOK; Nmain = 768; K = 384; rt0 = NTOK / 256;
      G = full ? 224 : (int)gridDim.x; c = full ? ((int)blockIdx.x + 96) % 224 : (int)blockIdx.x; E = E8Gen{0, (u16*)((char*)p.out + YS_QMLA), 768, 768, 0, 0, nullptr}; }
    else { A = (const u16*)(p.ws + WS_H); lda = DM; Bt = (const u16*)(p.ws + WS_WT0) + (size_t)2304 * DM; ldb = DM; M = IP0_DEFER_ROWT * 256; Nmain = 256; K = DM; rt0 = IP0_DEFER_ROWT;
      G = 32; c = (int)blockIdx.x - 224; E = E8Gen{0, U, L0C, L0C, 0, 9, nullptr}; }
    {
      int Ko = K; asm volatile("" : "+s"(Ko));
      pg8::Gemm gm{A, Bt, M, Nmain, Ko, lda, ldb};
      pg8::Ip0Order S; S.init(M, Nmain, rt0, G, c);
      __syncthreads();
      pg8::gemm_phase<E8Gen, pg8::Ip0Order, false>((PG8_LAS unsigned char*)lds, gm, S, E, nullptr);
      __syncthreads();
    }
    if (g == 0) { gsync(); phase_l0prep(p, lds); gsync(); }
  }
}
DI void prep_deferred_layer1_weights(const Params& p, char* lds) {
  if (gridDim.x != 256 || blockIdx.x < 64) return;
  __syncthreads();
#pragma unroll 1
  for (int bq = 258 + (int)blockIdx.x - 64; bq < 562; bq += 192) {
    if (bq < 498) transpose_tiles4<4>(p, (bq - 258) * 4, lds);
    else transpose_tiles4<5>(p, (bq - 498) * 4, lds);
  }
}
DI void phase8_outproj(const Params& p, int layer, char* lds) {
  gemm8((const u16*)(p.ws + WS_H), DM, (const u16*)(p.ws + (layer ? WS_WO1 : WS_WO0)), DM, NTOK, DM, DM, lds,
        E8Gy{(u16*)(p.ws + (layer ? WS_GY1 : WS_GY0)), (const float*)(p.ws + WS_MOD) + (size_t)layer * 9 * 3072});
}
DI void phase8_inproj1(const Params& p, char* lds) {
  gemm8((const u16*)(p.ws + WS_H), DM, (const u16*)(p.ws + WS_WT1), DM, NTOK, L1CP, DM, lds, E8U1{(u16*)(p.ws + WS_U1A), (u16*)(p.ws + WS_U1B), (float*)(p.ws + WS_AB)});
}

template <int KIND, int DBGV = 0>
DI void attn_item(const Params& p, int s, int hsel, int q0, char* lds) {
  constexpr int DQK = KIND == 0 ? 96 : (KIND == 1 ? 64 : 128);
  constexpr int DV = KIND == 2 ? 128 : 64;
  constexpr int KT = KIND == 2 ? 64 : 128;
  constexpr int NKB = KT / 32;
  constexpr int KS = DQK + 8, VS = KT + 8;
  constexpr int CPR = DQK / 8;
  constexpr int VPR = KT / 8;
  constexpr int KCH = KT * CPR, NKC = (KCH + 511) / 512;
  constexpr int VCH = DV * VPR, NVC = VCH / 512;
  constexpr float SCALE = KIND == 0 ? 0.10206207261596577f : (KIND == 1 ? 0.125f : 0.08838834764831845f);
  constexpr float C = SCALE * LOG2E;
  const int tid = TIDX(), lane = tid & 63, wid = tid >> 6, r32 = lane & 31, h = lane >> 5;
  u16* sK0 = (u16*)lds;
  const int tok0 = tok0_of(s), kr0 = krow0_of(s), cap = cap_of(s), len = len_of(s);
  const bool smp = s >= 16;
  int hq, hkv, qrow0;
  if (KIND == 0) { hq = hsel; hkv = hsel; qrow0 = q0 + 32 * wid; }
  else if (KIND == 1) { hkv = hsel >> 1; hq = hkv * 4 + (hsel & 1) * 2 + (wid >> 2); qrow0 = q0 + 32 * (wid & 3); }
  else { hkv = hsel; hq = hkv * 2 + (wid >> 2); qrow0 = q0 + 32 * (wid & 3); }
  const int tok = tok0 + qrow0 + r32;
  const u16* U0 = (const u16*)(p.ws + WS_U);
  u16* U1B = (u16*)(p.ws + WS_U1B);
  const u16* qp;
  if (KIND == 0) qp = (const u16*)((const char*)p.out + YS_QMLA) + (size_t)tok * 768 + hq * 96 + h * 8;
  else if (KIND == 1) qp = U0 + (size_t)tok * L0C + C0_QB + hq * 64 + h * 8;
  else qp = U1B + (size_t)tok * U1B_LD + C1_QD + hq * 128 + h * 8;
  bf16x8 qf[DQK / 16];
#pragma unroll
  for (int d0 = 0; d0 < DQK / 16; ++d0) qf[d0] = *(const bf16x8*)(qp + d0 * 16);
  if (KIND == 0 && smp) {
    const float2* tabM = (const float2*)(p.ws + WS_ROPE);
    const int qpos = qrow0 + r32;
#pragma unroll
    for (int d0 = 4; d0 < 6; ++d0) {
      float x[8], xp[8];
      unpack8(__builtin_bit_cast(u32x4, qf[d0 < DQK / 16 ? d0 : 0]), x);
      shfl8(x, xp, 32);
      rope8(x, xp, tabM, 8, d0 == 4 ? (qpos >> 6) : (qpos & 63), 0, h != 0);
      if (d0 < DQK / 16) qf[d0 < DQK / 16 ? d0 : 0] = __builtin_bit_cast(bf16x8, pack8f(x));
    }
  }
  int nwin = 0, wlo = 0, nt = cap / KT;
  if (KIND == 1 && smp) { wlo = q0 - 128 < 0 ? 0 : q0 - 128; const int whi = q0 + 256 > 2048 ? 2048 : q0 + 256; nwin = (whi - wlo) / KT; nt = nwin + 512 / KT; }
  const u16* Kn = (const u16*)((const char*)p.out + YS_KN);
  const u16* KR = (const u16*)(p.ws + WS_KROPE);
  const u16* KSW = (const u16*)(p.ws + WS_KSWA);
  const u16* KCc = (const u16*)(p.ws + WS_KC);
  const u16* VT;
  if (KIND == 0) VT = (const u16*)((const char*)p.out + YS_VTMLA) + (size_t)kr0 * 512;
  else if (KIND == 1) VT = (const u16*)(p.ws + WS_VTSWA) + (size_t)kr0 * 128;
  else VT = (const u16*)(p.ws + WS_VTATT) + (size_t)kr0 * 256;
  bf16x8 rk[NKC], rv[NVC];
  int kkey[NKC], kd[NKC];
#pragma unroll
  for (int i = 0; i < NKC; ++i) { const int c = tid + 512 * i; kkey[i] = c / CPR; kd[i] = (c % CPR) * 8; }
  auto kt0_of = [&](int t) -> int { return (KIND == 1 && smp) ? (t < nwin ? wlo + KT * t : 2048 + KT * (t - nwin)) : KT * t; };
  auto gload = [&](int t) {
    const int kt0 = (DBGV == 2) ? 0 : kt0_of(t);
#pragma unroll
    for (int i = 0; i < NKC; ++i) {
      if (tid + 512 * i < KCH) {
        const int g = kt0 + kkey[i], d = kd[i];
        const u16* src;
        if (KIND == 0) src = d < 64 ? Kn + ((size_t)(kr0 + g) * 8 + hkv) * 64 + d : KR + (size_t)(kr0 + g) * 32 + (d - 64);
        else if (KIND == 1) src = KSW + ((size_t)(kr0 + g) * 2 + hkv) * 64 + d;
        else src = g < len ? U1B + (size_t)(tok0 + g) * U1B_LD + C1_KD + hkv * 128 + d : KCc + ((size_t)((s - 16) * 512 + g - 2048) * 2 + hkv) * 128 + d;
        rk[i] = *(const bf16x8*)src;
      }
    }
#pragma unroll
    for (int i = 0; i < NVC; ++i) {
      const int c = tid + 512 * i, dv = c / VPR, kc = c % VPR;
      rv[i] = *(const bf16x8*)(VT + (size_t)(hkv * DV + dv) * cap + kt0 + kc * 8);
    }
  };
  auto swrite = [&](int buf) {
    u16* sK = sK0 + buf * (KT * KS + DV * VS); u16* sV = sK + KT * KS;
#pragma unroll
    for (int i = 0; i < NKC; ++i) if (tid + 512 * i < KCH) *(bf16x8*)(sK + kkey[i] * KS + kd[i]) = rk[i];
#pragma unroll
    for (int i = 0; i < NVC; ++i) { const int c = tid + 512 * i; *(bf16x8*)(sV + (c / VPR) * VS + (c % VPR) * 8) = rv[i]; }
  };
  f32x16 o[DV / 32];
#pragma unroll
  for (int db = 0; db < DV / 32; ++db)
#pragma unroll
    for (int r = 0; r < 16; ++r) o[db][r] = 0.f;
  float m = -1e30f, l = 0.f;
  constexpr int ABUF = KT * KS + DV * VS;
  constexpr int ND = DQK / 16, NB = DV / 32;
#define SBAR() __builtin_amdgcn_sched_barrier(0)
  __syncthreads();
  gload(0); swrite(0);
  if (nt > 1) { gload(1); swrite(1); }
  __syncthreads();
  if (nt > 2) gload(2);
  int bcur = 0;
#pragma unroll 1
  for (int t = 0; t < nt; ++t) {
    const int bnxt = bcur == 2 ? 0 : bcur + 1, bnn = bnxt == 2 ? 0 : bnxt + 1;
    const u16* sK = sK0 + bcur * ABUF; const u16* sV = sK + KT * KS;
    f32x16 sc[NKB];
#pragma unroll
    for (int kb = 0; kb < NKB; ++kb)
#pragma unroll
      for (int r = 0; r < 16; ++r) sc[kb][r] = 0.f;
    constexpr int BS = NKB == 4 ? 1 : (ND <= 4 ? 2 : 3), NBK = (ND + BS - 1) / BS;
    bf16x8 kf[NBK][NKB * BS];
#pragma unroll
    for (int i = 0; i < BS; ++i)
#pragma unroll
      for (int kb = 0; kb < NKB; ++kb) kf[0][NKB * i + kb] = *(const bf16x8*)(sK + (32 * kb + r32) * KS + i * 16 + h * 8);
    SBAR();
    constexpr int NVG = NB * NKB / 2;
    bf16x8 vf[2][4];
#pragma unroll
    for (int bk = 0; bk < NBK; ++bk) {
      if (bk + 1 < NBK) {
#pragma unroll
        for (int i = 0; i < BS; ++i) { const int d0 = (bk + 1) * BS + i;
          if (d0 < ND) {
#pragma unroll
            for (int kb = 0; kb < NKB; ++kb) kf[bk + 1 < NBK ? bk + 1 : 0][NKB * i + kb] = *(const bf16x8*)(sK + (32 * kb + r32) * KS + d0 * 16 + h * 8); } }
      } else {
#pragma unroll
        for (int q = 0; q < 4; ++q) vf[0][q] = *(const bf16x8*)(sV + r32 * VS + h * 8 + 16 * q);
      }
      SBAR();
#pragma unroll
      for (int i = 0; i < BS; ++i) { const int d0 = bk * BS + i; if (d0 < ND) {
#pragma unroll
        for (int kb = 0; kb < NKB; ++kb) sc[kb] = MFMA(kf[bk][NKB * i + kb], qf[d0 < ND ? d0 : 0], sc[kb]); } }
      SBAR();
    }
    if (KIND == 1 && smp && t < nwin) {
      const int kt0 = kt0_of(t), qi = qrow0 + r32;
#pragma unroll
      for (int kb = 0; kb < NKB; ++kb)
#pragma unroll
        for (int r = 0; r < 16; ++r) { const int d0 = qi - (kt0 + 32 * kb + crow(r, h)); sc[kb][r] = (d0 <= 128 && d0 >= -128) ? sc[kb][r] : -INFINITY; }
    }
    float mx = sc[0][0];
#pragma unroll
    for (int kb = 0; kb < NKB; ++kb)
#pragma unroll
      for (int r = 0; r < 16; ++r) mx = fmaxf(mx, sc[kb][r]);
    { auto rr = __builtin_amdgcn_permlane32_swap(__float_as_uint(mx), __float_as_uint(mx), false, false);
      mx = fmaxf(__uint_as_float(rr[0]), __uint_as_float(rr[1])); }
    const float mnew = fmaxf(m, mx * C);
    const float alpha = __builtin_amdgcn_exp2f(m - mnew);
    m = mnew;
    float ps = 0.f;
#pragma unroll
    for (int kb = 0; kb < NKB; ++kb)
#pragma unroll
      for (int r = 0; r < 16; ++r) { sc[kb][r] = __builtin_amdgcn_exp2f(sc[kb][r] * C - mnew); ps += sc[kb][r]; }
    l = l * alpha + ps;
#pragma unroll
    for (int db = 0; db < NB; ++db)
#pragma unroll
      for (int r = 0; r < 16; ++r) o[db][r] *= alpha;
    bf16x8 pf[2 * NKB];
#pragma unroll
    for (int kb = 0; kb < NKB; ++kb) { pf[2 * kb] = pack8(sc[kb], 0); pf[2 * kb + 1] = pack8(sc[kb], 1); }
    SBAR();
#pragma unroll
    for (int g = 0; g < NVG; ++g) {
      if (g + 1 < NVG) {
        const int db1 = (g + 1) / (NKB / 2), kq1 = ((g + 1) % (NKB / 2)) * 4;
#pragma unroll
        for (int q = 0; q < 4; ++q) vf[(g + 1) & 1][q] = *(const bf16x8*)(sV + (db1 * 32 + r32) * VS + h * 8 + 16 * (kq1 + q));
      }
      SBAR();
      const int db = g / (NKB / 2), kq = (g % (NKB / 2)) * 4;
      o[db] = MFMA(vf[g & 1][0], pf[kq], o[db]); o[db] = MFMA(vf[g & 1][1], pf[kq + 1], o[db]); o[db] = MFMA(vf[g & 1][2], pf[kq + 2], o[db]); o[db] = MFMA(vf[g & 1][3], pf[kq + 3], o[db]);
      SBAR();
    }
    if (t + 2 < nt) {
      swrite(bnn);
      __syncthreads();
      if (t + 3 < nt) gload(t + 3);
    }
    bcur = bnxt;
  }
#undef SBAR
  float lt = l + __shfl_xor(l, 32);
  if (KIND == 1) lt += __builtin_amdgcn_exp2f(p.swa_sink[hq] * LOG2E - m);
  const float inv = 1.f / lt;
  const u16* zp; u16* op;
  if (KIND == 0) { zp = U0 + (size_t)tok * L0C + C0_ZA + hq * 64; op = (u16*)(p.ws + WS_H) + (size_t)tok * DM + hq * 64; }
  else if (KIND == 1) { zp = U0 + (size_t)tok * L0C + C0_ZB + hq * 64; op = (u16*)(p.ws + WS_H) + (size_t)tok * DM + 512 + hq * 64; }
  else { zp = U1B + (size_t)tok * U1B_LD + C1_ZD + hq * 128; op = (u16*)(p.ws + WS_H) + (size_t)tok * DM + 512 + hq * 128; }
#pragma unroll
  for (int db = 0; db < DV / 32; ++db)
#pragma unroll
    for (int g = 0; g < 4; ++g) {
      const int dv = db * 32 + 8 * g + 4 * h;
      const u32x2 zw = *(const u32x2*)(zp + dv);
      const float z0 = bf2f((u16)(zw[0] & 0xffffu)), z1 = bf2f((u16)(zw[0] >> 16)), z2 = bf2f((u16)(zw[1] & 0xffffu)), z3 = bf2f((u16)(zw[1] >> 16));
      u32x2 w = {pack2(o[db][4 * g] * inv * siluf(z0), o[db][4 * g + 1] * inv * siluf(z1)), pack2(o[db][4 * g + 2] * inv * siluf(z2), o[db][4 * g + 3] * inv * siluf(z3))};
      if (DBGV == 0) *(u32x2*)(op + dv) = w; else asm volatile("" :: "v"(w[0]), "v"(w[1]));
    }
  __syncthreads();
}

DI void phase_attn0(const Params& p, char* lds, unsigned long long code_end) {
#pragma unroll 1
  for (int it = blockIdx.x; it < 1280; it += gridDim.x) {
    const int x = it & 7;
    int kind, s, hs, q0;
    if (it < 512) { const int j = it >> 3; const int pr = (j & 7) * 8 + x, qb = j >> 3; kind = 0; s = 16 + (pr >> 3); hs = pr & 7; q0 = qb * 256; }
    else if (it < 1024) { const int j = (it - 512) >> 3; const int pr = (j & 1) * 8 + x, sub = j >> 1;
      kind = 1; s = 16 + (pr >> 1); hs = (pr & 1) * 2 + (sub & 1); q0 = (sub >> 1) * 128; }
    else if (it < 1152) { const int j = it - 1024; kind = 0; s = j >> 3; hs = j & 7; q0 = 0; }
    else { const int j = it - 1152; kind = 1; s = j >> 3; hs = (j & 7) >> 1; q0 = (j & 1) * 128; }
    if (it >= 512 && it < 768) code_prefetch(code_end);
    if (kind == 0) attn_item<0>(p, s, hs, q0, lds); else attn_item<1>(p, s, hs, q0, lds);
  }
}
template <int DBGV>
DI void phase_attn1_t(const Params& p, char* lds) {
#pragma unroll 1
  for (int it = blockIdx.x; it < 320; it += gridDim.x) {
    const int x = it & 7;
    int s, hs, q0;
    if (it < 256) { const int j = it >> 3; const int pr = (j & 1) * 8 + x, qb = j >> 1; s = 16 + (pr >> 1); hs = pr & 1; q0 = qb * 128; }
    else { const int j = it - 256; s = j >> 2; hs = (j & 3) >> 1; q0 = (j & 1) * 128; }
    attn_item<2, DBGV>(p, s, hs, q0, lds);
  }
}
DI void phase_attn1(const Params& p, char* lds) { phase_attn1_t<0>(p, lds); }

DI float group16_sum(float v) {
#pragma unroll
  for (int o = 8; o > 0; o >>= 1) v += __shfl_xor(v, o);
  return v;
}
template <bool GDN, bool ATT>
DI void l1prep_t(const Params& p, char* lds, int rank, int nblk) {
  const int tid = TIDX(), lane = tid & 63, wid = tid >> 6;
  const u16* UA = (const u16*)(p.ws + WS_U1A);
  u16* UB = (u16*)(p.ws + WS_U1B);
  u16* QK = (u16*)(p.ws + WS_H);
  u16* VC = (u16*)(p.ws + WS_VC);
  float* GB = (float*)(p.ws + WS_GB);
  const float* AB = (const float*)(p.ws + WS_AB);
  const float2* tabA = (const float2*)(p.ws + WS_ROPE) + 1536;
  u16* sv = (u16*)lds;
  float* sconv = (float*)(lds + 16384);
  if (GDN) { for (int i = tid; i < 1152; i += NTHREADS) *(float4*)(sconv + 4 * i) = *(const float4*)(p.gdn_conv + 4 * i); }
  __syncthreads();
  constexpr int N_TOK_ITEMS = NTOK / 16;
  constexpr int N_KC_ITEMS = 256;
  constexpr int N_VC_ITEMS = 256;
  for (int it = rank; it < (ATT ? N_TOK_ITEMS + N_KC_ITEMS + N_VC_ITEMS : N_TOK_ITEMS); it += nblk) {
    if (it >= N_TOK_ITEMS + N_KC_ITEMS) {
      const int t = it - N_TOK_ITEMS - N_KC_ITEMS; const int b = t >> 5, g = t & 31;
      {
        const int key = tid >> 5, c8 = (tid & 31) * 8;
        const float* src = p.c_attv + ((size_t)(b * 512 + g * 16 + key)) * 256 + c8;
        const float4 a = ntload4(src), b4 = ntload4(src + 4);
        u32x4 w = {pack2(a.x, a.y), pack2(a.z, a.w), pack2(b4.x, b4.y), pack2(b4.z, b4.w)};
        *(u32x4*)(sv + key * 264 + c8) = w;
      }
      __syncthreads();
      vt_store16(sv, 264, 256, (u16*)(p.ws + WS_VTATT) + (size_t)krow0_of(16 + b) * 256, 2560, 2048 + g * 16);
      __syncthreads();
      continue;
    }
    if (it >= N_TOK_ITEMS) {
      const size_t i = (size_t)(it - N_TOK_ITEMS) * 4096 + tid * 8;
      const float4 a = ntload4(p.c_attk + i), b4 = ntload4(p.c_attk + i + 4);
      u32x4 w = {pack2(a.x, a.y), pack2(a.z, a.w), pack2(b4.x, b4.y), pack2(b4.z, b4.w)};
      *(u32x4*)((u16*)(p.ws + WS_KC) + i) = w;
      continue;
    }
    const int m0 = it * 16;
    for (int tt = 0; tt < 2; ++tt) {
      const int ml = wid * 2 + tt, m = m0 + ml;
      const bool ctx = m < NCTX;
      const int pos = pos_of_tok(m), prow = pos >> 6, pcol = pos & 63, len = ctx ? 256 : 2048;
      const int li = lane & 15;
      const u16* r1 = UA + (size_t)m * U1A_LD;
      u32x4 xw[3][3]; float cw[3][3][8];
      if constexpr (GDN) {
#pragma unroll
      for (int j = 0; j < 3; ++j) {
        const int ch = j * 512 + lane * 8;
        xw[j][1] = *(const u32x4*)(r1 + ch);
        xw[j][0] = (pos > 0) ? *(const u32x4*)(r1 - U1A_LD + ch) : (u32x4){0u, 0u, 0u, 0u};
        xw[j][2] = (pos < len - 1) ? *(const u32x4*)(r1 + U1A_LD + ch) : (u32x4){0u, 0u, 0u, 0u};
#pragma unroll
        for (int kk = 0; kk < 3; ++kk) {
          const float4 wa = *(const float4*)(sconv + kk * 1536 + ch), wb = *(const float4*)(sconv + kk * 1536 + ch + 4);
          cw[j][kk][0] = wa.x; cw[j][kk][1] = wa.y; cw[j][kk][2] = wa.z; cw[j][kk][3] = wa.w; cw[j][kk][4] = wb.x; cw[j][kk][5] = wb.y; cw[j][kk][6] = wb.z; cw[j][kk][7] = wb.w;
        }
      }
      }
      u16* qp = UB + (size_t)m * U1B_LD + C1_QD + lane * 8;
      u16* kp = UB + (size_t)m * U1B_LD + C1_KD + (lane & 31) * 8;
      u32x4 qdw, kdw, vdw; float abv = 0.f;
      if constexpr (ATT) { qdw = ntload4u(qp); kdw = ntload4u(kp); vdw = ntload4u(UB + (size_t)m * U1B_LD + C1_VD + (lane & 31) * 8); }
      if constexpr (GDN) abv = AB[(size_t)m * 16 + (lane & 15)];
      float qn8[8], kn8[8]; float2 cs8[8];
      if constexpr (ATT) {
        const float4 a0 = *(const float4*)(p.att_q_norm + li * 8), a1 = *(const float4*)(p.att_q_norm + li * 8 + 4), b0 = *(const float4*)(p.att_k_norm + li * 8), b1 = *(const float4*)(p.att_k_norm + li * 8 + 4);
        qn8[0] = a0.x; qn8[1] = a0.y; qn8[2] = a0.z; qn8[3] = a0.w; qn8[4] = a1.x; qn8[5] = a1.y; qn8[6] = a1.z; qn8[7] = a1.w;
        kn8[0] = b0.x; kn8[1] = b0.y; kn8[2] = b0.z; kn8[3] = b0.w; kn8[4] = b1.x; kn8[5] = b1.y; kn8[6] = b1.z; kn8[7] = b1.w;
        const int b32 = li >> 2, pp = (b32 >= 2) ? pcol : prow;
#pragma unroll
        for (int e = 0; e < 8; ++e) cs8[e] = tabA[pp * 32 + (li & 3) * 8 + e];
      }
      const bool is_x2 = ((li >> 2) & 1) != 0;
      if constexpr (GDN) {
#pragma unroll
      for (int j = 0; j < 3; ++j) {
        float x0[8], x1[8], x2[8], y[8];
        unpack8(xw[j][0], x0); unpack8(xw[j][1], x1); unpack8(xw[j][2], x2);
        float ss = 0.f;
#pragma unroll
        for (int e = 0; e < 8; ++e) { const float a = cw[j][0][e] * x0[e] + cw[j][1][e] * x1[e] + cw[j][2][e] * x2[e]; y[e] = siluf(a); ss += y[e] * y[e]; }
        if (j < 2) {
          ss = group16_sum(ss);
          const float rs = rsqrtf(ss + EPS) * (j == 0 ? 0.08838834764831845f : 1.f);
#pragma unroll
          for (int e = 0; e < 8; ++e) y[e] *= rs;
          *(u32x4*)(QK + (size_t)m * DM + j * 512 + lane * 8) = pack8f(y);
        } else {
          *(u32x4*)(VC + (size_t)m * 512 + lane * 8) = pack8f(y);
        }
      }
      if (lane < 16) {
        float r;
        if (lane < 8) { const float x = abv + p.gdn_dt_bias[lane]; const float ex = __expf(x);
          const float sp = x > 20.f ? x : (ex < 0.03125f ? ex * (1.f - ex * (0.5f - ex * (0.33333333f - 0.25f * ex))) : __logf(1.f + ex));
          r = -__expf(p.gdn_a_log[lane]) * sp; }
        else r = __builtin_amdgcn_rcpf(1.f + __expf(-abv));
        GB[(size_t)m * 16 + lane] = r;
      }
      }
      if constexpr (ATT) {
        float x[8], xp[8];
        unpack8(qdw, x);
        float ss = 0.f;
#pragma unroll
        for (int e = 0; e < 8; ++e) ss += x[e] * x[e];
        ss = group16_sum(ss);
        const float rs = rsqrtf(ss * (1.f / 128.f) + EPS);
#pragma unroll
        for (int e = 0; e < 8; ++e) x[e] *= rs * qn8[e];
        shfl8(x, xp, 4);
        if (!ctx) {
#pragma unroll
          for (int e = 0; e < 8; ++e) x[e] = is_x2 ? (x[e] * cs8[e].x + xp[e] * cs8[e].y) : (x[e] * cs8[e].x - xp[e] * cs8[e].y);
        }
        *(u32x4*)qp = pack8f(x);
      }
      if constexpr (ATT) {
        float x[8], xp[8];
        unpack8(kdw, x);
        float ss = 0.f;
#pragma unroll
        for (int e = 0; e < 8; ++e) ss += x[e] * x[e];
        ss = group16_sum(ss);
        const float rs = rsqrtf(ss * (1.f / 128.f) + EPS);
#pragma unroll
        for (int e = 0; e < 8; ++e) x[e] *= rs * kn8[e];
        if (ctx && lane < 32) {
          *(float4*)(p.out + O_ATTK + (size_t)m * 256 + lane * 8) = make_float4(x[0], x[1], x[2], x[3]);
          *(float4*)(p.out + O_ATTK + (size_t)m * 256 + lane * 8 + 4) = make_float4(x[4], x[5], x[6], x[7]);
        }
        shfl8(x, xp, 4);
        if (!ctx) {
#pragma unroll
          for (int e = 0; e < 8; ++e) x[e] = is_x2 ? (x[e] * cs8[e].x + xp[e] * cs8[e].y) : (x[e] * cs8[e].x - xp[e] * cs8[e].y);
        }
        if (lane < 32) {
          *(u32x4*)kp = pack8f(x);
          *(u32x4*)(sv + ml * 264 + lane * 8) = vdw;
          if (ctx) {
            float v[8]; unpack8(vdw, v);
            *(float4*)(p.out + O_ATTV + (size_t)m * 256 + lane * 8) = make_float4(v[0], v[1], v[2], v[3]);
            *(float4*)(p.out + O_ATTV + (size_t)m * 256 + lane * 8 + 4) = make_float4(v[4], v[5], v[6], v[7]);
          }
        }
      }
    }
    if constexpr (ATT) {
      __syncthreads();
      {
        const int s = seq_of_tok(m0);
        vt_store16(sv, 264, 256, (u16*)(p.ws + WS_VTATT) + (size_t)krow0_of(s) * 256, cap_of(s), pos_of_tok(m0));
      }
      __syncthreads();
    }
  }
  __syncthreads();
}
DI int cp_main_chunk(int it) { if (it < 64) return it; const int j = it - 64, b = j / 24, cc = j % 24; return 64 + b * 32 + (cc < 12 ? cc : cc + 8); }
DI int cp_deferred_chunk(int it) { return 64 + (it >> 3) * 32 + 12 + (it & 7); }
DI void l1prep_gdn(const Params& p, int rank, int nblk) {
  const int tid = TIDX(), lane = tid & 63, wid = tid >> 6;
  const u16* UA = (const u16*)(p.ws + WS_U1A);
  u16* QK = (u16*)(p.ws + WS_H);
  u16* VC = (u16*)(p.ws + WS_VC);
  float* GB = (float*)(p.ws + WS_GB);
  const float* AB = (const float*)(p.ws + WS_AB);
  float cw[3][3][8];
#pragma unroll
  for (int j = 0; j < 3; ++j)
#pragma unroll
    for (int kk = 0; kk < 3; ++kk) {
      const float4 wa = *(const float4*)(p.gdn_conv + kk * 1536 + j * 512 + lane * 8), wb = *(const float4*)(p.gdn_conv + kk * 1536 + j * 512 + lane * 8 + 4);
      cw[j][kk][0] = wa.x; cw[j][kk][1] = wa.y; cw[j][kk][2] = wa.z; cw[j][kk][3] = wa.w; cw[j][kk][4] = wb.x; cw[j][kk][5] = wb.y; cw[j][kk][6] = wb.z; cw[j][kk][7] = wb.w;
    }
  const float dtb = p.gdn_dt_bias[lane & 7], nalog = -__expf(p.gdn_a_log[lane & 7]);
  constexpr int N_TOK_ITEMS = NTOK / 16;
  const int nit = rank < N_TOK_ITEMS ? (N_TOK_ITEMS - 1 - rank) / nblk + 1 : 0, nq = nit * 2;
  const bool own = nblk == 256;
  const int own_tok0 = cp_main_chunk(rank) * 64, def_tok0 = cp_deferred_chunk(rank >> 2) * 64 + (rank & 3) * 16;
#define L1G_TOK(q_) (own ? (((q_) >> 1) < 4 ? own_tok0 + ((q_) >> 1) * 16 : def_tok0) + wid * 2 + ((q_) & 1) : (rank + ((q_) >> 1) * nblk) * 16 + wid * 2 + ((q_) & 1))
#define L1G_LOAD(X_, A_, m_) do { const int pos_ = pos_of_tok(m_), len_ = (m_) < NCTX ? 256 : 2048; const u16* r1_ = UA + (size_t)(m_) * U1A_LD; \
    const u16* rp_ = pos_ > 0 ? r1_ - U1A_LD : r1_; const u16* rn_ = pos_ < len_ - 1 ? r1_ + U1A_LD : r1_; \
    _Pragma("unroll") for (int j = 0; j < 3; ++j) { const int ch_ = j * 512 + lane * 8; X_[j][0] = *(const u32x4*)(rp_ + ch_); X_[j][1] = *(const u32x4*)(r1_ + ch_); X_[j][2] = *(const u32x4*)(rn_ + ch_); } \
    A_ = AB[(size_t)(m_) * 16 + (lane & 15)]; } while (0)
  u32x4 xc[3][3], xn[3][3]; float abc = 0.f, abn = 0.f;
  if (nq > 0) { const int m0 = L1G_TOK(0); L1G_LOAD(xc, abc, m0); }
#pragma unroll 1
  for (int q = 0; q < nq; ++q) {
    const int m = L1G_TOK(q);
    if (q + 1 < nq) { const int mn = L1G_TOK(q + 1); L1G_LOAD(xn, abn, mn); }
    const int pos = pos_of_tok(m), len = m < NCTX ? 256 : 2048;
    const float e0 = pos > 0 ? 1.f : 0.f, e2 = pos < len - 1 ? 1.f : 0.f;
#pragma unroll
    for (int j = 0; j < 3; ++j) {
      float x0[8], x1[8], x2[8], y[8];
      unpack8(xc[j][0], x0); unpack8(xc[j][1], x1); unpack8(xc[j][2], x2);
      float ss = 0.f;
#pragma unroll
      for (int e = 0; e < 8; ++e) { const float a = cw[j][0][e] * (x0[e] * e0) + cw[j][1][e] * x1[e] + cw[j][2][e] * (x2[e] * e2); y[e] = siluf(a); ss += y[e] * y[e]; }
      if (j < 2) {
        ss = group16_sum(ss);
        const float rs = rsqrtf(ss + EPS) * (j == 0 ? 0.08838834764831845f : 1.f);
#pragma unroll
        for (int e = 0; e < 8; ++e) y[e] *= rs;
        *(u32x4*)(QK + (size_t)m * DM + j * 512 + lane * 8) = pack8f(y);
      } else {
        *(u32x4*)(VC + (size_t)m * 512 + lane * 8) = pack8f(y);
      }
    }
    if (lane < 16) {
      float r;
      if (lane < 8) { const float x = abc + dtb; const float ex = __expf(x);
        const float sp = x > 20.f ? x : (ex < 0.03125f ? ex * (1.f - ex * (0.5f - ex * (0.33333333f - 0.25f * ex))) : __logf(1.f + ex));
        r = nalog * sp; }
      else r = __builtin_amdgcn_rcpf(1.f + __expf(-abc));
      GB[(size_t)m * 16 + lane] = r;
    }
#pragma unroll
    for (int j = 0; j < 3; ++j)
#pragma unroll
      for (int kk = 0; kk < 3; ++kk) xc[j][kk] = xn[j][kk];
    abc = abn;
  }
#undef L1G_TOK
#undef L1G_LOAD
}
DI void phase_l1prep(const Params& p, char* lds) {
  l1prep_gdn(p, (int)blockIdx.x, (int)gridDim.x);
  if (gridDim.x != 256) l1prep_t<false, true>(p, lds, (int)blockIdx.x, (int)gridDim.x);
}


DI void phase_gdnfinal(const Params& p) {
  const int tid_ = TIDX(), lane = tid_ & 63, wid = tid_ >> 6;
  const u16* OF = (const u16*)(p.ws + WS_OF); const u16* OBk = (const u16*)(p.ws + WS_OB);
  const u16* UB = (const u16*)(p.ws + WS_U1B);
  u16* H = (u16*)(p.ws + WS_H);
  for (int m = blockIdx.x * 8 + wid; m < NTOK; m += gridDim.x * 8) {
    float a[8], b[8], z[8];
    unpack8(ntload4u(OF + (size_t)m * 512 + lane * 8), a);
    unpack8(ntload4u(OBk + (size_t)m * 512 + lane * 8), b);
    unpack8(ntload4u(UB + (size_t)m * U1B_LD + C1_ZC + lane * 8), z);
    float ss = 0.f;
#pragma unroll
    for (int e = 0; e < 8; ++e) { a[e] += b[e]; ss += a[e] * a[e]; }
    ss = group16_sum(ss);
    const float rs = rsqrtf(ss * (1.f / 128.f) + EPS);
    const int li = lane & 15;
#pragma unroll
    for (int e = 0; e < 8; ++e) a[e] = a[e] * rs * p.gdn_norm[li * 8 + e] * siluf(z[e]);
    *(u32x4*)(H + (size_t)m * DM + lane * 8) = pack8f(a);
  }
}

DI float dbg_rel(const Params& p);
#ifndef DBG_CHECK
#define DBG_CHECK 0
#endif
#ifndef DBG_AMP
#define DBG_AMP 10.f
#endif
DI void phase_final(const Params& p) {
  const int tid_ = TIDX(), lane = tid_ & 63, wid = tid_ >> 6;
  const u16* GY = (const u16*)(p.ws + WS_GY1);
  float4 g4[4];
#pragma unroll
  for (int j = 0; j < 4; ++j) g4[j] = *(const float4*)(p.ln_f + (j * 64 + lane) * 4);
  const int stride = gridDim.x * 8;
  int m = blockIdx.x * 8 + wid;
  float4 cur[4], nxt[4]; u32x2 cg[4], ng[4];
  if (m < NTOK) {
#pragma unroll
    for (int j = 0; j < 4; ++j) { cur[j] = ntload4(p.out + (size_t)m * DM + (j * 64 + lane) * 4); cg[j] = ntload2u(GY + (size_t)m * DM + (j * 64 + lane) * 4); } }
  for (; m < NTOK; m += stride) {
    const int mn = m + stride;
    if (mn < NTOK) {
#pragma unroll
      for (int j = 0; j < 4; ++j) { nxt[j] = ntload4(p.out + (size_t)mn * DM + (j * 64 + lane) * 4); ng[j] = ntload2u(GY + (size_t)mn * DM + (j * 64 + lane) * 4); } }
    float ss = 0.f;
#pragma unroll
    for (int j = 0; j < 4; ++j) {
      cur[j].x += bf2f((u16)(cg[j][0] & 0xffffu)); cur[j].y += bf2f((u16)(cg[j][0] >> 16)); cur[j].z += bf2f((u16)(cg[j][1] & 0xffffu)); cur[j].w += bf2f((u16)(cg[j][1] >> 16));
      ss += cur[j].x * cur[j].x + cur[j].y * cur[j].y + cur[j].z * cur[j].z + cur[j].w * cur[j].w;
    }
    ss = wave_sum(ss);
    const float rs = rsqrtf(ss * (1.f / 1024.f) + EPS);
#pragma unroll
    for (int j = 0; j < 4; ++j)
      { typedef float nt4 __attribute__((ext_vector_type(4))); const nt4 yv = {cur[j].x * rs * g4[j].x, cur[j].y * rs * g4[j].y, cur[j].z * rs * g4[j].z, cur[j].w * rs * g4[j].w};
        __builtin_nontemporal_store(yv, (nt4*)(p.out + (size_t)m * DM + (j * 64 + lane) * 4)); }
#pragma unroll
    for (int j = 0; j < 4; ++j) { cur[j] = nxt[j]; cg[j] = ng[j]; }
  }
}

template <class F>
DI void ngemm(const GemmA A, const u16* __restrict__ Wt, int ldw, int K, int M, int N, char* lds, F f) {
  u16* sA = (u16*)lds;
  const int tid = TIDX();
  const int ncol = (N + 511) / 512;
  for (int it = blockIdx.x; it < (M / 8) * ncol; it += gridDim.x) {
    const int m0 = (it / ncol) * 8, n = (it % ncol) * 512 + tid;
    __syncthreads();
    for (int i = tid; i < 8 * (K / 8); i += NTHREADS) {
      const int r = i / (K / 8), k8 = (i % (K / 8)) * 8;
      const u16* src = k8 < A.ksplit ? A.p0 + (size_t)(m0 + r) * A.ld0 + k8 : A.p1 + (size_t)(m0 + r) * A.ld1 + (k8 - A.ksplit);
      *(u32x4*)(sA + r * K + k8) = *(const u32x4*)src;
    }
    __syncthreads();
    if (n < N) {
      float acc[8];
#pragma unroll
      for (int r = 0; r < 8; ++r) acc[r] = 0.f;
      for (int k8 = 0; k8 < K; k8 += 8) {
        float w[8]; unpack8(*(const u32x4*)(Wt + (size_t)n * ldw + k8), w);
#pragma unroll
        for (int r = 0; r < 8; ++r) {
          float a[8]; unpack8(*(const u32x4*)(sA + r * K + k8), a);
#pragma unroll
          for (int e = 0; e < 8; ++e) acc[r] += a[e] * w[e];
        }
      }
#pragma unroll
      for (int r = 0; r < 8; ++r) f(m0 + r, n, acc[r]);
    }
  }
}
DI void nphase_inproj0(const Params& p, char* lds) {
  u16* U = (u16*)(p.ws + WS_U); const u16* H = (const u16*)(p.ws + WS_H);
  ngemm(GemmA{H, DM, H, DM, 1 << 30}, (const u16*)(p.ws + WS_WT0), DM, DM, NTOK, L0C, lds, [=](int m, int n, float v) { U[(size_t)m * L0C + n] = f2bf(v); });
}
DI void nphase_l0gemms(const Params& p, char* lds) {
  const u16* U0 = (const u16*)(p.ws + WS_U); const u16* ck = (const u16*)(p.ws + WS_CKVN);
  u16* Kn = (u16*)((char*)p.out + YS_KN); u16* Vt = (u16*)((char*)p.out + YS_VTMLA); u16* Q = (u16*)((char*)p.out + YS_QMLA);
  ngemm(GemmA{ck, 256, ck, 256, 1 << 30}, (const u16*)(p.ws + WS_WUKV), 256, 256, NKROW, 1024, lds, [=](int kr, int n, float v) {
    if (n < 512) Kn[(size_t)kr * 512 + n] = f2bf(v);
    else {
      int seq, key;
      if (kr < NCTX) { seq = kr >> 8; key = kr & 255; } else { const int r = kr - NCTX; seq = 16 + r / 2560; key = r % 2560; }
      Vt[(size_t)krow0_of(seq) * 512 + (size_t)(n - 512) * cap_of(seq) + (key & ~15) + swz16(key & 15)] = f2bf(v);
    }
  });
  ngemm(GemmA{U0 + C0_CQ, L0C, U0 + C0_CQ, L0C, 1 << 30}, (const u16*)(p.ws + WS_WUQ), 384, 384, NTOK, 768, lds, [=](int m, int n, float v) { Q[(size_t)m * 768 + n] = f2bf(v); });
}
DI void nphase_qmla_rope(const Params& p) {
  u16* Q = (u16*)((char*)p.out + YS_QMLA);
  const float2* tab = (const float2*)(p.ws + WS_ROPE);
  for (size_t i = (size_t)blockIdx.x * NTHREADS + threadIdx.x; i < (size_t)(NTOK - NCTX) * 8 * 16; i += (size_t)gridDim.x * NTHREADS) {
    const int m = NCTX + (int)(i >> 7), head = (int)(i >> 4) & 7, j = (int)i & 15;
    const int pos = pos_of_tok(m), pp = (j >> 3) ? (pos & 63) : (pos >> 6);
    u16* q = Q + (size_t)m * 768 + head * 96 + 64 + (j >> 3) * 16 + (j & 7);
    const float x1 = bf2f(q[0]), x2 = bf2f(q[8]);
    const float2 cs = tab[pp * 8 + (j & 7)];
    q[0] = f2bf(x1 * cs.x - x2 * cs.y); q[8] = f2bf(x2 * cs.x + x1 * cs.y);
  }
}
DI void nphase_outproj(const Params& p, int layer, char* lds) {
  const u16* H = (const u16*)(p.ws + WS_H);
  const GemmA A{H, DM, H, DM, 1 << 30};
  const float* mod = (const float*)(p.ws + WS_MOD) + (size_t)layer * 9 * 3072 + 2048;
  const Params* pp = &p;
  ngemm(A, (const u16*)(p.ws + (layer ? WS_WO1 : WS_WO0)), DM, DM, NTOK, DM, lds, [=](int m, int n, float v) {
    const float gate = mod[(size_t)modidx_of_tok(m) * 3072 + n];
    const float xv = layer ? pp->out[(size_t)m * DM + n] : xrow(*pp, m)[n];
    pp->out[(size_t)m * DM + n] = xv + gate * v;
  });
}
DI void nphase_inproj1(const Params& p, char* lds) {
  u16* UA = (u16*)(p.ws + WS_U1A); u16* UB = (u16*)(p.ws + WS_U1B); float* AB = (float*)(p.ws + WS_AB);
  const u16* H = (const u16*)(p.ws + WS_H);
  ngemm(GemmA{H, DM, H, DM, 1 << 30}, (const u16*)(p.ws + WS_WT1), DM, DM, NTOK, L1C, lds, [=](int m, int n, float v) {
    if (n < 1536) UA[(size_t)m * U1A_LD + n] = f2bf(v);
    else if (n < 3584) UB[(size_t)m * U1B_LD + n - 1536] = f2bf(v);
    else AB[(size_t)m * 16 + n - 3584] = v;
  });
}

template <int KIND>
DI void nattn(const Params& p) {
  constexpr int DQK = KIND == 0 ? 96 : (KIND == 1 ? 64 : 128);
  constexpr int DV = KIND == 2 ? 128 : 64;
  constexpr int NH = KIND == 2 ? 4 : 8;
  constexpr float SCALE = KIND == 0 ? 0.10206207261596577f : (KIND == 1 ? 0.125f : 0.08838834764831845f);
  const int tid_ = TIDX(), lane = tid_ & 63, wid = tid_ >> 6;
  const u16* U0 = (const u16*)(p.ws + WS_U);
  u16* U1B = (u16*)(p.ws + WS_U1B);
  for (int it = blockIdx.x * 8 + wid; it < NTOK * NH; it += gridDim.x * 8) {
    const int tok = it / NH, hq = it % NH;
    const int s = seq_of_tok(tok), tok0 = tok0_of(s), kr0 = krow0_of(s), cap = cap_of(s), len = len_of(s), qi = tok - tok0;
    const bool smp = s >= 16;
    const int hkv = KIND == 0 ? hq : (KIND == 1 ? hq >> 2 : hq >> 1);
    const u16* qp; const u16* VT;
    if (KIND == 0) { qp = (const u16*)((const char*)p.out + YS_QMLA) + (size_t)tok * 768 + hq * 96; VT = (const u16*)((const char*)p.out + YS_VTMLA) + (size_t)kr0 * 512; }
    else if (KIND == 1) { qp = U0 + (size_t)tok * L0C + C0_QB + hq * 64; VT = (const u16*)(p.ws + WS_VTSWA) + (size_t)kr0 * 128; }
    else { qp = U1B + (size_t)tok * U1B_LD + C1_QD + hq * 128; VT = (const u16*)(p.ws + WS_VTATT) + (size_t)kr0 * 256; }
    const float q0 = bf2f(qp[lane]);
    float q1 = (DQK > 64 && lane + 64 < DQK) ? bf2f(qp[lane + 64]) : 0.f;
    if (KIND == 0) {
      const float q1p = __shfl_xor(q1, 8);
      if (smp && lane < 32) {
        const float2 cs = ((const float2*)(p.ws + WS_ROPE))[((lane >> 4) ? (qi & 63) : (qi >> 6)) * 8 + (lane & 7)];
        q1 = (lane & 8) ? (q1 * cs.x + q1p * cs.y) : (q1 * cs.x - q1p * cs.y);
      }
    }
    float m = -1e30f, l = 0.f, o0 = 0.f, o1 = 0.f;
    int glo = 0, ghi = cap >> 4;
    const int nseqg = len >> 4;
    for (int gidx = glo; gidx < ghi; ++gidx) {
      const int g0 = gidx * 16;
      if (KIND == 1 && smp && g0 < 2048) { if (g0 + 15 < qi - 128 || g0 > qi + 128) continue; }
      float sc[16];
#pragma unroll
      for (int j = 0; j < 16; ++j) {
        const int g = g0 + j;
        const u16* kp;
        float part;
        if (KIND == 0) {
          const u16* kn = (const u16*)((const char*)p.out + YS_KN) + ((size_t)(kr0 + g) * 8 + hkv) * 64;
          const u16* kr = (const u16*)(p.ws + WS_KROPE) + (size_t)(kr0 + g) * 32;
          part = q0 * bf2f(kn[lane]) + (lane < 32 ? q1 * bf2f(kr[lane]) : 0.f);
        } else if (KIND == 1) {
          kp = (const u16*)(p.ws + WS_KSWA) + ((size_t)(kr0 + g) * 2 + hkv) * 64;
          part = q0 * bf2f(kp[lane]);
        } else {
          kp = g < len ? U1B + (size_t)(tok0 + g) * U1B_LD + C1_KD + hkv * 128 : (const u16*)(p.ws + WS_KC) + ((size_t)((s - 16) * 512 + g - 2048) * 2 + hkv) * 128;
          part = q0 * bf2f(kp[lane]) + q1 * bf2f(kp[lane + 64]);
        }
        float sv_ = wave_sum(part) * SCALE;
        if (KIND == 1 && smp && g < 2048) { const int d = qi - g; if (d > 128 || d < -128) sv_ = -INFINITY; }
        sc[j] = sv_;
      }
      float mx = sc[0];
#pragma unroll
      for (int j = 1; j < 16; ++j) mx = fmaxf(mx, sc[j]);
      const float mnew = fmaxf(m, mx);
      const float alpha = __expf(m - mnew);
      m = mnew; l *= alpha; o0 *= alpha; o1 *= alpha;
      const u32x4 va = *(const u32x4*)(VT + (size_t)(hkv * DV + lane) * cap + g0), vb = *(const u32x4*)(VT + (size_t)(hkv * DV + lane) * cap + g0 + 8);
      float v0[16]; { float t8[8]; unpack8(va, t8); for (int e = 0; e < 8; ++e) v0[e] = t8[e]; unpack8(vb, t8); for (int e = 0; e < 8; ++e) v0[8 + e] = t8[e]; }
      float v1[16];
      if (DV > 64) {
        const u32x4 vc = *(const u32x4*)(VT + (size_t)(hkv * DV + 64 + lane) * cap + g0), vd = *(const u32x4*)(VT + (size_t)(hkv * DV + 64 + lane) * cap + g0 + 8);
        float t8[8]; unpack8(vc, t8); for (int e = 0; e < 8; ++e) v1[e] = t8[e]; unpack8(vd, t8); for (int e = 0; e < 8; ++e) v1[8 + e] = t8[e];
      }
#pragma unroll
      for (int j = 0; j < 16; ++j) {
        const float pj = __expf(sc[j] - mnew);
        l += pj;
        o0 += pj * v0[swz16(j)];
        if (DV > 64) o1 += pj * v1[swz16(j)];
      }
    }
    (void)nseqg; (void)glo;
    if (KIND == 1) l += __expf(p.swa_sink[hq] - m);
    const float inv = 1.f / l;
    if (KIND == 0) { const float z = bf2f(U0[(size_t)tok * L0C + C0_ZA + hq * 64 + lane]); ((u16*)(p.ws + WS_H))[(size_t)tok * DM + hq * 64 + lane] = f2bf(o0 * inv * siluf(z)); }
    else if (KIND == 1) { const float z = bf2f(U0[(size_t)tok * L0C + C0_ZB + hq * 64 + lane]); ((u16*)(p.ws + WS_H))[(size_t)tok * DM + 512 + hq * 64 + lane] = f2bf(o0 * inv * siluf(z)); }
    else {
      const float z0 = bf2f(U1B[(size_t)tok * U1B_LD + C1_ZD + hq * 128 + lane]), z1 = bf2f(U1B[(size_t)tok * U1B_LD + C1_ZD + hq * 128 + 64 + lane]);
      ((u16*)(p.ws + WS_H))[(size_t)tok * DM + 512 + hq * 128 + lane] = f2bf(o0 * inv * siluf(z0));
      ((u16*)(p.ws + WS_H))[(size_t)tok * DM + 512 + hq * 128 + 64 + lane] = f2bf(o1 * inv * siluf(z1));
    }
  }
}

DI void nphase_gdn(const Params& p, char* lds) {
  const int tid = TIDX();
  float* sq = (float*)lds; float* sk = sq + 128;
  const u16* QK = (const u16*)(p.ws + WS_H); const u16* VC = (const u16*)(p.ws + WS_VC); const float* GB = (const float*)(p.ws + WS_GB);
  for (int it = blockIdx.x; it < 192; it += gridDim.x) {
    int s, head, dir;
    if (it < 64) { s = 16 + (it >> 3); head = (it >> 1) & 3; dir = it & 1; } else { const int j = it - 64; s = j >> 3; head = (j >> 1) & 3; dir = j & 1; }
    const int tok0 = tok0_of(s), T = len_of(s);
    u16* O = (u16*)(p.ws + (dir ? WS_OB : WS_OF));
    float S[128];
    if (tid < 128) {
      if (s >= 16) {
        const float* st = p.c_state + ((size_t)(((s - 16) * 2 + dir) * 4 + head)) * 16384;
#pragma unroll
        for (int d = 0; d < 128; ++d) S[d] = st[d * 128 + tid];
      } else {
#pragma unroll
        for (int d = 0; d < 128; ++d) S[d] = 0.f;
      }
    }
    for (int tau = 0; tau < T; ++tau) {
      const int m = tok0 + (dir ? T - 1 - tau : tau);
      __syncthreads();
      if (tid < 128) { sq[tid] = bf2f(QK[(size_t)m * DM + head * 128 + tid]); sk[tid] = bf2f(QK[(size_t)m * DM + 512 + head * 128 + tid]); }
      __syncthreads();
      if (tid < 128) {
        const float g = GB[(size_t)m * 16 + dir * 4 + head], beta = GB[(size_t)m * 16 + 8 + dir * 4 + head];
        const float alpha = __expf(g);
        const float v = bf2f(VC[(size_t)m * 512 + head * 128 + tid]);
        float r = 0.f;
#pragma unroll
        for (int c = 0; c < 16; ++c) {
          const float4 ka = *(const float4*)(sk + c * 8), kb = *(const float4*)(sk + c * 8 + 4);
          r += ka.x * S[c * 8] + ka.y * S[c * 8 + 1] + ka.z * S[c * 8 + 2] + ka.w * S[c * 8 + 3] + kb.x * S[c * 8 + 4] + kb.y * S[c * 8 + 5] + kb.z * S[c * 8 + 6] + kb.w * S[c * 8 + 7];
          asm volatile("" ::: "memory");
        }
        const float dd = beta * (v - alpha * r);
        float o = 0.f;
#pragma unroll
        for (int c = 0; c < 16; ++c) {
          const float4 ka = *(const float4*)(sk + c * 8), kb = *(const float4*)(sk + c * 8 + 4);
          const float4 qa = *(const float4*)(sq + c * 8), qb = *(const float4*)(sq + c * 8 + 4);
          const float kk[8] = {ka.x, ka.y, ka.z, ka.w, kb.x, kb.y, kb.z, kb.w};
          const float qq[8] = {qa.x, qa.y, qa.z, qa.w, qb.x, qb.y, qb.z, qb.w};
#pragma unroll
          for (int e = 0; e < 8; ++e) { S[c * 8 + e] = alpha * S[c * 8 + e] + kk[e] * dd; o += qq[e] * S[c * 8 + e]; }
          asm volatile("" ::: "memory");
        }
        O[(size_t)m * 512 + head * 128 + tid] = f2bf(o);
      }
    }
    if (tid < 128 && s < 16) {
      float* st = p.out + O_STATE + ((size_t)((s * 2 + dir) * 4 + head)) * 16384;
#pragma unroll
      for (int d = 0; d < 128; ++d) st[d * 128 + tid] = S[d];
    }
    __syncthreads();
  }
}


DI bf16x8 afrag(const u16* base, int stride, int row, int kbase, int h) {
  const bf16x4 lo = *(const bf16x4*)(base + row * stride + kbase + 4 * h);
  const bf16x4 hi = *(const bf16x4*)(base + row * stride + kbase + 8 + 4 * h);
  return cat4(lo, hi);
}
DI void chunkprep_item(const Params& p, int cgi, char* lds) {
  const int tid0 = TIDX(), wid = tid0 >> 6, head = wid >> 1, dir = wid & 1;
  u16* tiles = (u16*)lds;
  float* vecs = (float*)(lds + 4 * 34816) + wid * 128;
  const u16* QK = (const u16*)(p.ws + WS_H); const float* GB = (const float*)(p.ws + WS_GB);
  {
    const int tok0 = cgi * 64;
    const int oz = opaque_zero();
    const int tid = TIDX() + oz, lane = tid & 63, r32 = lane & 31, h = lane >> 5;
    __syncthreads();
#pragma unroll
    for (int i = 0; i < 16; ++i) {
      const int c = tid + 512 * i, row = c >> 7, col8 = (c & 127) * 8, which = col8 >> 9, hh = (col8 >> 7) & 3, d8 = col8 & 127;
      *(u32x4*)(tiles + hh * 17408 + which * 8704 + row * 136 + d8) = *(const u32x4*)(QK + (size_t)(tok0 + row) * DM + col8);
    }
    {
      const float g = GB[(size_t)(tok0 + lane) * 16 + dir * 4 + head];
      float pre = g;
#pragma unroll
      for (int o = 1; o < 64; o <<= 1) { const float t = __shfl_up(pre, o); if (lane >= o) pre += t; }
      const float tot = __shfl(pre, 63);
      vecs[lane] = dir ? (tot - pre + g) : pre;
      vecs[64 + lane] = GB[(size_t)(tok0 + lane) * 16 + 8 + dir * 4 + head];
    }
    __syncthreads();
    const u16* sq = tiles + head * 17408; const u16* sk = sq + 8704;
    const float* gc = vecs; const float* be = vecs + 64;
    const size_t tm = ((size_t)(cgi * 4 + head) * 2 + dir) * 4096;
    u16* AM = (u16*)(p.ws + WS_AM) + tm;
    f32x16 P[2][2];
#pragma unroll 1
    for (int q4 = 0; q4 < 4; ++q4) {
      const int ib = q4 >> 1, jb = q4 & 1;
      f32x16 kk, qk, pt;
#pragma unroll
      for (int r = 0; r < 16; ++r) { kk[r] = 0.f; qk[r] = 0.f; }
#pragma unroll
      for (int s2 = 0; s2 < 8; ++s2) {
        const bf16x8 ka = *(const bf16x8*)(sk + (32 * ib + r32) * 136 + 16 * s2 + 8 * h);
        const bf16x8 kb = *(const bf16x8*)(sk + (32 * jb + r32) * 136 + 16 * s2 + 8 * h);
        const bf16x8 qb = *(const bf16x8*)(sq + (32 * jb + r32) * 136 + 16 * s2 + 8 * h);
        kk = MFMA(ka, kb, kk);
        qk = MFMA(ka, qb, qk);
      }
      const int cidx = 32 * jb + r32; const float gcol = gc[cidx], bcol = be[cidx];
#pragma unroll
      for (int g4 = 0; g4 < 4; ++g4) {
        const int b0 = 32 * ib + 8 * g4 + 4 * h;
        const float4 gv = *(const float4*)(gc + b0);
        const float gq[4] = {gv.x, gv.y, gv.z, gv.w};
        float v[4];
#pragma unroll
        for (int j = 0; j < 4; ++j) {
          const int rr = b0 + j;
          const float ea = __expf(fminf(gcol - gq[j], 0.f));
          const bool va = dir ? (rr >= cidx) : (rr <= cidx);
          const bool vs = dir ? (rr > cidx) : (rr < cidx);
          v[j] = va ? qk[4 * g4 + j] * ea : 0.f;
          pt[4 * g4 + j] = vs ? bcol * kk[4 * g4 + j] * ea : 0.f;
        }
        u32x2 w = {pack2(v[0], v[1]), pack2(v[2], v[3])};
        *(u32x2*)(AM + cidx * 64 + b0) = w;
      }
      if (q4 == 0) P[0][0] = pt; else if (q4 == 1) P[0][1] = pt; else if (q4 == 2) P[1][0] = pt; else P[1][1] = pt;
      asm volatile("" ::: "memory");
    }
    __syncthreads();
    u16* img = tiles + head * 17408 + dir * 8704;
    const int pcol = (r32 & ~15) | swz16(r32 & 15);
    f32x16 R[2][2];
#pragma unroll
    for (int I = 0; I < 2; ++I)
#pragma unroll
      for (int J = 0; J < 2; ++J)
#pragma unroll
        for (int r = 0; r < 16; ++r) R[I][J][r] = ((I == J && crow(r, h) == r32) ? 1.f : 0.f) - P[I][J][r];
#define CP_ZERO(a_, b_) (dir ? ((a_) == 0 && (b_) == 1) : ((a_) == 1 && (b_) == 0))
#define CP_IMG(T_) do { _Pragma("unroll") for (int I_ = 0; I_ < 2; ++I_) _Pragma("unroll") for (int J_ = 0; J_ < 2; ++J_) if (!CP_ZERO(I_, J_)) { \
      _Pragma("unroll") for (int r_ = 0; r_ < 16; r_ += 2) { const unsigned w_ = pack2(T_[I_][J_][r_], T_[I_][J_][r_ + 1]); \
        img[(32 * I_ + crow(r_, h)) * 72 + 32 * J_ + pcol] = (u16)(w_ & 0xffffu); img[(32 * I_ + crow(r_ + 1, h)) * 72 + 32 * J_ + pcol] = (u16)(w_ >> 16); } } } while (0)
    {
      const int zi = dir ? 0 : 1, zj = dir ? 1 : 0;
#pragma unroll
      for (int r = 0; r < 16; ++r) img[(32 * zi + crow(r, h)) * 72 + 32 * zj + pcol] = 0;
    }
    CP_IMG(P);
#pragma unroll 1
    for (int itn = 0; itn < 5; ++itn) {
#pragma unroll
      for (int J = 0; J < 2; ++J) {
        f32x16 n0, n1;
#pragma unroll
        for (int r = 0; r < 16; ++r) { n0[r] = 0.f; n1[r] = 0.f; }
#pragma unroll
        for (int K = 0; K < 2; ++K) if (!CP_ZERO(K, J)) {
#pragma unroll
          for (int s2 = 0; s2 < 2; ++s2) {
            const bf16x8 bfr = pack8(P[K][J], s2);
            if (!CP_ZERO(0, K) && !CP_ZERO(0, J)) n0 = MFMA(*(const bf16x8*)(img + r32 * 72 + 32 * K + 16 * s2 + 8 * h), bfr, n0);
            if (!CP_ZERO(1, K) && !CP_ZERO(1, J)) n1 = MFMA(*(const bf16x8*)(img + (32 + r32) * 72 + 32 * K + 16 * s2 + 8 * h), bfr, n1);
          }
        }
        P[0][J] = n0; P[1][J] = n1;
      }
      CP_IMG(P);
#pragma unroll
      for (int J = 0; J < 2; ++J) {
        f32x16 n0 = R[0][J], n1 = R[1][J];
#pragma unroll
        for (int K = 0; K < 2; ++K) if (!CP_ZERO(K, J)) {
#pragma unroll
          for (int s2 = 0; s2 < 2; ++s2) {
            const bf16x8 bfr = pack8(R[K][J], s2);
            if (!CP_ZERO(0, K) && !CP_ZERO(0, J)) n0 = MFMA(*(const bf16x8*)(img + r32 * 72 + 32 * K + 16 * s2 + 8 * h), bfr, n0);
            if (!CP_ZERO(1, K) && !CP_ZERO(1, J)) n1 = MFMA(*(const bf16x8*)(img + (32 + r32) * 72 + 32 * K + 16 * s2 + 8 * h), bfr, n1);
          }
        }
        R[0][J] = n0; R[1][J] = n1;
      }
    }
#undef CP_ZERO
#undef CP_IMG
    {
      u16* TB = (u16*)(p.ws + WS_TB) + tm;
#pragma unroll
      for (int I = 0; I < 2; ++I)
#pragma unroll
        for (int J = 0; J < 2; ++J)
#pragma unroll
          for (int g4 = 0; g4 < 4; ++g4) {
            const int b0 = 32 * I + 8 * g4 + 4 * h;
            const float4 bv = *(const float4*)(be + b0);
            u32x2 w = {pack2(R[I][J][4 * g4] * bv.x, R[I][J][4 * g4 + 1] * bv.y), pack2(R[I][J][4 * g4 + 2] * bv.z, R[I][J][4 * g4 + 3] * bv.w)};
            *(u32x2*)(TB + (32 * J + r32) * 64 + b0) = w;
          }
    }
  }
}

constexpr int CP_CNT_WORD = 4000;
DI void phase_chunkprep(const Params& p, char* lds) {
  for (int it = blockIdx.x; it < 256; it += gridDim.x) chunkprep_item(p, cp_main_chunk(it), lds);
  __syncthreads();
}
DI void chunkprep_deferred(const Params& p, char* lds) {
  const int it = (int)blockIdx.x - 64;
  if (it < 0 || it >= 64) return;
  chunkprep_item(p, cp_deferred_chunk(it), lds);
  asm volatile("s_waitcnt vmcnt(0)" ::: "memory");
  __syncthreads();
  if (threadIdx.x == 0) {
    __builtin_amdgcn_fence(__ATOMIC_RELEASE, "agent");
    asm volatile("s_waitcnt vmcnt(0)" ::: "memory");
    __hip_atomic_fetch_add((unsigned*)(p.ws + WS_BAR) + CP_CNT_WORD, 1u, __ATOMIC_RELAXED, __HIP_MEMORY_SCOPE_AGENT);
  }
  __syncthreads();
}
DI void chunkprep_wait_deferred(const Params& p, int lane) {
  unsigned* cnt = (unsigned*)(p.ws + WS_BAR) + CP_CNT_WORD;
  if (lane == 0) {
    unsigned spins = 0;
    while (__hip_atomic_load(cnt, __ATOMIC_RELAXED, __HIP_MEMORY_SCOPE_AGENT) < 64u) { __builtin_amdgcn_s_sleep(2); if (++spins > (1u << 22)) break; }
  }
  __builtin_amdgcn_fence(__ATOMIC_ACQUIRE, "agent");
  asm volatile("s_waitcnt vmcnt(0)" ::: "memory");
}
DI void phase_scan(const Params& p, char* lds) {
  const int tid0 = TIDX(), wid = tid0 >> 6;
  u16* sq = (u16*)lds; u16* sk = sq + 64 * 136; u16* skT = sk + 64 * 136; u16* sv = skT + 128 * 72; u16* sTb = sv + 64 * 136; u16* sA = sTb + 64 * 72;
  float* vec0 = (float*)(sA + 64 * 72);
  const u16* QK = (const u16*)(p.ws + WS_H); const u16* VC = (const u16*)(p.ws + WS_VC); const float* GB = (const float*)(p.ws + WS_GB);
  chunkprep_deferred(p, lds);
  for (int it = blockIdx.x; it < 192; it += gridDim.x) {
    int s, head, dir;
    if (it < 64) { s = 16 + (it >> 3); head = (it >> 1) & 3; dir = it & 1; } else { const int j = it - 64; s = j >> 3; head = (j >> 1) & 3; dir = j & 1; }
    const int tokS = tok0_of(s), nch = len_of(s) >> 6;
    __syncthreads();
    if (wid >= 4) {
      const int t2 = TIDX() - 256, lane = t2 & 63, lw = t2 >> 6;
      u32x4 R0[20], R1[20]; float g0 = 0.f, g1 = 0.f;
#define SC_LOAD(R, G, STEP) do { const int ch_ = dir ? nch - 1 - (STEP) : (STEP); const int tok0_ = tokS + ch_ * 64; \
        const size_t tm_ = ((size_t)((tok0_ >> 6) * 4 + head) * 2 + dir) * 4096; \
        _Pragma("unroll") for (int j_ = 0; j_ < 4; ++j_) { const int c_ = t2 + 256 * j_, row_ = c_ >> 4, d8_ = (c_ & 15) * 8; \
          R[j_]      = *(const u32x4*)(QK + (size_t)(tok0_ + row_) * DM + head * 128 + d8_); \
          R[4 + j_]  = *(const u32x4*)(QK + (size_t)(tok0_ + row_) * DM + 512 + head * 128 + d8_); \
          R[8 + j_]  = *(const u32x4*)(QK + (size_t)(tok0_ + lane) * DM + 512 + head * 128 + (lw * 4 + j_) * 8); \
          R[12 + j_] = *(const u32x4*)(VC + (size_t)(tok0_ + row_) * 512 + head * 128 + d8_); } \
        _Pragma("unroll") for (int j_ = 0; j_ < 2; ++j_) { const int c_ = t2 + 256 * j_; \
          R[16 + j_] = *(const u32x4*)((const u16*)(p.ws + WS_TB) + tm_ + (c_ >> 3) * 64 + (c_ & 7) * 8); \
          R[18 + j_] = *(const u32x4*)((const u16*)(p.ws + WS_AM) + tm_ + (c_ >> 3) * 64 + (c_ & 7) * 8); } \
        if (lw == 3) G = GB[(size_t)(tok0_ + lane) * 16 + dir * 4 + head]; } while (0)
#define SC_W2(BASE, STRIDE, ROW, C0, W) do { const int a_ = ((C0) >> 3) & 1, g_ = (C0) & ~15; \
        u32x2 lo_ = {(W)[0], (W)[1]}, hi_ = {(W)[2], (W)[3]}; \
        *(u32x2*)((BASE) + (ROW) * (STRIDE) + g_ + 4 * a_) = lo_; *(u32x2*)((BASE) + (ROW) * (STRIDE) + g_ + 8 + 4 * a_) = hi_; } while (0)
#define SC_WRITE1(R) do { \
        _Pragma("unroll") for (int j_ = 0; j_ < 4; ++j_) { const int c_ = t2 + 256 * j_, row_ = c_ >> 4, d8_ = (c_ & 15) * 8; \
          SC_W2(sq, 136, row_, d8_, R[j_]); SC_W2(sk, 136, row_, d8_, R[4 + j_]); \
          *(u32x4*)(sv + row_ * 136 + d8_) = R[12 + j_]; } \
        _Pragma("unroll") for (int j_ = 0; j_ < 2; ++j_) { const int c_ = t2 + 256 * j_; \
          SC_W2(sTb, 72, c_ >> 3, (c_ & 7) * 8, R[16 + j_]); SC_W2(sA, 72, c_ >> 3, (c_ & 7) * 8, R[18 + j_]); } } while (0)
#define SC_WKT(R) do { \
        _Pragma("unroll") for (int j_ = 0; j_ < 4; ++j_) { \
          { const int dd_ = (lw * 4 + j_) * 8, pos_ = (lane & ~15) + swz16(lane & 15); \
            _Pragma("unroll") for (int e_ = 0; e_ < 4; ++e_) { skT[(dd_ + 2 * e_) * 72 + pos_] = (u16)(R[8 + j_][e_] & 0xffffu); skT[(dd_ + 2 * e_ + 1) * 72 + pos_] = (u16)(R[8 + j_][e_] >> 16); } } } } while (0)
#define SC_VEC(G, PAR) do { \
        if (lw == 3) { float* vw_ = vec0 + (PAR) * 132; float pre_ = G; \
          _Pragma("unroll") for (int o_ = 1; o_ < 64; o_ <<= 1) { const float t_ = __shfl_up(pre_, o_); if (lane >= o_) pre_ += t_; } \
          const float tot_ = __shfl(pre_, 63); const float gc_ = dir ? (tot_ - pre_ + G) : pre_; \
          vw_[lane] = __expf(gc_); vw_[64 + lane] = __expf(tot_ - gc_); if (lane == 0) vw_[128] = __expf(tot_); } } while (0)
      SC_LOAD(R0, g0, 0);
      if (nch > 1) SC_LOAD(R1, g1, 1);
      SC_WRITE1(R0); SC_VEC(g0, 0);
#pragma unroll 1
      for (int step = 0; step < nch; step += 2) {
        __syncthreads();
        SC_WKT(R0);
        if (s >= 16 && step + 2 == 12) chunkprep_wait_deferred(p, lane);
        float g0n = g0;
        if (step + 2 < nch) SC_LOAD(R0, g0n, step + 2);
        __syncthreads();
        SC_WRITE1(R1); SC_VEC(g1, 1);
        __syncthreads();
        SC_WKT(R1);
        if (step + 3 < nch) SC_LOAD(R1, g1, step + 3);
        __syncthreads();
        g0 = g0n;
        if (step + 2 < nch) { SC_WRITE1(R0); SC_VEC(g0, 0); }
      }
#undef SC_LOAD
#undef SC_W2
#undef SC_WRITE1
#undef SC_WKT
#undef SC_VEC
    } else {
      const int lane = TIDX() & 63, r32 = lane & 31, h = lane >> 5;
      u16* O = (u16*)(p.ws + (dir ? WS_OB : WS_OF));
      const int e0 = 32 * wid;
      f32x16 S[4];
      if (s >= 16) {
        const float* st = p.c_state + ((size_t)(((s - 16) * 2 + dir) * 4 + head)) * 16384;
#pragma unroll
        for (int db = 0; db < 4; ++db)
#pragma unroll
          for (int r = 0; r < 16; ++r) S[db][r] = st[(32 * db + crow(r, h)) * 128 + e0 + r32];
      } else {
#pragma unroll
        for (int db = 0; db < 4; ++db)
#pragma unroll
          for (int r = 0; r < 16; ++r) S[db][r] = 0.f;
      }
#define SC_AF(BASE, STRIDE, ROW, KB) (*(const bf16x8*)((BASE) + (ROW) * (STRIDE) + (KB) + 8 * h))
#pragma unroll 1
      for (int step = 0; step < nch; ++step) {
        const int ch = dir ? nch - 1 - step : step;
        const int tok0 = tokS + ch * 64;
        const float* vec = vec0 + (step & 1) * 132;
        __syncthreads();
        f32x16 VN[2], Oa[2];
        {
          f32x16 KS[2];
#pragma unroll
          for (int ib = 0; ib < 2; ++ib)
#pragma unroll
            for (int r = 0; r < 16; ++r) { KS[ib][r] = 0.f; VN[ib][r] = 0.f; Oa[ib][r] = 0.f; }
#pragma unroll
          for (int db = 0; db < 4; ++db)
#pragma unroll
            for (int s2 = 0; s2 < 2; ++s2) {
              const bf16x8 sb = pack8(S[db], s2);
#pragma unroll
              for (int ib = 0; ib < 2; ++ib) KS[ib] = MFMA(SC_AF(sk, 136, 32 * ib + r32, 32 * db + 16 * s2), sb, KS[ib]);
#pragma unroll
              for (int ib = 0; ib < 2; ++ib) Oa[ib] = MFMA(SC_AF(sq, 136, 32 * ib + r32, 32 * db + 16 * s2), sb, Oa[ib]);
            }
#pragma unroll
          for (int ib = 0; ib < 2; ++ib)
#pragma unroll
            for (int r = 0; r < 16; ++r) {
              const int i = 32 * ib + crow(r, h);
              KS[ib][r] = bf2f(sv[i * 136 + e0 + r32]) - vec[i] * KS[ib][r];
            }
#pragma unroll
          for (int ib = 0; ib < 2; ++ib)
#pragma unroll
            for (int s2 = 0; s2 < 2; ++s2) {
              const bf16x8 xb = pack8(KS[ib], s2);
#pragma unroll
              for (int i2 = 0; i2 < 2; ++i2) VN[i2] = MFMA(SC_AF(sTb, 72, 32 * i2 + r32, 32 * ib + 16 * s2), xb, VN[i2]);
            }
        }
        {
#pragma unroll
          for (int ib = 0; ib < 2; ++ib)
#pragma unroll
            for (int r = 0; r < 16; ++r) Oa[ib][r] *= vec[32 * ib + crow(r, h)];
#pragma unroll
          for (int ib = 0; ib < 2; ++ib)
#pragma unroll
            for (int s2 = 0; s2 < 2; ++s2) {
              const bf16x8 vb = pack8(VN[ib], s2);
#pragma unroll
              for (int i2 = 0; i2 < 2; ++i2) Oa[i2] = MFMA(SC_AF(sA, 72, 32 * i2 + r32, 32 * ib + 16 * s2), vb, Oa[i2]);
            }
          __syncthreads();
#pragma unroll
          for (int ib = 0; ib < 2; ++ib) {
            u16* op_ = O + (size_t)(tok0 + 32 * ib + 4 * h) * 512 + head * 128 + e0 + r32;
#pragma unroll
            for (int r = 0; r < 16; r += 2) { const unsigned w_ = pack2(Oa[ib][r], Oa[ib][r + 1]);
              op_[(size_t)((r & 3) + 8 * (r >> 2)) * 512] = (u16)(w_ & 0xffffu); op_[(size_t)((r & 3) + 8 * (r >> 2) + 1) * 512] = (u16)(w_ >> 16); }
          }
        }
        const float eg = vec[128];
#pragma unroll
        for (int db = 0; db < 4; ++db)
#pragma unroll
          for (int r = 0; r < 16; ++r) S[db][r] *= eg;
#pragma unroll
        for (int ib = 0; ib < 2; ++ib) {
#pragma unroll
          for (int r = 0; r < 16; ++r) VN[ib][r] *= vec[64 + 32 * ib + crow(r, h)];
#pragma unroll
          for (int s2 = 0; s2 < 2; ++s2) {
            const bf16x8 vb = pack8(VN[ib], s2);
#pragma unroll
            for (int db = 0; db < 4; ++db) S[db] = MFMA(SC_AF(skT, 72, 32 * db + r32, 32 * ib + 16 * s2), vb, S[db]);
          }
        }
      }
#undef SC_AF
      if (s < 16) {
        float* st = p.out + O_STATE + ((size_t)((s * 2 + dir) * 4 + head)) * 16384;
#pragma unroll
        for (int db = 0; db < 4; ++db)
#pragma unroll
          for (int r = 0; r < 16; ++r) st[(32 * db + crow(r, h)) * 128 + e0 + r32] = S[db][r];
      }
    }
  }
  __syncthreads();
  if (gridDim.x == 256 && blockIdx.x >= 64) l1prep_t<false, true>(p, lds, (int)blockIdx.x - 64, 192);
}

#ifndef DBG_CHECK
#define DBG_CHECK 0
#endif
#ifndef DBG_AMP
#define DBG_AMP 10.f
#endif
constexpr size_t WS_DBG = WS_END + 16384;
DI void fingerprint(const Params& p, const void* buf, size_t n, bool isf32, int slot, char* lds) {
  float acc[9];
#pragma unroll
  for (int k = 0; k < 9; ++k) acc[k] = 0.f;
  for (size_t i = (size_t)blockIdx.x * NTHREADS + threadIdx.x; i < n; i += (size_t)gridDim.x * NTHREADS) {
    const float x = isf32 ? ((const float*)buf)[i] : bf2f(((const u16*)buf)[i]);
    unsigned hsh = (unsigned)i * 0x9E3779B1u; hsh ^= hsh >> 15; hsh *= 0x85EBCA77u; hsh ^= hsh >> 13;
#pragma unroll
    for (int k = 0; k < 8; ++k) acc[k] += ((hsh >> k) & 1u) ? x : -x;
    acc[8] += x * x;
  }
  float* red = (float*)lds;
  __syncthreads();
#pragma unroll
  for (int k = 0; k < 9; ++k) { const float v = wave_sum(acc[k]); if ((threadIdx.x & 63) == 0) red[(threadIdx.x >> 6) * 9 + k] = v; }
  __syncthreads();
  if (threadIdx.x < 9) {
    float v = 0.f;
    for (int w = 0; w < 8; ++w) v += red[w * 9 + threadIdx.x];
    ((float*)(p.ws + WS_DBG))[((size_t)slot * 256 + blockIdx.x) * 16 + threadIdx.x] = v;
  }
  __syncthreads();
}
DI float dbg_rel(const Params& p) {
  const float* d = (const float*)(p.ws + WS_DBG);
  float fn[9], ff[9];
#pragma unroll
  for (int k = 0; k < 9; ++k) { fn[k] = 0.f; ff[k] = 0.f; }
  for (int b = 0; b < (int)gridDim.x; ++b)
#pragma unroll
    for (int k = 0; k < 9; ++k) { fn[k] += d[((size_t)b) * 16 + k]; ff[k] += d[((size_t)256 + b) * 16 + k]; }
  float s = 0.f;
#pragma unroll
  for (int k = 0; k < 8; ++k) s += (ff[k] - fn[k]) * (ff[k] - fn[k]);
  return sqrtf(s * 0.125f / fn[8]);
}


#define XB_TMO      128
#define XB_XCNT(j)  (256  + 64 * (j))
#define XB_XSUB(j)  (1280 + 64 * (j))
#define XB_XGEN(j)  (2304 + 64 * (j))
#define XB_TOP      3328
#define XB_TOPGEN   3392
#define XCD_BAR_WORDS 3456
#define XB_SPIN_CAP (1u << 18)
#define LAS __attribute__((address_space(3)))
DI unsigned xb_ld(unsigned* p)              { return __hip_atomic_load(p, __ATOMIC_RELAXED, __HIP_MEMORY_SCOPE_AGENT); }
DI unsigned xb_add(unsigned* p, unsigned v) { return __hip_atomic_fetch_add(p, v, __ATOMIC_RELAXED, __HIP_MEMORY_SCOPE_AGENT); }
DI unsigned xb_xcc_id() { return (unsigned)__builtin_amdgcn_s_getreg((3 << 11) | 20) & 0xFu; }
#define XB_SPIN(cond, bar) do { unsigned _sp = 0; while (cond) { __builtin_amdgcn_s_sleep(1); \
    if ((++_sp & 255u) == 0u) { if (xb_ld(&(bar)[XB_TMO])) break; if (_sp > XB_SPIN_CAP) { atomicAdd(&(bar)[XB_TMO], 1u); break; } } } } while (0)
struct XcdBarrier { unsigned* bar; unsigned x; volatile LAS unsigned* st; };
DI XcdBarrier xcd_barrier_post(unsigned* bar, volatile LAS unsigned* st) {
  XcdBarrier b; b.bar = bar; b.x = xb_xcc_id(); b.st = st;
  if (threadIdx.x == 0) (void)xb_add(&bar[XB_XCNT(b.x)], 1u);
  return b;
}
DI void xcd_barrier_complete(unsigned* bar, unsigned x, unsigned& nloc, unsigned& nx) {
  const unsigned G = gridDim.x * gridDim.y * gridDim.z;
  unsigned sum, cnt, mine, sp = 0u;
  for (;;) {
    sum = 0u; cnt = 0u; mine = 0u;
#pragma unroll
    for (unsigned j = 0; j < 16; ++j) { const unsigned c = xb_ld(&bar[XB_XCNT(j)]); sum += c; cnt += (c > 0u) ? 1u : 0u; mine = (j == x) ? c : mine; }
    if (sum == G) break;
    __builtin_amdgcn_s_sleep(1);
    if ((++sp & 255u) == 0u) { if (xb_ld(&bar[XB_TMO])) break; if (sp > XB_SPIN_CAP) { atomicAdd(&bar[XB_TMO], 1u); break; } }
  }
  nloc = mine > 0u ? mine : 1u; nx = cnt > 0u ? cnt : 1u;
}
DI void xcd_barrier(const XcdBarrier& b) {
  asm volatile("s_waitcnt vmcnt(0)" ::: "memory");
  __syncthreads();
  if (threadIdx.x == 0) {
    unsigned* bar = b.bar;
    __builtin_amdgcn_s_waitcnt(0);
    unsigned nloc = b.st[0], nx = b.st[1];
    if (nloc == 0u) { xcd_barrier_complete(bar, b.x, nloc, nx); b.st[0] = nloc; b.st[1] = nx; }
    const unsigned old = xb_add(&bar[XB_XSUB(b.x)], 1u);
    const unsigned gen = old / nloc;
    if (old + 1u == (gen + 1u) * nloc) {
      __builtin_amdgcn_fence(__ATOMIC_RELEASE, "agent");
      asm volatile("s_waitcnt vmcnt(0)" ::: "memory");
      const unsigned og = xb_add(&bar[XB_TOP], 1u);
      const unsigned tg = og / nx;
      if (og + 1u == (tg + 1u) * nx) xb_add(&bar[XB_TOPGEN], 1u);
      else XB_SPIN(xb_ld(&bar[XB_TOPGEN]) == tg, bar);
      __builtin_amdgcn_fence(__ATOMIC_ACQUIRE, "agent");
      xb_add(&bar[XB_XGEN(b.x)], 1u);
      asm volatile("s_waitcnt vmcnt(0)" ::: "memory");
    } else {
      XB_SPIN(xb_ld(&bar[XB_XGEN(b.x)]) == gen, bar);
      __builtin_amdgcn_fence(__ATOMIC_ACQUIRE, "agent");
      asm volatile("s_waitcnt vmcnt(0)" ::: "memory");
    }
  }
  __syncthreads();
}

extern __shared__ __attribute__((aligned(16))) char smem[];
constexpr int LDS_BYTES = 147456;

#ifndef REPEAT
#define REPEAT 0
#endif
#ifndef FAST_MASK
#define FAST_MASK 255
#endif
DI void code_prefetch(unsigned long long code_end) {
  unsigned long long pc;
  asm volatile("s_getpc_b64 %0" : "=s"(pc));
  pc &= ~63ull;
  const unsigned rem = code_end > pc ? (unsigned)(code_end - pc) : 0u;
  const unsigned o0 = threadIdx.x * 64u, o1 = o0 + 32768u;
  const char* base = (const char*)pc;
  const int v0 = *(const volatile int*)(base + (o0 < rem ? o0 : rem));
  const int v1 = *(const volatile int*)(base + (o1 < rem ? o1 : rem));
  asm volatile("" :: "v"(v0), "v"(v1));
}
#define GSYNC() do { code_prefetch(code_end); xcd_barrier(xb); } while (0)
#define GSYNC_KB(kb) GSYNC()

#ifndef DBG_TIME
#define DBG_TIME -1
#endif
#if DBG_TIME >= 0
#define TSTAMP(i) do { if (blockIdx.x == 0 && threadIdx.x == 0) ((volatile unsigned long long*)(smem + LDS_BYTES - 512))[i] = __builtin_amdgcn_s_memrealtime(); } while (0)
#else
#define TSTAMP(i) do {} while (0)
#endif
__global__ void __launch_bounds__(NTHREADS) fwd_megakernel(Params p) {
  unsigned long long code_end; unsigned code_len;
  asm volatile("s_getpc_b64 %0\n.Lcp_base:\n\ts_mov_b32 %1, .Lcp_end-.Lcp_base" : "=s"(code_end), "=s"(code_len));
  code_end = (code_end + code_len) & ~63ull;
  cg::grid_group grid = cg::this_grid();
  char* lds = smem;
  __shared__ uint4 xb_words;
  if (threadIdx.x == 0) xb_words = make_uint4(0u, 0u, 0u, 0u);
  __syncthreads();
  XcdBarrier xb = xcd_barrier_post((unsigned*)(p.ws + WS_BAR), (volatile LAS unsigned*)&xb_words);
  TSTAMP(0);
  phase_prep(p, lds);            GSYNC(); TSTAMP(1);
  if (p.ws == nullptr) grid.sync();
  phase_adaln(p, 0);             GSYNC(); TSTAMP(2);
  phase8_layer0_gemms(p, lds, [&]() { GSYNC(); });   GSYNC(); TSTAMP(5);
  phase_attn0(p, lds, code_end); GSYNC(); TSTAMP(6);
  phase8_outproj(p, 0, lds);     prep_deferred_layer1_weights(p, lds); GSYNC(); TSTAMP(7);
  phase_adaln(p, 1);             GSYNC(); TSTAMP(8);
  phase8_inproj1(p, lds);        GSYNC(); TSTAMP(9);
  phase_l1prep(p, lds);
  if (gridDim.x == 256) { asm volatile("s_waitcnt vmcnt(0)" ::: "memory"); __syncthreads(); }
  else GSYNC();
  TSTAMP(10);
  phase_chunkprep(p, lds);       GSYNC_KB(32); TSTAMP(11);
  phase_scan(p, lds);            GSYNC_KB(24); TSTAMP(12);
  phase_gdnfinal(p);
  code_prefetch(code_end);
  phase_attn1(p, lds);           GSYNC_KB(12); TSTAMP(13);
  phase8_outproj(p, 1, lds);     GSYNC_KB(3); TSTAMP(14);
  phase_final(p);
#if DBG_TIME >= 0
  GSYNC(); TSTAMP(15);
  if (blockIdx.x == 0) {
    __syncthreads();
    const size_t offs[7] = {O_CKV, O_KROPE, O_SWAK, O_SWAV, O_STATE, O_ATTK, O_ATTV};
    volatile unsigned long long* tb = (volatile unsigned long long*)(smem + LDS_BYTES - 512);
    for (int k = 0; k < 7; ++k) {
      const int i0 = DBG_TIME + k;
      if (i0 + 1 > 15) break;
      const unsigned long long dt = tb[i0 + 1] - tb[i0];
      const int n = (int)(dt / 100ull);
      for (int e = threadIdx.x; e < n; e += NTHREADS) ((unsigned*)p.out)[offs[k] + e] = 0xAAAAAAAAu;
    }
  }
#endif
  asm volatile(".Lcp_end:");
}

extern "C" void kernel_launch(void* const* d_in, const int* in_sizes, int n_in, void* d_out, int out_size, void* d_ws, size_t ws_size, hipStream_t stream) {
  static int grid_blocks = 0;
  if (!grid_blocks) {
    int dev = 0, cus = 0, per_cu = 0;
    (void)hipGetDevice(&dev);
    (void)hipDeviceGetAttribute(&cus, hipDeviceAttributeMultiprocessorCount, dev);
    (void)hipFuncSetAttribute((const void*)fwd_megakernel, hipFuncAttributeMaxDynamicSharedMemorySize, LDS_BYTES);
    (void)hipOccupancyMaxActiveBlocksPerMultiprocessor(&per_cu, fwd_megakernel, NTHREADS, LDS_BYTES);
    if (per_cu > 1) per_cu = 1;
    grid_blocks = (cus * per_cu) & ~7;
    if (grid_blocks <= 0) { fprintf(stderr, "occupancy query failed (cus %d per_cu %d)\n", cus, per_cu); grid_blocks = 0; return; }
  }
  if (n_in != 33 || ws_size < WS_END + 65536) { fprintf(stderr, "kernel_launch: unexpected n_in %d / ws %zu\n", n_in, ws_size); return; }
  Params p{};
  const float** pp = (const float**)&p;
  for (int i = 0; i < 33; ++i) pp[i] = (const float*)d_in[i];
  p.out = (float*)d_out;
  p.ws = (char*)d_ws;
  (void)hipMemsetAsync((char*)d_ws + WS_BAR, 0, 16384, stream);
  void* args[] = {&p};
  hipError_t e = hipLaunchCooperativeKernel((void*)fwd_megakernel, dim3(grid_blocks), dim3(NTHREADS), args, LDS_BYTES, stream);
  if (e != hipSuccess) fprintf(stderr, "cooperative launch failed: %s (grid %d)\n", hipGetErrorString(e), grid_blocks);
}
```

```cpp
#include <hip/hip_runtime.h>
#include <hip/hip_cooperative_groups.h>
#include <cstdio>
#include <cstdint>
namespace cg = cooperative_groups;

#define DI __device__ __forceinline__
typedef unsigned short u16;
using bf16x8 = __attribute__((ext_vector_type(8))) short;
using bf16x4 = __attribute__((ext_vector_type(4))) short;
using f32x16 = __attribute__((ext_vector_type(16))) float;
using f32x4  = __attribute__((ext_vector_type(4))) float;
using u32x4  = __attribute__((ext_vector_type(4))) unsigned;
using u32x2  = __attribute__((ext_vector_type(2))) unsigned;

#ifndef PHASE_LIMIT
#define PHASE_LIMIT 99
#endif

constexpr int NTHREADS = 512;
constexpr int DM = 1024, NTOK = 20480, NCTX = 4096, NKROW = 24576;
constexpr int L0C = 2464, L0CP = 2560, L1C = 3600, L1CP = 3840;
constexpr int U1A_LD = 1536, U1B_LD = 2048;
constexpr int C0_CQ = 0, C0_CKV = 384, C0_KR = 640, C0_ZA = 672, C0_QB = 1184, C0_KB = 1696, C0_VB = 1824, C0_ZB = 1952;
constexpr int C1_ZC = 0, C1_QD = 512, C1_KD = 1024, C1_VD = 1280, C1_ZD = 1536;
constexpr float EPS = 1e-6f;
constexpr float LOG2E = 1.4426950408889634f;

constexpr size_t O_Y = 0;
constexpr size_t O_CKV = 20971520, O_KROPE = 22020096, O_SWAK = 22151168, O_SWAV = 22675456, O_STATE = 23199744, O_ATTK = 25296896, O_ATTV = 26345472;

constexpr size_t WS_WO1 = 0;
constexpr size_t WS_MOD = WS_WO1 + 2097152;
constexpr size_t WS_ROPE = WS_MOD + 221184;
constexpr size_t WS_W2 = WS_ROPE + 32768;
constexpr size_t WS_WT0 = WS_W2;
constexpr size_t WS_WUQ = WS_WT0 + 5242880;
constexpr size_t WS_WUKV = WS_WUQ + 589824;
constexpr size_t WS_WO0 = WS_WUKV + 524288;
constexpr size_t WS_WT1 = WS_WO0 + 2097152;
constexpr size_t WS_W2_END = WS_WT1 + 7864320;
constexpr size_t WS_VTATT = WS_W2;
constexpr size_t WS_KC = WS_VTATT + 12582912;
constexpr size_t WS_GB = WS_KC + 2097152;
static_assert(WS_GB + 1310720 <= WS_W2_END, "layer-1 reuse overflow");
constexpr size_t WS_H = WS_W2_END;
constexpr size_t WS_U = WS_H + 41943040;
constexpr size_t WS_U0X = WS_U + (size_t)NTOK * L0C * 2;
constexpr size_t WS_KSWA = WS_U0X;
constexpr size_t WS_VTSWA = WS_KSWA + 6291456;
constexpr size_t WS_CKVN = WS_VTSWA + 6291456;
constexpr size_t WS_KROPE = WS_CKVN + 12582912;
static_assert(WS_KROPE + 1572864 <= WS_U + 147456000, "layer-0 extras overflow");
constexpr size_t WS_GY0 = WS_U;
constexpr size_t WS_U1A = WS_U;
constexpr size_t WS_U1B = WS_U + 62914560;
constexpr size_t WS_GY1 = WS_U1A;
constexpr size_t WS_TB = WS_U1A;
constexpr size_t WS_AM = WS_TB + 20971520;
constexpr size_t WS_OB = WS_AM + 20971520;
constexpr size_t WS_X = WS_U + 147456000;
constexpr size_t WS_VC = WS_X;
constexpr size_t WS_OF = WS_VC + 20971520;
constexpr size_t WS_AB = WS_OF + 20971520;
constexpr size_t WS_END = WS_AB + 1310720;
static_assert(WS_END <= 268435456ull, "ws overflow");
constexpr size_t WS_BAR = WS_END;
constexpr size_t YS_QMLA = 0;
constexpr size_t YS_KN = YS_QMLA + 31457280;
constexpr size_t YS_VTMLA = YS_KN + 25165824;
static_assert(YS_VTMLA + 25165824 <= (size_t)NTOK * DM * 4, "y scratch overflow");

struct Params {
  const float *x_prompt, *x_sample, *c_ckv, *c_krope, *c_swak, *c_swav, *c_state, *c_attk, *c_attv, *c, *c_ctx;
  const float *w_mod0, *b_mod0, *ln0, *w_in0, *mla_q_norm, *w_uq, *mla_kv_norm, *w_ukv, *swa_sink, *w_out0;
  const float *w_mod1, *b_mod1, *ln1, *w_in1, *gdn_conv, *gdn_a_log, *gdn_dt_bias, *gdn_norm, *att_q_norm, *att_k_norm, *w_out1, *ln_f;
  float* out;
  char* ws;
};

DI int opaque_zero() { int z = 0; asm volatile("" : "+v"(z)); return z; }
DI int opaque_tid() { int t = (int)threadIdx.x; asm volatile("" : "+v"(t)); return t; }
#define TIDX() opaque_tid()
DI void code_prefetch(unsigned long long code_end);
DI float bf2f(u16 b) { return __uint_as_float(((unsigned)b) << 16); }
typedef float ntf4 __attribute__((ext_vector_type(4)));
DI u32x4 ntload4u(const u16* q) { return __builtin_nontemporal_load((const u32x4*)q); }
DI u32x2 ntload2u(const u16* q) { return __builtin_nontemporal_load((const u32x2*)q); }
DI float4 ntload4(const float* q) { const ntf4 v = __builtin_nontemporal_load((const ntf4*)q); return make_float4(v[0], v[1], v[2], v[3]); }
DI u16 f2bf(float x) { unsigned u = __float_as_uint(x); u += 0x7fffu + ((u >> 16) & 1u); return (u16)(u >> 16); }
typedef __bf16 hwbf16x2_t __attribute__((ext_vector_type(2)));
typedef float hwf32x2_t __attribute__((ext_vector_type(2)));
DI unsigned pack2(float lo, float hi) { const hwf32x2_t v = {lo, hi}; return __builtin_bit_cast(unsigned, __builtin_convertvector(v, hwbf16x2_t)); }
DI int crow(int reg, int h) { return (reg & 3) + 8 * (reg >> 2) + 4 * h; }
DI int swz16(int k) { return (k & ~12) | ((k & 4) << 1) | ((k & 8) >> 1); }
DI float siluf(float x) { return x * __builtin_amdgcn_rcpf(1.f + __expf(-x)); }
DI int seq_of_tok(int m) { return m < NCTX ? (m >> 8) : 16 + ((m - NCTX) >> 11); }
DI int tok0_of(int s) { return s < 16 ? s * 256 : NCTX + (s - 16) * 2048; }
DI int krow0_of(int s) { return s < 16 ? s * 256 : NCTX + (s - 16) * 2560; }
DI int cap_of(int s) { return s < 16 ? 256 : 2560; }
DI int len_of(int s) { return s < 16 ? 256 : 2048; }
DI int modidx_of_tok(int m) { return m < NCTX ? 0 : 1 + ((m - NCTX) >> 11); }
DI int krow_of_tok(int m) { return m < NCTX ? m : NCTX + ((m - NCTX) >> 11) * 2560 + ((m - NCTX) & 2047); }
DI int pos_of_tok(int m) { return m < NCTX ? (m & 255) : ((m - NCTX) & 2047); }
DI const float* xrow(const Params& p, int m) { return m < NCTX ? p.x_prompt + (size_t)m * DM : p.x_sample + (size_t)(m - NCTX) * DM; }
DI float wave_sum(float v) {
#pragma unroll
  for (int o = 32; o > 0; o >>= 1) v += __shfl_xor(v, o);
  return v;
}
DI bf16x8 pack8(const f32x16& x, int s) {
  u32x4 w = {pack2(x[8 * s + 0], x[8 * s + 1]), pack2(x[8 * s + 2], x[8 * s + 3]), pack2(x[8 * s + 4], x[8 * s + 5]), pack2(x[8 * s + 6], x[8 * s + 7])};
  return __builtin_bit_cast(bf16x8, w);
}
DI bf16x8 cat4(bf16x4 lo, bf16x4 hi) { return __builtin_shufflevector(lo, hi, 0, 1, 2, 3, 4, 5, 6, 7); }
#define MFMA(a, b, c) __builtin_amdgcn_mfma_f32_32x32x16_bf16((a), (b), (c), 0, 0, 0)

DI void transpose_tile(const float* __restrict__ W, int ldw, int k0, int srccol0, int nvalid, u16* __restrict__ Wt, int ldt, int dstrow0, char* lds) {
  u16* t = (u16*)lds;
  const int tid = TIDX(), kr = tid >> 3, cc = (tid & 7) * 8;
  float v[8];
  if (cc < nvalid) {
    const float4 a = *(const float4*)(W + (size_t)(k0 + kr) * ldw + srccol0 + cc);
    const float4 b = *(const float4*)(W + (size_t)(k0 + kr) * ldw + srccol0 + cc + 4);
    v[0] = a.x; v[1] = a.y; v[2] = a.z; v[3] = a.w; v[4] = b.x; v[5] = b.y; v[6] = b.z; v[7] = b.w;
  } else {
#pragma unroll
    for (int e = 0; e < 8; ++e) v[e] = 0.f;
  }
#pragma unroll
  for (int e = 0; e < 8; ++e) t[(cc + e) * 72 + kr] = f2bf(v[e]);
  __syncthreads();
  const int n = tid >> 3, kc = (tid & 7) * 8;
  *(bf16x8*)(Wt + (size_t)(dstrow0 + n) * ldt + k0 + kc) = *(const bf16x8*)(t + n * 72 + kc);
  __syncthreads();
}

template <int MAT>
DI void transpose_tiles4(const Params& p, int t0, char* lds) {
  constexpr int NTN = MAT == 0 ? 40 : MAT == 1 ? 12 : MAT == 2 ? 16 : MAT == 4 ? 60 : 16;
  constexpr int NKT = MAT == 1 ? 6 : MAT == 2 ? 4 : 16;
  constexpr int LDW = MAT == 0 ? L0C : MAT == 1 ? 768 : MAT == 4 ? L1C : 1024;
  constexpr int LDT = MAT == 1 ? 384 : MAT == 2 ? 256 : 1024;
  const float* W = MAT == 0 ? p.w_in0 : MAT == 1 ? p.w_uq : MAT == 2 ? p.w_ukv : MAT == 3 ? p.w_out0 : MAT == 4 ? p.w_in1 : p.w_out1;
  u16* Wt = (u16*)(p.ws + (MAT == 0 ? WS_WT0 : MAT == 1 ? WS_WUQ : MAT == 2 ? WS_WUKV : MAT == 3 ? WS_WO0 : MAT == 4 ? WS_WT1 : WS_WO1));
  const int tid = TIDX(), kr = tid >> 3, cc = (tid & 7) * 8;
  float v[4][8];
#pragma unroll
  for (int q = 0; q < 4; ++q) {
    const int t = t0 + q;
#pragma unroll
    for (int e = 0; e < 8; ++e) v[q][e] = 0.f;
    if (t < NTN * NKT) {
      const int kt = t / NTN, nt = t % NTN, n0 = nt * 64;
      int src = n0, nv = 64;
      if (MAT == 0) { nv = L0C - n0; nv = nv < 0 ? 0 : (nv > 64 ? 64 : nv); }
      if (MAT == 2) src = nt < 8 ? nt * 128 : (nt - 8) * 128 + 64;
      if (MAT == 4) { if (n0 < 1536) { src = n0; } else if (n0 < 3584) { src = n0 + 16; } else if (n0 == 3584) { src = 1536; nv = 16; } else { src = 0; nv = 0; } }
      if (cc < nv) {
        const float4 a = ntload4(W + (size_t)(kt * 64 + kr) * LDW + src + cc);
        const float4 b = ntload4(W + (size_t)(kt * 64 + kr) * LDW + src + cc + 4);
        v[q][0] = a.x; v[q][1] = a.y; v[q][2] = a.z; v[q][3] = a.w; v[q][4] = b.x; v[q][5] = b.y; v[q][6] = b.z; v[q][7] = b.w;
      }
    }
  }
#pragma unroll
  for (int q = 0; q < 4; ++q) {
    u16* tl = (u16*)lds + q * 64 * 72;
#pragma unroll
    for (int e = 0; e < 8; ++e) tl[(cc + e) * 72 + (kr ^ cc)] = f2bf(v[q][e]);
  }
  __syncthreads();
  const int n = tid >> 3, kc = (tid & 7) * 8;
#pragma unroll
  for (int q = 0; q < 4; ++q) {
    const int t = t0 + q;
    if (t < NTN * NKT) {
      const int kt = t / NTN, nt = t % NTN;
      *(bf16x8*)(Wt + (size_t)(nt * 64 + n) * LDT + kt * 64 + kc) = *(const bf16x8*)((const u16*)lds + q * 64 * 72 + n * 72 + (kc ^ (n & 56)));
    }
  }
  __syncthreads();
}

DI void vt_store16(const u16* sv, int CS, int C, u16* __restrict__ vt, size_t cap, int key16base) {
  for (int i = TIDX(); i < C * 4; i += NTHREADS) {
    const int ch = i >> 2, q = i & 3;
    u16 e[4];
#pragma unroll
    for (int j = 0; j < 4; ++j) e[j] = sv[swz16(q * 4 + j) * CS + ch];
    u32x2 w = {(unsigned)e[0] | ((unsigned)e[1] << 16), (unsigned)e[2] | ((unsigned)e[3] << 16)};
    *(u32x2*)(vt + (size_t)ch * cap + key16base + q * 4) = w;
  }
}

DI void prep_convert_item(const Params& p, int t) {
  const int tid = TIDX();
      const int e0 = tid * 8;
      if (t < 256) {
        const size_t i = (size_t)t * 4096 + e0; const int b = (int)(i >> 17), rem = (int)(i & 131071), pp = rem >> 8, cc = rem & 255;
        const float4 a = ntload4(p.c_ckv + i), b4 = ntload4(p.c_ckv + i + 4);
        u32x4 w = {pack2(a.x, a.y), pack2(a.z, a.w), pack2(b4.x, b4.y), pack2(b4.z, b4.w)};
        *(u32x4*)((u16*)(p.ws + WS_CKVN) + (size_t)(NCTX + b * 2560 + 2048 + pp) * 256 + cc) = w;
      } else if (t < 288) {
        const size_t i = (size_t)(t - 256) * 4096 + e0; const int b = (int)(i >> 14), rem = (int)(i & 16383), pp = rem >> 5, cc = rem & 31;
        const float4 a = *(const float4*)(p.c_krope + i), b4 = *(const float4*)(p.c_krope + i + 4);
        u32x4 w = {pack2(a.x, a.y), pack2(a.z, a.w), pack2(b4.x, b4.y), pack2(b4.z, b4.w)};
        *(u32x4*)((u16*)(p.ws + WS_KROPE) + (size_t)(NCTX + b * 2560 + 2048 + pp) * 32 + cc) = w;
      } else {
        const size_t i = (size_t)(t - 288) * 4096 + e0; const int b = (int)(i >> 16), rem = (int)(i & 65535), pp = rem >> 7, cc = rem & 127;
        const float4 a = ntload4(p.c_swak + i), b4 = ntload4(p.c_swak + i + 4);
        u32x4 w = {pack2(a.x, a.y), pack2(a.z, a.w), pack2(b4.x, b4.y), pack2(b4.z, b4.w)};
        *(u32x4*)((u16*)(p.ws + WS_KSWA) + (size_t)(NCTX + b * 2560 + 2048 + pp) * 128 + cc) = w;
      }
}
DI void prep_vt_item(const Params& p, int t, char* lds) {
  const int tid = TIDX();
      const int b = t >> 5, g = t & 31;
      u16* sv = (u16*)lds;
      {
        const int key = tid >> 5, c4 = (tid & 31) * 4;
        const float4 a = *(const float4*)(p.c_swav + ((size_t)(b * 512 + g * 16 + key)) * 128 + c4);
        u32x2 w = {pack2(a.x, a.y), pack2(a.z, a.w)};
        *(u32x2*)(sv + key * 136 + c4) = w;
      }
      __syncthreads();
      vt_store16(sv, 136, 128, (u16*)(p.ws + WS_VTSWA) + (size_t)krow0_of(16 + b) * 128, 2560, 2048 + g * 16);
      __syncthreads();
}
DI void phase_prep(const Params& p, char* lds) {
  const int tid = TIDX();
  constexpr int N_MOD = 192;
  constexpr int T_IN0 = 16 * 40, T_UQ = 6 * 12, T_UKV = 4 * 16, T_O0 = 256, T_IN1 = 16 * 60, T_O1 = 256;
  constexpr int N_TR = T_IN0 + T_UQ + T_UKV + T_O0 + T_IN1 + T_O1;
  constexpr int N_CV = 256 + 32 + 128;
  constexpr int N_VT = 256;
  const int N_TRQ = gridDim.x == 256 ? 258 : 562;
  const int N_ITEMS = N_MOD + N_TRQ + N_CV + N_VT + 1;
  const bool full = gridDim.x == 256;
  const int n_here = full ? 192 + 194 + 256 + 1 : N_ITEMS;
  for (int i = blockIdx.x; i < n_here; i += gridDim.x) {
    int it = i;
    if (full && i >= 386) it = i < 642 ? N_MOD + N_TRQ + (i - 386) : N_ITEMS - 1;
    if (it < N_MOD) {
      const int layer = it / 96, col0 = (it % 96) * 32;
      const float* Wm = layer ? p.w_mod1 : p.w_mod0;
      const float* bm = layer ? p.b_mod1 : p.b_mod0;
      float* sc = (float*)lds;
      float* red = sc + 9 * 1024;
      for (int i = tid; i < 9 * 1024; i += NTHREADS) {
        const int s = i >> 10, k = i & 1023;
        const float cv = s == 0 ? p.c_ctx[k] : p.c[(s - 1) * 1024 + k];
        sc[i] = siluf(cv);
      }
      __syncthreads();
      const int col = tid & 31, kg = tid >> 5;
      float acc[9];
#pragma unroll
      for (int s = 0; s < 9; ++s) acc[s] = 0.f;
      for (int kk = 0; kk < 64; ++kk) {
        const int k = kg * 64 + kk;
        const float w = __builtin_nontemporal_load(Wm + (size_t)k * 3072 + col0 + col);
#pragma unroll
        for (int s = 0; s < 9; ++s) acc[s] += sc[s * 1024 + k] * w;
      }
#pragma unroll
      for (int s = 0; s < 9; ++s) red[(kg * 9 + s) * 32 + col] = acc[s];
      __syncthreads();
      if (tid < 288) {
        const int s = tid >> 5, c2 = tid & 31;
        float a = bm[col0 + c2];
        for (int g = 0; g < 16; ++g) a += red[(g * 9 + s) * 32 + c2];
        ((float*)(p.ws + WS_MOD))[(size_t)(layer * 9 + s) * 3072 + col0 + c2] = a;
      }
      __syncthreads();
    } else if (it < N_MOD + N_TRQ) {
      int bq = it - N_MOD;
      if (bq < 160) transpose_tiles4<0>(p, bq * 4, lds);
      else if (bq < 178) transpose_tiles4<1>(p, (bq - 160) * 4, lds);
      else if (bq < 194) transpose_tiles4<2>(p, (bq - 178) * 4, lds);
      else if (bq < 258) transpose_tiles4<3>(p, (bq - 194) * 4, lds);
      else if (bq < 498) transpose_tiles4<4>(p, (bq - 258) * 4, lds);
      else transpose_tiles4<5>(p, (bq - 498) * 4, lds);
    } else if (it < N_MOD + N_TRQ + N_CV) {
      prep_convert_item(p, it - N_MOD - N_TRQ);
    } else if (it < N_MOD + N_TRQ + N_CV + N_VT) {
      prep_vt_item(p, it - N_MOD - N_TRQ - N_CV, lds);
    } else {
      float2* tab = (float2*)(p.ws + WS_ROPE);
      for (int i = tid; i < 64 * 8 + 64 * 16 + 64 * 32; i += NTHREADS) {
        int q, pos, f, j = i;
        if (j < 512) { q = 8; } else if (j < 1536) { q = 16; j -= 512; } else { q = 32; j -= 1536; }
        pos = j / q; f = j % q;
        const float inv = __builtin_amdgcn_exp2f(-(float)f / (float)q * 13.287712379549449f);
        const float rev = (float)pos * inv * 0.15915494309189535f;
        tab[i] = make_float2(__builtin_amdgcn_cosf(rev), __builtin_amdgcn_sinf(rev));
      }
    }
  }
}

DI void phase_adaln(const Params& p, int layer) {
  const int tid_ = TIDX(), lane = tid_ & 63, wid = tid_ >> 6;
  const float* ln = layer ? p.ln1 : p.ln0;
  const float* mod = (const float*)(p.ws + WS_MOD) + (size_t)layer * 9 * 3072;
  u16* H = (u16*)(p.ws + WS_H);
  const u16* GY = (const u16*)(p.ws + WS_GY0);
  float4 g4[4];
#pragma unroll
  for (int j = 0; j < 4; ++j) g4[j] = *(const float4*)(ln + (j * 64 + lane) * 4);
  const int stride = gridDim.x * 8;
  int m = blockIdx.x * 8 + wid;
  float4 cur[4], nxt[4]; u32x2 cg[4], ng[4];
  if (m < NTOK) { const float* x = xrow(p, m);
#pragma unroll
    for (int j = 0; j < 4; ++j) { cur[j] = ntload4(x + (j * 64 + lane) * 4); if (layer) cg[j] = ntload2u(GY + (size_t)m * DM + (j * 64 + lane) * 4); } }
  for (; m < NTOK; m += stride) {
    const int mn = m + stride;
    if (mn < NTOK) { const float* xn = xrow(p, mn);
#pragma unroll
      for (int j = 0; j < 4; ++j) { nxt[j] = ntload4(xn + (j * 64 + lane) * 4); if (layer) ng[j] = ntload2u(GY + (size_t)mn * DM + (j * 64 + lane) * 4); } }
    const float* md = mod + (size_t)modidx_of_tok(m) * 3072;
    float4 sh[4], sc[4];
#pragma unroll
    for (int j = 0; j < 4; ++j) { sh[j] = *(const float4*)(md + (j * 64 + lane) * 4); sc[j] = *(const float4*)(md + 1024 + (j * 64 + lane) * 4); }
    if (layer) {
#pragma unroll
      for (int j = 0; j < 4; ++j) {
        cur[j].x += bf2f((u16)(cg[j][0] & 0xffffu)); cur[j].y += bf2f((u16)(cg[j][0] >> 16)); cur[j].z += bf2f((u16)(cg[j][1] & 0xffffu)); cur[j].w += bf2f((u16)(cg[j][1] >> 16));
        { typedef float nt4 __attribute__((ext_vector_type(4))); const nt4 xv = {cur[j].x, cur[j].y, cur[j].z, cur[j].w}; __builtin_nontemporal_store(xv, (nt4*)(p.out + (size_t)m * DM + (j * 64 + lane) * 4)); }
      }
    }
    float ss = 0.f;
#pragma unroll
    for (int j = 0; j < 4; ++j) ss += cur[j].x * cur[j].x + cur[j].y * cur[j].y + cur[j].z * cur[j].z + cur[j].w * cur[j].w;
    ss = wave_sum(ss);
    const float rs = rsqrtf(ss * (1.f / 1024.f) + EPS);
#pragma unroll
    for (int j = 0; j < 4; ++j) {
      const int c = (j * 64 + lane) * 4;
      const float a0 = cur[j].x * rs * g4[j].x * (1.f + sc[j].x) + sh[j].x, a1 = cur[j].y * rs * g4[j].y * (1.f + sc[j].y) + sh[j].y;
      const float a2 = cur[j].z * rs * g4[j].z * (1.f + sc[j].z) + sh[j].z, a3 = cur[j].w * rs * g4[j].w * (1.f + sc[j].w) + sh[j].w;
      u32x2 w = {pack2(a0, a1), pack2(a2, a3)};
      *(u32x2*)(H + (size_t)m * DM + c) = w;
    }
#pragma unroll
    for (int j = 0; j < 4; ++j) { cur[j] = nxt[j]; cg[j] = ng[j]; }
  }
}

struct GemmA { const u16* p0; int ld0; const u16* p1; int ld1; int ksplit; };
constexpr int G_LDS_A = 256 * 72 * 2;
template <class Epi>
DI void gemm_tile(const GemmA A, const u16* __restrict__ B, int ldb, int K, int m0, int n0, char* lds, Epi& epi) {
  u16* sA = (u16*)lds;
  const int tid = TIDX(), lane = tid & 63, wid = tid >> 6, r32 = lane & 31, h = lane >> 5;
  const int wm = wid >> 1, wn = wid & 1;
  const int lr = tid >> 3, lc = (tid & 7) * 8;
  f32x16 acc[2][2];
#pragma unroll
  for (int i = 0; i < 2; ++i)
#pragma unroll
    for (int j = 0; j < 2; ++j)
#pragma unroll
      for (int r = 0; r < 16; ++r) acc[i][j][r] = 0.f;
  bf16x8 ra0[4], rb0[2], ra1[4], rb1[2];
  const int nk = K >> 6;
  constexpr int GBUF = 256 * 72 + 128 * 72;
#define G_LOAD(RA, RB, KT) do { const int k0_ = (KT) * 64; const u16* ap_; int lda_, kk_; \
    if (k0_ < A.ksplit) { ap_ = A.p0; lda_ = A.ld0; kk_ = k0_; } else { ap_ = A.p1; lda_ = A.ld1; kk_ = k0_ - A.ksplit; } \
    _Pragma("unroll") for (int i_ = 0; i_ < 4; ++i_) RA[i_] = *(const bf16x8*)(ap_ + (size_t)(m0 + lr + 64 * i_) * lda_ + kk_ + lc); \
    _Pragma("unroll") for (int i_ = 0; i_ < 2; ++i_) RB[i_] = *(const bf16x8*)(B + (size_t)(n0 + lr + 64 * i_) * ldb + k0_ + lc); } while (0)
#define G_WRITE(RA, RB, BUF) do { u16* a_ = sA + (BUF) * GBUF; u16* b_ = a_ + 256 * 72; \
    _Pragma("unroll") for (int i_ = 0; i_ < 4; ++i_) *(bf16x8*)(a_ + (lr + 64 * i_) * 72 + lc) = RA[i_]; \
    _Pragma("unroll") for (int i_ = 0; i_ < 2; ++i_) *(bf16x8*)(b_ + (lr + 64 * i_) * 72 + lc) = RB[i_]; } while (0)
#define G_COMPUTE(BUF) do { const u16* a_ = sA + (BUF) * GBUF; const u16* b_ = a_ + 256 * 72; \
    _Pragma("unroll") for (int ks = 0; ks < 4; ++ks) { \
      bf16x8 a0 = *(const bf16x8*)(a_ + (wm * 64 + r32) * 72 + ks * 16 + h * 8); \
      bf16x8 a1 = *(const bf16x8*)(a_ + (wm * 64 + 32 + r32) * 72 + ks * 16 + h * 8); \
      bf16x8 b0 = *(const bf16x8*)(b_ + (wn * 64 + r32) * 72 + ks * 16 + h * 8); \
      bf16x8 b1 = *(const bf16x8*)(b_ + (wn * 64 + 32 + r32) * 72 + ks * 16 + h * 8); \
      acc[0][0] = MFMA(a0, b0, acc[0][0]); acc[0][1] = MFMA(a0, b1, acc[0][1]); \
      acc[1][0] = MFMA(a1, b0, acc[1][0]); acc[1][1] = MFMA(a1, b1, acc[1][1]); } } while (0)
  __syncthreads();
  G_LOAD(ra0, rb0, 0);
  if (nk > 1) G_LOAD(ra1, rb1, 1);
  G_WRITE(ra0, rb0, 0);
  __syncthreads();
  if (nk > 2) G_LOAD(ra0, rb0, 2);
#pragma unroll 1
  for (int kt = 0; kt < nk; kt += 2) {
    G_COMPUTE(0);
    if (kt + 1 < nk) {
      G_WRITE(ra1, rb1, 1);
      __syncthreads();
      if (kt + 3 < nk) G_LOAD(ra1, rb1, kt + 3);
      G_COMPUTE(1);
      if (kt + 2 < nk) {
        G_WRITE(ra0, rb0, 0);
        __syncthreads();
        if (kt + 4 < nk) G_LOAD(ra0, rb0, kt + 4);
      }
    }
  }
#undef G_LOAD
#undef G_WRITE
#undef G_COMPUTE
#pragma unroll
  for (int i = 0; i < 2; ++i)
#pragma unroll
    for (int j = 0; j < 2; ++j) epi(acc[i][j], m0 + wm * 64 + i * 32, n0 + wn * 64 + j * 32 + r32, h);
}

struct EpiU0 {
  u16* U;
  DI void operator()(const f32x16& a, int row0, int col, int h) const {
    if (col < L0C) {
#pragma unroll
      for (int r = 0; r < 16; ++r) U[(size_t)(row0 + crow(r, h)) * L0C + col] = f2bf(a[r]);
    }
  }
};
struct EpiQmla {
  u16* Q; const float2* tab;
  DI void operator()(const f32x16& a, int f0, int tok, int h) const {
    float v[16];
#pragma unroll
    for (int r = 0; r < 16; ++r) v[r] = a[r];
    if ((f0 % 96) == 64 && tok >= NCTX) {
      const int pos = pos_of_tok(tok), prow = pos >> 6, pcol = pos & 63;
#pragma unroll
      for (int j = 0; j < 4; ++j) {
        const int fi = 4 * h + j;
        const float2 cr = tab[prow * 8 + fi], cc = tab[pcol * 8 + fi];
        const float x1 = v[j], x2 = v[4 + j];
        v[j] = x1 * cr.x - x2 * cr.y; v[4 + j] = x2 * cr.x + x1 * cr.y;
        const float y1 = v[8 + j], y2 = v[12 + j];
        v[8 + j] = y1 * cc.x - y2 * cc.y; v[12 + j] = y2 * cc.x + y1 * cc.y;
      }
    }
#pragma unroll
    for (int g = 0; g < 4; ++g) {
      u32x2 w = {pack2(v[4 * g], v[4 * g + 1]), pack2(v[4 * g + 2], v[4 * g + 3])};
      *(u32x2*)(Q + (size_t)tok * 768 + f0 + 8 * g + 4 * h) = w;
    }
  }
};
struct EpiKvexp {
  u16* Kn; u16* Vt;
  DI void operator()(const f32x16& a, int kr0, int n, int h) const {
    const int head = n >> 7, within = n & 127;
    if (within < 64) {
#pragma unroll
      for (int r = 0; r < 16; ++r) Kn[((size_t)(kr0 + crow(r, h)) * 8 + head) * 64 + within] = f2bf(a[r]);
    } else {
      int seq, key0;
      if (kr0 < NCTX) { seq = kr0 >> 8; key0 = kr0 & 255; } else { const int r = kr0 - NCTX; seq = 16 + r / 2560; key0 = r % 2560; }
      const size_t cap = cap_of(seq);
      u16* base = Vt + (size_t)krow0_of(seq) * 512 + (size_t)(head * 64 + within - 64) * cap;
#pragma unroll
      for (int g = 0; g < 4; ++g) {
        const int pos = key0 + 16 * (g >> 1) + 8 * h + 4 * (g & 1);
        u32x2 w = {pack2(a[4 * g], a[4 * g + 1]), pack2(a[4 * g + 2], a[4 * g + 3])};
        *(u32x2*)(base + pos) = w;
      }
    }
  }
};
struct EpiOut {
  const Params* p; int layer;
  DI void operator()(const f32x16& a, int row0, int col, int h) const {
    const float* mod = (const float*)(p->ws + WS_MOD) + (size_t)(layer * 9 + modidx_of_tok(row0)) * 3072 + 2048;
    const float gate = mod[col];
#pragma unroll
    for (int r = 0; r < 16; ++r) {
      const int m = row0 + crow(r, h);
      const float xv = layer ? p->out[(size_t)m * DM + col] : xrow(*p, m)[col];
      p->out[(size_t)m * DM + col] = xv + gate * a[r];
    }
  }
};
struct EpiU1 {
  u16* UA; u16* UB; float* AB;
  DI void operator()(const f32x16& a, int row0, int col, int h) const {
    if (col < 1536) {
#pragma unroll
      for (int r = 0; r < 16; ++r) UA[(size_t)(row0 + crow(r, h)) * U1A_LD + col] = f2bf(a[r]);
    } else if (col < 3584) {
#pragma unroll
      for (int r = 0; r < 16; ++r) UB[(size_t)(row0 + crow(r, h)) * U1B_LD + col - 1536] = f2bf(a[r]);
    } else if (col < 3600) {
#pragma unroll
      for (int r = 0; r < 16; ++r) AB[(size_t)(row0 + crow(r, h)) * 16 + col - 3584] = a[r];
    }
  }
};


struct XcdIter {
  int xcd, lb, nlb, per, nmin, li;
  DI XcdIter(int nmaj, int nmin_) { xcd = blockIdx.x & 7; lb = blockIdx.x >> 3; nlb = gridDim.x >> 3; per = (nmaj >> 3) * nmin_; nmin = nmin_; li = lb; }
  DI bool valid() const { return li < per; }
  DI void next() { li += nlb; }
  DI int major() const { return xcd * (per / nmin) + li / nmin; }
  DI int minor() const { return li % nmin; }
};
DI void phase_inproj0(const Params& p, char* lds) {
  EpiU0 epi{(u16*)(p.ws + WS_U)};
  const u16* H = (const u16*)(p.ws + WS_H);
  const GemmA A{H, DM, H, DM, 1 << 30};
  for (XcdIter xi(80, 20); xi.valid(); xi.next())
    gemm_tile(A, (const u16*)(p.ws + WS_WT0), DM, DM, xi.major() * 256, xi.minor() * 128, lds, epi);
}
DI void phase_l0gemms(const Params& p, char* lds) {
  const u16* U0 = (const u16*)(p.ws + WS_U);
  EpiKvexp ek{(u16*)((char*)p.out + YS_KN), (u16*)((char*)p.out + YS_VTMLA)};
  EpiQmla eq{(u16*)((char*)p.out + YS_QMLA), (const float2*)(p.ws + WS_ROPE)};
  const u16* ck = (const u16*)(p.ws + WS_CKVN);
  const u16* wq = (const u16*)(p.ws + WS_WUQ);
  const GemmA Ak{ck, 256, ck, 256, 1 << 30};
  const GemmA Aq{wq, 384, wq, 384, 1 << 30};
  for (XcdIter xi(96, 8); xi.valid(); xi.next())
    gemm_tile(Ak, (const u16*)(p.ws + WS_WUKV), 256, 256, xi.major() * 256, xi.minor() * 128, lds, ek);
  for (XcdIter xi(160, 3); xi.valid(); xi.next())
    gemm_tile(Aq, U0 + C0_CQ, L0C, 384, xi.minor() * 256, xi.major() * 128, lds, eq);
}
DI void phase_outproj(const Params& p, int layer, char* lds) {
  EpiOut epi{&p, layer};
  const u16* H = (const u16*)(p.ws + WS_H);
  const GemmA A{H, DM, H, DM, 1 << 30};
  const u16* W = (const u16*)(p.ws + (layer ? WS_WO1 : WS_WO0));
  for (XcdIter xi(80, 8); xi.valid(); xi.next())
    gemm_tile(A, W, DM, DM, xi.major() * 256, xi.minor() * 128, lds, epi);
}
DI void phase_inproj1(const Params& p, char* lds) {
  EpiU1 epi{(u16*)(p.ws + WS_U1A), (u16*)(p.ws + WS_U1B), (float*)(p.ws + WS_AB)};
  const u16* H = (const u16*)(p.ws + WS_H);
  const GemmA A{H, DM, H, DM, 1 << 30};
  for (XcdIter xi(80, 29); xi.valid(); xi.next())
    gemm_tile(A, (const u16*)(p.ws + WS_WT1), DM, DM, xi.major() * 256, xi.minor() * 128, lds, epi);
}

DI void rope8(float (&x)[8], const float (&xp)[8], const float2* tab, int q, int pp, int fi0, bool is_x2) {
#pragma unroll
  for (int e = 0; e < 8; ++e) {
    const float2 cs = tab[pp * q + fi0 + e];
    x[e] = is_x2 ? (x[e] * cs.x + xp[e] * cs.y) : (x[e] * cs.x - xp[e] * cs.y);
  }
}
DI void unpack8(const u32x4 w, float (&x)[8]) {
#pragma unroll
  for (int i = 0; i < 4; ++i) { x[2 * i] = bf2f((u16)(w[i] & 0xffffu)); x[2 * i + 1] = bf2f((u16)(w[i] >> 16)); }
}
DI u32x4 pack8f(const float (&x)[8]) { u32x4 w = {pack2(x[0], x[1]), pack2(x[2], x[3]), pack2(x[4], x[5]), pack2(x[6], x[7])}; return w; }
DI void shfl8(const float (&x)[8], float (&xp)[8], int mask) {
#pragma unroll
  for (int e = 0; e < 8; ++e) xp[e] = __shfl_xor(x[e], mask);
}

DI void phase_l0prep(const Params& p, char* lds) {
  const int tid = TIDX(), lane = tid & 63, wid = tid >> 6;
  u16* U0 = (u16*)(p.ws + WS_U);
  u16* sv = (u16*)lds;
  const float2* tabM = (const float2*)(p.ws + WS_ROPE);
  const float2* tabS = tabM + 512;
  u16* CKVN = (u16*)(p.ws + WS_CKVN); u16* KROPE = (u16*)(p.ws + WS_KROPE); u16* KSWA = (u16*)(p.ws + WS_KSWA);
  float qn[6];
#pragma unroll
  for (int j = 0; j < 3; ++j) { const float2 t = *(const float2*)(p.mla_q_norm + 128 * j + 2 * lane); qn[2 * j] = t.x; qn[2 * j + 1] = t.y; }
  const float4 kvn = *(const float4*)(p.mla_kv_norm + 4 * lane);
  for (int it = blockIdx.x; it < NTOK / 16; it += gridDim.x) {
    const int m0 = it * 16;
    const bool ctx = m0 < NCTX;
    unsigned cqw[2][3]; u32x2 ckvw[2]; u16 krw[2]; u32x4 qbw[2], kbw[2], vbw[2]; float2 csm[2]; float2 css[2][8];
#pragma unroll
    for (int tt = 0; tt < 2; ++tt) {
      const int m = m0 + wid * 2 + tt;
      const u16* row = U0 + (size_t)m * L0C;
#pragma unroll
      for (int j = 0; j < 3; ++j) cqw[tt][j] = *(const unsigned*)(row + C0_CQ + 128 * j + 2 * lane);
      ckvw[tt] = ntload2u(row + C0_CKV + 4 * lane);
      krw[tt] = row[C0_KR + (lane & 31)];
      qbw[tt] = ntload4u(row + C0_QB + lane * 8);
      kbw[tt] = ntload4u(row + C0_KB + (lane & 15) * 8);
      vbw[tt] = ntload4u(row + C0_VB + (lane & 15) * 8);
      const int pos = pos_of_tok(m), prow = pos >> 6, pcol = pos & 63;
      csm[tt] = tabM[(((lane >> 4) & 1) ? pcol : prow) * 8 + (lane & 7)];
      const int b16 = (lane & 7) >> 1, pp = (b16 >= 2) ? pcol : prow, fi0 = (lane & 1) * 8;
#pragma unroll
      for (int e = 0; e < 8; ++e) css[tt][e] = tabS[pp * 16 + fi0 + e];
    }
#pragma unroll
    for (int tt = 0; tt < 2; ++tt) {
      const int ml = wid * 2 + tt, m = m0 + ml;
      u16* row = U0 + (size_t)m * L0C;
      const int krow = krow_of_tok(m);
      {
        float lo[3], hi[3], ss = 0.f;
#pragma unroll
        for (int j = 0; j < 3; ++j) { const unsigned w = cqw[tt][j]; lo[j] = bf2f((u16)(w & 0xffffu)); hi[j] = bf2f((u16)(w >> 16)); ss += lo[j] * lo[j] + hi[j] * hi[j]; }
        ss = wave_sum(ss);
        const float rs = rsqrtf(ss * (1.f / 384.f) + EPS);
#pragma unroll
        for (int j = 0; j < 3; ++j) *(unsigned*)(row + C0_CQ + 128 * j + 2 * lane) = pack2(lo[j] * rs * qn[2 * j], hi[j] * rs * qn[2 * j + 1]);
      }
      {
        const u32x2 w = ckvw[tt];
        float x[4] = {bf2f((u16)(w[0] & 0xffffu)), bf2f((u16)(w[0] >> 16)), bf2f((u16)(w[1] & 0xffffu)), bf2f((u16)(w[1] >> 16))};
        float ss = x[0] * x[0] + x[1] * x[1] + x[2] * x[2] + x[3] * x[3];
        ss = wave_sum(ss);
        const float rs = rsqrtf(ss * (1.f / 256.f) + EPS);
        x[0] *= rs * kvn.x; x[1] *= rs * kvn.y; x[2] *= rs * kvn.z; x[3] *= rs * kvn.w;
        u32x2 o = {pack2(x[0], x[1]), pack2(x[2], x[3])};
        *(u32x2*)(CKVN + (size_t)krow * 256 + 4 * lane) = o;
        if (ctx) *(float4*)(p.out + O_CKV + (size_t)m * 256 + 4 * lane) = make_float4(x[0], x[1], x[2], x[3]);
      }
      {
        const float x = bf2f(krw[tt]);
        const float xp = __shfl_xor(x, 8);
        float val = x;
        if (!ctx) { const float2 cs = csm[tt]; val = (lane & 15) < 8 ? (x * cs.x - xp * cs.y) : (x * cs.x + xp * cs.y); }
        if (lane < 32) {
          KROPE[(size_t)krow * 32 + lane] = f2bf(val);
          if (ctx) p.out[O_KROPE + (size_t)m * 32 + lane] = x;
        }
      }
      const bool is_x2 = (((lane & 7) >> 1) & 1) != 0;
      if (!ctx) {
        float x[8], xp[8];
        unpack8(qbw[tt], x);
        shfl8(x, xp, 2);
#pragma unroll
        for (int e = 0; e < 8; ++e) { const float2 cs = css[tt][e]; x[e] = is_x2 ? (x[e] * cs.x + xp[e] * cs.y) : (x[e] * cs.x - xp[e] * cs.y); }
        *(u32x4*)(row + C0_QB + lane * 8) = pack8f(x);
      }
      {
        float x[8], xp[8];
        unpack8(kbw[tt], x);
        if (ctx && lane < 16) {
          *(float4*)(p.out + O_SWAK + (size_t)m * 128 + lane * 8) = make_float4(x[0], x[1], x[2], x[3]);
          *(float4*)(p.out + O_SWAK + (size_t)m * 128 + lane * 8 + 4) = make_float4(x[4], x[5], x[6], x[7]);
        }
        shfl8(x, xp, 2);
        if (!ctx) {
#pragma unroll
          for (int e = 0; e < 8; ++e) { const float2 cs = css[tt][e]; x[e] = is_x2 ? (x[e] * cs.x + xp[e] * cs.y) : (x[e] * cs.x - xp[e] * cs.y); }
        }
        if (lane < 16) {
          *(u32x4*)(KSWA + (size_t)krow * 128 + lane * 8) = pack8f(x);
          const u32x4 vw = vbw[tt];
          *(u32x4*)(sv + ml * 136 + lane * 8) = vw;
          if (ctx) {
            float v[8]; unpack8(vw, v);
            *(float4*)(p.out + O_SWAV + (size_t)m * 128 + lane * 8) = make_float4(v[0], v[1], v[2], v[3]);
            *(float4*)(p.out + O_SWAV + (size_t)m * 128 + lane * 8 + 4) = make_float4(v[4], v[5], v[6], v[7]);
          }
        }
      }
    }
    __syncthreads();
    {
      const int s = seq_of_tok(m0);
      vt_store16(sv, 136, 128, (u16*)(p.ws + WS_VTSWA) + (size_t)krow0_of(s) * 128, cap_of(s), pos_of_tok(m0));
    }
    __syncthreads();
  }
}

namespace pg8 {
#define PG8_LAS __attribute__((address_space(3)))
typedef unsigned short bf16_t;
typedef short bf16x8 __attribute__((ext_vector_type(8)));
typedef float f32x4 __attribute__((ext_vector_type(4)));
typedef unsigned u32x4 __attribute__((ext_vector_type(4)));
constexpr int BM = 256, BK = 64, HALF = 128, HTB = HALF * BK * 2  , STAGE_BYTES = 8 * HTB, NXCD = 8, WGM = 8;

__host__ __device__ __forceinline__ int lds_byte(int r, int c) { const int st = (r >> 4) * 2 + (c >> 5), rr = r & 15, cc = c & 31, ob = rr * 64 + cc * 2; return st * 1024 + (ob ^ (((ob >> 9) & 1) << 5)); }
__host__ __device__ __forceinline__ void stage_rc(int b, int& R, int& C) { const int st = b / 1024, sb = b % 1024, swz = sb ^ (((sb >> 9) & 1) << 5); R = (st >> 1) * 16 + swz / 64; C = (st & 1) * 32 + (swz % 64) / 2; }
__host__ __device__ __forceinline__ int perm32(int rho) { const int n = rho >> 4, i = rho & 15; return 8 * (i >> 2) + 4 * n + (i & 3); }

struct Unit { int pm, pn; };
struct Gemm { const bf16_t* A; const bf16_t* Bt; int M, N, K, lda, ldb; };

struct StaticOrder {
    int nM, nN, nwg, G, c;
    __host__ __device__ void init(int M, int N, int G_, int c_) { nM = M / BM; nN = N / BM; nwg = nM * nN; G = G_; c = c_; }
    __host__ __device__ bool next(int i, Unit& u) const {
        const long L = (long)i * G + c; if (L >= nwg) return false;
        int wgid = (int)L; { const int q = nwg / NXCD, r = nwg % NXCD, xcd = wgid % NXCD, off = wgid / NXCD; wgid = (xcd < r ? xcd * (q + 1) : r * (q + 1) + (xcd - r) * q) + off; }
        const int nig = WGM * nN, gid = wgid / nig, fm = gid * WGM, gsz = (nM - fm) < WGM ? (nM - fm) : WGM;
        u.pm = fm + ((wgid % nig) % gsz); u.pn = (wgid % nig) / gsz; return true;
    }
    __device__ __forceinline__ void a_ready(const Unit&) const {}
    __device__ __forceinline__ void done(const Unit&) const {}
};
struct Ip0Order {
    StaticOrder S9; int rt0, nwg9, ntot, G, c;
    __device__ void init(int M, int Nmain, int rt0_, int G_, int c_) { S9.init(M, Nmain, G_, c_); rt0 = rt0_; nwg9 = S9.nwg; ntot = nwg9 + (M / BM - rt0_); G = G_; c = c_; }
    __device__ bool next(int i, Unit& u) const {
        const int L = i * G + c; if (L >= ntot) return false;
        if (L < nwg9) return S9.next(i, u);
        u.pm = rt0 + (L - nwg9); u.pn = S9.nN; return true;
    }
    __device__ __forceinline__ void a_ready(const Unit&) const {}
    __device__ __forceinline__ void done(const Unit&) const {}
};
template <class Epi, class Sched, bool STAMP = false>
__device__ __forceinline__ void gemm_phase(PG8_LAS unsigned char* lds, const Gemm g, const Sched& S, const Epi& E, unsigned long long* stamps) {
    const int tid = TIDX(), wid = __builtin_amdgcn_readfirstlane(tid >> 6), lane = tid & 63, wr = wid >> 2, wc = wid & 3, fr = lane & 15, fq = lane >> 4;
    const int K = g.K, nt = K / BK;
    int ts_lo = 0, ts_hi = 0, nts = 0; const unsigned long long rt_entry = STAMP ? (unsigned long long)wall_clock64() : 0ull;
#define PG8_STAMP() do { if (STAMP && wid == 0 && nts < 64) { const unsigned long long _c = (unsigned long long)clock64(); \
        ts_lo = (lane == nts) ? (int)(unsigned)_c : ts_lo; ts_hi = (lane == nts) ? (int)(unsigned)(_c >> 32) : ts_hi; ++nts; } } while (0)
    PG8_STAMP();
    unsigned voffA[2], voffB[2];
#pragma unroll
    for (int i = 0; i < 2; ++i) { int R, C; stage_rc(tid * 16 + i * 8192, R, C); const int Rb = Epi::PERM ? ((R & ~31) + perm32(R & 31)) : R;
        voffA[i] = (unsigned)(R * g.lda + C) * 2u; voffB[i] = (unsigned)(Rb * g.ldb + C) * 2u; }
    const size_t kstep = (size_t)(BK * 2);
    const size_t hstepA = (size_t)HALF * g.lda * 2, hstepB = (size_t)HALF * g.ldb * 2;
    const size_t tstepA = 2 * hstepA, tstepB = 2 * hstepB;
    const unsigned ldsw = (unsigned)wid * 1024u;
    const int aoff = lds_byte(wr * 64 + fr, fq * 8), boff = lds_byte(wc * 32 + fr, fq * 8);
#define PG8_SA(b, h) (((b) * 2 + (h)) * HTB)
#define PG8_SB(b, h) ((4 + (b) * 2 + (h)) * HTB)
#define PG8_STAGE(bufoff, gbase, voff) do { _Pragma("unroll") for (int _i = 0; _i < 2; ++_i) \
        __builtin_amdgcn_global_load_lds((const unsigned*)((const char*)(gbase) + (voff)[_i]), (PG8_LAS unsigned*)(lds + (bufoff) + ldsw + _i * 8192), 16, 0, 0); } while (0)
#define PG8_LDA(dst, b, h) do { _Pragma("unroll") for (int m = 0; m < 4; ++m) _Pragma("unroll") for (int k = 0; k < 2; ++k) dst[m][k] = *(const PG8_LAS bf16x8*)(lds + PG8_SA(b, h) + aoff + m * 2048 + k * 1024); } while (0)
#define PG8_LDB(dst, b, h) do { _Pragma("unroll") for (int n = 0; n < 2; ++n) _Pragma("unroll") for (int k = 0; k < 2; ++k) dst[n][k] = *(const PG8_LAS bf16x8*)(lds + PG8_SB(b, h) + boff + n * 2048 + k * 1024); } while (0)
#define PG8_MMA(ai, bj, At, Bt) do { __builtin_amdgcn_s_setprio(1); _Pragma("unroll") for (int m = 0; m < 4; ++m) _Pragma("unroll") for (int n = 0; n < 2; ++n) _Pragma("unroll") for (int k = 0; k < 2; ++k) \
        acc[ai][bj][m][n] = __builtin_amdgcn_mfma_f32_16x16x32_bf16(Bt[n][k], At[m][k], acc[ai][bj][m][n], 0, 0, 0); __builtin_amdgcn_s_setprio(0); } while (0)
#define PG8_WAIT_V(n) asm volatile("s_waitcnt vmcnt(" #n ")" ::: "memory")
#define PG8_WAIT_L(n) asm volatile("s_waitcnt lgkmcnt(" #n ")" ::: "memory")
#define PG8_BAR __builtin_amdgcn_s_barrier()
#define PG8_SCHED __builtin_amdgcn_sched_barrier(0)
    Unit cur, nxt; int ui = 0;
    if (!S.next(0, cur)) return;
    f32x4 acc[2][2][4][2];
#pragma unroll
    for (int a = 0; a < 2; ++a)
#pragma unroll
        for (int b = 0; b < 2; ++b)
#pragma unroll
            for (int m = 0; m < 4; ++m)
#pragma unroll
                for (int n = 0; n < 2; ++n) acc[a][b][m][n] = (f32x4){0.f, 0.f, 0.f, 0.f};
    bf16x8 At[4][2], B0[2][2], B1[2][2];
    const char* cA = (const char*)g.A + (size_t)cur.pm * tstepA; const char* cB = (const char*)g.Bt + (size_t)cur.pn * tstepB;
    S.a_ready(cur);
    PG8_STAGE(PG8_SB(0, 0), cB, voffB); PG8_STAGE(PG8_SA(0, 0), cA, voffA); PG8_STAGE(PG8_SB(0, 1), cB + hstepB, voffB); PG8_STAGE(PG8_SA(0, 1), cA + hstepA, voffA);
    if (wr == 1) PG8_BAR;
    PG8_WAIT_V(4); PG8_BAR;
    PG8_STAGE(PG8_SB(1, 0), cB + kstep, voffB); PG8_STAGE(PG8_SA(1, 0), cA + kstep, voffA); PG8_STAGE(PG8_SB(1, 1), cB + hstepB + kstep, voffB);
    PG8_WAIT_V(6); PG8_BAR;
    PG8_STAMP();
    for (;;) {
        const bool has_next = S.next(ui + 1, nxt);
        const char* nA = has_next ? (const char*)g.A + (size_t)nxt.pm * tstepA : cA; const char* nB = has_next ? (const char*)g.Bt + (size_t)nxt.pn * tstepB : cB;
#pragma unroll 1
        for (int t = 0; t < nt; t += 2) {
            const bool last = (t == nt - 2);
            const char* a1 = cA + (size_t)(t + 1) * kstep;
            const char* a2 = last ? nA : cA + (size_t)(t + 2) * kstep; const char* b2 = last ? nB : cB + (size_t)(t + 2) * kstep;
            const char* a3 = a2 + kstep; const char* b3 = b2 + kstep;
            if (last && has_next) S.a_ready(nxt);
            PG8_LDB(B0, 0, 0); PG8_SCHED; PG8_LDA(At, 0, 0); PG8_STAGE(PG8_SA(1, 1), a1 + hstepA, voffA);
            PG8_WAIT_L(8); PG8_BAR; PG8_WAIT_L(0); PG8_MMA(0, 0, At, B0); PG8_BAR; PG8_SCHED;
            PG8_LDB(B1, 0, 1); PG8_STAGE(PG8_SB(0, 0), b2, voffB);
            PG8_BAR; PG8_WAIT_L(0); PG8_MMA(0, 1, At, B1); PG8_BAR;
            PG8_LDA(At, 0, 1); PG8_STAGE(PG8_SA(0, 0), a2, voffA);
            PG8_BAR; PG8_WAIT_L(0); PG8_MMA(1, 0, At, B0); PG8_BAR; PG8_SCHED;
            PG8_STAGE(PG8_SB(0, 1), b2 + hstepB, voffB);
            PG8_WAIT_V(6); PG8_BAR; PG8_MMA(1, 1, At, B1); PG8_BAR;
            PG8_LDB(B0, 1, 0); PG8_SCHED; PG8_LDA(At, 1, 0); PG8_STAGE(PG8_SA(0, 1), a2 + hstepA, voffA);
            PG8_WAIT_L(8); PG8_BAR; PG8_WAIT_L(0); PG8_MMA(0, 0, At, B0); PG8_BAR; PG8_SCHED;
            PG8_LDB(B1, 1, 1); PG8_STAGE(PG8_SB(1, 0), b3, voffB);
            PG8_BAR; PG8_WAIT_L(0); PG8_MMA(0, 1, At, B1); PG8_BAR;
            PG8_LDA(At, 1, 1); PG8_STAGE(PG8_SA(1, 0), a3, voffA);
            PG8_BAR; PG8_WAIT_L(0); PG8_MMA(1, 0, At, B0); PG8_BAR; PG8_SCHED;
            PG8_STAGE(PG8_SB(1, 1), b3 + hstepB, voffB);
            PG8_WAIT_V(6); PG8_BAR; PG8_MMA(1, 1, At, B1); PG8_BAR;
        }
        PG8_STAMP();
        if constexpr (!Epi::AFTER_DRAIN) { E(acc, cur, wr, wc, fr, fq); S.done(cur); }
        PG8_STAMP();
        if (!has_next) break;
#pragma unroll
        for (int a = 0; a < 2; ++a)
#pragma unroll
            for (int b = 0; b < 2; ++b)
#pragma unroll
                for (int m = 0; m < 4; ++m)
#pragma unroll
                    for (int n = 0; n < 2; ++n) acc[a][b][m][n] = (f32x4){0.f, 0.f, 0.f, 0.f};
        cur = nxt; cA = nA; cB = nB; ++ui;
    }
    PG8_WAIT_V(0);
    if (wr == 0) PG8_BAR;
    PG8_BAR;
    if constexpr (Epi::AFTER_DRAIN) { E.fused(acc, cur, wr, wc, fr, fq, lds, wid, lane); S.done(cur); }
    PG8_STAMP();
    if (STAMP && wid == 0) { stamps[lane] = lane < nts ? (((unsigned long long)(unsigned)ts_hi << 32) | (unsigned)ts_lo) : 0ull;
        if (lane == 62) stamps[62] = rt_entry; if (lane == 63) stamps[63] = (unsigned long long)wall_clock64(); }
#undef PG8_STAMP
#undef PG8_SA
#undef PG8_SB
#undef PG8_STAGE
#undef PG8_LDA
#undef PG8_LDB
#undef PG8_MMA
#undef PG8_WAIT_V
#undef PG8_WAIT_L
#undef PG8_BAR
#undef PG8_SCHED
}
}

using pg8::Unit;
typedef pg8::f32x4 (acc8_t)[2][2][4][2];
DI u32x4 pk8(const pg8::f32x4& v0, const pg8::f32x4& v1) { u32x4 w = {pack2(v0[0], v0[1]), pack2(v0[2], v0[3]), pack2(v1[0], v1[1]), pack2(v1[2], v1[3])}; return w; }
struct E8U0 { static constexpr bool PERM = true, AFTER_DRAIN = false; u16* U; int pm0, pn0;
  DI void operator()(const acc8_t& acc, const Unit& u, int wr, int wc, int fr, int fq) const {
#pragma unroll
    for (int ai = 0; ai < 2; ++ai)
#pragma unroll
      for (int m = 0; m < 4; ++m) { const size_t row = (size_t)((u.pm + pm0) * 256 + wr * 64 + ai * 128 + m * 16 + fr);
#pragma unroll
        for (int bj = 0; bj < 2; ++bj) { const int col = (u.pn + pn0) * 256 + wc * 32 + bj * 128 + 8 * fq;
          if (col < L0C) *(u32x4*)(U + row * L0C + col) = pk8(acc[ai][bj][m][0], acc[ai][bj][m][1]); } }
  } };
struct E8U1 { static constexpr bool PERM = true, AFTER_DRAIN = false; u16* UA; u16* UB; float* AB;
  DI void operator()(const acc8_t& acc, const Unit& u, int wr, int wc, int fr, int fq) const {
#pragma unroll
    for (int ai = 0; ai < 2; ++ai)
#pragma unroll
      for (int m = 0; m < 4; ++m) { const size_t row = (size_t)(u.pm * 256 + wr * 64 + ai * 128 + m * 16 + fr);
#pragma unroll
        for (int bj = 0; bj < 2; ++bj) { const int col = u.pn * 256 + wc * 32 + bj * 128 + 8 * fq;
          if (col < 1536) *(u32x4*)(UA + row * U1A_LD + col) = pk8(acc[ai][bj][m][0], acc[ai][bj][m][1]);
          else if (col < 3584) *(u32x4*)(UB + row * U1B_LD + col - 1536) = pk8(acc[ai][bj][m][0], acc[ai][bj][m][1]);
          else if (col < 3600) { *(pg8::f32x4*)(AB + row * 16 + col - 3584) = acc[ai][bj][m][0]; *(pg8::f32x4*)(AB + row * 16 + col - 3584 + 4) = acc[ai][bj][m][1]; } } }
  } };
struct E8Gy { static constexpr bool PERM = true, AFTER_DRAIN = false; u16* GY; const float* mod;
  DI void operator()(const acc8_t& acc, const Unit& u, int wr, int wc, int fr, int fq) const {
    const float* gp = mod + (size_t)modidx_of_tok(u.pm * 256) * 3072 + 2048;
#pragma unroll
    for (int bj = 0; bj < 2; ++bj) { const int col = u.pn * 256 + wc * 32 + bj * 128 + 8 * fq;
      const pg8::f32x4 g0 = *(const pg8::f32x4*)(gp + col), g1 = *(const pg8::f32x4*)(gp + col + 4);
#pragma unroll
      for (int ai = 0; ai < 2; ++ai)
#pragma unroll
        for (int m = 0; m < 4; ++m) { const size_t row = (size_t)(u.pm * 256 + wr * 64 + ai * 128 + m * 16 + fr);
          *(u32x4*)(GY + row * DM + col) = pk8(acc[ai][bj][m][0] * g0, acc[ai][bj][m][1] * g1); } }
  } };
struct E8KV { static constexpr bool PERM = true, AFTER_DRAIN = false; u16* Kn; u16* Vt;
  DI void operator()(const acc8_t& acc, const Unit& u, int wr, int wc, int fr, int fq) const {
    if (u.pn < 2) {
#pragma unroll
      for (int ai = 0; ai < 2; ++ai)
#pragma unroll
        for (int m = 0; m < 4; ++m) { const size_t row = (size_t)(u.pm * 256 + wr * 64 + ai * 128 + m * 16 + fr);
#pragma unroll
          for (int bj = 0; bj < 2; ++bj) { const int col = u.pn * 256 + wc * 32 + bj * 128 + 8 * fq;
            *(u32x4*)(Kn + row * 512 + col) = pk8(acc[ai][bj][m][0], acc[ai][bj][m][1]); } }
    } else {
      const int krt = __builtin_amdgcn_readfirstlane(u.pm * 256);
      int seq, keyt;
      if (krt < NCTX) { seq = krt >> 8; keyt = 0; } else { const int r = krt - NCTX; seq = 16 + r / 2560; keyt = r - (seq - 16) * 2560; }
      const unsigned cap = (unsigned)cap_of(seq);
      u16* base = Vt + (size_t)krow0_of(seq) * 512 + keyt;
#pragma unroll
      for (int bj = 0; bj < 2; ++bj) {
        const unsigned f0 = (unsigned)((u.pn - 2) * 256 + wc * 32 + bj * 128 + 8 * fq);
        unsigned off = f0 * cap + (unsigned)(wr * 64 + swz16(fr));
#pragma unroll
        for (int ai = 0; ai < 2; ++ai) {
#pragma unroll
          for (int m = 0; m < 4; ++m) {
#pragma unroll
            for (int t = 0; t < 4; ++t) { base[off + t * cap] = f2bf(acc[ai][bj][m][0][t]); base[off + (4 + t) * cap] = f2bf(acc[ai][bj][m][1][t]); }
            off += 16;
            asm volatile("" ::: "memory"); }
          off += 64; } }
    }
  } };
struct E8Q { static constexpr bool PERM = true, AFTER_DRAIN = false; u16* Q;
  DI void operator()(const acc8_t& acc, const Unit& u, int wr, int wc, int fr, int fq) const {
#pragma unroll
    for (int ai = 0; ai < 2; ++ai)
#pragma unroll
      for (int m = 0; m < 4; ++m) { const size_t row = (size_t)(u.pm * 256 + wr * 64 + ai * 128 + m * 16 + fr);
#pragma unroll
        for (int bj = 0; bj < 2; ++bj) { const int col = u.pn * 256 + wc * 32 + bj * 128 + 8 * fq;
          *(u32x4*)(Q + row * 768 + col) = pk8(acc[ai][bj][m][0], acc[ai][bj][m][1]); } }
  } };
template <class Epi>
DI void gemm8_sub(const u16* A, int lda, const u16* Bt, int ldb, int M, int N, int K, char* lds, const Epi& E, int G, int c) {
  int Ko = K; asm volatile("" : "+s"(Ko));
  pg8::Gemm g{A, Bt, M, N, Ko, lda, ldb};
  pg8::StaticOrder S; S.init(M, N, G, c);
  __syncthreads();
  pg8::gemm_phase<Epi, pg8::StaticOrder, false>((PG8_LAS unsigned char*)lds, g, S, E, nullptr);
  __syncthreads();
}
template <class Epi>
DI void gemm8(const u16* A, int lda, const u16* Bt, int ldb, int M, int N, int K, char* lds, const Epi& E) { gemm8_sub(A, lda, Bt, ldb, M, N, K, lds, E, (int)gridDim.x, (int)blockIdx.x); }
struct E8Gen { static constexpr bool PERM = true, AFTER_DRAIN = false; int kv; u16* base; int ld, ncols, pm0, pn0; u16* Vt;
  DI void operator()(const acc8_t& acc, const Unit& u, int wr, int wc, int fr, int fq) const {
    if (kv && u.pn >= 2) {
      const int krt = __builtin_amdgcn_readfirstlane(u.pm * 256);
      int seq, keyt;
      if (krt < NCTX) { seq = krt >> 8; keyt = 0; } else { const int r = krt - NCTX; seq = 16 + r / 2560; keyt = r - (seq - 16) * 2560; }
      const unsigned cap = (unsigned)cap_of(seq);
      u16* vb = Vt + (size_t)krow0_of(seq) * 512 + keyt;
#pragma unroll
      for (int bj = 0; bj < 2; ++bj) {
        const unsigned f0 = (unsigned)((u.pn - 2) * 256 + wc * 32 + bj * 128 + 8 * fq);
        unsigned off = f0 * cap + (unsigned)(wr * 64 + swz16(fr));
#pragma unroll
        for (int ai = 0; ai < 2; ++ai) {
#pragma unroll
          for (int m = 0; m < 4; ++m) {
#pragma unroll
            for (int t = 0; t < 4; ++t) { vb[off + t * cap] = f2bf(acc[ai][bj][m][0][t]); vb[off + (4 + t) * cap] = f2bf(acc[ai][bj][m][1][t]); }
            off += 16;
            asm volatile("" ::: "memory"); }
          off += 64; } }
    } else {
#pragma unroll
      for (int ai = 0; ai < 2; ++ai)
#pragma unroll
        for (int m = 0; m < 4; ++m) { const size_t row = (size_t)((u.pm + pm0) * 256 + wr * 64 + ai * 128 + m * 16 + fr);
#pragma unroll
          for (int bj = 0; bj < 2; ++bj) { const int col = (u.pn + pn0) * 256 + wc * 32 + bj * 128 + 8 * fq;
            if (col < ncols) *(u32x4*)(base + row * ld + col) = pk8(acc[ai][bj][m][0], acc[ai][bj][m][1]); } }
    }
  } };
constexpr int IP0_DEFER_ROWT = 32;
template <class SyncF>
DI void phase8_layer0_gemms(const Params& p, char* lds, const SyncF& gsync) {
  const bool full = gridDim.x == 256;
  const int ng = 3 + opaque_zero();
#pragma unroll 1
  for (int g = 0; g < ng; ++g) {
    const u16* A; const u16* Bt; int lda, ldb, M, Nmain, K, rt0, G, c; E8Gen E;
    u16* U = (u16*)(p.ws + WS_U);
    if (g == 0) { A = (const u16*)(p.ws + WS_H); lda = DM; Bt = (const u16*)(p.ws + WS_WT0); ldb = DM; M = NTOK; K = DM; G = (int)gridDim.x; c = (int)blockIdx.x;
      Nmain = full ? 2304 : L0CP; rt0 = full ? IP0_DEFER_ROWT : NTOK / 256; E = E8Gen{0, U, L0C, L0C, 0, 0, nullptr}; }
    else if (g == 1) { A = (const u16*)(p.ws + WS_CKVN); lda = 256; Bt = (const u16*)(p.ws + WS_WUKV); ldb = 256; M = NKROW; Nmain = 1024; K = 256; rt0 = NKROW / 256; G = (int)gridDim.x; c = (int)blockIdx.x;
      E = E8Gen{1, (u16*)((char*)p.out + YS_KN), 512, 512, 0, 0, (u16*)((char*)p.out + YS_VTMLA)}; }
    else if (!full || blockIdx.x < 224) { A = U + C0_CQ; lda = L0C; Bt = (const u16*)(p.ws + WS_WUQ); ldb = 384; M = NTOK; Nmain = 768; K = 384; rt0 = NTOK / 256;
      G = full ? 224 : (int)gridDim.x; c = full ? ((int)blockIdx.x + 96) % 224 : (int)blockIdx.x; E = E8Gen{0, (u16*)((char*)p.out + YS_QMLA), 768, 768, 0, 0, nullptr}; }
    else { A = (const u16*)(p.ws + WS_H); lda = DM; Bt = (const u16*)(p.ws + WS_WT0) + (size_t)2304 * DM; ldb = DM; M = IP0_DEFER_ROWT * 256; Nmain = 256; K = DM; rt0 = IP0_DEFER_ROWT;
      G = 32; c = (int)blockIdx.x - 224; E = E8Gen{0, U, L0C, L0C, 0, 9, nullptr}; }
    {
      int Ko = K; asm volatile("" : "+s"(Ko));
      pg8::Gemm gm{A, Bt, M, Nmain, Ko, lda, ldb};
      pg8::Ip0Order S; S.init(M, Nmain, rt0, G, c);
      __syncthreads();
      pg8::gemm_phase<E8Gen, pg8::Ip0Order, false>((PG8_LAS unsigned char*)lds, gm, S, E, nullptr);
      __syncthreads();
    }
    if (g == 0) { gsync(); phase_l0prep(p, lds); gsync(); }
  }
  if (full && blockIdx.x >= 144 && blockIdx.x < 224) {
#pragma unroll 1
    for (int j = (int)blockIdx.x - 144; j < 480; j += 80) {
      if (j < 64) transpose_tiles4<3>(p, j * 4, lds);
      else if (j < 224) prep_convert_item(p, 256 + (j - 64));
      else prep_vt_item(p, j - 224, lds);
    }
  }
}
DI void prep_deferred_layer1_weights(const Params& p, char* lds) {
  if (gridDim.x != 256 || blockIdx.x < 64) return;
  __syncthreads();
#pragma unroll 1
  for (int bq = 258 + (int)blockIdx.x - 64; bq < 562; bq += 192) {
    if (bq < 498) transpose_tiles4<4>(p, (bq - 258) * 4, lds);
    else transpose_tiles4<5>(p, (bq - 498) * 4, lds);
  }
}
DI void phase8_outproj(const Params& p, int layer, char* lds) {
  gemm8((const u16*)(p.ws + WS_H), DM, (const u16*)(p.ws + (layer ? WS_WO1 : WS_WO0)), DM, NTOK, DM, DM, lds,
        E8Gy{(u16*)(p.ws + (layer ? WS_GY1 : WS_GY0)), (const float*)(p.ws + WS_MOD) + (size_t)layer * 9 * 3072});
}
DI void phase8_inproj1(const Params& p, char* lds) {
  gemm8((const u16*)(p.ws + WS_H), DM, (const u16*)(p.ws + WS_WT1), DM, NTOK, L1CP, DM, lds, E8U1{(u16*)(p.ws + WS_U1A), (u16*)(p.ws + WS_U1B), (float*)(p.ws + WS_AB)});
}

template <int KIND, int DBGV = 0>
DI void attn_item(const Params& p, int s, int hsel, int q0, char* lds) {
  constexpr int DQK = KIND == 0 ? 96 : (KIND == 1 ? 64 : 128);
  constexpr int DV = KIND == 2 ? 128 : 64;
  constexpr int KT = KIND == 2 ? 64 : 128;
  constexpr int NKB = KT / 32;
  constexpr int KS = DQK + 8, VS = KT + 8;
  constexpr int CPR = DQK / 8;
  constexpr int VPR = KT / 8;
  constexpr int KCH = KT * CPR, NKC = (KCH + 511) / 512;
  constexpr int VCH = DV * VPR, NVC = VCH / 512;
  constexpr float SCALE = KIND == 0 ? 0.10206207261596577f : (KIND == 1 ? 0.125f : 0.08838834764831845f);
  constexpr float C = SCALE * LOG2E;
  const int tid = TIDX(), lane = tid & 63, wid = tid >> 6, r32 = lane & 31, h = lane >> 5;
  u16* sK0 = (u16*)lds;
  const int tok0 = tok0_of(s), kr0 = krow0_of(s), cap = cap_of(s), len = len_of(s);
  const bool smp = s >= 16;
  int hq, hkv, qrow0;
  if (KIND == 0) { hq = hsel; hkv = hsel; qrow0 = q0 + 32 * wid; }
  else if (KIND == 1) { hkv = hsel >> 1; hq = hkv * 4 + (hsel & 1) * 2 + (wid >> 2); qrow0 = q0 + 32 * (wid & 3); }
  else { hkv = hsel; hq = hkv * 2 + (wid >> 2); qrow0 = q0 + 32 * (wid & 3); }
  const int tok = tok0 + qrow0 + r32;
  const u16* U0 = (const u16*)(p.ws + WS_U);
  u16* U1B = (u16*)(p.ws + WS_U1B);
  const u16* qp;
  if (KIND == 0) qp = (const u16*)((const char*)p.out + YS_QMLA) + (size_t)tok * 768 + hq * 96 + h * 8;
  else if (KIND == 1) qp = U0 + (size_t)tok * L0C + C0_QB + hq * 64 + h * 8;
  else qp = U1B + (size_t)tok * U1B_LD + C1_QD + hq * 128 + h * 8;
  bf16x8 qf[DQK / 16];
#pragma unroll
  for (int d0 = 0; d0 < DQK / 16; ++d0) qf[d0] = *(const bf16x8*)(qp + d0 * 16);
  if (KIND == 0 && smp) {
    const float2* tabM = (const float2*)(p.ws + WS_ROPE);
    const int qpos = qrow0 + r32;
#pragma unroll
    for (int d0 = 4; d0 < 6; ++d0) {
      float x[8], xp[8];
      unpack8(__builtin_bit_cast(u32x4, qf[d0 < DQK / 16 ? d0 : 0]), x);
      shfl8(x, xp, 32);
      rope8(x, xp, tabM, 8, d0 == 4 ? (qpos >> 6) : (qpos & 63), 0, h != 0);
      if (d0 < DQK / 16) qf[d0 < DQK / 16 ? d0 : 0] = __builtin_bit_cast(bf16x8, pack8f(x));
    }
  }
  int nwin = 0, wlo = 0, nt = cap / KT;
  if (KIND == 1 && smp) { wlo = q0 - 128 < 0 ? 0 : q0 - 128; const int whi = q0 + 256 > 2048 ? 2048 : q0 + 256; nwin = (whi - wlo) / KT; nt = nwin + 512 / KT; }
  const u16* Kn = (const u16*)((const char*)p.out + YS_KN);
  const u16* KR = (const u16*)(p.ws + WS_KROPE);
  const u16* KSW = (const u16*)(p.ws + WS_KSWA);
  const u16* KCc = (const u16*)(p.ws + WS_KC);
  const u16* VT;
  if (KIND == 0) VT = (const u16*)((const char*)p.out + YS_VTMLA) + (size_t)kr0 * 512;
  else if (KIND == 1) VT = (const u16*)(p.ws + WS_VTSWA) + (size_t)kr0 * 128;
  else VT = (const u16*)(p.ws + WS_VTATT) + (size_t)kr0 * 256;
  bf16x8 rk[NKC], rv[NVC];
  int kkey[NKC], kd[NKC];
#pragma unroll
  for (int i = 0; i < NKC; ++i) { const int c = tid + 512 * i; kkey[i] = c / CPR; kd[i] = (c % CPR) * 8; }
  auto kt0_of = [&](int t) -> int { return (KIND == 1 && smp) ? (t < nwin ? wlo + KT * t : 2048 + KT * (t - nwin)) : KT * t; };
  auto gload = [&](int t) {
    const int kt0 = (DBGV == 2) ? 0 : kt0_of(t);
#pragma unroll
    for (int i = 0; i < NKC; ++i) {
      if (tid + 512 * i < KCH) {
        const int g = kt0 + kkey[i], d = kd[i];
        const u16* src;
        if (KIND == 0) src = d < 64 ? Kn + ((size_t)(kr0 + g) * 8 + hkv) * 64 + d : KR + (size_t)(kr0 + g) * 32 + (d - 64);
        else if (KIND == 1) src = KSW + ((size_t)(kr0 + g) * 2 + hkv) * 64 + d;
        else src = g < len ? U1B + (size_t)(tok0 + g) * U1B_LD + C1_KD + hkv * 128 + d : KCc + ((size_t)((s - 16) * 512 + g - 2048) * 2 + hkv) * 128 + d;
        rk[i] = *(const bf16x8*)src;
      }
    }
#pragma unroll
    for (int i = 0; i < NVC; ++i) {
      const int c = tid + 512 * i, dv = c / VPR, kc = c % VPR;
      rv[i] = *(const bf16x8*)(VT + (size_t)(hkv * DV + dv) * cap + kt0 + kc * 8);
    }
  };
  auto swrite = [&](int buf) {
    u16* sK = sK0 + buf * (KT * KS + DV * VS); u16* sV = sK + KT * KS;
#pragma unroll
    for (int i = 0; i < NKC; ++i) if (tid + 512 * i < KCH) *(bf16x8*)(sK + kkey[i] * KS + kd[i]) = rk[i];
#pragma unroll
    for (int i = 0; i < NVC; ++i) { const int c = tid + 512 * i; *(bf16x8*)(sV + (c / VPR) * VS + (c % VPR) * 8) = rv[i]; }
  };
  f32x16 o[DV / 32];
#pragma unroll
  for (int db = 0; db < DV / 32; ++db)
#pragma unroll
    for (int r = 0; r < 16; ++r) o[db][r] = 0.f;
  float m = -1e30f, l = 0.f;
  constexpr int ABUF = KT * KS + DV * VS;
  constexpr int ND = DQK / 16, NB = DV / 32;
#define SBAR() __builtin_amdgcn_sched_barrier(0)
  __syncthreads();
  gload(0); swrite(0);
  if (nt > 1) { gload(1); swrite(1); }
  __syncthreads();
  if (nt > 2) gload(2);
  int bcur = 0;
#pragma unroll 1
  for (int t = 0; t < nt; ++t) {
    const int bnxt = bcur == 2 ? 0 : bcur + 1, bnn = bnxt == 2 ? 0 : bnxt + 1;
    const u16* sK = sK0 + bcur * ABUF; const u16* sV = sK + KT * KS;
    f32x16 sc[NKB];
#pragma unroll
    for (int kb = 0; kb < NKB; ++kb)
#pragma unroll
      for (int r = 0; r < 16; ++r) sc[kb][r] = 0.f;
    constexpr int BS = NKB == 4 ? 1 : (ND <= 4 ? 2 : 3), NBK = (ND + BS - 1) / BS;
    bf16x8 kf[NBK][NKB * BS];
#pragma unroll
    for (int i = 0; i < BS; ++i)
#pragma unroll
      for (int kb = 0; kb < NKB; ++kb) kf[0][NKB * i + kb] = *(const bf16x8*)(sK + (32 * kb + r32) * KS + i * 16 + h * 8);
    SBAR();
    constexpr int NVG = NB * NKB / 2;
    bf16x8 vf[2][4];
#pragma unroll
    for (int bk = 0; bk < NBK; ++bk) {
      if (bk + 1 < NBK) {
#pragma unroll
        for (int i = 0; i < BS; ++i) { const int d0 = (bk + 1) * BS + i;
          if (d0 < ND) {
#pragma unroll
            for (int kb = 0; kb < NKB; ++kb) kf[bk + 1 < NBK ? bk + 1 : 0][NKB * i + kb] = *(const bf16x8*)(sK + (32 * kb + r32) * KS + d0 * 16 + h * 8); } }
      } else {
#pragma unroll
        for (int q = 0; q < 4; ++q) vf[0][q] = *(const bf16x8*)(sV + r32 * VS + h * 8 + 16 * q);
      }
      SBAR();
#pragma unroll
      for (int i = 0; i < BS; ++i) { const int d0 = bk * BS + i; if (d0 < ND) {
#pragma unroll
        for (int kb = 0; kb < NKB; ++kb) sc[kb] = MFMA(kf[bk][NKB * i + kb], qf[d0 < ND ? d0 : 0], sc[kb]); } }
      SBAR();
    }
    if (KIND == 1 && smp && t < nwin) {
      const int kt0 = kt0_of(t), qi = qrow0 + r32;
#pragma unroll
      for (int kb = 0; kb < NKB; ++kb)
#pragma unroll
        for (int r = 0; r < 16; ++r) { const int d0 = qi - (kt0 + 32 * kb + crow(r, h)); sc[kb][r] = (d0 <= 128 && d0 >= -128) ? sc[kb][r] : -INFINITY; }
    }
    float mx = sc[0][0];
#pragma unroll
    for (int kb = 0; kb < NKB; ++kb)
#pragma unroll
      for (int r = 0; r < 16; ++r) mx = fmaxf(mx, sc[kb][r]);
    { auto rr = __builtin_amdgcn_permlane32_swap(__float_as_uint(mx), __float_as_uint(mx), false, false);
      mx = fmaxf(__uint_as_float(rr[0]), __uint_as_float(rr[1])); }
    const float mnew = fmaxf(m, mx * C);
    const float alpha = __builtin_amdgcn_exp2f(m - mnew);
    m = mnew;
    float ps = 0.f;
#pragma unroll
    for (int kb = 0; kb < NKB; ++kb)
#pragma unroll
      for (int r = 0; r < 16; ++r) { sc[kb][r] = __builtin_amdgcn_exp2f(sc[kb][r] * C - mnew); ps += sc[kb][r]; }
    l = l * alpha + ps;
#pragma unroll
    for (int db = 0; db < NB; ++db)
#pragma unroll
      for (int r = 0; r < 16; ++r) o[db][r] *= alpha;
    bf16x8 pf[2 * NKB];
#pragma unroll
    for (int kb = 0; kb < NKB; ++kb) { pf[2 * kb] = pack8(sc[kb], 0); pf[2 * kb + 1] = pack8(sc[kb], 1); }
    SBAR();
#pragma unroll
    for (int g = 0; g < NVG; ++g) {
      if (g + 1 < NVG) {
        const int db1 = (g + 1) / (NKB / 2), kq1 = ((g + 1) % (NKB / 2)) * 4;
#pragma unroll
        for (int q = 0; q < 4; ++q) vf[(g + 1) & 1][q] = *(const bf16x8*)(sV + (db1 * 32 + r32) * VS + h * 8 + 16 * (kq1 + q));
      }
      SBAR();
      const int db = g / (NKB / 2), kq = (g % (NKB / 2)) * 4;
      o[db] = MFMA(vf[g & 1][0], pf[kq], o[db]); o[db] = MFMA(vf[g & 1][1], pf[kq + 1], o[db]); o[db] = MFMA(vf[g & 1][2], pf[kq + 2], o[db]); o[db] = MFMA(vf[g & 1][3], pf[kq + 3], o[db]);
      SBAR();
    }
    if (t + 2 < nt) {
      swrite(bnn);
      __syncthreads();
      if (t + 3 < nt) gload(t + 3);
    }
    bcur = bnxt;
  }
#undef SBAR
  float lt = l + __shfl_xor(l, 32);
  if (KIND == 1) lt += __builtin_amdgcn_exp2f(p.swa_sink[hq] * LOG2E - m);
  const float inv = 1.f / lt;
  const u16* zp; u16* op;
  if (KIND == 0) { zp = U0 + (size_t)tok * L0C + C0_ZA + hq * 64; op = (u16*)(p.ws + WS_H) + (size_t)tok * DM + hq * 64; }
  else if (KIND == 1) { zp = U0 + (size_t)tok * L0C + C0_ZB + hq * 64; op = (u16*)(p.ws + WS_H) + (size_t)tok * DM + 512 + hq * 64; }
  else { zp = U1B + (size_t)tok * U1B_LD + C1_ZD + hq * 128; op = (u16*)(p.ws + WS_H) + (size_t)tok * DM + 512 + hq * 128; }
#pragma unroll
  for (int db = 0; db < DV / 32; ++db)
#pragma unroll
    for (int g = 0; g < 4; ++g) {
      const int dv = db * 32 + 8 * g + 4 * h;
      const u32x2 zw = *(const u32x2*)(zp + dv);
      const float z0 = bf2f((u16)(zw[0] & 0xffffu)), z1 = bf2f((u16)(zw[0] >> 16)), z2 = bf2f((u16)(zw[1] & 0xffffu)), z3 = bf2f((u16)(zw[1] >> 16));
      u32x2 w = {pack2(o[db][4 * g] * inv * siluf(z0), o[db][4 * g + 1] * inv * siluf(z1)), pack2(o[db][4 * g + 2] * inv * siluf(z2), o[db][4 * g + 3] * inv * siluf(z3))};
      if (DBGV == 0) *(u32x2*)(op + dv) = w; else asm volatile("" :: "v"(w[0]), "v"(w[1]));
    }
  __syncthreads();
}

DI void phase_attn0(const Params& p, char* lds, unsigned long long code_end) {
#pragma unroll 1
  for (int it = blockIdx.x; it < 1280; it += gridDim.x) {
    const int x = it & 7;
    int kind, s, hs, q0;
    if (it < 512) { const int j = it >> 3; const int pr = (j & 7) * 8 + x, qb = j >> 3; kind = 0; s = 16 + (pr >> 3); hs = pr & 7; q0 = qb * 256; }
    else if (it < 1024) { const int j = (it - 512) >> 3; const int pr = (j & 1) * 8 + x, sub = j >> 1;
      kind = 1; s = 16 + (pr >> 1); hs = (pr & 1) * 2 + (sub & 1); q0 = (sub >> 1) * 128; }
    else if (it < 1152) { const int j = it - 1024; kind = 0; s = j >> 3; hs = j & 7; q0 = 0; }
    else { const int j = it - 1152; kind = 1; s = j >> 3; hs = (j & 7) >> 1; q0 = (j & 1) * 128; }
    if (it >= 512 && it < 768) code_prefetch(code_end);
    if (kind == 0) attn_item<0>(p, s, hs, q0, lds); else attn_item<1>(p, s, hs, q0, lds);
  }
}
template <int DBGV>
DI void phase_attn1_t(const Params& p, char* lds) {
#pragma unroll 1
  for (int it = blockIdx.x; it < 320; it += gridDim.x) {
    const int x = it & 7;
    int s, hs, q0;
    if (it < 256) { const int j = it >> 3; const int pr = (j & 1) * 8 + x, qb = j >> 1; s = 16 + (pr >> 1); hs = pr & 1; q0 = qb * 128; }
    else { const int j = it - 256; s = j >> 2; hs = (j & 3) >> 1; q0 = (j & 1) * 128; }
    attn_item<2, DBGV>(p, s, hs, q0, lds);
  }
}
DI void phase_attn1(const Params& p, char* lds) { phase_attn1_t<0>(p, lds); }

DI float group16_sum(float v) {
#pragma unroll
  for (int o = 8; o > 0; o >>= 1) v += __shfl_xor(v, o);
  return v;
}
template <bool GDN, bool ATT>
DI void l1prep_t(const Params& p, char* lds, int rank, int nblk) {
  const int tid = TIDX(), lane = tid & 63, wid = tid >> 6;
  const u16* UA = (const u16*)(p.ws + WS_U1A);
  u16* UB = (u16*)(p.ws + WS_U1B);
  u16* QK = (u16*)(p.ws + WS_H);
  u16* VC = (u16*)(p.ws + WS_VC);
  float* GB = (float*)(p.ws + WS_GB);
  const float* AB = (const float*)(p.ws + WS_AB);
  const float2* tabA = (const float2*)(p.ws + WS_ROPE) + 1536;
  u16* sv = (u16*)lds;
  float* sconv = (float*)(lds + 16384);
  if (GDN) { for (int i = tid; i < 1152; i += NTHREADS) *(float4*)(sconv + 4 * i) = *(const float4*)(p.gdn_conv + 4 * i); }
  __syncthreads();
  constexpr int N_TOK_ITEMS = NTOK / 16;
  constexpr int N_KC_ITEMS = 256;
  constexpr int N_VC_ITEMS = 256;
  for (int it = rank; it < (ATT ? N_TOK_ITEMS + N_KC_ITEMS + N_VC_ITEMS : N_TOK_ITEMS); it += nblk) {
    if (it >= N_TOK_ITEMS + N_KC_ITEMS) {
      const int t = it - N_TOK_ITEMS - N_KC_ITEMS; const int b = t >> 5, g = t & 31;
      {
        const int key = tid >> 5, c8 = (tid & 31) * 8;
        const float* src = p.c_attv + ((size_t)(b * 512 + g * 16 + key)) * 256 + c8;
        const float4 a = ntload4(src), b4 = ntload4(src + 4);
        u32x4 w = {pack2(a.x, a.y), pack2(a.z, a.w), pack2(b4.x, b4.y), pack2(b4.z, b4.w)};
        *(u32x4*)(sv + key * 264 + c8) = w;
      }
      __syncthreads();
      vt_store16(sv, 264, 256, (u16*)(p.ws + WS_VTATT) + (size_t)krow0_of(16 + b) * 256, 2560, 2048 + g * 16);
      __syncthreads();
      continue;
    }
    if (it >= N_TOK_ITEMS) {
      const size_t i = (size_t)(it - N_TOK_ITEMS) * 4096 + tid * 8;
      const float4 a = ntload4(p.c_attk + i), b4 = ntload4(p.c_attk + i + 4);
      u32x4 w = {pack2(a.x, a.y), pack2(a.z, a.w), pack2(b4.x, b4.y), pack2(b4.z, b4.w)};
      *(u32x4*)((u16*)(p.ws + WS_KC) + i) = w;
      continue;
    }
    const int m0 = it * 16;
    for (int tt = 0; tt < 2; ++tt) {
      const int ml = wid * 2 + tt, m = m0 + ml;
      const bool ctx = m < NCTX;
      const int pos = pos_of_tok(m), prow = pos >> 6, pcol = pos & 63, len = ctx ? 256 : 2048;
      const int li = lane & 15;
      const u16* r1 = UA + (size_t)m * U1A_LD;
      u32x4 xw[3][3]; float cw[3][3][8];
      if constexpr (GDN) {
#pragma unroll
      for (int j = 0; j < 3; ++j) {
        const int ch = j * 512 + lane * 8;
        xw[j][1] = *(const u32x4*)(r1 + ch);
        xw[j][0] = (pos > 0) ? *(const u32x4*)(r1 - U1A_LD + ch) : (u32x4){0u, 0u, 0u, 0u};
        xw[j][2] = (pos < len - 1) ? *(const u32x4*)(r1 + U1A_LD + ch) : (u32x4){0u, 0u, 0u, 0u};
#pragma unroll
        for (int kk = 0; kk < 3; ++kk) {
          const float4 wa = *(const float4*)(sconv + kk * 1536 + ch), wb = *(const float4*)(sconv + kk * 1536 + ch + 4);
          cw[j][kk][0] = wa.x; cw[j][kk][1] = wa.y; cw[j][kk][2] = wa.z; cw[j][kk][3] = wa.w; cw[j][kk][4] = wb.x; cw[j][kk][5] = wb.y; cw[j][kk][6] = wb.z; cw[j][kk][7] = wb.w;
        }
      }
      }
      u16* qp = UB + (size_t)m * U1B_LD + C1_QD + lane * 8;
      u16* kp = UB + (size_t)m * U1B_LD + C1_KD + (lane & 31) * 8;
      u32x4 qdw, kdw, vdw; float abv = 0.f;
      if constexpr (ATT) { qdw = ntload4u(qp); kdw = ntload4u(kp); vdw = ntload4u(UB + (size_t)m * U1B_LD + C1_VD + (lane & 31) * 8); }
      if constexpr (GDN) abv = AB[(size_t)m * 16 + (lane & 15)];
      float qn8[8], kn8[8]; float2 cs8[8];
      if constexpr (ATT) {
        const float4 a0 = *(const float4*)(p.att_q_norm + li * 8), a1 = *(const float4*)(p.att_q_norm + li * 8 + 4), b0 = *(const float4*)(p.att_k_norm + li * 8), b1 = *(const float4*)(p.att_k_norm + li * 8 + 4);
        qn8[0] = a0.x; qn8[1] = a0.y; qn8[2] = a0.z; qn8[3] = a0.w; qn8[4] = a1.x; qn8[5] = a1.y; qn8[6] = a1.z; qn8[7] = a1.w;
        kn8[0] = b0.x; kn8[1] = b0.y; kn8[2] = b0.z; kn8[3] = b0.w; kn8[4] = b1.x; kn8[5] = b1.y; kn8[6] = b1.z; kn8[7] = b1.w;
        const int b32 = li >> 2, pp = (b32 >= 2) ? pcol : prow;
#pragma unroll
        for (int e = 0; e < 8; ++e) cs8[e] = tabA[pp * 32 + (li & 3) * 8 + e];
      }
      const bool is_x2 = ((li >> 2) & 1) != 0;
      if constexpr (GDN) {
#pragma unroll
      for (int j = 0; j < 3; ++j) {
        float x0[8], x1[8], x2[8], y[8];
        unpack8(xw[j][0], x0); unpack8(xw[j][1], x1); unpack8(xw[j][2], x2);
        float ss = 0.f;
#pragma unroll
        for (int e = 0; e < 8; ++e) { const float a = cw[j][0][e] * x0[e] + cw[j][1][e] * x1[e] + cw[j][2][e] * x2[e]; y[e] = siluf(a); ss += y[e] * y[e]; }
        if (j < 2) {
          ss = group16_sum(ss);
          const float rs = rsqrtf(ss + EPS) * (j == 0 ? 0.08838834764831845f : 1.f);
#pragma unroll
          for (int e = 0; e < 8; ++e) y[e] *= rs;
          *(u32x4*)(QK + (size_t)m * DM + j * 512 + lane * 8) = pack8f(y);
        } else {
          *(u32x4*)(VC + (size_t)m * 512 + lane * 8) = pack8f(y);
        }
      }
      if (lane < 16) {
        float r;
        if (lane < 8) { const float x = abv + p.gdn_dt_bias[lane]; const float ex = __expf(x);
          const float sp = x > 20.f ? x : (ex < 0.03125f ? ex * (1.f - ex * (0.5f - ex * (0.33333333f - 0.25f * ex))) : __logf(1.f + ex));
          r = -__expf(p.gdn_a_log[lane]) * sp; }
        else r = __builtin_amdgcn_rcpf(1.f + __expf(-abv));
        GB[(size_t)m * 16 + lane] = r;
      }
      }
      if constexpr (ATT) {
        float x[8], xp[8];
        unpack8(qdw, x);
        float ss = 0.f;
#pragma unroll
        for (int e = 0; e < 8; ++e) ss += x[e] * x[e];
        ss = group16_sum(ss);
        const float rs = rsqrtf(ss * (1.f / 128.f) + EPS);
#pragma unroll
        for (int e = 0; e < 8; ++e) x[e] *= rs * qn8[e];
        shfl8(x, xp, 4);
        if (!ctx) {
#pragma unroll
          for (int e = 0; e < 8; ++e) x[e] = is_x2 ? (x[e] * cs8[e].x + xp[e] * cs8[e].y) : (x[e] * cs8[e].x - xp[e] * cs8[e].y);
        }
        *(u32x4*)qp = pack8f(x);
      }
      if constexpr (ATT) {
        float x[8], xp[8];
        unpack8(kdw, x);
        float ss = 0.f;
#pragma unroll
        for (int e = 0; e < 8; ++e) ss += x[e] * x[e];
        ss = group16_sum(ss);
        const float rs = rsqrtf(ss * (1.f / 128.f) + EPS);
#pragma unroll
        for (int e = 0; e < 8; ++e) x[e] *= rs * kn8[e];
        if (ctx && lane < 32) {
          *(float4*)(p.out + O_ATTK + (size_t)m * 256 + lane * 8) = make_float4(x[0], x[1], x[2], x[3]);
          *(float4*)(p.out + O_ATTK + (size_t)m * 256 + lane * 8 + 4) = make_float4(x[4], x[5], x[6], x[7]);
        }
        shfl8(x, xp, 4);
        if (!ctx) {
#pragma unroll
          for (int e = 0; e < 8; ++e) x[e] = is_x2 ? (x[e] * cs8[e].x + xp[e] * cs8[e].y) : (x[e] * cs8[e].x - xp[e] * cs8[e].y);
        }
        if (lane < 32) {
          *(u32x4*)kp = pack8f(x);
          *(u32x4*)(sv + ml * 264 + lane * 8) = vdw;
          if (ctx) {
            float v[8]; unpack8(vdw, v);
            *(float4*)(p.out + O_ATTV + (size_t)m * 256 + lane * 8) = make_float4(v[0], v[1], v[2], v[3]);
            *(float4*)(p.out + O_ATTV + (size_t)m * 256 + lane * 8 + 4) = make_float4(v[4], v[5], v[6], v[7]);
          }
        }
      }
    }
    if constexpr (ATT) {
      __syncthreads();
      {
        const int s = seq_of_tok(m0);
        vt_store16(sv, 264, 256, (u16*)(p.ws + WS_VTATT) + (size_t)krow0_of(s) * 256, cap_of(s), pos_of_tok(m0));
      }
      __syncthreads();
    }
  }
  __syncthreads();
}
DI int cp_main_chunk(int it) { if (it < 64) return it; const int j = it - 64, b = j / 24, cc = j % 24; return 64 + b * 32 + (cc < 12 ? cc : cc + 8); }
DI int cp_deferred_chunk(int it) { return 64 + (it >> 3) * 32 + 12 + (it & 7); }
DI void l1prep_gdn(const Params& p, int rank, int nblk) {
  const int tid = TIDX(), lane = tid & 63, wid = tid >> 6;
  const u16* UA = (const u16*)(p.ws + WS_U1A);
  u16* QK = (u16*)(p.ws + WS_H);
  u16* VC = (u16*)(p.ws + WS_VC);
  float* GB = (float*)(p.ws + WS_GB);
  const float* AB = (const float*)(p.ws + WS_AB);
  float cw[3][3][8];
#pragma unroll
  for (int j = 0; j < 3; ++j)
#pragma unroll
    for (int kk = 0; kk < 3; ++kk) {
      const float4 wa = *(const float4*)(p.gdn_conv + kk * 1536 + j * 512 + lane * 8), wb = *(const float4*)(p.gdn_conv + kk * 1536 + j * 512 + lane * 8 + 4);
      cw[j][kk][0] = wa.x; cw[j][kk][1] = wa.y; cw[j][kk][2] = wa.z; cw[j][kk][3] = wa.w; cw[j][kk][4] = wb.x; cw[j][kk][5] = wb.y; cw[j][kk][6] = wb.z; cw[j][kk][7] = wb.w;
    }
  const float dtb = p.gdn_dt_bias[lane & 7], nalog = -__expf(p.gdn_a_log[lane & 7]);
  constexpr int N_TOK_ITEMS = NTOK / 16;
  const int nit = rank < N_TOK_ITEMS ? (N_TOK_ITEMS - 1 - rank) / nblk + 1 : 0, nq = nit * 2;
  const bool own = nblk == 256;
  const int own_tok0 = cp_main_chunk(rank) * 64, def_tok0 = cp_deferred_chunk(rank >> 2) * 64 + (rank & 3) * 16;
#define L1G_TOK(q_) (own ? (((q_) >> 1) < 4 ? own_tok0 + ((q_) >> 1) * 16 : def_tok0) + wid * 2 + ((q_) & 1) : (rank + ((q_) >> 1) * nblk) * 16 + wid * 2 + ((q_) & 1))
#define L1G_LOAD(X_, A_, m_) do { const int pos_ = pos_of_tok(m_), len_ = (m_) < NCTX ? 256 : 2048; const u16* r1_ = UA + (size_t)(m_) * U1A_LD; \
    const u16* rp_ = pos_ > 0 ? r1_ - U1A_LD : r1_; const u16* rn_ = pos_ < len_ - 1 ? r1_ + U1A_LD : r1_; \
    _Pragma("unroll") for (int j = 0; j < 3; ++j) { const int ch_ = j * 512 + lane * 8; X_[j][0] = *(const u32x4*)(rp_ + ch_); X_[j][1] = *(const u32x4*)(r1_ + ch_); X_[j][2] = *(const u32x4*)(rn_ + ch_); } \
    A_ = AB[(size_t)(m_) * 16 + (lane & 15)]; } while (0)
  u32x4 xc[3][3], xn[3][3]; float abc = 0.f, abn = 0.f;
  if (nq > 0) { const int m0 = L1G_TOK(0); L1G_LOAD(xc, abc, m0); }
#pragma unroll 1
  for (int q = 0; q < nq; ++q) {
    const int m = L1G_TOK(q);
    if (q + 1 < nq) { const int mn = L1G_TOK(q + 1); L1G_LOAD(xn, abn, mn); }
    const int pos = pos_of_tok(m), len = m < NCTX ? 256 : 2048;
    const float e0 = pos > 0 ? 1.f : 0.f, e2 = pos < len - 1 ? 1.f : 0.f;
#pragma unroll
    for (int j = 0; j < 3; ++j) {
      float x0[8], x1[8], x2[8], y[8];
      unpack8(xc[j][0], x0); unpack8(xc[j][1], x1); unpack8(xc[j][2], x2);
      float ss = 0.f;
#pragma unroll
      for (int e = 0; e < 8; ++e) { const float a = cw[j][0][e] * (x0[e] * e0) + cw[j][1][e] * x1[e] + cw[j][2][e] * (x2[e] * e2); y[e] = siluf(a); ss += y[e] * y[e]; }
      if (j < 2) {
        ss = group16_sum(ss);
        const float rs = rsqrtf(ss + EPS) * (j == 0 ? 0.08838834764831845f : 1.f);
#pragma unroll
        for (int e = 0; e < 8; ++e) y[e] *= rs;
        *(u32x4*)(QK + (size_t)m * DM + j * 512 + lane * 8) = pack8f(y);
      } else {
        *(u32x4*)(VC + (size_t)m * 512 + lane * 8) = pack8f(y);
      }
    }
    if (lane < 16) {
      float r;
      if (lane < 8) { const float x = abc + dtb; const float ex = __expf(x);
        const float sp = x > 20.f ? x : (ex < 0.03125f ? ex * (1.f - ex * (0.5f - ex * (0.33333333f - 0.25f * ex))) : __logf(1.f + ex));
        r = nalog * sp; }
      else r = __builtin_amdgcn_rcpf(1.f + __expf(-abc));
      GB[(size_t)m * 16 + lane] = r;
    }
#pragma unroll
    for (int j = 0; j < 3; ++j)
#pragma unroll
      for (int kk = 0; kk < 3; ++kk) xc[j][kk] = xn[j][kk];
    abc = abn;
  }
#undef L1G_TOK
#undef L1G_LOAD
}
DI void phase_l1prep(const Params& p, char* lds) {
  l1prep_gdn(p, (int)blockIdx.x, (int)gridDim.x);
  if (gridDim.x != 256) l1prep_t<false, true>(p, lds, (int)blockIdx.x, (int)gridDim.x);
}


DI void phase_gdnfinal(const Params& p) {
  const int tid_ = TIDX(), lane = tid_ & 63, wid = tid_ >> 6;
  const u16* OF = (const u16*)(p.ws + WS_OF); const u16* OBk = (const u16*)(p.ws + WS_OB);
  const u16* UB = (const u16*)(p.ws + WS_U1B);
  u16* H = (u16*)(p.ws + WS_H);
  for (int m = blockIdx.x * 8 + wid; m < NTOK; m += gridDim.x * 8) {
    float a[8], b[8], z[8];
    unpack8(ntload4u(OF + (size_t)m * 512 + lane * 8), a);
    unpack8(ntload4u(OBk + (size_t)m * 512 + lane * 8), b);
    unpack8(ntload4u(UB + (size_t)m * U1B_LD + C1_ZC + lane * 8), z);
    float ss = 0.f;
#pragma unroll
    for (int e = 0; e < 8; ++e) { a[e] += b[e]; ss += a[e] * a[e]; }
    ss = group16_sum(ss);
    const float rs = rsqrtf(ss * (1.f / 128.f) + EPS);
    const int li = lane & 15;
#pragma unroll
    for (int e = 0; e < 8; ++e) a[e] = a[e] * rs * p.gdn_norm[li * 8 + e] * siluf(z[e]);
    *(u32x4*)(H + (size_t)m * DM + lane * 8) = pack8f(a);
  }
}

DI float dbg_rel(const Params& p);
#ifndef DBG_CHECK
#define DBG_CHECK 0
#endif
#ifndef DBG_AMP
#define DBG_AMP 10.f
#endif
DI void phase_final(const Params& p) {
  const int tid_ = TIDX(), lane = tid_ & 63, wid = tid_ >> 6;
  const u16* GY = (const u16*)(p.ws + WS_GY1);
  float4 g4[4];
#pragma unroll
  for (int j = 0; j < 4; ++j) g4[j] = *(const float4*)(p.ln_f + (j * 64 + lane) * 4);
  const int stride = gridDim.x * 8;
  int m = blockIdx.x * 8 + wid;
  float4 cur[4], nxt[4]; u32x2 cg[4], ng[4];
  if (m < NTOK) {
#pragma unroll
    for (int j = 0; j < 4; ++j) { cur[j] = ntload4(p.out + (size_t)m * DM + (j * 64 + lane) * 4); cg[j] = ntload2u(GY + (size_t)m * DM + (j * 64 + lane) * 4); } }
  for (; m < NTOK; m += stride) {
    const int mn = m + stride;
    if (mn < NTOK) {
#pragma unroll
      for (int j = 0; j < 4; ++j) { nxt[j] = ntload4(p.out + (size_t)mn * DM + (j * 64 + lane) * 4); ng[j] = ntload2u(GY + (size_t)mn * DM + (j * 64 + lane) * 4); } }
    float ss = 0.f;
#pragma unroll
    for (int j = 0; j < 4; ++j) {
      cur[j].x += bf2f((u16)(cg[j][0] & 0xffffu)); cur[j].y += bf2f((u16)(cg[j][0] >> 16)); cur[j].z += bf2f((u16)(cg[j][1] & 0xffffu)); cur[j].w += bf2f((u16)(cg[j][1] >> 16));
      ss += cur[j].x * cur[j].x + cur[j].y * cur[j].y + cur[j].z * cur[j].z + cur[j].w * cur[j].w;
    }
    ss = wave_sum(ss);
    const float rs = rsqrtf(ss * (1.f / 1024.f) + EPS);
#pragma unroll
    for (int j = 0; j < 4; ++j)
      { typedef float nt4 __attribute__((ext_vector_type(4))); const nt4 yv = {cur[j].x * rs * g4[j].x, cur[j].y * rs * g4[j].y, cur[j].z * rs * g4[j].z, cur[j].w * rs * g4[j].w};
        __builtin_nontemporal_store(yv, (nt4*)(p.out + (size_t)m * DM + (j * 64 + lane) * 4)); }
#pragma unroll
    for (int j = 0; j < 4; ++j) { cur[j] = nxt[j]; cg[j] = ng[j]; }
  }
}

template <class F>
DI void ngemm(const GemmA A, const u16* __restrict__ Wt, int ldw, int K, int M, int N, char* lds, F f) {
  u16* sA = (u16*)lds;
  const int tid = TIDX();
  const int ncol = (N + 511) / 512;
  for (int it = blockIdx.x; it < (M / 8) * ncol; it += gridDim.x) {
    const int m0 = (it / ncol) * 8, n = (it % ncol) * 512 + tid;
    __syncthreads();
    for (int i = tid; i < 8 * (K / 8); i += NTHREADS) {
      const int r = i / (K / 8), k8 = (i % (K / 8)) * 8;
      const u16* src = k8 < A.ksplit ? A.p0 + (size_t)(m0 + r) * A.ld0 + k8 : A.p1 + (size_t)(m0 + r) * A.ld1 + (k8 - A.ksplit);
      *(u32x4*)(sA + r * K + k8) = *(const u32x4*)src;
    }
    __syncthreads();
    if (n < N) {
      float acc[8];
#pragma unroll
      for (int r = 0; r < 8; ++r) acc[r] = 0.f;
      for (int k8 = 0; k8 < K; k8 += 8) {
        float w[8]; unpack8(*(const u32x4*)(Wt + (size_t)n * ldw + k8), w);
#pragma unroll
        for (int r = 0; r < 8; ++r) {
          float a[8]; unpack8(*(const u32x4*)(sA + r * K + k8), a);
#pragma unroll
          for (int e = 0; e < 8; ++e) acc[r] += a[e] * w[e];
        }
      }
#pragma unroll
      for (int r = 0; r < 8; ++r) f(m0 + r, n, acc[r]);
    }
  }
}
DI void nphase_inproj0(const Params& p, char* lds) {
  u16* U = (u16*)(p.ws + WS_U); const u16* H = (const u16*)(p.ws + WS_H);
  ngemm(GemmA{H, DM, H, DM, 1 << 30}, (const u16*)(p.ws + WS_WT0), DM, DM, NTOK, L0C, lds, [=](int m, int n, float v) { U[(size_t)m * L0C + n] = f2bf(v); });
}
DI void nphase_l0gemms(const Params& p, char* lds) {
  const u16* U0 = (const u16*)(p.ws + WS_U); const u16* ck = (const u16*)(p.ws + WS_CKVN);
  u16* Kn = (u16*)((char*)p.out + YS_KN); u16* Vt = (u16*)((char*)p.out + YS_VTMLA); u16* Q = (u16*)((char*)p.out + YS_QMLA);
  ngemm(GemmA{ck, 256, ck, 256, 1 << 30}, (const u16*)(p.ws + WS_WUKV), 256, 256, NKROW, 1024, lds, [=](int kr, int n, float v) {
    if (n < 512) Kn[(size_t)kr * 512 + n] = f2bf(v);
    else {
      int seq, key;
      if (kr < NCTX) { seq = kr >> 8; key = kr & 255; } else { const int r = kr - NCTX; seq = 16 + r / 2560; key = r % 2560; }
      Vt[(size_t)krow0_of(seq) * 512 + (size_t)(n - 512) * cap_of(seq) + (key & ~15) + swz16(key & 15)] = f2bf(v);
    }
  });
  ngemm(GemmA{U0 + C0_CQ, L0C, U0 + C0_CQ, L0C, 1 << 30}, (const u16*)(p.ws + WS_WUQ), 384, 384, NTOK, 768, lds, [=](int m, int n, float v) { Q[(size_t)m * 768 + n] = f2bf(v); });
}
DI void nphase_qmla_rope(const Params& p) {
  u16* Q = (u16*)((char*)p.out + YS_QMLA);
  const float2* tab = (const float2*)(p.ws + WS_ROPE);
  for (size_t i = (size_t)blockIdx.x * NTHREADS + threadIdx.x; i < (size_t)(NTOK - NCTX) * 8 * 16; i += (size_t)gridDim.x * NTHREADS) {
    const int m = NCTX + (int)(i >> 7), head = (int)(i >> 4) & 7, j = (int)i & 15;
    const int pos = pos_of_tok(m), pp = (j >> 3) ? (pos & 63) : (pos >> 6);
    u16* q = Q + (size_t)m * 768 + head * 96 + 64 + (j >> 3) * 16 + (j & 7);
    const float x1 = bf2f(q[0]), x2 = bf2f(q[8]);
    const float2 cs = tab[pp * 8 + (j & 7)];
    q[0] = f2bf(x1 * cs.x - x2 * cs.y); q[8] = f2bf(x2 * cs.x + x1 * cs.y);
  }
}
DI void nphase_outproj(const Params& p, int layer, char* lds) {
  const u16* H = (const u16*)(p.ws + WS_H);
  const GemmA A{H, DM, H, DM, 1 << 30};
  const float* mod = (const float*)(p.ws + WS_MOD) + (size_t)layer * 9 * 3072 + 2048;
  const Params* pp = &p;
  ngemm(A, (const u16*)(p.ws + (layer ? WS_WO1 : WS_WO0)), DM, DM, NTOK, DM, lds, [=](int m, int n, float v) {
    const float gate = mod[(size_t)modidx_of_tok(m) * 3072 + n];
    const float xv = layer ? pp->out[(size_t)m * DM + n] : xrow(*pp, m)[n];
    pp->out[(size_t)m * DM + n] = xv + gate * v;
  });
}
DI void nphase_inproj1(const Params& p, char* lds) {
  u16* UA = (u16*)(p.ws + WS_U1A); u16* UB = (u16*)(p.ws + WS_U1B); float* AB = (float*)(p.ws + WS_AB);
  const u16* H = (const u16*)(p.ws + WS_H);
  ngemm(GemmA{H, DM, H, DM, 1 << 30}, (const u16*)(p.ws + WS_WT1), DM, DM, NTOK, L1C, lds, [=](int m, int n, float v) {
    if (n < 1536) UA[(size_t)m * U1A_LD + n] = f2bf(v);
    else if (n < 3584) UB[(size_t)m * U1B_LD + n - 1536] = f2bf(v);
    else AB[(size_t)m * 16 + n - 3584] = v;
  });
}

template <int KIND>
DI void nattn(const Params& p) {
  constexpr int DQK = KIND == 0 ? 96 : (KIND == 1 ? 64 : 128);
  constexpr int DV = KIND == 2 ? 128 : 64;
  constexpr int NH = KIND == 2 ? 4 : 8;
  constexpr float SCALE = KIND == 0 ? 0.10206207261596577f : (KIND == 1 ? 0.125f : 0.08838834764831845f);
  const int tid_ = TIDX(), lane = tid_ & 63, wid = tid_ >> 6;
  const u16* U0 = (const u16*)(p.ws + WS_U);
  u16* U1B = (u16*)(p.ws + WS_U1B);
  for (int it = blockIdx.x * 8 + wid; it < NTOK * NH; it += gridDim.x * 8) {
    const int tok = it / NH, hq = it % NH;
    const int s = seq_of_tok(tok), tok0 = tok0_of(s), kr0 = krow0_of(s), cap = cap_of(s), len = len_of(s), qi = tok - tok0;
    const bool smp = s >= 16;
    const int hkv = KIND == 0 ? hq : (KIND == 1 ? hq >> 2 : hq >> 1);
    const u16* qp; const u16* VT;
    if (KIND == 0) { qp = (const u16*)((const char*)p.out + YS_QMLA) + (size_t)tok * 768 + hq * 96; VT = (const u16*)((const char*)p.out + YS_VTMLA) + (size_t)kr0 * 512; }
    else if (KIND == 1) { qp = U0 + (size_t)tok * L0C + C0_QB + hq * 64; VT = (const u16*)(p.ws + WS_VTSWA) + (size_t)kr0 * 128; }
    else { qp = U1B + (size_t)tok * U1B_LD + C1_QD + hq * 128; VT = (const u16*)(p.ws + WS_VTATT) + (size_t)kr0 * 256; }
    const float q0 = bf2f(qp[lane]);
    float q1 = (DQK > 64 && lane + 64 < DQK) ? bf2f(qp[lane + 64]) : 0.f;
    if (KIND == 0) {
      const float q1p = __shfl_xor(q1, 8);
      if (smp && lane < 32) {
        const float2 cs = ((const float2*)(p.ws + WS_ROPE))[((lane >> 4) ? (qi & 63) : (qi >> 6)) * 8 + (lane & 7)];
        q1 = (lane & 8) ? (q1 * cs.x + q1p * cs.y) : (q1 * cs.x - q1p * cs.y);
      }
    }
    float m = -1e30f, l = 0.f, o0 = 0.f, o1 = 0.f;
    int glo = 0, ghi = cap >> 4;
    const int nseqg = len >> 4;
    for (int gidx = glo; gidx < ghi; ++gidx) {
      const int g0 = gidx * 16;
      if (KIND == 1 && smp && g0 < 2048) { if (g0 + 15 < qi - 128 || g0 > qi + 128) continue; }
      float sc[16];
#pragma unroll
      for (int j = 0; j < 16; ++j) {
        const int g = g0 + j;
        const u16* kp;
        float part;
        if (KIND == 0) {
          const u16* kn = (const u16*)((const char*)p.out + YS_KN) + ((size_t)(kr0 + g) * 8 + hkv) * 64;
          const u16* kr = (const u16*)(p.ws + WS_KROPE) + (size_t)(kr0 + g) * 32;
          part = q0 * bf2f(kn[lane]) + (lane < 32 ? q1 * bf2f(kr[lane]) : 0.f);
        } else if (KIND == 1) {
          kp = (const u16*)(p.ws + WS_KSWA) + ((size_t)(kr0 + g) * 2 + hkv) * 64;
          part = q0 * bf2f(kp[lane]);
        } else {
          kp = g < len ? U1B + (size_t)(tok0 + g) * U1B_LD + C1_KD + hkv * 128 : (const u16*)(p.ws + WS_KC) + ((size_t)((s - 16) * 512 + g - 2048) * 2 + hkv) * 128;
          part = q0 * bf2f(kp[lane]) + q1 * bf2f(kp[lane + 64]);
        }
        float sv_ = wave_sum(part) * SCALE;
        if (KIND == 1 && smp && g < 2048) { const int d = qi - g; if (d > 128 || d < -128) sv_ = -INFINITY; }
        sc[j] = sv_;
      }
      float mx = sc[0];
#pragma unroll
      for (int j = 1; j < 16; ++j) mx = fmaxf(mx, sc[j]);
      const float mnew = fmaxf(m, mx);
      const float alpha = __expf(m - mnew);
      m = mnew; l *= alpha; o0 *= alpha; o1 *= alpha;
      const u32x4 va = *(const u32x4*)(VT + (size_t)(hkv * DV + lane) * cap + g0), vb = *(const u32x4*)(VT + (size_t)(hkv * DV + lane) * cap + g0 + 8);
      float v0[16]; { float t8[8]; unpack8(va, t8); for (int e = 0; e < 8; ++e) v0[e] = t8[e]; unpack8(vb, t8); for (int e = 0; e < 8; ++e) v0[8 + e] = t8[e]; }
      float v1[16];
      if (DV > 64) {
        const u32x4 vc = *(const u32x4*)(VT + (size_t)(hkv * DV + 64 + lane) * cap + g0), vd = *(const u32x4*)(VT + (size_t)(hkv * DV + 64 + lane) * cap + g0 + 8);
        float t8[8]; unpack8(vc, t8); for (int e = 0; e < 8; ++e) v1[e] = t8[e]; unpack8(vd, t8); for (int e = 0; e < 8; ++e) v1[8 + e] = t8[e];
      }
#pragma unroll
      for (int j = 0; j < 16; ++j) {
        const float pj = __expf(sc[j] - mnew);
        l += pj;
        o0 += pj * v0[swz16(j)];
        if (DV > 64) o1 += pj * v1[swz16(j)];
      }
    }
    (void)nseqg; (void)glo;
    if (KIND == 1) l += __expf(p.swa_sink[hq] - m);
    const float inv = 1.f / l;
    if (KIND == 0) { const float z = bf2f(U0[(size_t)tok * L0C + C0_ZA + hq * 64 + lane]); ((u16*)(p.ws + WS_H))[(size_t)tok * DM + hq * 64 + lane] = f2bf(o0 * inv * siluf(z)); }
    else if (KIND == 1) { const float z = bf2f(U0[(size_t)tok * L0C + C0_ZB + hq * 64 + lane]); ((u16*)(p.ws + WS_H))[(size_t)tok * DM + 512 + hq * 64 + lane] = f2bf(o0 * inv * siluf(z)); }
    else {
      const float z0 = bf2f(U1B[(size_t)tok * U1B_LD + C1_ZD + hq * 128 + lane]), z1 = bf2f(U1B[(size_t)tok * U1B_LD + C1_ZD + hq * 128 + 64 + lane]);
      ((u16*)(p.ws + WS_H))[(size_t)tok * DM + 512 + hq * 128 + lane] = f2bf(o0 * inv * siluf(z0));
      ((u16*)(p.ws + WS_H))[(size_t)tok * DM + 512 + hq * 128 + 64 + lane] = f2bf(o1 * inv * siluf(z1));
    }
  }
}

DI void nphase_gdn(const Params& p, char* lds) {
  const int tid = TIDX();
  float* sq = (float*)lds; float* sk = sq + 128;
  const u16* QK = (const u16*)(p.ws + WS_H); const u16* VC = (const u16*)(p.ws + WS_VC); const float* GB = (const float*)(p.ws + WS_GB);
  for (int it = blockIdx.x; it < 192; it += gridDim.x) {
    int s, head, dir;
    if (it < 64) { s = 16 + (it >> 3); head = (it >> 1) & 3; dir = it & 1; } else { const int j = it - 64; s = j >> 3; head = (j >> 1) & 3; dir = j & 1; }
    const int tok0 = tok0_of(s), T = len_of(s);
    u16* O = (u16*)(p.ws + (dir ? WS_OB : WS_OF));
    float S[128];
    if (tid < 128) {
      if (s >= 16) {
        const float* st = p.c_state + ((size_t)(((s - 16) * 2 + dir) * 4 + head)) * 16384;
#pragma unroll
        for (int d = 0; d < 128; ++d) S[d] = st[d * 128 + tid];
      } else {
#pragma unroll
        for (int d = 0; d < 128; ++d) S[d] = 0.f;
      }
    }
    for (int tau = 0; tau < T; ++tau) {
      const int m = tok0 + (dir ? T - 1 - tau : tau);
      __syncthreads();
      if (tid < 128) { sq[tid] = bf2f(QK[(size_t)m * DM + head * 128 + tid]); sk[tid] = bf2f(QK[(size_t)m * DM + 512 + head * 128 + tid]); }
      __syncthreads();
      if (tid < 128) {
        const float g = GB[(size_t)m * 16 + dir * 4 + head], beta = GB[(size_t)m * 16 + 8 + dir * 4 + head];
        const float alpha = __expf(g);
        const float v = bf2f(VC[(size_t)m * 512 + head * 128 + tid]);
        float r = 0.f;
#pragma unroll
        for (int c = 0; c < 16; ++c) {
          const float4 ka = *(const float4*)(sk + c * 8), kb = *(const float4*)(sk + c * 8 + 4);
          r += ka.x * S[c * 8] + ka.y * S[c * 8 + 1] + ka.z * S[c * 8 + 2] + ka.w * S[c * 8 + 3] + kb.x * S[c * 8 + 4] + kb.y * S[c * 8 + 5] + kb.z * S[c * 8 + 6] + kb.w * S[c * 8 + 7];
          asm volatile("" ::: "memory");
        }
        const float dd = beta * (v - alpha * r);
        float o = 0.f;
#pragma unroll
        for (int c = 0; c < 16; ++c) {
          const float4 ka = *(const float4*)(sk + c * 8), kb = *(const float4*)(sk + c * 8 + 4);
          const float4 qa = *(const float4*)(sq + c * 8), qb = *(const float4*)(sq + c * 8 + 4);
          const float kk[8] = {ka.x, ka.y, ka.z, ka.w, kb.x, kb.y, kb.z, kb.w};
          const float qq[8] = {qa.x, qa.y, qa.z, qa.w, qb.x, qb.y, qb.z, qb.w};
#pragma unroll
          for (int e = 0; e < 8; ++e) { S[c * 8 + e] = alpha * S[c * 8 + e] + kk[e] * dd; o += qq[e] * S[c * 8 + e]; }
          asm volatile("" ::: "memory");
        }
        O[(size_t)m * 512 + head * 128 + tid] = f2bf(o);
      }
    }
    if (tid < 128 && s < 16) {
      float* st = p.out + O_STATE + ((size_t)((s * 2 + dir) * 4 + head)) * 16384;
#pragma unroll
      for (int d = 0; d < 128; ++d) st[d * 128 + tid] = S[d];
    }
    __syncthreads();
  }
}


DI bf16x8 afrag(const u16* base, int stride, int row, int kbase, int h) {
  const bf16x4 lo = *(const bf16x4*)(base + row * stride + kbase + 4 * h);
  const bf16x4 hi = *(const bf16x4*)(base + row * stride + kbase + 8 + 4 * h);
  return cat4(lo, hi);
}
DI void chunkprep_item(const Params& p, int cgi, char* lds) {
  const int tid0 = TIDX(), wid = tid0 >> 6, head = wid >> 1, dir = wid & 1;
  u16* tiles = (u16*)lds;
  float* vecs = (float*)(lds + 4 * 34816) + wid * 128;
  const u16* QK = (const u16*)(p.ws + WS_H); const float* GB = (const float*)(p.ws + WS_GB);
  {
    const int tok0 = cgi * 64;
    const int oz = opaque_zero();
    const int tid = TIDX() + oz, lane = tid & 63, r32 = lane & 31, h = lane >> 5;
    __syncthreads();
#pragma unroll
    for (int i = 0; i < 16; ++i) {
      const int c = tid + 512 * i, row = c >> 7, col8 = (c & 127) * 8, which = col8 >> 9, hh = (col8 >> 7) & 3, d8 = col8 & 127;
      *(u32x4*)(tiles + hh * 17408 + which * 8704 + row * 136 + d8) = *(const u32x4*)(QK + (size_t)(tok0 + row) * DM + col8);
    }
    {
      const float g = GB[(size_t)(tok0 + lane) * 16 + dir * 4 + head];
      float pre = g;
#pragma unroll
      for (int o = 1; o < 64; o <<= 1) { const float t = __shfl_up(pre, o); if (lane >= o) pre += t; }
      const float tot = __shfl(pre, 63);
      vecs[lane] = dir ? (tot - pre + g) : pre;
      vecs[64 + lane] = GB[(size_t)(tok0 + lane) * 16 + 8 + dir * 4 + head];
    }
    __syncthreads();
    const u16* sq = tiles + head * 17408; const u16* sk = sq + 8704;
    const float* gc = vecs; const float* be = vecs + 64;
    const size_t tm = ((size_t)(cgi * 4 + head) * 2 + dir) * 4096;
    u16* AM = (u16*)(p.ws + WS_AM) + tm;
    f32x16 P[2][2];
#pragma unroll 1
    for (int q4 = 0; q4 < 4; ++q4) {
      const int ib = q4 >> 1, jb = q4 & 1;
      f32x16 kk, qk, pt;
#pragma unroll
      for (int r = 0; r < 16; ++r) { kk[r] = 0.f; qk[r] = 0.f; }
#pragma unroll
      for (int s2 = 0; s2 < 8; ++s2) {
        const bf16x8 ka = *(const bf16x8*)(sk + (32 * ib + r32) * 136 + 16 * s2 + 8 * h);
        const bf16x8 kb = *(const bf16x8*)(sk + (32 * jb + r32) * 136 + 16 * s2 + 8 * h);
        const bf16x8 qb = *(const bf16x8*)(sq + (32 * jb + r32) * 136 + 16 * s2 + 8 * h);
        kk = MFMA(ka, kb, kk);
        qk = MFMA(ka, qb, qk);
      }
      const int cidx = 32 * jb + r32; const float gcol = gc[cidx], bcol = be[cidx];
#pragma unroll
      for (int g4 = 0; g4 < 4; ++g4) {
        const int b0 = 32 * ib + 8 * g4 + 4 * h;
        const float4 gv = *(const float4*)(gc + b0);
        const float gq[4] = {gv.x, gv.y, gv.z, gv.w};
        float v[4];
#pragma unroll
        for (int j = 0; j < 4; ++j) {
          const int rr = b0 + j;
          const float ea = __expf(fminf(gcol - gq[j], 0.f));
          const bool va = dir ? (rr >= cidx) : (rr <= cidx);
          const bool vs = dir ? (rr > cidx) : (rr < cidx);
          v[j] = va ? qk[4 * g4 + j] * ea : 0.f;
          pt[4 * g4 + j] = vs ? bcol * kk[4 * g4 + j] * ea : 0.f;
        }
        u32x2 w = {pack2(v[0], v[1]), pack2(v[2], v[3])};
        *(u32x2*)(AM + cidx * 64 + b0) = w;
      }
      if (q4 == 0) P[0][0] = pt; else if (q4 == 1) P[0][1] = pt; else if (q4 == 2) P[1][0] = pt; else P[1][1] = pt;
      asm volatile("" ::: "memory");
    }
    __syncthreads();
    u16* img = tiles + head * 17408 + dir * 8704;
    const int pcol = (r32 & ~15) | swz16(r32 & 15);
    f32x16 R[2][2];
#pragma unroll
    for (int I = 0; I < 2; ++I)
#pragma unroll
      for (int J = 0; J < 2; ++J)
#pragma unroll
        for (int r = 0; r < 16; ++r) R[I][J][r] = ((I == J && crow(r, h) == r32) ? 1.f : 0.f) - P[I][J][r];
#define CP_ZERO(a_, b_) (dir ? ((a_) == 0 && (b_) == 1) : ((a_) == 1 && (b_) == 0))
#define CP_IMG(T_) do { _Pragma("unroll") for (int I_ = 0; I_ < 2; ++I_) _Pragma("unroll") for (int J_ = 0; J_ < 2; ++J_) if (!CP_ZERO(I_, J_)) { \
      _Pragma("unroll") for (int r_ = 0; r_ < 16; r_ += 2) { const unsigned w_ = pack2(T_[I_][J_][r_], T_[I_][J_][r_ + 1]); \
        img[(32 * I_ + crow(r_, h)) * 72 + 32 * J_ + pcol] = (u16)(w_ & 0xffffu); img[(32 * I_ + crow(r_ + 1, h)) * 72 + 32 * J_ + pcol] = (u16)(w_ >> 16); } } } while (0)
    {
      const int zi = dir ? 0 : 1, zj = dir ? 1 : 0;
#pragma unroll
      for (int r = 0; r < 16; ++r) img[(32 * zi + crow(r, h)) * 72 + 32 * zj + pcol] = 0;
    }
    CP_IMG(P);
#pragma unroll 1
    for (int itn = 0; itn < 5; ++itn) {
#pragma unroll
      for (int J = 0; J < 2; ++J) {
        f32x16 n0, n1;
#pragma unroll
        for (int r = 0; r < 16; ++r) { n0[r] = 0.f; n1[r] = 0.f; }
#pragma unroll
        for (int K = 0; K < 2; ++K) if (!CP_ZERO(K, J)) {
#pragma unroll
          for (int s2 = 0; s2 < 2; ++s2) {
            const bf16x8 bfr = pack8(P[K][J], s2);
            if (!CP_ZERO(0, K) && !CP_ZERO(0, J)) n0 = MFMA(*(const bf16x8*)(img + r32 * 72 + 32 * K + 16 * s2 + 8 * h), bfr, n0);
            if (!CP_ZERO(1, K) && !CP_ZERO(1, J)) n1 = MFMA(*(const bf16x8*)(img + (32 + r32) * 72 + 32 * K + 16 * s2 + 8 * h), bfr, n1);
          }
        }
        P[0][J] = n0; P[1][J] = n1;
      }
      CP_IMG(P);
#pragma unroll
      for (int J = 0; J < 2; ++J) {
        f32x16 n0 = R[0][J], n1 = R[1][J];
#pragma unroll
        for (int K = 0; K < 2; ++K) if (!CP_ZERO(K, J)) {
#pragma unroll
          for (int s2 = 0; s2 < 2; ++s2) {
            const bf16x8 bfr = pack8(R[K][J], s2);
            if (!CP_ZERO(0, K) && !CP_ZERO(0, J)) n0 = MFMA(*(const bf16x8*)(img + r32 * 72 + 32 * K + 16 * s2 + 8 * h), bfr, n0);
            if (!CP_ZERO(1, K) && !CP_ZERO(1, J)) n1 = MFMA(*(const bf16x8*)(img + (32 + r32) * 72 + 32 * K + 16 * s2 + 8 * h), bfr, n1);
          }
        }
        R[0][J] = n0; R[1][J] = n1;
      }
    }
#undef CP_ZERO
#undef CP_IMG
    {
      u16* TB = (u16*)(p.ws + WS_TB) + tm;
#pragma unroll
      for (int I = 0; I < 2; ++I)
#pragma unroll
        for (int J = 0; J < 2; ++J)
#pragma unroll
          for (int g4 = 0; g4 < 4; ++g4) {
            const int b0 = 32 * I + 8 * g4 + 4 * h;
            const float4 bv = *(const float4*)(be + b0);
            u32x2 w = {pack2(R[I][J][4 * g4] * bv.x, R[I][J][4 * g4 + 1] * bv.y), pack2(R[I][J][4 * g4 + 2] * bv.z, R[I][J][4 * g4 + 3] * bv.w)};
            *(u32x2*)(TB + (32 * J + r32) * 64 + b0) = w;
          }
    }
  }
}

constexpr int CP_CNT_WORD = 4000;
DI void phase_chunkprep(const Params& p, char* lds) {
  for (int it = blockIdx.x; it < 256; it += gridDim.x) chunkprep_item(p, cp_main_chunk(it), lds);
  __syncthreads();
}
DI void chunkprep_deferred(const Params& p, char* lds) {
  const int it = (int)blockIdx.x - 64;
  if (it < 0 || it >= 64) return;
  chunkprep_item(p, cp_deferred_chunk(it), lds);
  asm volatile("s_waitcnt vmcnt(0)" ::: "memory");
  __syncthreads();
  if (threadIdx.x == 0) {
    __builtin_amdgcn_fence(__ATOMIC_RELEASE, "agent");
    asm volatile("s_waitcnt vmcnt(0)" ::: "memory");
    __hip_atomic_fetch_add((unsigned*)(p.ws + WS_BAR) + CP_CNT_WORD, 1u, __ATOMIC_RELAXED, __HIP_MEMORY_SCOPE_AGENT);
  }
  __syncthreads();
}
DI void chunkprep_wait_deferred(const Params& p, int lane) {
  unsigned* cnt = (unsigned*)(p.ws + WS_BAR) + CP_CNT_WORD;
  if (lane == 0) {
    unsigned spins = 0;
    while (__hip_atomic_load(cnt, __ATOMIC_RELAXED, __HIP_MEMORY_SCOPE_AGENT) < 64u) { __builtin_amdgcn_s_sleep(2); if (++spins > (1u << 22)) break; }
  }
  __builtin_amdgcn_fence(__ATOMIC_ACQUIRE, "agent");
  asm volatile("s_waitcnt vmcnt(0)" ::: "memory");
}
DI void phase_scan(const Params& p, char* lds) {
  const int tid0 = TIDX(), wid = tid0 >> 6;
  u16* sq = (u16*)lds; u16* sk = sq + 64 * 136; u16* skT = sk + 64 * 136; u16* sv = skT + 128 * 72; u16* sTb = sv + 64 * 136; u16* sA = sTb + 64 * 72;
  float* vec0 = (float*)(sA + 64 * 72);
  const u16* QK = (const u16*)(p.ws + WS_H); const u16* VC = (const u16*)(p.ws + WS_VC); const float* GB = (const float*)(p.ws + WS_GB);
  chunkprep_deferred(p, lds);
  for (int it = blockIdx.x; it < 192; it += gridDim.x) {
    int s, head, dir;
    if (it < 64) { s = 16 + (it >> 3); head = (it >> 1) & 3; dir = it & 1; } else { const int j = it - 64; s = j >> 3; head = (j >> 1) & 3; dir = j & 1; }
    const int tokS = tok0_of(s), nch = len_of(s) >> 6;
    __syncthreads();
    if (wid >= 4) {
      const int t2 = TIDX() - 256, lane = t2 & 63, lw = t2 >> 6;
      u32x4 R0[20], R1[20]; float g0 = 0.f, g1 = 0.f;
#define SC_LOAD(R, G, STEP) do { const int ch_ = dir ? nch - 1 - (STEP) : (STEP); const int tok0_ = tokS + ch_ * 64; \
        const size_t tm_ = ((size_t)((tok0_ >> 6) * 4 + head) * 2 + dir) * 4096; \
        _Pragma("unroll") for (int j_ = 0; j_ < 4; ++j_) { const int c_ = t2 + 256 * j_, row_ = c_ >> 4, d8_ = (c_ & 15) * 8; \
          R[j_]      = *(const u32x4*)(QK + (size_t)(tok0_ + row_) * DM + head * 128 + d8_); \
          R[4 + j_]  = *(const u32x4*)(QK + (size_t)(tok0_ + row_) * DM + 512 + head * 128 + d8_); \
          R[8 + j_]  = *(const u32x4*)(QK + (size_t)(tok0_ + lane) * DM + 512 + head * 128 + (lw * 4 + j_) * 8); \
          R[12 + j_] = *(const u32x4*)(VC + (size_t)(tok0_ + row_) * 512 + head * 128 + d8_); } \
        _Pragma("unroll") for (int j_ = 0; j_ < 2; ++j_) { const int c_ = t2 + 256 * j_; \
          R[16 + j_] = *(const u32x4*)((const u16*)(p.ws + WS_TB) + tm_ + (c_ >> 3) * 64 + (c_ & 7) * 8); \
          R[18 + j_] = *(const u32x4*)((const u16*)(p.ws + WS_AM) + tm_ + (c_ >> 3) * 64 + (c_ & 7) * 8); } \
        if (lw == 3) G = GB[(size_t)(tok0_ + lane) * 16 + dir * 4 + head]; } while (0)
#define SC_W2(BASE, STRIDE, ROW, C0, W) do { const int a_ = ((C0) >> 3) & 1, g_ = (C0) & ~15; \
        u32x2 lo_ = {(W)[0], (W)[1]}, hi_ = {(W)[2], (W)[3]}; \
        *(u32x2*)((BASE) + (ROW) * (STRIDE) + g_ + 4 * a_) = lo_; *(u32x2*)((BASE) + (ROW) * (STRIDE) + g_ + 8 + 4 * a_) = hi_; } while (0)
#define SC_WRITE1(R) do { \
        _Pragma("unroll") for (int j_ = 0; j_ < 4; ++j_) { const int c_ = t2 + 256 * j_, row_ = c_ >> 4, d8_ = (c_ & 15) * 8; \
          SC_W2(sq, 136, row_, d8_, R[j_]); SC_W2(sk, 136, row_, d8_, R[4 + j_]); \
          *(u32x4*)(sv + row_ * 136 + d8_) = R[12 + j_]; } \
        _Pragma("unroll") for (int j_ = 0; j_ < 2; ++j_) { const int c_ = t2 + 256 * j_; \
          SC_W2(sTb, 72, c_ >> 3, (c_ & 7) * 8, R[16 + j_]); SC_W2(sA, 72, c_ >> 3, (c_ & 7) * 8, R[18 + j_]); } } while (0)
#define SC_WKT(R) do { \
        _Pragma("unroll") for (int j_ = 0; j_ < 4; ++j_) { \
          { const int dd_ = (lw * 4 + j_) * 8, pos_ = (lane & ~15) + swz16(lane & 15); \
            _Pragma("unroll") for (int e_ = 0; e_ < 4; ++e_) { skT[(dd_ + 2 * e_) * 72 + pos_] = (u16)(R[8 + j_][e_] & 0xffffu); skT[(dd_ + 2 * e_ + 1) * 72 + pos_] = (u16)(R[8 + j_][e_] >> 16); } } } } while (0)
#define SC_VEC(G, PAR) do { \
        if (lw == 3) { float* vw_ = vec0 + (PAR) * 132; float pre_ = G; \
          _Pragma("unroll") for (int o_ = 1; o_ < 64; o_ <<= 1) { const float t_ = __shfl_up(pre_, o_); if (lane >= o_) pre_ += t_; } \
          const float tot_ = __shfl(pre_, 63); const float gc_ = dir ? (tot_ - pre_ + G) : pre_; \
          vw_[lane] = __expf(gc_); vw_[64 + lane] = __expf(tot_ - gc_); if (lane == 0) vw_[128] = __expf(tot_); } } while (0)
      SC_LOAD(R0, g0, 0);
      if (nch > 1) SC_LOAD(R1, g1, 1);
      SC_WRITE1(R0); SC_VEC(g0, 0);
#pragma unroll 1
      for (int step = 0; step < nch; step += 2) {
        __syncthreads();
        SC_WKT(R0);
        if (s >= 16 && step + 2 == 12) chunkprep_wait_deferred(p, lane);
        float g0n = g0;
        if (step + 2 < nch) SC_LOAD(R0, g0n, step + 2);
        __syncthreads();
        SC_WRITE1(R1); SC_VEC(g1, 1);
        __syncthreads();
        SC_WKT(R1);
        if (step + 3 < nch) SC_LOAD(R1, g1, step + 3);
        __syncthreads();
        g0 = g0n;
        if (step + 2 < nch) { SC_WRITE1(R0); SC_VEC(g0, 0); }
      }
#undef SC_LOAD
#undef SC_W2
#undef SC_WRITE1
#undef SC_WKT
#undef SC_VEC
    } else {
      const int lane = TIDX() & 63, r32 = lane & 31, h = lane >> 5;
      u16* O = (u16*)(p.ws + (dir ? WS_OB : WS_OF));
      const int e0 = 32 * wid;
      f32x16 S[4];
      if (s >= 16) {
        const float* st = p.c_state + ((size_t)(((s - 16) * 2 + dir) * 4 + head)) * 16384;
#pragma unroll
        for (int db = 0; db < 4; ++db)
#pragma unroll
          for (int r = 0; r < 16; ++r) S[db][r] = st[(32 * db + crow(r, h)) * 128 + e0 + r32];
      } else {
#pragma unroll
        for (int db = 0; db < 4; ++db)
#pragma unroll
          for (int r = 0; r < 16; ++r) S[db][r] = 0.f;
      }
#define SC_AF(BASE, STRIDE, ROW, KB) (*(const bf16x8*)((BASE) + (ROW) * (STRIDE) + (KB) + 8 * h))
#pragma unroll 1
      for (int step = 0; step < nch; ++step) {
        const int ch = dir ? nch - 1 - step : step;
        const int tok0 = tokS + ch * 64;
        const float* vec = vec0 + (step & 1) * 132;
        __syncthreads();
        f32x16 VN[2], Oa[2];
        {
          f32x16 KS[2];
#pragma unroll
          for (int ib = 0; ib < 2; ++ib)
#pragma unroll
            for (int r = 0; r < 16; ++r) { KS[ib][r] = 0.f; VN[ib][r] = 0.f; Oa[ib][r] = 0.f; }
#pragma unroll
          for (int db = 0; db < 4; ++db)
#pragma unroll
            for (int s2 = 0; s2 < 2; ++s2) {
              const bf16x8 sb = pack8(S[db], s2);
#pragma unroll
              for (int ib = 0; ib < 2; ++ib) KS[ib] = MFMA(SC_AF(sk, 136, 32 * ib + r32, 32 * db + 16 * s2), sb, KS[ib]);
#pragma unroll
              for (int ib = 0; ib < 2; ++ib) Oa[ib] = MFMA(SC_AF(sq, 136, 32 * ib + r32, 32 * db + 16 * s2), sb, Oa[ib]);
            }
#pragma unroll
          for (int ib = 0; ib < 2; ++ib)
#pragma unroll
            for (int r = 0; r < 16; ++r) {
              const int i = 32 * ib + crow(r, h);
              KS[ib][r] = bf2f(sv[i * 136 + e0 + r32]) - vec[i] * KS[ib][r];
            }
#pragma unroll
          for (int ib = 0; ib < 2; ++ib)
#pragma unroll
            for (int s2 = 0; s2 < 2; ++s2) {
              const bf16x8 xb = pack8(KS[ib], s2);
#pragma unroll
              for (int i2 = 0; i2 < 2; ++i2) VN[i2] = MFMA(SC_AF(sTb, 72, 32 * i2 + r32, 32 * ib + 16 * s2), xb, VN[i2]);
            }
        }
        {
#pragma unroll
          for (int ib = 0; ib < 2; ++ib)
#pragma unroll
            for (int r = 0; r < 16; ++r) Oa[ib][r] *= vec[32 * ib + crow(r, h)];
#pragma unroll
          for (int ib = 0; ib < 2; ++ib)
#pragma unroll
            for (int s2 = 0; s2 < 2; ++s2) {
              const bf16x8 vb = pack8(VN[ib], s2);
#pragma unroll
              for (int i2 = 0; i2 < 2; ++i2) Oa[i2] = MFMA(SC_AF(sA, 72, 32 * i2 + r32, 32 * ib + 16 * s2), vb, Oa[i2]);
            }
          __syncthreads();
#pragma unroll
          for (int ib = 0; ib < 2; ++ib) {
            u16* op_ = O + (size_t)(tok0 + 32 * ib + 4 * h) * 512 + head * 128 + e0 + r32;
#pragma unroll
            for (int r = 0; r < 16; r += 2) { const unsigned w_ = pack2(Oa[ib][r], Oa[ib][r + 1]);
              op_[(size_t)((r & 3) + 8 * (r >> 2)) * 512] = (u16)(w_ & 0xffffu); op_[(size_t)((r & 3) + 8 * (r >> 2) + 1) * 512] = (u16)(w_ >> 16); }
          }
        }
        const float eg = vec[128];
#pragma unroll
        for (int db = 0; db < 4; ++db)
#pragma unroll
          for (int r = 0; r < 16; ++r) S[db][r] *= eg;
#pragma unroll
        for (int ib = 0; ib < 2; ++ib) {
#pragma unroll
          for (int r = 0; r < 16; ++r) VN[ib][r] *= vec[64 + 32 * ib + crow(r, h)];
#pragma unroll
          for (int s2 = 0; s2 < 2; ++s2) {
            const bf16x8 vb = pack8(VN[ib], s2);
#pragma unroll
            for (int db = 0; db < 4; ++db) S[db] = MFMA(SC_AF(skT, 72, 32 * db + r32, 32 * ib + 16 * s2), vb, S[db]);
          }
        }
      }
#undef SC_AF
      if (s < 16) {
        float* st = p.out + O_STATE + ((size_t)((s * 2 + dir) * 4 + head)) * 16384;
#pragma unroll
        for (int db = 0; db < 4; ++db)
#pragma unroll
          for (int r = 0; r < 16; ++r) st[(32 * db + crow(r, h)) * 128 + e0 + r32] = S[db][r];
      }
    }
  }
  __syncthreads();
  if (gridDim.x == 256 && blockIdx.x >= 64) l1prep_t<false, true>(p, lds, (int)blockIdx.x - 64, 192);
}

#ifndef DBG_CHECK
#define DBG_CHECK 0
#endif
#ifndef DBG_AMP
#define DBG_AMP 10.f
#endif
constexpr size_t WS_DBG = WS_END + 16384;
DI void fingerprint(const Params& p, const void* buf, size_t n, bool isf32, int slot, char* lds) {
  float acc[9];
#pragma unroll
  for (int k = 0; k < 9; ++k) acc[k] = 0.f;
  for (size_t i = (size_t)blockIdx.x * NTHREADS + threadIdx.x; i < n; i += (size_t)gridDim.x * NTHREADS) {
    const float x = isf32 ? ((const float*)buf)[i] : bf2f(((const u16*)buf)[i]);
    unsigned hsh = (unsigned)i * 0x9E3779B1u; hsh ^= hsh >> 15; hsh *= 0x85EBCA77u; hsh ^= hsh >> 13;
#pragma unroll
    for (int k = 0; k < 8; ++k) acc[k] += ((hsh >> k) & 1u) ? x : -x;
    acc[8] += x * x;
  }
  float* red = (float*)lds;
  __syncthreads();
#pragma unroll
  for (int k = 0; k < 9; ++k) { const float v = wave_sum(acc[k]); if ((threadIdx.x & 63) == 0) red[(threadIdx.x >> 6) * 9 + k] = v; }
  __syncthreads();
  if (threadIdx.x < 9) {
    float v = 0.f;
    for (int w = 0; w < 8; ++w) v += red[w * 9 + threadIdx.x];
    ((float*)(p.ws + WS_DBG))[((size_t)slot * 256 + blockIdx.x) * 16 + threadIdx.x] = v;
  }
  __syncthreads();
}
DI float dbg_rel(const Params& p) {
  const float* d = (const float*)(p.ws + WS_DBG);
  float fn[9], ff[9];
#pragma unroll
  for (int k = 0; k < 9; ++k) { fn[k] = 0.f; ff[k] = 0.f; }
  for (int b = 0; b < (int)gridDim.x; ++b)
#pragma unroll
    for (int k = 0; k < 9; ++k) { fn[k] += d[((size_t)b) * 16 + k]; ff[k] += d[((size_t)256 + b) * 16 + k]; }
  float s = 0.f;
#pragma unroll
  for (int k = 0; k < 8; ++k) s += (ff[k] - fn[k]) * (ff[k] - fn[k]);
  return sqrtf(s * 0.125f / fn[8]);
}


#define XB_TMO      128
#define XB_XCNT(j)  (256  + 64 * (j))
#define XB_XSUB(j)  (1280 + 64 * (j))
#define XB_XGEN(j)  (2304 + 64 * (j))
#define XB_TOP      3328
#define XB_TOPGEN   3392
#define XCD_BAR_WORDS 3456
#define XB_SPIN_CAP (1u << 18)
#define LAS __attribute__((address_space(3)))
DI unsigned xb_ld(unsigned* p)              { return __hip_atomic_load(p, __ATOMIC_RELAXED, __HIP_MEMORY_SCOPE_AGENT); }
DI unsigned xb_add(unsigned* p, unsigned v) { return __hip_atomic_fetch_add(p, v, __ATOMIC_RELAXED, __HIP_MEMORY_SCOPE_AGENT); }
DI unsigned xb_xcc_id() { return (unsigned)__builtin_amdgcn_s_getreg((3 << 11) | 20) & 0xFu; }
#define XB_SPIN(cond, bar) do { unsigned _sp = 0; while (cond) { __builtin_amdgcn_s_sleep(1); \
    if ((++_sp & 255u) == 0u) { if (xb_ld(&(bar)[XB_TMO])) break; if (_sp > XB_SPIN_CAP) { atomicAdd(&(bar)[XB_TMO], 1u); break; } } } } while (0)
struct XcdBarrier { unsigned* bar; unsigned x; volatile LAS unsigned* st; };
DI XcdBarrier xcd_barrier_post(unsigned* bar, volatile LAS unsigned* st) {
  XcdBarrier b; b.bar = bar; b.x = xb_xcc_id(); b.st = st;
  if (threadIdx.x == 0) (void)xb_add(&bar[XB_XCNT(b.x)], 1u);
  return b;
}
DI void xcd_barrier_complete(unsigned* bar, unsigned x, unsigned& nloc, unsigned& nx) {
  const unsigned G = gridDim.x * gridDim.y * gridDim.z;
  unsigned sum, cnt, mine, sp = 0u;
  for (;;) {
    sum = 0u; cnt = 0u; mine = 0u;
#pragma unroll
    for (unsigned j = 0; j < 16; ++j) { const unsigned c = xb_ld(&bar[XB_XCNT(j)]); sum += c; cnt += (c > 0u) ? 1u : 0u; mine = (j == x) ? c : mine; }
    if (sum == G) break;
    __builtin_amdgcn_s_sleep(1);
    if ((++sp & 255u) == 0u) { if (xb_ld(&bar[XB_TMO])) break; if (sp > XB_SPIN_CAP) { atomicAdd(&bar[XB_TMO], 1u); break; } }
  }
  nloc = mine > 0u ? mine : 1u; nx = cnt > 0u ? cnt : 1u;
}
DI void xcd_barrier(const XcdBarrier& b) {
  asm volatile("s_waitcnt vmcnt(0)" ::: "memory");
  __syncthreads();
  if (threadIdx.x == 0) {
    unsigned* bar = b.bar;
    __builtin_amdgcn_s_waitcnt(0);
    unsigned nloc = b.st[0], nx = b.st[1];
    if (nloc == 0u) { xcd_barrier_complete(bar, b.x, nloc, nx); b.st[0] = nloc; b.st[1] = nx; }
    const unsigned old = xb_add(&bar[XB_XSUB(b.x)], 1u);
    const unsigned gen = old / nloc;
    if (old + 1u == (gen + 1u) * nloc) {
      __builtin_amdgcn_fence(__ATOMIC_RELEASE, "agent");
      asm volatile("s_waitcnt vmcnt(0)" ::: "memory");
      const unsigned og = xb_add(&bar[XB_TOP], 1u);
      const unsigned tg = og / nx;
      if (og + 1u == (tg + 1u) * nx) xb_add(&bar[XB_TOPGEN], 1u);
      else XB_SPIN(xb_ld(&bar[XB_TOPGEN]) == tg, bar);
      __builtin_amdgcn_fence(__ATOMIC_ACQUIRE, "agent");
      xb_add(&bar[XB_XGEN(b.x)], 1u);
      asm volatile("s_waitcnt vmcnt(0)" ::: "memory");
    } else {
      XB_SPIN(xb_ld(&bar[XB_XGEN(b.x)]) == gen, bar);
      __builtin_amdgcn_fence(__ATOMIC_ACQUIRE, "agent");
      asm volatile("s_waitcnt vmcnt(0)" ::: "memory");
    }
  }
  __syncthreads();
}

extern __shared__ __attribute__((aligned(16))) char smem[];
constexpr int LDS_BYTES = 147456;

#ifndef REPEAT
#define REPEAT 0
#endif
#ifndef FAST_MASK
#define FAST_MASK 255
#endif
DI void code_prefetch(unsigned long long code_end) {
  unsigned long long pc;
  asm volatile("s_getpc_b64 %0" : "=s"(pc));
  pc &= ~63ull;
  const unsigned rem = code_end > pc ? (unsigned)(code_end - pc) : 0u;
  const unsigned o0 = threadIdx.x * 64u, o1 = o0 + 32768u;
  const char* base = (const char*)pc;
  const int v0 = *(const volatile int*)(base + (o0 < rem ? o0 : rem));
  const int v1 = *(const volatile int*)(base + (o1 < rem ? o1 : rem));
  asm volatile("" :: "v"(v0), "v"(v1));
}
#define GSYNC() do { code_prefetch(code_end); xcd_barrier(xb); } while (0)
#define GSYNC_KB(kb) GSYNC()

#ifndef DBG_TIME
#define DBG_TIME -1
#endif
#if DBG_TIME >= 0
#define TSTAMP(i) do { if (blockIdx.x == 0 && threadIdx.x == 0) ((volatile unsigned long long*)(smem + LDS_BYTES - 512))[i] = __builtin_amdgcn_s_memrealtime(); } while (0)
#else
#define TSTAMP(i) do {} while (0)
#endif
__global__ void __launch_bounds__(NTHREADS) fwd_megakernel(Params p) {
  unsigned long long code_end; unsigned code_len;
  asm volatile("s_getpc_b64 %0\n.Lcp_base:\n\ts_mov_b32 %1, .Lcp_end-.Lcp_base" : "=s"(code_end), "=s"(code_len));
  code_end = (code_end + code_len) & ~63ull;
  cg::grid_group grid = cg::this_grid();
  char* lds = smem;
  __shared__ uint4 xb_words;
  if (threadIdx.x == 0) xb_words = make_uint4(0u, 0u, 0u, 0u);
  __syncthreads();
  XcdBarrier xb = xcd_barrier_post((unsigned*)(p.ws + WS_BAR), (volatile LAS unsigned*)&xb_words);
  TSTAMP(0);
  phase_prep(p, lds);            GSYNC(); TSTAMP(1);
  if (p.ws == nullptr) grid.sync();
  phase_adaln(p, 0);             GSYNC(); TSTAMP(2);
  phase8_layer0_gemms(p, lds, [&]() { GSYNC(); });   GSYNC(); TSTAMP(5);
  phase_attn0(p, lds, code_end); GSYNC(); TSTAMP(6);
  phase8_outproj(p, 0, lds);     prep_deferred_layer1_weights(p, lds); GSYNC(); TSTAMP(7);
  phase_adaln(p, 1);             GSYNC(); TSTAMP(8);
  phase8_inproj1(p, lds);        GSYNC(); TSTAMP(9);
  phase_l1prep(p, lds);
  if (gridDim.x == 256) { asm volatile("s_waitcnt vmcnt(0)" ::: "memory"); __syncthreads(); }
  else GSYNC();
  TSTAMP(10);
  phase_chunkprep(p, lds);       GSYNC_KB(32); TSTAMP(11);
  phase_scan(p, lds);            GSYNC_KB(24); TSTAMP(12);
  phase_gdnfinal(p);
  code_prefetch(code_end);
  phase_attn1(p, lds);           GSYNC_KB(12); TSTAMP(13);
  phase8_outproj(p, 1, lds);     GSYNC_KB(3); TSTAMP(14);
  phase_final(p);
#if DBG_TIME >= 0
  GSYNC(); TSTAMP(15);
  if (blockIdx.x == 0) {
    __syncthreads();
    const size_t offs[7] = {O_CKV, O_KROPE, O_SWAK, O_SWAV, O_STATE, O_ATTK, O_ATTV};
    volatile unsigned long long* tb = (volatile unsigned long long*)(smem + LDS_BYTES - 512);
    for (int k = 0; k < 7; ++k) {
      const int i0 = DBG_TIME + k;
      if (i0 + 1 > 15) break;
      const unsigned long long dt = tb[i0 + 1] - tb[i0];
      const int n = (int)(dt / 100ull);
      for (int e = threadIdx.x; e < n; e += NTHREADS) ((unsigned*)p.out)[offs[k] + e] = 0xAAAAAAAAu;
    }
  }
#endif
  asm volatile(".Lcp_end:");
}

extern "C" void kernel_launch(void* const* d_in, const int* in_sizes, int n_in, void* d_out, int out_size, void* d_ws, size_t ws_size, hipStream_t stream) {
  static int grid_blocks = 0;
  if (!grid_blocks) {
    int dev = 0, cus = 0, per_cu = 0;
    (void)hipGetDevice(&dev);
    (void)hipDeviceGetAttribute(&cus, hipDeviceAttributeMultiprocessorCount, dev);
    (void)hipFuncSetAttribute((const void*)fwd_megakernel, hipFuncAttributeMaxDynamicSharedMemorySize, LDS_BYTES);
    (void)hipOccupancyMaxActiveBlocksPerMultiprocessor(&per_cu, fwd_megakernel, NTHREADS, LDS_BYTES);
    if (per_cu > 1) per_cu = 1;
    grid_blocks = (cus * per_cu) & ~7;
    if (grid_blocks <= 0) { fprintf(stderr, "occupancy query failed (cus %d per_cu %d)\n", cus, per_cu); grid_blocks = 0; return; }
  }
  if (n_in != 33 || ws_size < WS_END + 65536) { fprintf(stderr, "kernel_launch: unexpected n_in %d / ws %zu\n", n_in, ws_size); return; }
  Params p{};
  const float** pp = (const float**)&p;
  for (int i = 0; i < 33; ++i) pp[i] = (const float*)d_in[i];
  p.out = (float*)d_out;
  p.ws = (char*)d_ws;
  (void)hipMemsetAsync((char*)d_ws + WS_BAR, 0, 16384, stream);
  void* args[] = {&p};
  hipError_t e = hipLaunchCooperativeKernel((void*)fwd_megakernel, dim3(grid_blocks), dim3(NTHREADS), args, LDS_BYTES, stream);
  if (e != hipSuccess) fprintf(stderr, "cooperative launch failed: %s (grid %d)\n", hipGetErrorString(e), grid_blocks);
}
```

```cpp
#include <hip/hip_runtime.h>
#include <hip/hip_cooperative_groups.h>
#include <cstdio>
#include <cstdint>
namespace cg = cooperative_groups;

#define DI __device__ __forceinline__
typedef unsigned short u16;
using bf16x8 = __attribute__((ext_vector_type(8))) short;
using bf16x4 = __attribute__((ext_vector_type(4))) short;
using f32x16 = __attribute__((ext_vector_type(16))) float;
using f32x4  = __attribute__((ext_vector_type(4))) float;
using u32x4  = __attribute__((ext_vector_type(4))) unsigned;
using u32x2  = __attribute__((ext_vector_type(2))) unsigned;

#ifndef PHASE_LIMIT
#define PHASE_LIMIT 99
#endif

constexpr int NTHREADS = 512;
constexpr int DM = 1024, NTOK = 20480, NCTX = 4096, NKROW = 24576;
constexpr int L0C = 2464, L0CP = 2560, L1C = 3600, L1CP = 3840;
constexpr int U1A_LD = 1536, U1B_LD = 2048;
constexpr int C0_CQ = 0, C0_CKV = 384, C0_KR = 640, C0_ZA = 672, C0_QB = 1184, C0_KB = 1696, C0_VB = 1824, C0_ZB = 1952;
constexpr int C1_ZC = 0, C1_QD = 512, C1_KD = 1024, C1_VD = 1280, C1_ZD = 1536;
constexpr float EPS = 1e-6f;
constexpr float LOG2E = 1.4426950408889634f;

constexpr size_t O_Y = 0;
constexpr size_t O_CKV = 20971520, O_KROPE = 22020096, O_SWAK = 22151168, O_SWAV = 22675456, O_STATE = 23199744, O_ATTK = 25296896, O_ATTV = 26345472;

constexpr size_t WS_WO1 = 0;
constexpr size_t WS_MOD = WS_WO1 + 2097152;
constexpr size_t WS_ROPE = WS_MOD + 221184;
constexpr size_t WS_W2 = WS_ROPE + 32768;
constexpr size_t WS_WT0 = WS_W2;
constexpr size_t WS_WUQ = WS_WT0 + 5242880;
constexpr size_t WS_WUKV = WS_WUQ + 589824;
constexpr size_t WS_WO0 = WS_WUKV + 524288;
constexpr size_t WS_WT1 = WS_WO0 + 2097152;
constexpr size_t WS_W2_END = WS_WT1 + 7864320;
constexpr size_t WS_VTATT = WS_W2;
constexpr size_t WS_KC = WS_VTATT + 12582912;
constexpr size_t WS_GB = WS_KC + 2097152;
static_assert(WS_GB + 1310720 <= WS_W2_END, "layer-1 reuse overflow");
constexpr size_t WS_H = WS_W2_END;
constexpr size_t WS_U = WS_H + 41943040;
constexpr size_t WS_U0X = WS_U + (size_t)NTOK * L0C * 2;
constexpr size_t WS_KSWA = WS_U0X;
constexpr size_t WS_VTSWA = WS_KSWA + 6291456;
constexpr size_t WS_CKVN = WS_VTSWA + 6291456;
constexpr size_t WS_KROPE = WS_CKVN + 12582912;
static_assert(WS_KROPE + 1572864 <= WS_U + 147456000, "layer-0 extras overflow");
constexpr size_t WS_GY0 = WS_U;
constexpr size_t WS_U1A = WS_U;
constexpr size_t WS_U1B = WS_U + 62914560;
constexpr size_t WS_GY1 = WS_U1A;
constexpr size_t WS_TB = WS_U1A;
constexpr size_t WS_AM = WS_TB + 20971520;
constexpr size_t WS_OB = WS_AM + 20971520;
constexpr size_t WS_X = WS_U + 147456000;
constexpr size_t WS_VC = WS_X;
constexpr size_t WS_OF = WS_VC + 20971520;
constexpr size_t WS_AB = WS_OF + 20971520;
constexpr size_t WS_END = WS_AB + 1310720;
static_assert(WS_END <= 268435456ull, "ws overflow");
constexpr size_t WS_BAR = WS_END;
constexpr size_t YS_QMLA = 0;
constexpr size_t YS_KN = YS_QMLA + 31457280;
constexpr size_t YS_VTMLA = YS_KN + 25165824;
static_assert(YS_VTMLA + 25165824 <= (size_t)NTOK * DM * 4, "y scratch overflow");

struct Params {
  const float *x_prompt, *x_sample, *c_ckv, *c_krope, *c_swak, *c_swav, *c_state, *c_attk, *c_attv, *c, *c_ctx;
  const float *w_mod0, *b_mod0, *ln0, *w_in0, *mla_q_norm, *w_uq, *mla_kv_norm, *w_ukv, *swa_sink, *w_out0;
  const float *w_mod1, *b_mod1, *ln1, *w_in1, *gdn_conv, *gdn_a_log, *gdn_dt_bias, *gdn_norm, *att_q_norm, *att_k_norm, *w_out1, *ln_f;
  float* out;
  char* ws;
};

DI int opaque_zero() { int z = 0; asm volatile("" : "+v"(z)); return z; }
DI int opaque_tid() { int t = (int)threadIdx.x; asm volatile("" : "+v"(t)); return t; }
#define TIDX() opaque_tid()
DI void code_prefetch(unsigned long long code_end);
DI float bf2f(u16 b) { return __uint_as_float(((unsigned)b) << 16); }
typedef float ntf4 __attribute__((ext_vector_type(4)));
DI u32x4 ntload4u(const u16* q) { return __builtin_nontemporal_load((const u32x4*)q); }
DI u32x2 ntload2u(const u16* q) { return __builtin_nontemporal_load((const u32x2*)q); }
DI float4 ntload4(const float* q) { const ntf4 v = __builtin_nontemporal_load((const ntf4*)q); return make_float4(v[0], v[1], v[2], v[3]); }
DI u16 f2bf(float x) { unsigned u = __float_as_uint(x); u += 0x7fffu + ((u >> 16) & 1u); return (u16)(u >> 16); }
typedef __bf16 hwbf16x2_t __attribute__((ext_vector_type(2)));
typedef float hwf32x2_t __attribute__((ext_vector_type(2)));
DI unsigned pack2(float lo, float hi) { const hwf32x2_t v = {lo, hi}; return __builtin_bit_cast(unsigned, __builtin_convertvector(v, hwbf16x2_t)); }
DI int crow(int reg, int h) { return (reg & 3) + 8 * (reg >> 2) + 4 * h; }
DI int swz16(int k) { return (k & ~12) | ((k & 4) << 1) | ((k & 8) >> 1); }
DI float siluf(float x) { return x * __builtin_amdgcn_rcpf(1.f + __expf(-x)); }
DI int seq_of_tok(int m) { return m < NCTX ? (m >> 8) : 16 + ((m - NCTX) >> 11); }
DI int tok0_of(int s) { return s < 16 ? s * 256 : NCTX + (s - 16) * 2048; }
DI int krow0_of(int s) { return s < 16 ? s * 256 : NCTX + (s - 16) * 2560; }
DI int cap_of(int s) { return s < 16 ? 256 : 2560; }
DI int len_of(int s) { return s < 16 ? 256 : 2048; }
DI int modidx_of_tok(int m) { return m < NCTX ? 0 : 1 + ((m - NCTX) >> 11); }
DI int krow_of_tok(int m) { return m < NCTX ? m : NCTX + ((m - NCTX) >> 11) * 2560 + ((m - NCTX) & 2047); }
DI int pos_of_tok(int m) { return m < NCTX ? (m & 255) : ((m - NCTX) & 2047); }
DI const float* xrow(const Params& p, int m) { return m < NCTX ? p.x_prompt + (size_t)m * DM : p.x_sample + (size_t)(m - NCTX) * DM; }
DI float wave_sum(float v) {
#pragma unroll
  for (int o = 32; o > 0; o >>= 1) v += __shfl_xor(v, o);
  return v;
}
DI bf16x8 pack8(const f32x16& x, int s) {
  u32x4 w = {pack2(x[8 * s + 0], x[8 * s + 1]), pack2(x[8 * s + 2], x[8 * s + 3]), pack2(x[8 * s + 4], x[8 * s + 5]), pack2(x[8 * s + 6], x[8 * s + 7])};
  return __builtin_bit_cast(bf16x8, w);
}
DI bf16x8 cat4(bf16x4 lo, bf16x4 hi) { return __builtin_shufflevector(lo, hi, 0, 1, 2, 3, 4, 5, 6, 7); }
#define MFMA(a, b, c) __builtin_amdgcn_mfma_f32_32x32x16_bf16((a), (b), (c), 0, 0, 0)

DI void transpose_tile(const float* __restrict__ W, int ldw, int k0, int srccol0, int nvalid, u16* __restrict__ Wt, int ldt, int dstrow0, char* lds) {
  u16* t = (u16*)lds;
  const int tid = TIDX(), kr = tid >> 3, cc = (tid & 7) * 8;
  float v[8];
  if (cc < nvalid) {
    const float4 a = *(const float4*)(W + (size_t)(k0 + kr) * ldw + srccol0 + cc);
    const float4 b = *(const float4*)(W + (size_t)(k0 + kr) * ldw + srccol0 + cc + 4);
    v[0] = a.x; v[1] = a.y; v[2] = a.z; v[3] = a.w; v[4] = b.x; v[5] = b.y; v[6] = b.z; v[7] = b.w;
  } else {
#pragma unroll
    for (int e = 0; e < 8; ++e) v[e] = 0.f;
  }
#pragma unroll
  for (int e = 0; e < 8; ++e) t[(cc + e) * 72 + kr] = f2bf(v[e]);
  __syncthreads();
  const int n = tid >> 3, kc = (tid & 7) * 8;
  *(bf16x8*)(Wt + (size_t)(dstrow0 + n) * ldt + k0 + kc) = *(const bf16x8*)(t + n * 72 + kc);
  __syncthreads();
}

template <int MAT>
DI void transpose_tiles4(const Params& p, int t0, char* lds) {
  constexpr int NTN = MAT == 0 ? 40 : MAT == 1 ? 12 : MAT == 2 ? 16 : MAT == 4 ? 60 : 16;
  constexpr int NKT = MAT == 1 ? 6 : MAT == 2 ? 4 : 16;
  constexpr int LDW = MAT == 0 ? L0C : MAT == 1 ? 768 : MAT == 4 ? L1C : 1024;
  constexpr int LDT = MAT == 1 ? 384 : MAT == 2 ? 256 : 1024;
  const float* W = MAT == 0 ? p.w_in0 : MAT == 1 ? p.w_uq : MAT == 2 ? p.w_ukv : MAT == 3 ? p.w_out0 : MAT == 4 ? p.w_in1 : p.w_out1;
  u16* Wt = (u16*)(p.ws + (MAT == 0 ? WS_WT0 : MAT == 1 ? WS_WUQ : MAT == 2 ? WS_WUKV : MAT == 3 ? WS_WO0 : MAT == 4 ? WS_WT1 : WS_WO1));
  const int tid = TIDX(), kr = tid >> 3, cc = (tid & 7) * 8;
  float v[4][8];
#pragma unroll
  for (int q = 0; q < 4; ++q) {
    const int t = t0 + q;
#pragma unroll
    for (int e = 0; e < 8; ++e) v[q][e] = 0.f;
    if (t < NTN * NKT) {
      const int kt = t / NTN, nt = t % NTN, n0 = nt * 64;
      int src = n0, nv = 64;
      if (MAT == 0) { nv = L0C - n0; nv = nv < 0 ? 0 : (nv > 64 ? 64 : nv); }
      if (MAT == 2) src = nt < 8 ? nt * 128 : (nt - 8) * 128 + 64;
      if (MAT == 4) { if (n0 < 1536) { src = n0; } else if (n0 < 3584) { src = n0 + 16; } else if (n0 == 3584) { src = 1536; nv = 16; } else { src = 0; nv = 0; } }
      if (cc < nv) {
        const float4 a = ntload4(W + (size_t)(kt * 64 + kr) * LDW + src + cc);
        const float4 b = ntload4(W + (size_t)(kt * 64 + kr) * LDW + src + cc + 4);
        v[q][0] = a.x; v[q][1] = a.y; v[q][2] = a.z; v[q][3] = a.w; v[q][4] = b.x; v[q][5] = b.y; v[q][6] = b.z; v[q][7] = b.w;
      }
    }
  }
#pragma unroll
  for (int q = 0; q < 4; ++q) {
    u16* tl = (u16*)lds + q * 64 * 72;
#pragma unroll
    for (int e = 0; e < 8; ++e) tl[(cc + e) * 72 + (kr ^ cc)] = f2bf(v[q][e]);
  }
  __syncthreads();
  const int n = tid >> 3, kc = (tid & 7) * 8;
#pragma unroll
  for (int q = 0; q < 4; ++q) {
    const int t = t0 + q;
    if (t < NTN * NKT) {
      const int kt = t / NTN, nt = t % NTN;
      *(bf16x8*)(Wt + (size_t)(nt * 64 + n) * LDT + kt * 64 + kc) = *(const bf16x8*)((const u16*)lds + q * 64 * 72 + n * 72 + (kc ^ (n & 56)));
    }
  }
  __syncthreads();
}

DI void vt_store16(const u16* sv, int CS, int C, u16* __restrict__ vt, size_t cap, int key16base) {
  for (int i = TIDX(); i < C * 4; i += NTHREADS) {
    const int ch = i >> 2, q = i & 3;
    u16 e[4];
#pragma unroll
    for (int j = 0; j < 4; ++j) e[j] = sv[swz16(q * 4 + j) * CS + ch];
    u32x2 w = {(unsigned)e[0] | ((unsigned)e[1] << 16), (unsigned)e[2] | ((unsigned)e[3] << 16)};
    *(u32x2*)(vt + (size_t)ch * cap + key16base + q * 4) = w;
  }
}

DI void prep_convert_item(const Params& p, int t) {
  const int tid = TIDX();
      const int e0 = tid * 8;
      if (t < 256) {
        const size_t i = (size_t)t * 4096 + e0; const int b = (int)(i >> 17), rem = (int)(i & 131071), pp = rem >> 8, cc = rem & 255;
        const float4 a = ntload4(p.c_ckv + i), b4 = ntload4(p.c_ckv + i + 4);
        u32x4 w = {pack2(a.x, a.y), pack2(a.z, a.w), pack2(b4.x, b4.y), pack2(b4.z, b4.w)};
        *(u32x4*)((u16*)(p.ws + WS_CKVN) + (size_t)(NCTX + b * 2560 + 2048 + pp) * 256 + cc) = w;
      } else if (t < 288) {
        const size_t i = (size_t)(t - 256) * 4096 + e0; const int b = (int)(i >> 14), rem = (int)(i & 16383), pp = rem >> 5, cc = rem & 31;
        const float4 a = *(const float4*)(p.c_krope + i), b4 = *(const float4*)(p.c_krope + i + 4);
        u32x4 w = {pack2(a.x, a.y), pack2(a.z, a.w), pack2(b4.x, b4.y), pack2(b4.z, b4.w)};
        *(u32x4*)((u16*)(p.ws + WS_KROPE) + (size_t)(NCTX + b * 2560 + 2048 + pp) * 32 + cc) = w;
      } else {
        const size_t i = (size_t)(t - 288) * 4096 + e0; const int b = (int)(i >> 16), rem = (int)(i & 65535), pp = rem >> 7, cc = rem & 127;
        const float4 a = ntload4(p.c_swak + i), b4 = ntload4(p.c_swak + i + 4);
        u32x4 w = {pack2(a.x, a.y), pack2(a.z, a.w), pack2(b4.x, b4.y), pack2(b4.z, b4.w)};
        *(u32x4*)((u16*)(p.ws + WS_KSWA) + (size_t)(NCTX + b * 2560 + 2048 + pp) * 128 + cc) = w;
      }
}
DI void prep_vt_item(const Params& p, int t, char* lds) {
  const int tid = TIDX();
      const int b = t >> 5, g = t & 31;
      u16* sv = (u16*)lds;
      {
        const int key = tid >> 5, c4 = (tid & 31) * 4;
        const float4 a = *(const float4*)(p.c_swav + ((size_t)(b * 512 + g * 16 + key)) * 128 + c4);
        u32x2 w = {pack2(a.x, a.y), pack2(a.z, a.w)};
        *(u32x2*)(sv + key * 136 + c4) = w;
      }
      __syncthreads();
      vt_store16(sv, 136, 128, (u16*)(p.ws + WS_VTSWA) + (size_t)krow0_of(16 + b) * 128, 2560, 2048 + g * 16);
      __syncthreads();
}
DI void phase_prep(const Params& p, char* lds) {
  const int tid = TIDX();
  constexpr int N_MOD = 192;
  constexpr int T_IN0 = 16 * 40, T_UQ = 6 * 12, T_UKV = 4 * 16, T_O0 = 256, T_IN1 = 16 * 60, T_O1 = 256;
  constexpr int N_TR = T_IN0 + T_UQ + T_UKV + T_O0 + T_IN1 + T_O1;
  constexpr int N_CV = 256 + 32 + 128;
  constexpr int N_VT = 256;
  const int N_TRQ = gridDim.x == 256 ? 258 : 562;
  const int N_ITEMS = N_MOD + N_TRQ + N_CV + N_VT + 1;
  const bool full = gridDim.x == 256;
  const int n_here = full ? 192 + 194 + 256 + 1 : N_ITEMS;
  for (int i = blockIdx.x; i < n_here; i += gridDim.x) {
    int it = i;
    if (full && i >= 386) it = i < 642 ? N_MOD + N_TRQ + (i - 386) : N_ITEMS - 1;
    if (it < N_MOD) {
      const int layer = it / 96, col0 = (it % 96) * 32;
      const float* Wm = layer ? p.w_mod1 : p.w_mod0;
      const float* bm = layer ? p.b_mod1 : p.b_mod0;
      float* sc = (float*)lds;
      float* red = sc + 9 * 1024;
      for (int i = tid; i < 9 * 1024; i += NTHREADS) {
        const int s = i >> 10, k = i & 1023;
        const float cv = s == 0 ? p.c_ctx[k] : p.c[(s - 1) * 1024 + k];
        sc[i] = siluf(cv);
      }
      __syncthreads();
      const int col = tid & 31, kg = tid >> 5;
      float acc[9];
#pragma unroll
      for (int s = 0; s < 9; ++s) acc[s] = 0.f;
      for (int kk = 0; kk < 64; ++kk) {
        const int k = kg * 64 + kk;
        const float w = __builtin_nontemporal_load(Wm + (size_t)k * 3072 + col0 + col);
#pragma unroll
        for (int s = 0; s < 9; ++s) acc[s] += sc[s * 1024 + k] * w;
      }
#pragma unroll
      for (int s = 0; s < 9; ++s) red[(kg * 9 + s) * 32 + col] = acc[s];
      __syncthreads();
      if (tid < 288) {
        const int s = tid >> 5, c2 = tid & 31;
        float a = bm[col0 + c2];
        for (int g = 0; g < 16; ++g) a += red[(g * 9 + s) * 32 + c2];
        ((float*)(p.ws + WS_MOD))[(size_t)(layer * 9 + s) * 3072 + col0 + c2] = a;
      }
      __syncthreads();
    } else if (it < N_MOD + N_TRQ) {
      int bq = it - N_MOD;
      if (bq < 160) transpose_tiles4<0>(p, bq * 4, lds);
      else if (bq < 178) transpose_tiles4<1>(p, (bq - 160) * 4, lds);
      else if (bq < 194) transpose_tiles4<2>(p, (bq - 178) * 4, lds);
      else if (bq < 258) transpose_tiles4<3>(p, (bq - 194) * 4, lds);
      else if (bq < 498) transpose_tiles4<4>(p, (bq - 258) * 4, lds);
      else transpose_tiles4<5>(p, (bq - 498) * 4, lds);
    } else if (it < N_MOD + N_TRQ + N_CV) {
      prep_convert_item(p, it - N_MOD - N_TRQ);
    } else if (it < N_MOD + N_TRQ + N_CV + N_VT) {
      prep_vt_item(p, it - N_MOD - N_TRQ - N_CV, lds);
    } else {
      float2* tab = (float2*)(p.ws + WS_ROPE);
      for (int i = tid; i < 64 * 8 + 64 * 16 + 64 * 32; i += NTHREADS) {
        int q, pos, f, j = i;
        if (j < 512) { q = 8; } else if (j < 1536) { q = 16; j -= 512; } else { q = 32; j -= 1536; }
        pos = j / q; f = j % q;
        const float inv = __builtin_amdgcn_exp2f(-(float)f / (float)q * 13.287712379549449f);
        const float rev = (float)pos * inv * 0.15915494309189535f;
        tab[i] = make_float2(__builtin_amdgcn_cosf(rev), __builtin_amdgcn_sinf(rev));
      }
    }
  }
}

DI void phase_adaln(const Params& p, int layer) {
  const int tid_ = TIDX(), lane = tid_ & 63, wid = tid_ >> 6;
  const float* ln = layer ? p.ln1 : p.ln0;
  const float* mod = (const float*)(p.ws + WS_MOD) + (size_t)layer * 9 * 3072;
  u16* H = (u16*)(p.ws + WS_H);
  const u16* GY = (const u16*)(p.ws + WS_GY0);
  float4 g4[4];
#pragma unroll
  for (int j = 0; j < 4; ++j) g4[j] = *(const float4*)(ln + (j * 64 + lane) * 4);
  const int stride = gridDim.x * 8;
  int m = blockIdx.x * 8 + wid;
  float4 cur[4], nxt[4]; u32x2 cg[4], ng[4];
  if (m < NTOK) { const float* x = xrow(p, m);
#pragma unroll
    for (int j = 0; j < 4; ++j) { cur[j] = ntload4(x + (j * 64 + lane) * 4); if (layer) cg[j] = ntload2u(GY + (size_t)m * DM + (j * 64 + lane) * 4); } }
  for (; m < NTOK; m += stride) {
    const int mn = m + stride;
    if (mn < NTOK) { const float* xn = xrow(p, mn);
#pragma unroll
      for (int j = 0; j < 4; ++j) { nxt[j] = ntload4(xn + (j * 64 + lane) * 4); if (layer) ng[j] = ntload2u(GY + (size_t)mn * DM + (j * 64 + lane) * 4); } }
    const float* md = mod + (size_t)modidx_of_tok(m) * 3072;
    float4 sh[4], sc[4];
#pragma unroll
    for (int j = 0; j < 4; ++j) { sh[j] = *(const float4*)(md + (j * 64 + lane) * 4); sc[j] = *(const float4*)(md + 1024 + (j * 64 + lane) * 4); }
    if (layer) {
#pragma unroll
      for (int j = 0; j < 4; ++j) {
        cur[j].x += bf2f((u16)(cg[j][0] & 0xffffu)); cur[j].y += bf2f((u16)(cg[j][0] >> 16)); cur[j].z += bf2f((u16)(cg[j][1] & 0xffffu)); cur[j].w += bf2f((u16)(cg[j][1] >> 16));
        { typedef float nt4 __attribute__((ext_vector_type(4))); const nt4 xv = {cur[j].x, cur[j].y, cur[j].z, cur[j].w}; __builtin_nontemporal_store(xv, (nt4*)(p.out + (size_t)m * DM + (j * 64 + lane) * 4)); }
      }
    }
    float ss = 0.f;
#pragma unroll
    for (int j = 0; j < 4; ++j) ss += cur[j].x * cur[j].x + cur[j].y * cur[j].y + cur[j].z * cur[j].z + cur[j].w * cur[j].w;
    ss = wave_sum(ss);
    const float rs = rsqrtf(ss * (1.f / 1024.f) + EPS);
#pragma unroll
    for (int j = 0; j < 4; ++j) {
      const int c = (j * 64 + lane) * 4;
      const float a0 = cur[j].x * rs * g4[j].x * (1.f + sc[j].x) + sh[j].x, a1 = cur[j].y * rs * g4[j].y * (1.f + sc[j].y) + sh[j].y;
      const float a2 = cur[j].z * rs * g4[j].z * (1.f + sc[j].z) + sh[j].z, a3 = cur[j].w * rs * g4[j].w * (1.f + sc[j].w) + sh[j].w;
      u32x2 w = {pack2(a0, a1), pack2(a2, a3)};
      *(u32x2*)(H + (size_t)m * DM + c) = w;
    }
#pragma unroll
    for (int j = 0; j < 4; ++j) { cur[j] = nxt[j]; cg[j] = ng[j]; }
  }
}

struct GemmA { const u16* p0; int ld0; const u16* p1; int ld1; int ksplit; };
constexpr int G_LDS_A = 256 * 72 * 2;
template <class Epi>
DI void gemm_tile(const GemmA A, const u16* __restrict__ B, int ldb, int K, int m0, int n0, char* lds, Epi& epi) {
  u16* sA = (u16*)lds;
  const int tid = TIDX(), lane = tid & 63, wid = tid >> 6, r32 = lane & 31, h = lane >> 5;
  const int wm = wid >> 1, wn = wid & 1;
  const int lr = tid >> 3, lc = (tid & 7) * 8;
  f32x16 acc[2][2];
#pragma unroll
  for (int i = 0; i < 2; ++i)
#pragma unroll
    for (int j = 0; j < 2; ++j)
#pragma unroll
      for (int r = 0; r < 16; ++r) acc[i][j][r] = 0.f;
  bf16x8 ra0[4], rb0[2], ra1[4], rb1[2];
  const int nk = K >> 6;
  constexpr int GBUF = 256 * 72 + 128 * 72;
#define G_LOAD(RA, RB, KT) do { const int k0_ = (KT) * 64; const u16* ap_; int lda_, kk_; \
    if (k0_ < A.ksplit) { ap_ = A.p0; lda_ = A.ld0; kk_ = k0_; } else { ap_ = A.p1; lda_ = A.ld1; kk_ = k0_ - A.ksplit; } \
    _Pragma("unroll") for (int i_ = 0; i_ < 4; ++i_) RA[i_] = *(const bf16x8*)(ap_ + (size_t)(m0 + lr + 64 * i_) * lda_ + kk_ + lc); \
    _Pragma("unroll") for (int i_ = 0; i_ < 2; ++i_) RB[i_] = *(const bf16x8*)(B + (size_t)(n0 + lr + 64 * i_) * ldb + k0_ + lc); } while (0)
#define G_WRITE(RA, RB, BUF) do { u16* a_ = sA + (BUF) * GBUF; u16* b_ = a_ + 256 * 72; \
    _Pragma("unroll") for (int i_ = 0; i_ < 4; ++i_) *(bf16x8*)(a_ + (lr + 64 * i_) * 72 + lc) = RA[i_]; \
    _Pragma("unroll") for (int i_ = 0; i_ < 2; ++i_) *(bf16x8*)(b_ + (lr + 64 * i_) * 72 + lc) = RB[i_]; } while (0)
#define G_COMPUTE(BUF) do { const u16* a_ = sA + (BUF) * GBUF; const u16* b_ = a_ + 256 * 72; \
    _Pragma("unroll") for (int ks = 0; ks < 4; ++ks) { \
      bf16x8 a0 = *(const bf16x8*)(a_ + (wm * 64 + r32) * 72 + ks * 16 + h * 8); \
      bf16x8 a1 = *(const bf16x8*)(a_ + (wm * 64 + 32 + r32) * 72 + ks * 16 + h * 8); \
      bf16x8 b0 = *(const bf16x8*)(b_ + (wn * 64 + r32) * 72 + ks * 16 + h * 8); \
      bf16x8 b1 = *(const bf16x8*)(b_ + (wn * 64 + 32 + r32) * 72 + ks * 16 + h * 8); \
      acc[0][0] = MFMA(a0, b0, acc[0][0]); acc[0][1] = MFMA(a0, b1, acc[0][1]); \
      acc[1][0] = MFMA(a1, b0, acc[1][0]); acc[1][1] = MFMA(a1, b1, acc[1][1]); } } while (0)
  __syncthreads();
  G_LOAD(ra0, rb0, 0);
  if (nk > 1) G_LOAD(ra1, rb1, 1);
  G_WRITE(ra0, rb0, 0);
  __syncthreads();
  if (nk > 2) G_LOAD(ra0, rb0, 2);
#pragma unroll 1
  for (int kt = 0; kt < nk; kt += 2) {
    G_COMPUTE(0);
    if (kt + 1 < nk) {
      G_WRITE(ra1, rb1, 1);
      __syncthreads();
      if (kt + 3 < nk) G_LOAD(ra1, rb1, kt + 3);
      G_COMPUTE(1);
      if (kt + 2 < nk) {
        G_WRITE(ra0, rb0, 0);
        __syncthreads();
        if (kt + 4 < nk) G_LOAD(ra0, rb0, kt + 4);
      }
    }
  }
#undef G_LOAD
#undef G_WRITE
#undef G_COMPUTE
#pragma unroll
  for (int i = 0; i < 2; ++i)
#pragma unroll
    for (int j = 0; j < 2; ++j) epi(acc[i][j], m0 + wm * 64 + i * 32, n0 + wn * 64 + j * 32 + r32, h);
}

struct EpiU0 {
  u16* U;
  DI void operator()(const f32x16& a, int row0, int col, int h) const {
    if (col < L0C) {
#pragma unroll
      for (int r = 0; r < 16; ++r) U[(size_t)(row0 + crow(r, h)) * L0C + col] = f2bf(a[r]);
    }
  }
};
struct EpiQmla {
  u16* Q; const float2* tab;
  DI void operator()(const f32x16& a, int f0, int tok, int h) const {
    float v[16];
#pragma unroll
    for (int r = 0; r < 16; ++r) v[r] = a[r];
    if ((f0 % 96) == 64 && tok >= NCTX) {
      const int pos = pos_of_tok(tok), prow = pos >> 6, pcol = pos & 63;
#pragma unroll
      for (int j = 0; j < 4; ++j) {
        const int fi = 4 * h + j;
        const float2 cr = tab[prow * 8 + fi], cc = tab[pcol * 8 + fi];
        const float x1 = v[j], x2 = v[4 + j];
        v[j] = x1 * cr.x - x2 * cr.y; v[4 + j] = x2 * cr.x + x1 * cr.y;
        const float y1 = v[8 + j], y2 = v[12 + j];
        v[8 + j] = y1 * cc.x - y2 * cc.y; v[12 + j] = y2 * cc.x + y1 * cc.y;
      }
    }
#pragma unroll
    for (int g = 0; g < 4; ++g) {
      u32x2 w = {pack2(v[4 * g], v[4 * g + 1]), pack2(v[4 * g + 2], v[4 * g + 3])};
      *(u32x2*)(Q + (size_t)tok * 768 + f0 + 8 * g + 4 * h) = w;
    }
  }
};
struct EpiKvexp {
  u16* Kn; u16* Vt;
  DI void operator()(const f32x16& a, int kr0, int n, int h) const {
    const int head = n >> 7, within = n & 127;
    if (within < 64) {
#pragma unroll
      for (int r = 0; r < 16; ++r) Kn[((size_t)(kr0 + crow(r, h)) * 8 + head) * 64 + within] = f2bf(a[r]);
    } else {
      int seq, key0;
      if (kr0 < NCTX) { seq = kr0 >> 8; key0 = kr0 & 255; } else { const int r = kr0 - NCTX; seq = 16 + r / 2560; key0 = r % 2560; }
      const size_t cap = cap_of(seq);
      u16* base = Vt + (size_t)krow0_of(seq) * 512 + (size_t)(head * 64 + within - 64) * cap;
#pragma unroll
      for (int g = 0; g < 4; ++g) {
        const int pos = key0 + 16 * (g >> 1) + 8 * h + 4 * (g & 1);
        u32x2 w = {pack2(a[4 * g], a[4 * g + 1]), pack2(a[4 * g + 2], a[4 * g + 3])};
        *(u32x2*)(base + pos) = w;
      }
    }
  }
};
struct EpiOut {
  const Params* p; int layer;
  DI void operator()(const f32x16& a, int row0, int col, int h) const {
    const float* mod = (const float*)(p->ws + WS_MOD) + (size_t)(layer * 9 + modidx_of_tok(row0)) * 3072 + 2048;
    const float gate = mod[col];
#pragma unroll
    for (int r = 0; r < 16; ++r) {
      const int m = row0 + crow(r, h);
      const float xv = layer ? p->out[(size_t)m * DM + col] : xrow(*p, m)[col];
      p->out[(size_t)m * DM + col] = xv + gate * a[r];
    }
  }
};
struct EpiU1 {
  u16* UA; u16* UB; float* AB;
  DI void operator()(const f32x16& a, int row0, int col, int h) const {
    if (col < 1536) {
#pragma unroll
      for (int r = 0; r < 16; ++r) UA[(size_t)(row0 + crow(r, h)) * U1A_LD + col] = f2bf(a[r]);
    } else if (col < 3584) {
#pragma unroll
      for (int r = 0; r < 16; ++r) UB[(size_t)(row0 + crow(r, h)) * U1B_LD + col - 1536] = f2bf(a[r]);
    } else if (col < 3600) {
#pragma unroll
      for (int r = 0; r < 16; ++r) AB[(size_t)(row0 + crow(r, h)) * 16 + col - 3584] = a[r];
    }
  }
};


struct XcdIter {
  int xcd, lb, nlb, per, nmin, li;
  DI XcdIter(int nmaj, int nmin_) { xcd = blockIdx.x & 7; lb = blockIdx.x >> 3; nlb = gridDim.x >> 3; per = (nmaj >> 3) * nmin_; nmin = nmin_; li = lb; }
  DI bool valid() const { return li < per; }
  DI void next() { li += nlb; }
  DI int major() const { return xcd * (per / nmin) + li / nmin; }
  DI int minor() const { return li % nmin; }
};
DI void phase_inproj0(const Params& p, char* lds) {
  EpiU0 epi{(u16*)(p.ws + WS_U)};
  const u16* H = (const u16*)(p.ws + WS_H);
  const GemmA A{H, DM, H, DM, 1 << 30};
  for (XcdIter xi(80, 20); xi.valid(); xi.next())
    gemm_tile(A, (const u16*)(p.ws + WS_WT0), DM, DM, xi.major() * 256, xi.minor() * 128, lds, epi);
}
DI void phase_l0gemms(const Params& p, char* lds) {
  const u16* U0 = (const u16*)(p.ws + WS_U);
  EpiKvexp ek{(u16*)((char*)p.out + YS_KN), (u16*)((char*)p.out + YS_VTMLA)};
  EpiQmla eq{(u16*)((char*)p.out + YS_QMLA), (const float2*)(p.ws + WS_ROPE)};
  const u16* ck = (const u16*)(p.ws + WS_CKVN);
  const u16* wq = (const u16*)(p.ws + WS_WUQ);
  const GemmA Ak{ck, 256, ck, 256, 1 << 30};
  const GemmA Aq{wq, 384, wq, 384, 1 << 30};
  for (XcdIter xi(96, 8); xi.valid(); xi.next())
    gemm_tile(Ak, (const u16*)(p.ws + WS_WUKV), 256, 256, xi.major() * 256, xi.minor() * 128, lds, ek);
  for (XcdIter xi(160, 3); xi.valid(); xi.next())
    gemm_tile(Aq, U0 + C0_CQ, L0C, 384, xi.minor() * 256, xi.major() * 128, lds, eq);
}
DI void phase_outproj(const Params& p, int layer, char* lds) {
  EpiOut epi{&p, layer};
  const u16* H = (const u16*)(p.ws + WS_H);
  const GemmA A{H, DM, H, DM, 1 << 30};
  const u16* W = (const u16*)(p.ws + (layer ? WS_WO1 : WS_WO0));
  for (XcdIter xi(80, 8); xi.valid(); xi.next())
    gemm_tile(A, W, DM, DM, xi.major() * 256, xi.minor() * 128, lds, epi);
}
DI void phase_inproj1(const Params& p, char* lds) {
  EpiU1 epi{(u16*)(p.ws + WS_U1A), (u16*)(p.ws + WS_U1B), (float*)(p.ws + WS_AB)};
  const u16* H = (const u16*)(p.ws + WS_H);
  const GemmA A{H, DM, H, DM, 1 << 30};
  for (XcdIter xi(80, 29); xi.valid(); xi.next())
    gemm_tile(A, (const u16*)(p.ws + WS_WT1), DM, DM, xi.major() * 256, xi.minor() * 128, lds, epi);
}

DI void rope8(float (&x)[8], const float (&xp)[8], const float2* tab, int q, int pp, int fi0, bool is_x2) {
#pragma unroll
  for (int e = 0; e < 8; ++e) {
    const float2 cs = tab[pp * q + fi0 + e];
    x[e] = is_x2 ? (x[e] * cs.x + xp[e] * cs.y) : (x[e] * cs.x - xp[e] * cs.y);
  }
}
DI void unpack8(const u32x4 w, float (&x)[8]) {
#pragma unroll
  for (int i = 0; i < 4; ++i) { x[2 * i] = bf2f((u16)(w[i] & 0xffffu)); x[2 * i + 1] = bf2f((u16)(w[i] >> 16)); }
}
DI u32x4 pack8f(const float (&x)[8]) { u32x4 w = {pack2(x[0], x[1]), pack2(x[2], x[3]), pack2(x[4], x[5]), pack2(x[6], x[7])}; return w; }
DI void shfl8(const float (&x)[8], float (&xp)[8], int mask) {
#pragma unroll
  for (int e = 0; e < 8; ++e) xp[e] = __shfl_xor(x[e], mask);
}

DI void phase_l0prep(const Params& p, char* lds) {
  const int tid = TIDX(), lane = tid & 63, wid = tid >> 6;
  u16* U0 = (u16*)(p.ws + WS_U);
  u16* sv = (u16*)lds;
  const float2* tabM = (const float2*)(p.ws + WS_ROPE);
  const float2* tabS = tabM + 512;
  u16* CKVN = (u16*)(p.ws + WS_CKVN); u16* KROPE = (u16*)(p.ws + WS_KROPE); u16* KSWA = (u16*)(p.ws + WS_KSWA);
  float qn[6];
#pragma unroll
  for (int j = 0; j < 3; ++j) { const float2 t = *(const float2*)(p.mla_q_norm + 128 * j + 2 * lane); qn[2 * j] = t.x; qn[2 * j + 1] = t.y; }
  const float4 kvn = *(const float4*)(p.mla_kv_norm + 4 * lane);
  for (int it = blockIdx.x; it < NTOK / 16; it += gridDim.x) {
    const int m0 = it * 16;
    const bool ctx = m0 < NCTX;
    unsigned cqw[2][3]; u32x2 ckvw[2]; u16 krw[2]; u32x4 qbw[2], kbw[2], vbw[2]; float2 csm[2]; float2 css[2][8];
#pragma unroll
    for (int tt = 0; tt < 2; ++tt) {
      const int m = m0 + wid * 2 + tt;
      const u16* row = U0 + (size_t)m * L0C;
#pragma unroll
      for (int j = 0; j < 3; ++j) cqw[tt][j] = *(const unsigned*)(row + C0_CQ + 128 * j + 2 * lane);
      ckvw[tt] = ntload2u(row + C0_CKV + 4 * lane);
      krw[tt] = row[C0_KR + (lane & 31)];
      qbw[tt] = ntload4u(row + C0_QB + lane * 8);
      kbw[tt] = ntload4u(row + C0_KB + (lane & 15) * 8);
      vbw[tt] = ntload4u(row + C0_VB + (lane & 15) * 8);
      const int pos = pos_of_tok(m), prow = pos >> 6, pcol = pos & 63;
      csm[tt] = tabM[(((lane >> 4) & 1) ? pcol : prow) * 8 + (lane & 7)];
      const int b16 = (lane & 7) >> 1, pp = (b16 >= 2) ? pcol : prow, fi0 = (lane & 1) * 8;
#pragma unroll
      for (int e = 0; e < 8; ++e) css[tt][e] = tabS[pp * 16 + fi0 + e];
    }
#pragma unroll
    for (int tt = 0; tt < 2; ++tt) {
      const int ml = wid * 2 + tt, m = m0 + ml;
      u16* row = U0 + (size_t)m * L0C;
      const int krow = krow_of_tok(m);
      {
        float lo[3], hi[3], ss = 0.f;
#pragma unroll
        for (int j = 0; j < 3; ++j) { const unsigned w = cqw[tt][j]; lo[j] = bf2f((u16)(w & 0xffffu)); hi[j] = bf2f((u16)(w >> 16)); ss += lo[j] * lo[j] + hi[j] * hi[j]; }
        ss = wave_sum(ss);
        const float rs = rsqrtf(ss * (1.f / 384.f) + EPS);
#pragma unroll
        for (int j = 0; j < 3; ++j) *(unsigned*)(row + C0_CQ + 128 * j + 2 * lane) = pack2(lo[j] * rs * qn[2 * j], hi[j] * rs * qn[2 * j + 1]);
      }
      {
        const u32x2 w = ckvw[tt];
        float x[4] = {bf2f((u16)(w[0] & 0xffffu)), bf2f((u16)(w[0] >> 16)), bf2f((u16)(w[1] & 0xffffu)), bf2f((u16)(w[1] >> 16))};
        float ss = x[0] * x[0] + x[1] * x[1] + x[2] * x[2] + x[3] * x[3];
        ss = wave_sum(ss);
        const float rs = rsqrtf(ss * (1.f / 256.f) + EPS);
        x[0] *= rs * kvn.x; x[1] *= rs * kvn.y; x[2] *= rs * kvn.z; x[3] *= rs * kvn.w;
        u32x2 o = {pack2(x[0], x[1]), pack2(x[2], x[3])};
        *(u32x2*)(CKVN + (size_t)krow * 256 + 4 * lane) = o;
        if (ctx) *(float4*)(p.out + O_CKV + (size_t)m * 256 + 4 * lane) = make_float4(x[0], x[1], x[2], x[3]);
      }
      {
        const float x = bf2f(krw[tt]);
        const float xp = __shfl_xor(x, 8);
        float val = x;
        if (!ctx) { const float2 cs = csm[tt]; val = (lane & 15) < 8 ? (x * cs.x - xp * cs.y) : (x * cs.x + xp * cs.y); }
        if (lane < 32) {
          KROPE[(size_t)krow * 32 + lane] = f2bf(val);
          if (ctx) p.out[O_KROPE + (size_t)m * 32 + lane] = x;
        }
      }
      const bool is_x2 = (((lane & 7) >> 1) & 1) != 0;
      if (!ctx) {
        float x[8], xp[8];
        unpack8(qbw[tt], x);
        shfl8(x, xp, 2);
#pragma unroll
        for (int e = 0; e < 8; ++e) { const float2 cs = css[tt][e]; x[e] = is_x2 ? (x[e] * cs.x + xp[e] * cs.y) : (x[e] * cs.x - xp[e] * cs.y); }
        *(u32x4*)(row + C0_QB + lane * 8) = pack8f(x);
      }
      {
        float x[8], xp[8];
        unpack8(kbw[tt], x);
        if (ctx && lane < 16) {
          *(float4*)(p.out + O_SWAK + (size_t)m * 128 + lane * 8) = make_float4(x[0], x[1], x[2], x[3]);
          *(float4*)(p.out + O_SWAK + (size_t)m * 128 + lane * 8 + 4) = make_float4(x[4], x[5], x[6], x[7]);
        }
        shfl8(x, xp, 2);
        if (!ctx) {
#pragma unroll
          for (int e = 0; e < 8; ++e) { const float2 cs = css[tt][e]; x[e] = is_x2 ? (x[e] * cs.x + xp[e] * cs.y) : (x[e] * cs.x - xp[e] * cs.y); }
        }
        if (lane < 16) {
          *(u32x4*)(KSWA + (size_t)krow * 128 + lane * 8) = pack8f(x);
          const u32x4 vw = vbw[tt];
          *(u32x4*)(sv + ml * 136 + lane * 8) = vw;
          if (ctx) {
            float v[8]; unpack8(vw, v);
            *(float4*)(p.out + O_SWAV + (size_t)m * 128 + lane * 8) = make_float4(v[0], v[1], v[2], v[3]);
            *(float4*)(p.out + O_SWAV + (size_t)m * 128 + lane * 8 + 4) = make_float4(v[4], v[5], v[6], v[7]);
          }
        }
      }
    }
    __syncthreads();
    {
      const int s = seq_of_tok(m0);
      vt_store16(sv, 136, 128, (u16*)(p.ws + WS_VTSWA) + (size_t)krow0_of(s) * 128, cap_of(s), pos_of_tok(m0));
    }
    __syncthreads();
  }
}

namespace pg8 {
#define PG8_LAS __attribute__((address_space(3)))
typedef unsigned short bf16_t;
typedef short bf16x8 __attribute__((ext_vector_type(8)));
typedef float f32x4 __attribute__((ext_vector_type(4)));
typedef unsigned u32x4 __attribute__((ext_vector_type(4)));
constexpr int BM = 256, BK = 64, HALF = 128, HTB = HALF * BK * 2  , STAGE_BYTES = 8 * HTB, NXCD = 8, WGM = 8;

__host__ __device__ __forceinline__ int lds_byte(int r, int c) { const int st = (r >> 4) * 2 + (c >> 5), rr = r & 15, cc = c & 31, ob = rr * 64 + cc * 2; return st * 1024 + (ob ^ (((ob >> 9) & 1) << 5)); }
__host__ __device__ __forceinline__ void stage_rc(int b, int& R, int& C) { const int st = b / 1024, sb = b % 1024, swz = sb ^ (((sb >> 9) & 1) << 5); R = (st >> 1) * 16 + swz / 64; C = (st & 1) * 32 + (swz % 64) / 2; }
__host__ __device__ __forceinline__ int perm32(int rho) { const int n = rho >> 4, i = rho & 15; return 8 * (i >> 2) + 4 * n + (i & 3); }

struct Unit { int pm, pn; };
struct Gemm { const bf16_t* A; const bf16_t* Bt; int M, N, K, lda, ldb; };

struct StaticOrder {
    int nM, nN, nwg, G, c;
    __host__ __device__ void init(int M, int N, int G_, int c_) { nM = M / BM; nN = N / BM; nwg = nM * nN; G = G_; c = c_; }
    __host__ __device__ bool next(int i, Unit& u) const {
        const long L = (long)i * G + c; if (L >= nwg) return false;
        int wgid = (int)L; { const int q = nwg / NXCD, r = nwg % NXCD, xcd = wgid % NXCD, off = wgid / NXCD; wgid = (xcd < r ? xcd * (q + 1) : r * (q + 1) + (xcd - r) * q) + off; }
        const int nig = WGM * nN, gid = wgid / nig, fm = gid * WGM, gsz = (nM - fm) < WGM ? (nM - fm) : WGM;
        u.pm = fm + ((wgid % nig) % gsz); u.pn = (wgid % nig) / gsz; return true;
    }
    __device__ __forceinline__ void a_ready(const Unit&) const {}
    __device__ __forceinline__ void done(const Unit&) const {}
};
struct Ip0Order {
    StaticOrder S9; int rt0, nwg9, ntot, G, c;
    __device__ void init(int M, int Nmain, int rt0_, int G_, int c_) { S9.init(M, Nmain, G_, c_); rt0 = rt0_; nwg9 = S9.nwg; ntot = nwg9 + (M / BM - rt0_); G = G_; c = c_; }
    __device__ bool next(int i, Unit& u) const {
        const int L = i * G + c; if (L >= ntot) return false;
        if (L < nwg9) return S9.next(i, u);
        u.pm = rt0 + (L - nwg9); u.pn = S9.nN; return true;
    }
    __device__ __forceinline__ void a_ready(const Unit&) const {}
    __device__ __forceinline__ void done(const Unit&) const {}
};
template <class Epi, class Sched, bool STAMP = false>
__device__ __forceinline__ void gemm_phase(PG8_LAS unsigned char* lds, const Gemm g, const Sched& S, const Epi& E, unsigned long long* stamps) {
    const int tid = TIDX(), wid = __builtin_amdgcn_readfirstlane(tid >> 6), lane = tid & 63, wr = wid >> 2, wc = wid & 3, fr = lane & 15, fq = lane >> 4;
    const int K = g.K, nt = K / BK;
    int ts_lo = 0, ts_hi = 0, nts = 0; const unsigned long long rt_entry = STAMP ? (unsigned long long)wall_clock64() : 0ull;
#define PG8_STAMP() do { if (STAMP && wid == 0 && nts < 64) { const unsigned long long _c = (unsigned long long)clock64(); \
        ts_lo = (lane == nts) ? (int)(unsigned)_c : ts_lo; ts_hi = (lane == nts) ? (int)(unsigned)(_c >> 32) : ts_hi; ++nts; } } while (0)
    PG8_STAMP();
    unsigned voffA[2], voffB[2];
#pragma unroll
    for (int i = 0; i < 2; ++i) { int R, C; stage_rc(tid * 16 + i * 8192, R, C); const int Rb = Epi::PERM ? ((R & ~31) + perm32(R & 31)) : R;
        voffA[i] = (unsigned)(R * g.lda + C) * 2u; voffB[i] = (unsigned)(Rb * g.ldb + C) * 2u; }
    const size_t kstep = (size_t)(BK * 2);
    const size_t hstepA = (size_t)HALF * g.lda * 2, hstepB = (size_t)HALF * g.ldb * 2;
    const size_t tstepA = 2 * hstepA, tstepB = 2 * hstepB;
    const unsigned ldsw = (unsigned)wid * 1024u;
    const int aoff = lds_byte(wr * 64 + fr, fq * 8), boff = lds_byte(wc * 32 + fr, fq * 8);
#define PG8_SA(b, h) (((b) * 2 + (h)) * HTB)
#define PG8_SB(b, h) ((4 + (b) * 2 + (h)) * HTB)
#define PG8_STAGE(bufoff, gbase, voff) do { _Pragma("unroll") for (int _i = 0; _i < 2; ++_i) \
        __builtin_amdgcn_global_load_lds((const unsigned*)((const char*)(gbase) + (voff)[_i]), (PG8_LAS unsigned*)(lds + (bufoff) + ldsw + _i * 8192), 16, 0, 0); } while (0)
#define PG8_LDA(dst, b, h) do { _Pragma("unroll") for (int m = 0; m < 4; ++m) _Pragma("unroll") for (int k = 0; k < 2; ++k) dst[m][k] = *(const PG8_LAS bf16x8*)(lds + PG8_SA(b, h) + aoff + m * 2048 + k * 1024); } while (0)
#define PG8_LDB(dst, b, h) do { _Pragma("unroll") for (int n = 0; n < 2; ++n) _Pragma("unroll") for (int k = 0; k < 2; ++k) dst[n][k] = *(const PG8_LAS bf16x8*)(lds + PG8_SB(b, h) + boff + n * 2048 + k * 1024); } while (0)
#define PG8_MMA(ai, bj, At, Bt) do { __builtin_amdgcn_s_setprio(1); _Pragma("unroll") for (int m = 0; m < 4; ++m) _Pragma("unroll") for (int n = 0; n < 2; ++n) _Pragma("unroll") for (int k = 0; k < 2; ++k) \
        acc[ai][bj][m][n] = __builtin_amdgcn_mfma_f32_16x16x32_bf16(Bt[n][k], At[m][k], acc[ai][bj][m][n], 0, 0, 0); __builtin_amdgcn_s_setprio(0); } while (0)
#define PG8_WAIT_V(n) asm volatile("s_waitcnt vmcnt(" #n ")" ::: "memory")
#define PG8_WAIT_L(n) asm volatile("s_waitcnt lgkmcnt(" #n ")" ::: "memory")
#define PG8_BAR __builtin_amdgcn_s_barrier()
#define PG8_SCHED __builtin_amdgcn_sched_barrier(0)
    Unit cur, nxt; int ui = 0;
    if (!S.next(0, cur)) return;
    f32x4 acc[2][2][4][2];
#pragma unroll
    for (int a = 0; a < 2; ++a)
#pragma unroll
        for (int b = 0; b < 2; ++b)
#pragma unroll
            for (int m = 0; m < 4; ++m)
#pragma unroll
                for (int n = 0; n < 2; ++n) acc[a][b][m][n] = (f32x4){0.f, 0.f, 0.f, 0.f};
    bf16x8 At[4][2], B0[2][2], B1[2][2];
    const char* cA = (const char*)g.A + (size_t)cur.pm * tstepA; const char* cB = (const char*)g.Bt + (size_t)cur.pn * tstepB;
    S.a_ready(cur);
    PG8_STAGE(PG8_SB(0, 0), cB, voffB); PG8_STAGE(PG8_SA(0, 0), cA, voffA); PG8_STAGE(PG8_SB(0, 1), cB + hstepB, voffB); PG8_STAGE(PG8_SA(0, 1), cA + hstepA, voffA);
    if (wr == 1) PG8_BAR;
    PG8_WAIT_V(4); PG8_BAR;
    PG8_STAGE(PG8_SB(1, 0), cB + kstep, voffB); PG8_STAGE(PG8_SA(1, 0), cA + kstep, voffA); PG8_STAGE(PG8_SB(1, 1), cB + hstepB + kstep, voffB);
    PG8_WAIT_V(6); PG8_BAR;
    PG8_STAMP();
    for (;;) {
        const bool has_next = S.next(ui + 1, nxt);
        const char* nA = has_next ? (const char*)g.A + (size_t)nxt.pm * tstepA : cA; const char* nB = has_next ? (const char*)g.Bt + (size_t)nxt.pn * tstepB : cB;
#pragma unroll 1
        for (int t = 0; t < nt; t += 2) {
            const bool last = (t == nt - 2);
            const char* a1 = cA + (size_t)(t + 1) * kstep;
            const char* a2 = last ? nA : cA + (size_t)(t + 2) * kstep; const char* b2 = last ? nB : cB + (size_t)(t + 2) * kstep;
            const char* a3 = a2 + kstep; const char* b3 = b2 + kstep;
            if (last && has_next) S.a_ready(nxt);
            PG8_LDB(B0, 0, 0); PG8_SCHED; PG8_LDA(At, 0, 0); PG8_STAGE(PG8_SA(1, 1), a1 + hstepA, voffA);
            PG8_WAIT_L(8); PG8_BAR; PG8_WAIT_L(0); PG8_MMA(0, 0, At, B0); PG8_BAR; PG8_SCHED;
            PG8_LDB(B1, 0, 1); PG8_STAGE(PG8_SB(0, 0), b2, voffB);
            PG8_BAR; PG8_WAIT_L(0); PG8_MMA(0, 1, At, B1); PG8_BAR;
            PG8_LDA(At, 0, 1); PG8_STAGE(PG8_SA(0, 0), a2, voffA);
            PG8_BAR; PG8_WAIT_L(0); PG8_MMA(1, 0, At, B0); PG8_BAR; PG8_SCHED;
            PG8_STAGE(PG8_SB(0, 1), b2 + hstepB, voffB);
            PG8_WAIT_V(6); PG8_BAR; PG8_MMA(1, 1, At, B1); PG8_BAR;
            PG8_LDB(B0, 1, 0); PG8_SCHED; PG8_LDA(At, 1, 0); PG8_STAGE(PG8_SA(0, 1), a2 + hstepA, voffA);
            PG8_WAIT_L(8); PG8_BAR; PG8_WAIT_L(0); PG8_MMA(0, 0, At, B0); PG8_BAR; PG8_SCHED;
            PG8_LDB(B1, 1, 1); PG8_STAGE(PG8_SB(1, 0), b3, voffB);
            PG8_BAR; PG8_WAIT_L(0); PG8_MMA(0, 1, At, B1); PG8_BAR;
            PG8_LDA(At, 1, 1); PG8_STAGE(PG8_SA(1, 0), a3, voffA);
            PG8_BAR; PG8_WAIT_L(0); PG8_MMA(1, 0, At, B0); PG8_BAR; PG8_SCHED;
            PG8_STAGE(PG8_SB(1, 1), b3 + hstepB, voffB);
            PG8_WAIT_V(6); PG8_BAR; PG8_MMA(1, 1, At, B1); PG8_BAR;
        }
        PG8_STAMP();
        if constexpr (!Epi::AFTER_DRAIN) { E(acc, cur, wr, wc, fr, fq); S.done(cur); }
        PG8_STAMP();
        if (!has_next) break;
#pragma unroll
        for (int a = 0; a < 2; ++a)
#pragma unroll
            for (int b = 0; b < 2; ++b)
#pragma unroll
                for (int m = 0; m < 4; ++m)
#pragma unroll
                    for (int n = 0; n < 2; ++n) acc[a][b][m][n] = (f32x4){0.f, 0.f, 0.f, 0.f};
        cur = nxt; cA = nA; cB = nB; ++ui;
    }
    PG8_WAIT_V(0);
    if (wr == 0) PG8_BAR;
    PG8_BAR;
    if constexpr (Epi::AFTER_DRAIN) { E.fused(acc, cur, wr, wc, fr, fq, lds, wid, lane); S.done(cur); }
    PG8_STAMP();
    if (STAMP && wid == 0) { stamps[lane] = lane < nts ? (((unsigned long long)(unsigned)ts_hi << 32) | (unsigned)ts_lo) : 0ull;
        if (lane == 62) stamps[62] = rt_entry; if (lane == 63) stamps[63] = (unsigned long long)wall_clock64(); }
#undef PG8_STAMP
#undef PG8_SA
#undef PG8_SB
#undef PG8_STAGE
#undef PG8_LDA
#undef PG8_LDB
#undef PG8_MMA
#undef PG8_WAIT_V
#undef PG8_WAIT_L
#undef PG8_BAR
#undef PG8_SCHED
}
}

using pg8::Unit;
typedef pg8::f32x4 (acc8_t)[2][2][4][2];
DI u32x4 pk8(const pg8::f32x4& v0, const pg8::f32x4& v1) { u32x4 w = {pack2(v0[0], v0[1]), pack2(v0[2], v0[3]), pack2(v1[0], v1[1]), pack2(v1[2], v1[3])}; return w; }
struct E8U0 { static constexpr bool PERM = true, AFTER_DRAIN = false; u16* U; int pm0, pn0;
  DI void operator()(const acc8_t& acc, const Unit& u, int wr, int wc, int fr, int fq) const {
#pragma unroll
    for (int ai = 0; ai < 2; ++ai)
#pragma unroll
      for (int m = 0; m < 4; ++m) { const size_t row = (size_t)((u.pm + pm0) * 256 + wr * 64 + ai * 128 + m * 16 + fr);
#pragma unroll
        for (int bj = 0; bj < 2; ++bj) { const int col = (u.pn + pn0) * 256 + wc * 32 + bj * 128 + 8 * fq;
          if (col < L0C) *(u32x4*)(U + row * L0C + col) = pk8(acc[ai][bj][m][0], acc[ai][bj][m][1]); } }
  } };
struct E8U1 { static constexpr bool PERM = true, AFTER_DRAIN = false; u16* UA; u16* UB; float* AB;
  DI void operator()(const acc8_t& acc, const Unit& u, int wr, int wc, int fr, int fq) const {
#pragma unroll
    for (int ai = 0; ai < 2; ++ai)
#pragma unroll
      for (int m = 0; m < 4; ++m) { const size_t row = (size_t)(u.pm * 256 + wr * 64 + ai * 128 + m * 16 + fr);
#pragma unroll
        for (int bj = 0; bj < 2; ++bj) { const int col = u.pn * 256 + wc * 32 + bj * 128 + 8 * fq;
          if (col < 1536) *(u32x4*)(UA + row * U1A_LD + col) = pk8(acc[ai][bj][m][0], acc[ai][bj][m][1]);
          else if (col < 3584) *(u32x4*)(UB + row * U1B_LD + col - 1536) = pk8(acc[ai][bj][m][0], acc[ai][bj][m][1]);
          else if (col < 3600) { *(pg8::f32x4*)(AB + row * 16 + col - 3584) = acc[ai][bj][m][0]; *(pg8::f32x4*)(AB + row * 16 + col - 3584 + 4) = acc[ai][bj][m][1]; } } }
  } };
struct E8Gy { static constexpr bool PERM = true, AFTER_DRAIN = false; u16* GY; const float* mod;
  DI void operator()(const acc8_t& acc, const Unit& u, int wr, int wc, int fr, int fq) const {
    const float* gp = mod + (size_t)modidx_of_tok(u.pm * 256) * 3072 + 2048;
#pragma unroll
    for (int bj = 0; bj < 2; ++bj) { const int col = u.pn * 256 + wc * 32 + bj * 128 + 8 * fq;
      const pg8::f32x4 g0 = *(const pg8::f32x4*)(gp + col), g1 = *(const pg8::f32x4*)(gp + col + 4);
#pragma unroll
      for (int ai = 0; ai < 2; ++ai)
#pragma unroll
        for (int m = 0; m < 4; ++m) { const size_t row = (size_t)(u.pm * 256 + wr * 64 + ai * 128 + m * 16 + fr);
          *(u32x4*)(GY + row * DM + col) = pk8(acc[ai][bj][m][0] * g0, acc[ai][bj][m][1] * g1); } }
  } };
struct E8KV { static constexpr bool PERM = true, AFTER_DRAIN = false; u16* Kn; u16* Vt;
  DI void operator()(const acc8_t& acc, const Unit& u, int wr, int wc, int fr, int fq) const {
    if (u.pn < 2) {
#pragma unroll
      for (int ai = 0; ai < 2; ++ai)
#pragma unroll
        for (int m = 0; m < 4; ++m) { const size_t row = (size_t)(u.pm * 256 + wr * 64 + ai * 128 + m * 16 + fr);
#pragma unroll
          for (int bj = 0; bj < 2; ++bj) { const int col = u.pn * 256 + wc * 32 + bj * 128 + 8 * fq;
            *(u32x4*)(Kn + row * 512 + col) = pk8(acc[ai][bj][m][0], acc[ai][bj][m][1]); } }
    } else {
      const int krt = __builtin_amdgcn_readfirstlane(u.pm * 256);
      int seq, keyt;
      if (krt < NCTX) { seq = krt >> 8; keyt = 0; } else { const int r = krt - NCTX; seq = 16 + r / 2560; keyt = r - (seq - 16) * 2560; }
      const unsigned cap = (unsigned)cap_of(seq);
      u16* base = Vt + (size_t)krow0_of(seq) * 512 + keyt;
#pragma unroll
      for (int bj = 0; bj < 2; ++bj) {
        const unsigned f0 = (unsigned)((u.pn - 2) * 256 + wc * 32 + bj * 128 + 8 * fq);
        unsigned off = f0 * cap + (unsigned)(wr * 64 + swz16(fr));
#pragma unroll
        for (int ai = 0; ai < 2; ++ai) {
#pragma unroll
          for (int m = 0; m < 4; ++m) {
#pragma unroll
            for (int t = 0; t < 4; ++t) { base[off + t * cap] = f2bf(acc[ai][bj][m][0][t]); base[off + (4 + t) * cap] = f2bf(acc[ai][bj][m][1][t]); }
            off += 16;
            asm volatile("" ::: "memory"); }
          off += 64; } }
    }
  } };
struct E8Q { static constexpr bool PERM = true, AFTER_DRAIN = false; u16* Q;
  DI void operator()(const acc8_t& acc, const Unit& u, int wr, int wc, int fr, int fq) const {
#pragma unroll
    for (int ai = 0; ai < 2; ++ai)
#pragma unroll
      for (int m = 0; m < 4; ++m) { const size_t row = (size_t)(u.pm * 256 + wr * 64 + ai * 128 + m * 16 + fr);
#pragma unroll
        for (int bj = 0; bj < 2; ++bj) { const int col = u.pn * 256 + wc * 32 + bj * 128 + 8 * fq;
          *(u32x4*)(Q + row * 768 + col) = pk8(acc[ai][bj][m][0], acc[ai][bj][m][1]); } }
  } };
template <class Epi>
DI void gemm8_sub(const u16* A, int lda, const u16* Bt, int ldb, int M, int N, int K, char* lds, const Epi& E, int G, int c) {
  int Ko = K; asm volatile("" : "+s"(Ko));
  pg8::Gemm g{A, Bt, M, N, Ko, lda, ldb};
  pg8::StaticOrder S; S.init(M, N, G, c);
  __syncthreads();
  pg8::gemm_phase<Epi, pg8::StaticOrder, false>((PG8_LAS unsigned char*)lds, g, S, E, nullptr);
  __syncthreads();
}
template <class Epi>
DI void gemm8(const u16* A, int lda, const u16* Bt, int ldb, int M, int N, int K, char* lds, const Epi& E) { gemm8_sub(A, lda, Bt, ldb, M, N, K, lds, E, (int)gridDim.x, (int)blockIdx.x); }
struct E8Gen { static constexpr bool PERM = true, AFTER_DRAIN = false; int kv; u16* base; int ld, ncols, pm0, pn0; u16* Vt;
  DI void operator()(const acc8_t& acc, const Unit& u, int wr, int wc, int fr, int fq) const {
    if (kv && u.pn >= 2) {
      const int krt = __builtin_amdgcn_readfirstlane(u.pm * 256);
      int seq, keyt;
      if (krt < NCTX) { seq = krt >> 8; keyt = 0; } else { const int r = krt - NCTX; seq = 16 + r / 2560; keyt = r - (seq - 16) * 2560; }
      const unsigned cap = (unsigned)cap_of(seq);
      u16* vb = Vt + (size_t)krow0_of(seq) * 512 + keyt;
#pragma unroll
      for (int bj = 0; bj < 2; ++bj) {
        const unsigned f0 = (unsigned)((u.pn - 2) * 256 + wc * 32 + bj * 128 + 8 * fq);
        unsigned off = f0 * cap + (unsigned)(wr * 64 + swz16(fr));
#pragma unroll
        for (int ai = 0; ai < 2; ++ai) {
#pragma unroll
          for (int m = 0; m < 4; ++m) {
#pragma unroll
            for (int t = 0; t < 4; ++t) { vb[off + t * cap] = f2bf(acc[ai][bj][m][0][t]); vb[off + (4 + t) * cap] = f2bf(acc[ai][bj][m][1][t]); }
            off += 16;
            asm volatile("" ::: "memory"); }
          off += 64; } }
    } else {
#pragma unroll
      for (int ai = 0; ai < 2; ++ai)
#pragma unroll
        for (int m = 0; m < 4; ++m) { const size_t row = (size_t)((u.pm + pm0) * 256 + wr * 64 + ai * 128 + m * 16 + fr);
#pragma unroll
          for (int bj = 0; bj < 2; ++bj) { const int col = (u.pn + pn0) * 256 + wc * 32 + bj * 128 + 8 * fq;
            if (col < ncols) *(u32x4*)(base + row * ld + col) = pk8(acc[ai][bj][m][0], acc[ai][bj][m][1]); } }
    }
  } };
constexpr int IP0_DEFER_ROWT = 32;
template <class SyncF>
DI void phase8_layer0_gemms(const Params& p, char* lds, const SyncF& gsync) {
  const bool full = gridDim.x == 256;
  const int ng = 3 + opaque_zero();
#pragma unroll 1
  for (int g = 0; g < ng; ++g) {
    const u16* A; const u16* Bt; int lda, ldb, M, Nmain, K, rt0, G, c; E8Gen E;
    u16* U = (u16*)(p.ws + WS_U);
    if (g == 0) { A = (const u16*)(p.ws + WS_H); lda = DM; Bt = (const u16*)(p.ws + WS_WT0); ldb = DM; M = NTOK; K = DM; G = (int)gridDim.x; c = (int)blockIdx.x;
      Nmain = full ? 2304 : L0CP; rt0 = full ? IP0_DEFER_ROWT : NTOK / 256; E = E8Gen{0, U, L0C, L0C, 0, 0, nullptr}; }
    else if (g == 1) { A = (const u16*)(p.ws + WS_CKVN); lda = 256; Bt = (const u16*)(p.ws + WS_WUKV); ldb = 256; M = NKROW; Nmain = 1024; K = 256; rt0 = NKROW / 256; G = (int)gridDim.x; c = (int)blockIdx.x;
      E = E8Gen{1, (u16*)((char*)p.out + YS_KN), 512, 512, 0, 0, (u16*)((char*)p.out + YS_VTMLA)}; }
    else if (!full || blockIdx.x < 224) { A = U + C0_CQ; lda = L0C; Bt = (const u16*)(p.ws + WS_WUQ); ldb = 384; M = NTOK; Nmain = 768; K = 384; rt0 = NTOK / 256;
      G = full ? 224 : (int)gridDim.x; c = full ? ((int)blockIdx.x + 96) % 224 : (int)blockIdx.x; E = E8Gen{0, (u16*)((char*)p.out + YS_QMLA), 768, 768, 0, 0, nullptr}; }
    else { A = (const u16*)(p.ws + WS_H); lda = DM; Bt = (const u16*)(p.ws + WS_WT0) + (size_t)2304 * DM; ldb = DM; M = IP0_DEFER_ROWT * 256; Nmain = 256; K = DM; rt0 = IP0_DEFER_ROWT;
      G = 32; c = (int)blockIdx.x - 224; E = E8Gen{0, U, L0C, L0C, 0, 9, nullptr}; }
    {
      int Ko = K; asm volatile("" : "+s"(Ko));
      pg8::Gemm gm{A, Bt, M, Nmain, Ko, lda, ldb};
      pg8::Ip0Order S; S.init(M, Nmain, rt0, G, c);
      __syncthreads();
      pg8::gemm_phase<E8Gen, pg8::Ip0Order, false>((PG8_LAS unsigned char*)lds, gm, S, E, nullptr);
      __syncthreads();
    }
    if (g == 0) { gsync(); phase_l0prep(p, lds); gsync(); }
  }
  if (full && blockIdx.x >= 144 && blockIdx.x < 224) {
#pragma unroll 1
    for (int j = (int)blockIdx.x - 144; j < 480; j += 80) {
      if (j < 64) transpose_tiles4<3>(p, j * 4, lds);
      else if (j < 224) prep_convert_item(p, 256 + (j - 64));
      else prep_vt_item(p, j - 224, lds);
    }
  }
}
DI void prep_deferred_layer1_weights(const Params& p, char* lds) {
  if (gridDim.x != 256 || blockIdx.x < 64) return;
  __syncthreads();
#pragma unroll 1
  for (int bq = 258 + (int)blockIdx.x - 64; bq < 562; bq += 192) {
    if (bq < 498) transpose_tiles4<4>(p, (bq - 258) * 4, lds);
    else transpose_tiles4<5>(p, (bq - 498) * 4, lds);
  }
}
DI void phase8_outproj(const Params& p, int layer, char* lds) {
  gemm8((const u16*)(p.ws + WS_H), DM, (const u16*)(p.ws + (layer ? WS_WO1 : WS_WO0)), DM, NTOK, DM, DM, lds,
        E8Gy{(u16*)(p.ws + (layer ? WS_GY1 : WS_GY0)), (const float*)(p.ws + WS_MOD) + (size_t)layer * 9 * 3072});
}
DI void phase8_inproj1(const Params& p, char* lds) {
  gemm8((const u16*)(p.ws + WS_H), DM, (const u16*)(p.ws + WS_WT1), DM, NTOK, L1CP, DM, lds, E8U1{(u16*)(p.ws + WS_U1A), (u16*)(p.ws + WS_U1B), (float*)(p.ws + WS_AB)});
}

template <int KIND, int DBGV = 0>
DI void attn_item(const Params& p, int s, int hsel, int q0, char* lds) {
  constexpr int DQK = KIND == 0 ? 96 : (KIND == 1 ? 64 : 128);
  constexpr int DV = KIND == 2 ? 128 : 64;
  constexpr int KT = KIND == 2 ? 64 : 128;
  constexpr int NKB = KT / 32;
  constexpr int KS = DQK + 8, VS = KT + 8;
  constexpr int CPR = DQK / 8;
  constexpr int VPR = KT / 8;
  constexpr int KCH = KT * CPR, NKC = (KCH + 511) / 512;
  constexpr int VCH = DV * VPR, NVC = VCH / 512;
  constexpr float SCALE = KIND == 0 ? 0.10206207261596577f : (KIND == 1 ? 0.125f : 0.08838834764831845f);
  constexpr float C = SCALE * LOG2E;
  const int tid = TIDX(), lane = tid & 63, wid = tid >> 6, r32 = lane & 31, h = lane >> 5;
  u16* sK0 = (u16*)lds;
  const int tok0 = tok0_of(s), kr0 = krow0_of(s), cap = cap_of(s), len = len_of(s);
  const bool smp = s >= 16;
  int hq, hkv, qrow0;
  if (KIND == 0) { hq = hsel; hkv = hsel; qrow0 = q0 + 32 * wid; }
  else if (KIND == 1) { hkv = hsel >> 1; hq = hkv * 4 + (hsel & 1) * 2 + (wid >> 2); qrow0 = q0 + 32 * (wid & 3); }
  else { hkv = hsel; hq = hkv * 2 + (wid >> 2); qrow0 = q0 + 32 * (wid & 3); }
  const int tok = tok0 + qrow0 + r32;
  const u16* U0 = (const u16*)(p.ws + WS_U);
  u16* U1B = (u16*)(p.ws + WS_U1B);
  const u16* qp;
  if (KIND == 0) qp = (const u16*)((const char*)p.out + YS_QMLA) + (size_t)tok * 768 + hq * 96 + h * 8;
  else if (KIND == 1) qp = U0 + (size_t)tok * L0C + C0_QB + hq * 64 + h * 8;
  else qp = U1B + (size_t)tok * U1B_LD + C1_QD + hq * 128 + h * 8;
  bf16x8 qf[DQK / 16];
#pragma unroll
  for (int d0 = 0; d0 < DQK / 16; ++d0) qf[d0] = *(const bf16x8*)(qp + d0 * 16);
  if (KIND == 0 && smp) {
    const float2* tabM = (const float2*)(p.ws + WS_ROPE);
    const int qpos = qrow0 + r32;
#pragma unroll
    for (int d0 = 4; d0 < 6; ++d0) {
      float x[8], xp[8];
      unpack8(__builtin_bit_cast(u32x4, qf[d0 < DQK / 16 ? d0 : 0]), x);
      shfl8(x, xp, 32);
      rope8(x, xp, tabM, 8, d0 == 4 ? (qpos >> 6) : (qpos & 63), 0, h != 0);
      if (d0 < DQK / 16) qf[d0 < DQK / 16 ? d0 : 0] = __builtin_bit_cast(bf16x8, pack8f(x));
    }
  }
  int nwin = 0, wlo = 0, nt = cap / KT;
  if (KIND == 1 && smp) { wlo = q0 - 128 < 0 ? 0 : q0 - 128; const int whi = q0 + 256 > 2048 ? 2048 : q0 + 256; nwin = (whi - wlo) / KT; nt = nwin + 512 / KT; }
  const u16* Kn = (const u16*)((const char*)p.out + YS_KN);
  const u16* KR = (const u16*)(p.ws + WS_KROPE);
  const u16* KSW = (const u16*)(p.ws + WS_KSWA);
  const u16* KCc = (const u16*)(p.ws + WS_KC);
  const u16* VT;
  if (KIND == 0) VT = (const u16*)((const char*)p.out + YS_VTMLA) + (size_t)kr0 * 512;
  else if (KIND == 1) VT = (const u16*)(p.ws + WS_VTSWA) + (size_t)kr0 * 128;
  else VT = (const u16*)(p.ws + WS_VTATT) + (size_t)kr0 * 256;
  bf16x8 rk[NKC], rv[NVC];
  int kkey[NKC], kd[NKC];
#pragma unroll
  for (int i = 0; i < NKC; ++i) { const int c = tid + 512 * i; kkey[i] = c / CPR; kd[i] = (c % CPR) * 8; }
  auto kt0_of = [&](int t) -> int { return (KIND == 1 && smp) ? (t < nwin ? wlo + KT * t : 2048 + KT * (t - nwin)) : KT * t; };
  auto gload = [&](int t) {
    const int kt0 = (DBGV == 2) ? 0 : kt0_of(t);
#pragma unroll
    for (int i = 0; i < NKC; ++i) {
      if (tid + 512 * i < KCH) {
        const int g = kt0 + kkey[i], d = kd[i];
        const u16* src;
        if (KIND == 0) src = d < 64 ? Kn + ((size_t)(kr0 + g) * 8 + hkv) * 64 + d : KR + (size_t)(kr0 + g) * 32 + (d - 64);
        else if (KIND == 1) src = KSW + ((size_t)(kr0 + g) * 2 + hkv) * 64 + d;
        else src = g < len ? U1B + (size_t)(tok0 + g) * U1B_LD + C1_KD + hkv * 128 + d : KCc + ((size_t)((s - 16) * 512 + g - 2048) * 2 + hkv) * 128 + d;
        rk[i] = *(const bf16x8*)src;
      }
    }
#pragma unroll
    for (int i = 0; i < NVC; ++i) {
      const int c = tid + 512 * i, dv = c / VPR, kc = c % VPR;
      rv[i] = *(const bf16x8*)(VT + (size_t)(hkv * DV + dv) * cap + kt0 + kc * 8);
    }
  };
  auto swrite = [&](int buf) {
    u16* sK = sK0 + buf * (KT * KS + DV * VS); u16* sV = sK + KT * KS;
#pragma unroll
    for (int i = 0; i < NKC; ++i) if (tid + 512 * i < KCH) *(bf16x8*)(sK + kkey[i] * KS + kd[i]) = rk[i];
#pragma unroll
    for (int i = 0; i < NVC; ++i) { const int c = tid + 512 * i; *(bf16x8*)(sV + (c / VPR) * VS + (c % VPR) * 8) = rv[i]; }
  };
  f32x16 o[DV / 32];
#pragma unroll
  for (int db = 0; db < DV / 32; ++db)
#pragma unroll
    for (int r = 0; r < 16; ++r) o[db][r] = 0.f;
  float m = -1e30f, l = 0.f;
  constexpr int ABUF = KT * KS + DV * VS;
  constexpr int ND = DQK / 16, NB = DV / 32;
#define SBAR() __builtin_amdgcn_sched_barrier(0)
  __syncthreads();
  gload(0); swrite(0);
  if (nt > 1) { gload(1); swrite(1); }
  __syncthreads();
  if (nt > 2) gload(2);
  int bcur = 0;
#pragma unroll 1
  for (int t = 0; t < nt; ++t) {
    const int bnxt = bcur == 2 ? 0 : bcur + 1, bnn = bnxt == 2 ? 0 : bnxt + 1;
    const u16* sK = sK0 + bcur * ABUF; const u16* sV = sK + KT * KS;
    f32x16 sc[NKB];
#pragma unroll
    for (int kb = 0; kb < NKB; ++kb)
#pragma unroll
      for (int r = 0; r < 16; ++r) sc[kb][r] = 0.f;
    constexpr int BS = NKB == 4 ? 1 : (ND <= 4 ? 2 : 3), NBK = (ND + BS - 1) / BS;
    bf16x8 kf[NBK][NKB * BS];
#pragma unroll
    for (int i = 0; i < BS; ++i)
#pragma unroll
      for (int kb = 0; kb < NKB; ++kb) kf[0][NKB * i + kb] = *(const bf16x8*)(sK + (32 * kb + r32) * KS + i * 16 + h * 8);
    SBAR();
    constexpr int NVG = NB * NKB / 2;
    bf16x8 vf[2][4];
#pragma unroll
    for (int bk = 0; bk < NBK; ++bk) {
      if (bk + 1 < NBK) {
#pragma unroll
        for (int i = 0; i < BS; ++i) { const int d0 = (bk + 1) * BS + i;
          if (d0 < ND) {
#pragma unroll
            for (int kb = 0; kb < NKB; ++kb) kf[bk + 1 < NBK ? bk + 1 : 0][NKB * i + kb] = *(const bf16x8*)(sK + (32 * kb + r32) * KS + d0 * 16 + h * 8); } }
      } else {
#pragma unroll
        for (int q = 0; q < 4; ++q) vf[0][q] = *(const bf16x8*)(sV + r32 * VS + h * 8 + 16 * q);
      }
      SBAR();
#pragma unroll
      for (int i = 0; i < BS; ++i) { const int d0 = bk * BS + i; if (d0 < ND) {
#pragma unroll
        for (int kb = 0; kb < NKB; ++kb) sc[kb] = MFMA(kf[bk][NKB * i + kb], qf[d0 < ND ? d0 : 0], sc[kb]); } }
      SBAR();
    }
    if (KIND == 1 && smp && t < nwin) {
      const int kt0 = kt0_of(t), qi = qrow0 + r32;
#pragma unroll
      for (int kb = 0; kb < NKB; ++kb)
#pragma unroll
        for (int r = 0; r < 16; ++r) { const int d0 = qi - (kt0 + 32 * kb + crow(r, h)); sc[kb][r] = (d0 <= 128 && d0 >= -128) ? sc[kb][r] : -INFINITY; }
    }
    float mx = sc[0][0];
#pragma unroll
    for (int kb = 0; kb < NKB; ++kb)
#pragma unroll
      for (int r = 0; r < 16; ++r) mx = fmaxf(mx, sc[kb][r]);
    { auto rr = __builtin_amdgcn_permlane32_swap(__float_as_uint(mx), __float_as_uint(mx), false, false);
      mx = fmaxf(__uint_as_float(rr[0]), __uint_as_float(rr[1])); }
    const float mnew = fmaxf(m, mx * C);
    const float alpha = __builtin_amdgcn_exp2f(m - mnew);
    m = mnew;
    float ps = 0.f;
#pragma unroll
    for (int kb = 0; kb < NKB; ++kb)
#pragma unroll
      for (int r = 0; r < 16; ++r) { sc[kb][r] = __builtin_amdgcn_exp2f(sc[kb][r] * C - mnew); ps += sc[kb][r]; }
    l = l * alpha + ps;
#pragma unroll
    for (int db = 0; db < NB; ++db)
#pragma unroll
      for (int r = 0; r < 16; ++r) o[db][r] *= alpha;
    bf16x8 pf[2 * NKB];
#pragma unroll
    for (int kb = 0; kb < NKB; ++kb) { pf[2 * kb] = pack8(sc[kb], 0); pf[2 * kb + 1] = pack8(sc[kb], 1); }
    SBAR();
#pragma unroll
    for (int g = 0; g < NVG; ++g) {
      if (g + 1 < NVG) {
        const int db1 = (g + 1) / (NKB / 2), kq1 = ((g + 1) % (NKB / 2)) * 4;
#pragma unroll
        for (int q = 0; q < 4; ++q) vf[(g + 1) & 1][q] = *(const bf16x8*)(sV + (db1 * 32 + r32) * VS + h * 8 + 16 * (kq1 + q));
      }
      SBAR();
      const int db = g / (NKB / 2), kq = (g % (NKB / 2)) * 4;
      o[db] = MFMA(vf[g & 1][0], pf[kq], o[db]); o[db] = MFMA(vf[g & 1][1], pf[kq + 1], o[db]); o[db] = MFMA(vf[g & 1][2], pf[kq + 2], o[db]); o[db] = MFMA(vf[g & 1][3], pf[kq + 3], o[db]);
      SBAR();
    }
    if (t + 2 < nt) {
      swrite(bnn);
      __syncthreads();
      if (t + 3 < nt) gload(t + 3);
    }
    bcur = bnxt;
  }
#undef SBAR
  float lt = l + __shfl_xor(l, 32);
  if (KIND == 1) lt += __builtin_amdgcn_exp2f(p.swa_sink[hq] * LOG2E - m);
  const float inv = 1.f / lt;
  const u16* zp; u16* op;
  if (KIND == 0) { zp = U0 + (size_t)tok * L0C + C0_ZA + hq * 64; op = (u16*)(p.ws + WS_H) + (size_t)tok * DM + hq * 64; }
  else if (KIND == 1) { zp = U0 + (size_t)tok * L0C + C0_ZB + hq * 64; op = (u16*)(p.ws + WS_H) + (size_t)tok * DM + 512 + hq * 64; }
  else { zp = U1B + (size_t)tok * U1B_LD + C1_ZD + hq * 128; op = (u16*)(p.ws + WS_H) + (size_t)tok * DM + 512 + hq * 128; }
#pragma unroll
  for (int db = 0; db < DV / 32; ++db)
#pragma unroll
    for (int g = 0; g < 4; ++g) {
      const int dv = db * 32 + 8 * g + 4 * h;
      const u32x2 zw = *(const u32x2*)(zp + dv);
      const float z0 = bf2f((u16)(zw[0] & 0xffffu)), z1 = bf2f((u16)(zw[0] >> 16)), z2 = bf2f((u16)(zw[1] & 0xffffu)), z3 = bf2f((u16)(zw[1] >> 16));
      u32x2 w = {pack2(o[db][4 * g] * inv * siluf(z0), o[db][4 * g + 1] * inv * siluf(z1)), pack2(o[db][4 * g + 2] * inv * siluf(z2), o[db][4 * g + 3] * inv * siluf(z3))};
      if (DBGV == 0) *(u32x2*)(op + dv) = w; else asm volatile("" :: "v"(w[0]), "v"(w[1]));
    }
  __syncthreads();
}

DI void phase_attn0(const Params& p, char* lds, unsigned long long code_end) {
#pragma unroll 1
  for (int it = blockIdx.x; it < 1280; it += gridDim.x) {
    const int x = it & 7;
    int kind, s, hs, q0;
    if (it < 512) { const int j = it >> 3; const int pr = (j & 7) * 8 + x, qb = j >> 3; kind = 0; s = 16 + (pr >> 3); hs = pr & 7; q0 = qb * 256; }
    else if (it < 1024) { const int j = (it - 512) >> 3; const int pr = (j & 1) * 8 + x, sub = j >> 1;
      kind = 1; s = 16 + (pr >> 1); hs = (pr & 1) * 2 + (sub & 1); q0 = (sub >> 1) * 128; }
    else if (it < 1152) { const int j = it - 1024; kind = 0; s = j >> 3; hs = j & 7; q0 = 0; }
    else { const int j = it - 1152; kind = 1; s = j >> 3; hs = (j & 7) >> 1; q0 = (j & 1) * 128; }
    if (it >= 512 && it < 768) code_prefetch(code_end);
    if (kind == 0) attn_item<0>(p, s, hs, q0, lds); else attn_item<1>(p, s, hs, q0, lds);
  }
}
template <int DBGV>
DI void phase_attn1_t(const Params& p, char* lds) {
#pragma unroll 1
  for (int it = blockIdx.x; it < 320; it += gridDim.x) {
    const int x = it & 7;
    int s, hs, q0;
    if (it < 256) { const int j = it >> 3; const int pr = (j & 1) * 8 + x, qb = j >> 1; s = 16 + (pr >> 1); hs = pr & 1; q0 = qb * 128; }
    else { const int j = it - 256; s = j >> 2; hs = (j & 3) >> 1; q0 = (j & 1) * 128; }
    attn_item<2, DBGV>(p, s, hs, q0, lds);
  }
}
DI void phase_attn1(const Params& p, char* lds) { phase_attn1_t<0>(p, lds); }

DI float group16_sum(float v) {
#pragma unroll
  for (int o = 8; o > 0; o >>= 1) v += __shfl_xor(v, o);
  return v;
}
template <bool GDN, bool ATT>
DI void l1prep_t(const Params& p, char* lds, int rank, int nblk) {
  const int tid = TIDX(), lane = tid & 63, wid = tid >> 6;
  const u16* UA = (const u16*)(p.ws + WS_U1A);
  u16* UB = (u16*)(p.ws + WS_U1B);
  u16* QK = (u16*)(p.ws + WS_H);
  u16* VC = (u16*)(p.ws + WS_VC);
  float* GB = (float*)(p.ws + WS_GB);
  const float* AB = (const float*)(p.ws + WS_AB);
  const float2* tabA = (const float2*)(p.ws + WS_ROPE) + 1536;
  u16* sv = (u16*)lds;
  float* sconv = (float*)(lds + 16384);
  if (GDN) { for (int i = tid; i < 1152; i += NTHREADS) *(float4*)(sconv + 4 * i) = *(const float4*)(p.gdn_conv + 4 * i); }
  __syncthreads();
  constexpr int N_TOK_ITEMS = NTOK / 16;
  constexpr int N_KC_ITEMS = 256;
  constexpr int N_VC_ITEMS = 256;
  for (int it = rank; it < (ATT ? N_TOK_ITEMS + N_KC_ITEMS + N_VC_ITEMS : N_TOK_ITEMS); it += nblk) {
    if (it >= N_TOK_ITEMS + N_KC_ITEMS) {
      const int t = it - N_TOK_ITEMS - N_KC_ITEMS; const int b = t >> 5, g = t & 31;
      {
        const int key = tid >> 5, c8 = (tid & 31) * 8;
        const float* src = p.c_attv + ((size_t)(b * 512 + g * 16 + key)) * 256 + c8;
        const float4 a = ntload4(src), b4 = ntload4(src + 4);
        u32x4 w = {pack2(a.x, a.y), pack2(a.z, a.w), pack2(b4.x, b4.y), pack2(b4.z, b4.w)};
        *(u32x4*)(sv + key * 264 + c8) = w;
      }
      __syncthreads();
      vt_store16(sv, 264, 256, (u16*)(p.ws + WS_VTATT) + (size_t)krow0_of(16 + b) * 256, 2560, 2048 + g * 16);
      __syncthreads();
      continue;
    }
    if (it >= N_TOK_ITEMS) {
      const size_t i = (size_t)(it - N_TOK_ITEMS) * 4096 + tid * 8;
      const float4 a = ntload4(p.c_attk + i), b4 = ntload4(p.c_attk + i + 4);
      u32x4 w = {pack2(a.x, a.y), pack2(a.z, a.w), pack2(b4.x, b4.y), pack2(b4.z, b4.w)};
      *(u32x4*)((u16*)(p.ws + WS_KC) + i) = w;
      continue;
    }
    const int m0 = it * 16;
    for (int tt = 0; tt < 2; ++tt) {
      const int ml = wid * 2 + tt, m = m0 + ml;
      const bool ctx = m < NCTX;
      const int pos = pos_of_tok(m), prow = pos >> 6, pcol = pos & 63, len = ctx ? 256 : 2048;
      const int li = lane & 15;
      const u16* r1 = UA + (size_t)m * U1A_LD;
      u32x4 xw[3][3]; float cw[3][3][8];
      if constexpr (GDN) {
#pragma unroll
      for (int j = 0; j < 3; ++j) {
        const int ch = j * 512 + lane * 8;
        xw[j][1] = *(const u32x4*)(r1 + ch);
        xw[j][0] = (pos > 0) ? *(const u32x4*)(r1 - U1A_LD + ch) : (u32x4){0u, 0u, 0u, 0u};
        xw[j][2] = (pos < len - 1) ? *(const u32x4*)(r1 + U1A_LD + ch) : (u32x4){0u, 0u, 0u, 0u};
#pragma unroll
        for (int kk = 0; kk < 3; ++kk) {
          const float4 wa = *(const float4*)(sconv + kk * 1536 + ch), wb = *(const float4*)(sconv + kk * 1536 + ch + 4);
          cw[j][kk][0] = wa.x; cw[j][kk][1] = wa.y; cw[j][kk][2] = wa.z; cw[j][kk][3] = wa.w; cw[j][kk][4] = wb.x; cw[j][kk][5] = wb.y; cw[j][kk][6] = wb.z; cw[j][kk][7] = wb.w;
        }
      }
      }
      u16* qp = UB + (size_t)m * U1B_LD + C1_QD + lane * 8;
      u16* kp = UB + (size_t)m * U1B_LD + C1_KD + (lane & 31) * 8;
      u32x4 qdw, kdw, vdw; float abv = 0.f;
      if constexpr (ATT) { qdw = ntload4u(qp); kdw = ntload4u(kp); vdw = ntload4u(UB + (size_t)m * U1B_LD + C1_VD + (lane & 31) * 8); }
      if constexpr (GDN) abv = AB[(size_t)m * 16 + (lane & 15)];
      float qn8[8], kn8[8]; float2 cs8[8];
      if constexpr (ATT) {
        const float4 a0 = *(const float4*)(p.att_q_norm + li * 8), a1 = *(const float4*)(p.att_q_norm + li * 8 + 4), b0 = *(const float4*)(p.att_k_norm + li * 8), b1 = *(const float4*)(p.att_k_norm + li * 8 + 4);
        qn8[0] = a0.x; qn8[1] = a0.y; qn8[2] = a0.z; qn8[3] = a0.w; qn8[4] = a1.x; qn8[5] = a1.y; qn8[6] = a1.z; qn8[7] = a1.w;
        kn8[0] = b0.x; kn8[1] = b0.y; kn8[2] = b0.z; kn8[3] = b0.w; kn8[4] = b1.x; kn8[5] = b1.y; kn8[6] = b1.z; kn8[7] = b1.w;
        const int b32 = li >> 2, pp = (b32 >= 2) ? pcol : prow;
#pragma unroll
        for (int e = 0; e < 8; ++e) cs8[e] = tabA[pp * 32 + (li & 3) * 8 + e];
      }
      const bool is_x2 = ((li >> 2) & 1) != 0;
      if constexpr (GDN) {
#pragma unroll
      for (int j = 0; j < 3; ++j) {
        float x0[8], x1[8], x2[8], y[8];
        unpack8(xw[j][0], x0); unpack8(xw[j][1], x1); unpack8(xw[j][2], x2);
        float ss = 0.f;
#pragma unroll
        for (int e = 0; e < 8; ++e) { const float a = cw[j][0][e] * x0[e] + cw[j][1][e] * x1[e] + cw[j][2][e] * x2[e]; y[e] = siluf(a); ss += y[e] * y[e]; }
        if (j < 2) {
          ss = group16_sum(ss);
          const float rs = rsqrtf(ss + EPS) * (j == 0 ? 0.08838834764831845f : 1.f);
#pragma unroll
          for (int e = 0; e < 8; ++e) y[e] *= rs;
          *(u32x4*)(QK + (size_t)m * DM + j * 512 + lane * 8) = pack8f(y);
        } else {
          *(u32x4*)(VC + (size_t)m * 512 + lane * 8) = pack8f(y);
        }
      }
      if (lane < 16) {
        float r;
        if (lane < 8) { const float x = abv + p.gdn_dt_bias[lane]; const float ex = __expf(x);
          const float sp = x > 20.f ? x : (ex < 0.03125f ? ex * (1.f - ex * (0.5f - ex * (0.33333333f - 0.25f * ex))) : __logf(1.f + ex));
          r = -__expf(p.gdn_a_log[lane]) * sp; }
        else r = __builtin_amdgcn_rcpf(1.f + __expf(-abv));
        GB[(size_t)m * 16 + lane] = r;
      }
      }
      if constexpr (ATT) {
        float x[8], xp[8];
        unpack8(qdw, x);
        float ss = 0.f;
#pragma unroll
        for (int e = 0; e < 8; ++e) ss += x[e] * x[e];
        ss = group16_sum(ss);
        const float rs = rsqrtf(ss * (1.f / 128.f) + EPS);
#pragma unroll
        for (int e = 0; e < 8; ++e) x[e] *= rs * qn8[e];
        shfl8(x, xp, 4);
        if (!ctx) {
#pragma unroll
          for (int e = 0; e < 8; ++e) x[e] = is_x2 ? (x[e] * cs8[e].x + xp[e] * cs8[e].y) : (x[e] * cs8[e].x - xp[e] * cs8[e].y);
        }
        *(u32x4*)qp = pack8f(x);
      }
      if constexpr (ATT) {
        float x[8], xp[8];
        unpack8(kdw, x);
        float ss = 0.f;
#pragma unroll
        for (int e = 0; e < 8; ++e) ss += x[e] * x[e];
        ss = group16_sum(ss);
        const float rs = rsqrtf(ss * (1.f / 128.f) + EPS);
#pragma unroll
        for (int e = 0; e < 8; ++e) x[e] *= rs * kn8[e];
        if (ctx && lane < 32) {
          *(float4*)(p.out + O_ATTK + (size_t)m * 256 + lane * 8) = make_float4(x[0], x[1], x[2], x[3]);
          *(float4*)(p.out + O_ATTK + (size_t)m * 256 + lane * 8 + 4) = make_float4(x[4], x[5], x[6], x[7]);
        }
        shfl8(x, xp, 4);
        if (!ctx) {
#pragma unroll
          for (int e = 0; e < 8; ++e) x[e] = is_x2 ? (x[e] * cs8[e].x + xp[e] * cs8[e].y) : (x[e] * cs8[e].x - xp[e] * cs8[e].y);
        }
        if (lane < 32) {
          *(u32x4*)kp = pack8f(x);
          *(u32x4*)(sv + ml * 264 + lane * 8) = vdw;
          if (ctx) {
            float v[8]; unpack8(vdw, v);
            *(float4*)(p.out + O_ATTV + (size_t)m * 256 + lane * 8) = make_float4(v[0], v[1], v[2], v[3]);
            *(float4*)(p.out + O_ATTV + (size_t)m * 256 + lane * 8 + 4) = make_float4(v[4], v[5], v[6], v[7]);
          }
        }
      }
    }
    if constexpr (ATT) {
      __syncthreads();
      {
        const int s = seq_of_tok(m0);
        vt_store16(sv, 264, 256, (u16*)(p.ws + WS_VTATT) + (size_t)krow0_of(s) * 256, cap_of(s), pos_of_tok(m0));
      }
      __syncthreads();
    }
  }
  __syncthreads();
}
DI int cp_main_chunk(int it) { if (it < 64) return it; const int j = it - 64, b = j / 24, cc = j % 24; return 64 + b * 32 + (cc < 12 ? cc : cc + 8); }
DI int cp_deferred_chunk(int it) { return 64 + (it >> 3) * 32 + 12 + (it & 7); }
DI void l1prep_gdn(const Params& p, int rank, int nblk) {
  const int tid = TIDX(), lane = tid & 63, wid = tid >> 6;
  const u16* UA = (const u16*)(p.ws + WS_U1A);
  u16* QK = (u16*)(p.ws + WS_H);
  u16* VC = (u16*)(p.ws + WS_VC);
  float* GB = (float*)(p.ws + WS_GB);
  const float* AB = (const float*)(p.ws + WS_AB);
  float cw[3][3][8];
#pragma unroll
  for (int j = 0; j < 3; ++j)
#pragma unroll
    for (int kk = 0; kk < 3; ++kk) {
      const float4 wa = *(const float4*)(p.gdn_conv + kk * 1536 + j * 512 + lane * 8), wb = *(const float4*)(p.gdn_conv + kk * 1536 + j * 512 + lane * 8 + 4);
      cw[j][kk][0] = wa.x; cw[j][kk][1] = wa.y; cw[j][kk][2] = wa.z; cw[j][kk][3] = wa.w; cw[j][kk][4] = wb.x; cw[j][kk][5] = wb.y; cw[j][kk][6] = wb.z; cw[j][kk][7] = wb.w;
    }
  const float dtb = p.gdn_dt_bias[lane & 7], nalog = -__expf(p.gdn_a_log[lane & 7]);
  constexpr int N_TOK_ITEMS = NTOK / 16;
  const int nit = rank < N_TOK_ITEMS ? (N_TOK_ITEMS - 1 - rank) / nblk + 1 : 0, nq = nit * 2;
  const bool own = nblk == 256;
  const int own_tok0 = cp_main_chunk(rank) * 64, def_tok0 = cp_deferred_chunk(rank >> 2) * 64 + (rank & 3) * 16;
#define L1G_TOK(q_) (own ? (((q_) >> 1) < 4 ? own_tok0 + ((q_) >> 1) * 16 : def_tok0) + wid * 2 + ((q_) & 1) : (rank + ((q_) >> 1) * nblk) * 16 + wid * 2 + ((q_) & 1))
#define L1G_LOAD(X_, A_, m_) do { const int pos_ = pos_of_tok(m_), len_ = (m_) < NCTX ? 256 : 2048; const u16* r1_ = UA + (size_t)(m_) * U1A_LD; \
    const u16* rp_ = pos_ > 0 ? r1_ - U1A_LD : r1_; const u16* rn_ = pos_ < len_ - 1 ? r1_ + U1A_LD : r1_; \
    _Pragma("unroll") for (int j = 0; j < 3; ++j) { const int ch_ = j * 512 + lane * 8; X_[j][0] = *(const u32x4*)(rp_ + ch_); X_[j][1] = *(const u32x4*)(r1_ + ch_); X_[j][2] = *(const u32x4*)(rn_ + ch_); } \
    A_ = AB[(size_t)(m_) * 16 + (lane & 15)]; } while (0)
  u32x4 xc[3][3], xn[3][3]; float abc = 0.f, abn = 0.f;
  if (nq > 0) { const int m0 = L1G_TOK(0); L1G_LOAD(xc, abc, m0); }
#pragma unroll 1
  for (int q = 0; q < nq; ++q) {
    const int m = L1G_TOK(q);
    if (q + 1 < nq) { const int mn = L1G_TOK(q + 1); L1G_LOAD(xn, abn, mn); }
    const int pos = pos_of_tok(m), len = m < NCTX ? 256 : 2048;
    const float e0 = pos > 0 ? 1.f : 0.f, e2 = pos < len - 1 ? 1.f : 0.f;
#pragma unroll
    for (int j = 0; j < 3; ++j) {
      float x0[8], x1[8], x2[8], y[8];
      unpack8(xc[j][0], x0); unpack8(xc[j][1], x1); unpack8(xc[j][2], x2);
      float ss = 0.f;
#pragma unroll
      for (int e = 0; e < 8; ++e) { const float a = cw[j][0][e] * (x0[e] * e0) + cw[j][1][e] * x1[e] + cw[j][2][e] * (x2[e] * e2); y[e] = siluf(a); ss += y[e] * y[e]; }
      if (j < 2) {
        ss = group16_sum(ss);
        const float rs = rsqrtf(ss + EPS) * (j == 0 ? 0.08838834764831845f : 1.f);
#pragma unroll
        for (int e = 0; e < 8; ++e) y[e] *= rs;
        *(u32x4*)(QK + (size_t)m * DM + j * 512 + lane * 8) = pack8f(y);
      } else {
        *(u32x4*)(VC + (size_t)m * 512 + lane * 8) = pack8f(y);
      }
    }
    if (lane < 16) {
      float r;
      if (lane < 8) { const float x = abc + dtb; const float ex = __expf(x);
        const float sp = x > 20.f ? x : (ex < 0.03125f ? ex * (1.f - ex * (0.5f - ex * (0.33333333f - 0.25f * ex))) : __logf(1.f + ex));
        r = nalog * sp; }
      else r = __builtin_amdgcn_rcpf(1.f + __expf(-abc));
      GB[(size_t)m * 16 + lane] = r;
    }
#pragma unroll
    for (int j = 0; j < 3; ++j)
#pragma unroll
      for (int kk = 0; kk < 3; ++kk) xc[j][kk] = xn[j][kk];
    abc = abn;
  }
#undef L1G_TOK
#undef L1G_LOAD
}
DI void phase_l1prep(const Params& p, char* lds) {
  l1prep_gdn(p, (int)blockIdx.x, (int)gridDim.x);
  if (gridDim.x != 256) l1prep_t<false, true>(p, lds, (int)blockIdx.x, (int)gridDim.x);
}


DI void phase_gdnfinal(const Params& p) {
  const int tid_ = TIDX(), lane = tid_ & 63, wid = tid_ >> 6;
  const u16* OF = (const u16*)(p.ws + WS_OF); const u16* OBk = (const u16*)(p.ws + WS_OB);
  const u16* UB = (const u16*)(p.ws + WS_U1B);
  u16* H = (u16*)(p.ws + WS_H);
  for (int m = blockIdx.x * 8 + wid; m < NTOK; m += gridDim.x * 8) {
    float a[8], b[8], z[8];
    unpack8(ntload4u(OF + (size_t)m * 512 + lane * 8), a);
    unpack8(ntload4u(OBk + (size_t)m * 512 + lane * 8), b);
    unpack8(ntload4u(UB + (size_t)m * U1B_LD + C1_ZC + lane * 8), z);
    float ss = 0.f;
#pragma unroll
    for (int e = 0; e < 8; ++e) { a[e] += b[e]; ss += a[e] * a[e]; }
    ss = group16_sum(ss);
    const float rs = rsqrtf(ss * (1.f / 128.f) + EPS);
    const int li = lane & 15;
#pragma unroll
    for (int e = 0; e < 8; ++e) a[e] = a[e] * rs * p.gdn_norm[li * 8 + e] * siluf(z[e]);
    *(u32x4*)(H + (size_t)m * DM + lane * 8) = pack8f(a);
  }
}

DI float dbg_rel(const Params& p);
#ifndef DBG_CHECK
#define DBG_CHECK 0
#endif
#ifndef DBG_AMP
#define DBG_AMP 10.f
#endif
DI void phase_final(const Params& p) {
  const int tid_ = TIDX(), lane = tid_ & 63, wid = tid_ >> 6;
  const u16* GY = (const u16*)(p.ws + WS_GY1);
  float4 g4[4];
#pragma unroll
  for (int j = 0; j < 4; ++j) g4[j] = *(const float4*)(p.ln_f + (j * 64 + lane) * 4);
  const int stride = gridDim.x * 8;
  int m = blockIdx.x * 8 + wid;
  float4 cur[4], nxt[4]; u32x2 cg[4], ng[4];
  if (m < NTOK) {
#pragma unroll
    for (int j = 0; j < 4; ++j) { cur[j] = ntload4(p.out + (size_t)m * DM + (j * 64 + lane) * 4); cg[j] = ntload2u(GY + (size_t)m * DM + (j * 64 + lane) * 4); } }
  for (; m < NTOK; m += stride) {
    const int mn = m + stride;
    if (mn < NTOK) {
#pragma unroll
      for (int j = 0; j < 4; ++j) { nxt[j] = ntload4(p.out + (size_t)mn * DM + (j * 64 + lane) * 4); ng[j] = ntload2u(GY + (size_t)mn * DM + (j * 64 + lane) * 4); } }
    float ss = 0.f;
#pragma unroll
    for (int j = 0; j < 4; ++j) {
      cur[j].x += bf2f((u16)(cg[j][0] & 0xffffu)); cur[j].y += bf2f((u16)(cg[j][0] >> 16)); cur[j].z += bf2f((u16)(cg[j][1] & 0xffffu)); cur[j].w += bf2f((u16)(cg[j][1] >> 16));
      ss += cur[j].x * cur[j].x + cur[j].y * cur[j].y + cur[j].z * cur[j].z + cur[j].w * cur[j].w;
    }
    ss = wave_sum(ss);
    const float rs = rsqrtf(ss * (1.f / 1024.f) + EPS);
#pragma unroll
    for (int j = 0; j < 4; ++j)
      { typedef float nt4 __attribute__((ext_vector_type(4))); const nt4 yv = {cur[j].x * rs * g4[j].x, cur[j].y * rs * g4[j].y, cur[j].z * rs * g4[j].z, cur[j].w * rs * g4[j].w};
        __builtin_nontemporal_store(yv, (nt4*)(p.out + (size_t)m * DM + (j * 64 + lane) * 4)); }
#pragma unroll
    for (int j = 0; j < 4; ++j) { cur[j] = nxt[j]; cg[j] = ng[j]; }
  }
}

template <class F>
DI void ngemm(const GemmA A, const u16* __restrict__ Wt, int ldw, int K, int M, int N, char* lds, F f) {
  u16* sA = (u16*)lds;
  const int tid = TIDX();
  const int ncol = (N + 511) / 512;
  for (int it = blockIdx.x; it < (M / 8) * ncol; it += gridDim.x) {
    const int m0 = (it / ncol) * 8, n = (it % ncol) * 512 + tid;
    __syncthreads();
    for (int i = tid; i < 8 * (K / 8); i += NTHREADS) {
      const int r = i / (K / 8), k8 = (i % (K / 8)) * 8;
      const u16* src = k8 < A.ksplit ? A.p0 + (size_t)(m0 + r) * A.ld0 + k8 : A.p1 + (size_t)(m0 + r) * A.ld1 + (k8 - A.ksplit);
      *(u32x4*)(sA + r * K + k8) = *(const u32x4*)src;
    }
    __syncthreads();
    if (n < N) {
      float acc[8];
#pragma unroll
      for (int r = 0; r < 8; ++r) acc[r] = 0.f;
      for (int k8 = 0; k8 < K; k8 += 8) {
        float w[8]; unpack8(*(const u32x4*)(Wt + (size_t)n * ldw + k8), w);
#pragma unroll
        for (int r = 0; r < 8; ++r) {
          float a[8]; unpack8(*(const u32x4*)(sA + r * K + k8), a);
#pragma unroll
          for (int e = 0; e < 8; ++e) acc[r] += a[e] * w[e];
        }
      }
#pragma unroll
      for (int r = 0; r < 8; ++r) f(m0 + r, n, acc[r]);
    }
  }
}
DI void nphase_inproj0(const Params& p, char* lds) {
  u16* U = (u16*)(p.ws + WS_U); const u16* H = (const u16*)(p.ws + WS_H);
  ngemm(GemmA{H, DM, H, DM, 1 << 30}, (const u16*)(p.ws + WS_WT0), DM, DM, NTOK, L0C, lds, [=](int m, int n, float v) { U[(size_t)m * L0C + n] = f2bf(v); });
}
DI void nphase_l0gemms(const Params& p, char* lds) {
  const u16* U0 = (const u16*)(p.ws + WS_U); const u16* ck = (const u16*)(p.ws + WS_CKVN);
  u16* Kn = (u16*)((char*)p.out + YS_KN); u16* Vt = (u16*)((char*)p.out + YS_VTMLA); u16* Q = (u16*)((char*)p.out + YS_QMLA);
  ngemm(GemmA{ck, 256, ck, 256, 1 << 30}, (const u16*)(p.ws + WS_WUKV), 256, 256, NKROW, 1024, lds, [=](int kr, int n, float v) {
    if (n < 512) Kn[(size_t)kr * 512 + n] = f2bf(v);
    else {
      int seq, key;
      if (kr < NCTX) { seq = kr >> 8; key = kr & 255; } else { const int r = kr - NCTX; seq = 16 + r / 2560; key = r % 2560; }
      Vt[(size_t)krow0_of(seq) * 512 + (size_t)(n - 512) * cap_of(seq) + (key & ~15) + swz16(key & 15)] = f2bf(v);
    }
  });
  ngemm(GemmA{U0 + C0_CQ, L0C, U0 + C0_CQ, L0C, 1 << 30}, (const u16*)(p.ws + WS_WUQ), 384, 384, NTOK, 768, lds, [=](int m, int n, float v) { Q[(size_t)m * 768 + n] = f2bf(v); });
}
DI void nphase_qmla_rope(const Params& p) {
  u16* Q = (u16*)((char*)p.out + YS_QMLA);
  const float2* tab = (const float2*)(p.ws + WS_ROPE);
  for (size_t i = (size_t)blockIdx.x * NTHREADS + threadIdx.x; i < (size_t)(NTOK - NCTX) * 8 * 16; i += (size_t)gridDim.x * NTHREADS) {
    const int m = NCTX + (int)(i >> 7), head = (int)(i >> 4) & 7, j = (int)i & 15;
    const int pos = pos_of_tok(m), pp = (j >> 3) ? (pos & 63) : (pos >> 6);
    u16* q = Q + (size_t)m * 768 + head * 96 + 64 + (j >> 3) * 16 + (j & 7);
    const float x1 = bf2f(q[0]), x2 = bf2f(q[8]);
    const float2 cs = tab[pp * 8 + (j & 7)];
    q[0] = f2bf(x1 * cs.x - x2 * cs.y); q[8] = f2bf(x2 * cs.x + x1 * cs.y);
  }
}
DI void nphase_outproj(const Params& p, int layer, char* lds) {
  const u16* H = (const u16*)(p.ws + WS_H);
  const GemmA A{H, DM, H, DM, 1 << 30};
  const float* mod = (const float*)(p.ws + WS_MOD) + (size_t)layer * 9 * 3072 + 2048;
  const Params* pp = &p;
  ngemm(A, (const u16*)(p.ws + (layer ? WS_WO1 : WS_WO0)), DM, DM, NTOK, DM, lds, [=](int m, int n, float v) {
    const float gate = mod[(size_t)modidx_of_tok(m) * 3072 + n];
    const float xv = layer ? pp->out[(size_t)m * DM + n] : xrow(*pp, m)[n];
    pp->out[(size_t)m * DM + n] = xv + gate * v;
  });
}
DI void nphase_inproj1(const Params& p, char* lds) {
  u16* UA = (u16*)(p.ws + WS_U1A); u16* UB = (u16*)(p.ws + WS_U1B); float* AB = (float*)(p.ws + WS_AB);
  const u16* H = (const u16*)(p.ws + WS_H);
  ngemm(GemmA{H, DM, H, DM, 1 << 30}, (const u16*)(p.ws + WS_WT1), DM, DM, NTOK, L1C, lds, [=](int m, int n, float v) {
    if (n < 1536) UA[(size_t)m * U1A_LD + n] = f2bf(v);
    else if (n < 3584) UB[(size_t)m * U1B_LD + n - 1536] = f2bf(v);
    else AB[(size_t)m * 16 + n - 3584] = v;
  });
}

template <int KIND>
DI void nattn(const Params& p) {
  constexpr int DQK = KIND == 0 ? 96 : (KIND == 1 ? 64 : 128);
  constexpr int DV = KIND == 2 ? 128 : 64;
  constexpr int NH = KIND == 2 ? 4 : 8;
  constexpr float SCALE = KIND == 0 ? 0.10206207261596577f : (KIND == 1 ? 0.125f : 0.08838834764831845f);
  const int tid_ = TIDX(), lane = tid_ & 63, wid = tid_ >> 6;
  const u16* U0 = (const u16*)(p.ws + WS_U);
  u16* U1B = (u16*)(p.ws + WS_U1B);
  for (int it = blockIdx.x * 8 + wid; it < NTOK * NH; it += gridDim.x * 8) {
    const int tok = it / NH, hq = it % NH;
    const int s = seq_of_tok(tok), tok0 = tok0_of(s), kr0 = krow0_of(s), cap = cap_of(s), len = len_of(s), qi = tok - tok0;
    const bool smp = s >= 16;
    const int hkv = KIND == 0 ? hq : (KIND == 1 ? hq >> 2 : hq >> 1);
    const u16* qp; const u16* VT;
    if (KIND == 0) { qp = (const u16*)((const char*)p.out + YS_QMLA) + (size_t)tok * 768 + hq * 96; VT = (const u16*)((const char*)p.out + YS_VTMLA) + (size_t)kr0 * 512; }
    else if (KIND == 1) { qp = U0 + (size_t)tok * L0C + C0_QB + hq * 64; VT = (const u16*)(p.ws + WS_VTSWA) + (size_t)kr0 * 128; }
    else { qp = U1B + (size_t)tok * U1B_LD + C1_QD + hq * 128; VT = (const u16*)(p.ws + WS_VTATT) + (size_t)kr0 * 256; }
    const float q0 = bf2f(qp[lane]);
    float q1 = (DQK > 64 && lane + 64 < DQK) ? bf2f(qp[lane + 64]) : 0.f;
    if (KIND == 0) {
      const float q1p = __shfl_xor(q1, 8);
      if (smp && lane < 32) {
        const float2 cs = ((const float2*)(p.ws + WS_ROPE))[((lane >> 4) ? (qi & 63) : (qi >> 6)) * 8 + (lane & 7)];
        q1 = (lane & 8) ? (q1 * cs.x + q1p * cs.y) : (q1 * cs.x - q1p * cs.y);
      }
    }
    float m = -1e30f, l = 0.f, o0 = 0.f, o1 = 0.f;
    int glo = 0, ghi = cap >> 4;
    const int nseqg = len >> 4;
    for (int gidx = glo; gidx < ghi; ++gidx) {
      const int g0 = gidx * 16;
      if (KIND == 1 && smp && g0 < 2048) { if (g0 + 15 < qi - 128 || g0 > qi + 128) continue; }
      float sc[16];
#pragma unroll
      for (int j = 0; j < 16; ++j) {
        const int g = g0 + j;
        const u16* kp;
        float part;
        if (KIND == 0) {
          const u16* kn = (const u16*)((const char*)p.out + YS_KN) + ((size_t)(kr0 + g) * 8 + hkv) * 64;
          const u16* kr = (const u16*)(p.ws + WS_KROPE) + (size_t)(kr0 + g) * 32;
          part = q0 * bf2f(kn[lane]) + (lane < 32 ? q1 * bf2f(kr[lane]) : 0.f);
        } else if (KIND == 1) {
          kp = (const u16*)(p.ws + WS_KSWA) + ((size_t)(kr0 + g) * 2 + hkv) * 64;
          part = q0 * bf2f(kp[lane]);
        } else {
          kp = g < len ? U1B + (size_t)(tok0 + g) * U1B_LD + C1_KD + hkv * 128 : (const u16*)(p.ws + WS_KC) + ((size_t)((s - 16) * 512 + g - 2048) * 2 + hkv) * 128;
          part = q0 * bf2f(kp[lane]) + q1 * bf2f(kp[lane + 64]);
        }
        float sv_ = wave_sum(part) * SCALE;
        if (KIND == 1 && smp && g < 2048) { const int d = qi - g; if (d > 128 || d < -128) sv_ = -INFINITY; }
        sc[j] = sv_;
      }
      float mx = sc[0];
#pragma unroll
      for (int j = 1; j < 16; ++j) mx = fmaxf(mx, sc[j]);
      const float mnew = fmaxf(m, mx);
      const float alpha = __expf(m - mnew);
      m = mnew; l *= alpha; o0 *= alpha; o1 *= alpha;
      const u32x4 va = *(const u32x4*)(VT + (size_t)(hkv * DV + lane) * cap + g0), vb = *(const u32x4*)(VT + (size_t)(hkv * DV + lane) * cap + g0 + 8);
      float v0[16]; { float t8[8]; unpack8(va, t8); for (int e = 0; e < 8; ++e) v0[e] = t8[e]; unpack8(vb, t8); for (int e = 0; e < 8; ++e) v0[8 + e] = t8[e]; }
      float v1[16];
      if (DV > 64) {
        const u32x4 vc = *(const u32x4*)(VT + (size_t)(hkv * DV + 64 + lane) * cap + g0), vd = *(const u32x4*)(VT + (size_t)(hkv * DV + 64 + lane) * cap + g0 + 8);
        float t8[8]; unpack8(vc, t8); for (int e = 0; e < 8; ++e) v1[e] = t8[e]; unpack8(vd, t8); for (int e = 0; e < 8; ++e) v1[8 + e] = t8[e];
      }
#pragma unroll
      for (int j = 0; j < 16; ++j) {
        const float pj = __expf(sc[j] - mnew);
        l += pj;
        o0 += pj * v0[swz16(j)];
        if (DV > 64) o1 += pj * v1[swz16(j)];
      }
    }
    (void)nseqg; (void)glo;
    if (KIND == 1) l += __expf(p.swa_sink[hq] - m);
    const float inv = 1.f / l;
    if (KIND == 0) { const float z = bf2f(U0[(size_t)tok * L0C + C0_ZA + hq * 64 + lane]); ((u16*)(p.ws + WS_H))[(size_t)tok * DM + hq * 64 + lane] = f2bf(o0 * inv * siluf(z)); }
    else if (KIND == 1) { const float z = bf2f(U0[(size_t)tok * L0C + C0_ZB + hq * 64 + lane]); ((u16*)(p.ws + WS_H))[(size_t)tok * DM + 512 + hq * 64 + lane] = f2bf(o0 * inv * siluf(z)); }
    else {
      const float z0 = bf2f(U1B[(size_t)tok * U1B_LD + C1_ZD + hq * 128 + lane]), z1 = bf2f(U1B[(size_t)tok * U1B_LD + C1_ZD + hq * 128 + 64 + lane]);
      ((u16*)(p.ws + WS_H))[(size_t)tok * DM + 512 + hq * 128 + lane] = f2bf(o0 * inv * siluf(z0));
      ((u16*)(p.ws + WS_H))[(size_t)tok * DM + 512 + hq * 128 + 64 + lane] = f2bf(o1 * inv * siluf(z1));
    }
  }
}

DI void nphase_gdn(const Params& p, char* lds) {
  const int tid = TIDX();
  float* sq = (float*)lds; float* sk = sq + 128;
  const u16* QK = (const u16*)(p.ws + WS_H); const u16* VC = (const u16*)(p.ws + WS_VC); const float* GB = (const float*)(p.ws + WS_GB);
  for (int it = blockIdx.x; it < 192; it += gridDim.x) {
    int s, head, dir;
    if (it < 64) { s = 16 + (it >> 3); head = (it >> 1) & 3; dir = it & 1; } else { const int j = it - 64; s = j >> 3; head = (j >> 1) & 3; dir = j & 1; }
    const int tok0 = tok0_of(s), T = len_of(s);
    u16* O = (u16*)(p.ws + (dir ? WS_OB : WS_OF));
    float S[128];
    if (tid < 128) {
      if (s >= 16) {
        const float* st = p.c_state + ((size_t)(((s - 16) * 2 + dir) * 4 + head)) * 16384;
#pragma unroll
        for (int d = 0; d < 128; ++d) S[d] = st[d * 128 + tid];
      } else {
#pragma unroll
        for (int d = 0; d < 128; ++d) S[d] = 0.f;
      }
    }
    for (int tau = 0; tau < T; ++tau) {
      const int m = tok0 + (dir ? T - 1 - tau : tau);
      __syncthreads();
      if (tid < 128) { sq[tid] = bf2f(QK[(size_t)m * DM + head * 128 + tid]); sk[tid] = bf2f(QK[(size_t)m * DM + 512 + head * 128 + tid]); }
      __syncthreads();
      if (tid < 128) {
        const float g = GB[(size_t)m * 16 + dir * 4 + head], beta = GB[(size_t)m * 16 + 8 + dir * 4 + head];
        const float alpha = __expf(g);
        const float v = bf2f(VC[(size_t)m * 512 + head * 128 + tid]);
        float r = 0.f;
#pragma unroll
        for (int c = 0; c < 16; ++c) {
          const float4 ka = *(const float4*)(sk + c * 8), kb = *(const float4*)(sk + c * 8 + 4);
          r += ka.x * S[c * 8] + ka.y * S[c * 8 + 1] + ka.z * S[c * 8 + 2] + ka.w * S[c * 8 + 3] + kb.x * S[c * 8 + 4] + kb.y * S[c * 8 + 5] + kb.z * S[c * 8 + 6] + kb.w * S[c * 8 + 7];
          asm volatile("" ::: "memory");
        }
        const float dd = beta * (v - alpha * r);
        float o = 0.f;
#pragma unroll
        for (int c = 0; c < 16; ++c) {
          const float4 ka = *(const float4*)(sk + c * 8), kb = *(const float4*)(sk + c * 8 + 4);
          const float4 qa = *(const float4*)(sq + c * 8), qb = *(const float4*)(sq + c * 8 + 4);
          const float kk[8] = {ka.x, ka.y, ka.z, ka.w, kb.x, kb.y, kb.z, kb.w};
          const float qq[8] = {qa.x, qa.y, qa.z, qa.w, qb.x, qb.y, qb.z, qb.w};
#pragma unroll
          for (int e = 0; e < 8; ++e) { S[c * 8 + e] = alpha * S[c * 8 + e] + kk[e] * dd; o += qq[e] * S[c * 8 + e]; }
          asm volatile("" ::: "memory");
        }
        O[(size_t)m * 512 + head * 128 + tid] = f2bf(o);
      }
    }
    if (tid < 128 && s < 16) {
      float* st = p.out + O_STATE + ((size_t)((s * 2 + dir) * 4 + head)) * 16384;
#pragma unroll
      for (int d = 0; d < 128; ++d) st[d * 128 + tid] = S[d];
    }
    __syncthreads();
  }
}


DI bf16x8 afrag(const u16* base, int stride, int row, int kbase, int h) {
  const bf16x4 lo = *(const bf16x4*)(base + row * stride + kbase + 4 * h);
  const bf16x4 hi = *(const bf16x4*)(base + row * stride + kbase + 8 + 4 * h);
  return cat4(lo, hi);
}
DI void chunkprep_item(const Params& p, int cgi, char* lds) {
  const int tid0 = TIDX(), wid = tid0 >> 6, head = wid >> 1, dir = wid & 1;
  u16* tiles = (u16*)lds;
  float* vecs = (float*)(lds + 4 * 34816) + wid * 128;
  const u16* QK = (const u16*)(p.ws + WS_H); const float* GB = (const float*)(p.ws + WS_GB);
  {
    const int tok0 = cgi * 64;
    const int oz = opaque_zero();
    const int tid = TIDX() + oz, lane = tid & 63, r32 = lane & 31, h = lane >> 5;
    __syncthreads();
#pragma unroll
    for (int i = 0; i < 16; ++i) {
      const int c = tid + 512 * i, row = c >> 7, col8 = (c & 127) * 8, which = col8 >> 9, hh = (col8 >> 7) & 3, d8 = col8 & 127;
      *(u32x4*)(tiles + hh * 17408 + which * 8704 + row * 136 + d8) = *(const u32x4*)(QK + (size_t)(tok0 + row) * DM + col8);
    }
    {
      const float g = GB[(size_t)(tok0 + lane) * 16 + dir * 4 + head];
      float pre = g;
#pragma unroll
      for (int o = 1; o < 64; o <<= 1) { const float t = __shfl_up(pre, o); if (lane >= o) pre += t; }
      const float tot = __shfl(pre, 63);
      vecs[lane] = dir ? (tot - pre + g) : pre;
      vecs[64 + lane] = GB[(size_t)(tok0 + lane) * 16 + 8 + dir * 4 + head];
    }
    __syncthreads();
    const u16* sq = tiles + head * 17408; const u16* sk = sq + 8704;
    const float* gc = vecs; const float* be = vecs + 64;
    const size_t tm = ((size_t)(cgi * 4 + head) * 2 + dir) * 4096;
    u16* AM = (u16*)(p.ws + WS_AM) + tm;
    f32x16 P[2][2];
#pragma unroll 1
    for (int q4 = 0; q4 < 4; ++q4) {
      const int ib = q4 >> 1, jb = q4 & 1;
      f32x16 kk, qk, pt;
#pragma unroll
      for (int r = 0; r < 16; ++r) { kk[r] = 0.f; qk[r] = 0.f; }
#pragma unroll
      for (int s2 = 0; s2 < 8; ++s2) {
        const bf16x8 ka = *(const bf16x8*)(sk + (32 * ib + r32) * 136 + 16 * s2 + 8 * h);
        const bf16x8 kb = *(const bf16x8*)(sk + (32 * jb + r32) * 136 + 16 * s2 + 8 * h);
        const bf16x8 qb = *(const bf16x8*)(sq + (32 * jb + r32) * 136 + 16 * s2 + 8 * h);
        kk = MFMA(ka, kb, kk);
        qk = MFMA(ka, qb, qk);
      }
      const int cidx = 32 * jb + r32; const float gcol = gc[cidx], bcol = be[cidx];
#pragma unroll
      for (int g4 = 0; g4 < 4; ++g4) {
        const int b0 = 32 * ib + 8 * g4 + 4 * h;
        const float4 gv = *(const float4*)(gc + b0);
        const float gq[4] = {gv.x, gv.y, gv.z, gv.w};
        float v[4];
#pragma unroll
        for (int j = 0; j < 4; ++j) {
          const int rr = b0 + j;
          const float ea = __expf(fminf(gcol - gq[j], 0.f));
          const bool va = dir ? (rr >= cidx) : (rr <= cidx);
          const bool vs = dir ? (rr > cidx) : (rr < cidx);
          v[j] = va ? qk[4 * g4 + j] * ea : 0.f;
          pt[4 * g4 + j] = vs ? bcol * kk[4 * g4 + j] * ea : 0.f;
        }
        u32x2 w = {pack2(v[0], v[1]), pack2(v[2], v[3])};
        *(u32x2*)(AM + cidx * 64 + b0) = w;
      }
      if (q4 == 0) P[0][0] = pt; else if (q4 == 1) P[0][1] = pt; else if (q4 == 2) P[1][0] = pt; else P[1][1] = pt;
      asm volatile("" ::: "memory");
    }
    __syncthreads();
    u16* img = tiles + head * 17408 + dir * 8704;
    const int pcol = (r32 & ~15) | swz16(r32 & 15);
    f32x16 R[2][2];
#pragma unroll
    for (int I = 0; I < 2; ++I)
#pragma unroll
      for (int J = 0; J < 2; ++J)
#pragma unroll
        for (int r = 0; r < 16; ++r) R[I][J][r] = ((I == J && crow(r, h) == r32) ? 1.f : 0.f) - P[I][J][r];
#define CP_ZERO(a_, b_) (dir ? ((a_) == 0 && (b_) == 1) : ((a_) == 1 && (b_) == 0))
#define CP_IMG(T_) do { _Pragma("unroll") for (int I_ = 0; I_ < 2; ++I_) _Pragma("unroll") for (int J_ = 0; J_ < 2; ++J_) if (!CP_ZERO(I_, J_)) { \
      _Pragma("unroll") for (int r_ = 0; r_ < 16; r_ += 2) { const unsigned w_ = pack2(T_[I_][J_][r_], T_[I_][J_][r_ + 1]); \
        img[(32 * I_ + crow(r_, h)) * 72 + 32 * J_ + pcol] = (u16)(w_ & 0xffffu); img[(32 * I_ + crow(r_ + 1, h)) * 72 + 32 * J_ + pcol] = (u16)(w_ >> 16); } } } while (0)
    {
      const int zi = dir ? 0 : 1, zj = dir ? 1 : 0;
#pragma unroll
      for (int r = 0; r < 16; ++r) img[(32 * zi + crow(r, h)) * 72 + 32 * zj + pcol] = 0;
    }
    CP_IMG(P);
#pragma unroll 1
    for (int itn = 0; itn < 5; ++itn) {
#pragma unroll
      for (int J = 0; J < 2; ++J) {
        f32x16 n0, n1;
#pragma unroll
        for (int r = 0; r < 16; ++r) { n0[r] = 0.f; n1[r] = 0.f; }
#pragma unroll
        for (int K = 0; K < 2; ++K) if (!CP_ZERO(K, J)) {
#pragma unroll
          for (int s2 = 0; s2 < 2; ++s2) {
            const bf16x8 bfr = pack8(P[K][J], s2);
            if (!CP_ZERO(0, K) && !CP_ZERO(0, J)) n0 = MFMA(*(const bf16x8*)(img + r32 * 72 + 32 * K + 16 * s2 + 8 * h), bfr, n0);
            if (!CP_ZERO(1, K) && !CP_ZERO(1, J)) n1 = MFMA(*(const bf16x8*)(img + (32 + r32) * 72 + 32 * K + 16 * s2 + 8 * h), bfr, n1);
          }
        }
        P[0][J] = n0; P[1][J] = n1;
      }
      CP_IMG(P);
#pragma unroll
      for (int J = 0; J < 2; ++J) {
        f32x16 n0 = R[0][J], n1 = R[1][J];
#pragma unroll
        for (int K = 0; K < 2; ++K) if (!CP_ZERO(K, J)) {
#pragma unroll
          for (int s2 = 0; s2 < 2; ++s2) {
            const bf16x8 bfr = pack8(R[K][J], s2);
            if (!CP_ZERO(0, K) && !CP_ZERO(0, J)) n0 = MFMA(*(const bf16x8*)(img + r32 * 72 + 32 * K + 16 * s2 + 8 * h), bfr, n0);
            if (!CP_ZERO(1, K) && !CP_ZERO(1, J)) n1 = MFMA(*(const bf16x8*)(img + (32 + r32) * 72 + 32 * K + 16 * s2 + 8 * h), bfr, n1);
          }
        }
        R[0][J] = n0; R[1][J] = n1;
      }
    }
#undef CP_ZERO
#undef CP_IMG
    {
      u16* TB = (u16*)(p.ws + WS_TB) + tm;
#pragma unroll
      for (int I = 0; I < 2; ++I)
#pragma unroll
        for (int J = 0; J < 2; ++J)
#pragma unroll
          for (int g4 = 0; g4 < 4; ++g4) {
            const int b0 = 32 * I + 8 * g4 + 4 * h;
            const float4 bv = *(const float4*)(be + b0);
            u32x2 w = {pack2(R[I][J][4 * g4] * bv.x, R[I][J][4 * g4 + 1] * bv.y), pack2(R[I][J][4 * g4 + 2] * bv.z, R[I][J][4 * g4 + 3] * bv.w)};
            *(u32x2*)(TB + (32 * J + r32) * 64 + b0) = w;
          }
    }
  }
}

constexpr int CP_CNT_WORD = 4000;
DI void phase_chunkprep(const Params& p, char* lds) {
  for (int it = blockIdx.x; it < 256; it += gridDim.x) chunkprep_item(p, cp_main_chunk(it), lds);
  __syncthreads();
}
DI void chunkprep_deferred(const Params& p, char* lds) {
  const int it = (int)blockIdx.x - 64;
  if (it < 0 || it >= 64) return;
  chunkprep_item(p, cp_deferred_chunk(it), lds);
  asm volatile("s_waitcnt vmcnt(0)" ::: "memory");
  __syncthreads();
  if (threadIdx.x == 0) {
    __builtin_amdgcn_fence(__ATOMIC_RELEASE, "agent");
    asm volatile("s_waitcnt vmcnt(0)" ::: "memory");
    __hip_atomic_fetch_add((unsigned*)(p.ws + WS_BAR) + CP_CNT_WORD, 1u, __ATOMIC_RELAXED, __HIP_MEMORY_SCOPE_AGENT);
  }
  __syncthreads();
}
DI void chunkprep_wait_deferred(const Params& p, int lane) {
  unsigned* cnt = (unsigned*)(p.ws + WS_BAR) + CP_CNT_WORD;
  if (lane == 0) {
    unsigned spins = 0;
    while (__hip_atomic_load(cnt, __ATOMIC_RELAXED, __HIP_MEMORY_SCOPE_AGENT) < 64u) { __builtin_amdgcn_s_sleep(2); if (++spins > (1u << 22)) break; }
  }
  __builtin_amdgcn_fence(__ATOMIC_ACQUIRE, "agent");
  asm volatile("s_waitcnt vmcnt(0)" ::: "memory");
}
DI void phase_scan(const Params& p, char* lds) {
  const int tid0 = TIDX(), wid = tid0 >> 6;
  u16* sq = (u16*)lds; u16* sk = sq + 64 * 136; u16* skT = sk + 64 * 136; u16* sv = skT + 128 * 72; u16* sTb = sv + 64 * 136; u16* sA = sTb + 64 * 72;
  float* vec0 = (float*)(sA + 64 * 72);
  const u16* QK = (const u16*)(p.ws + WS_H); const u16* VC = (const u16*)(p.ws + WS_VC); const float* GB = (const float*)(p.ws + WS_GB);
  chunkprep_deferred(p, lds);
  for (int it = blockIdx.x; it < 192; it += gridDim.x) {
    int s, head, dir;
    if (it < 64) { s = 16 + (it >> 3); head = (it >> 1) & 3; dir = it & 1; } else { const int j = it - 64; s = j >> 3; head = (j >> 1) & 3; dir = j & 1; }
    const int tokS = tok0_of(s), nch = len_of(s) >> 6;
    __syncthreads();
    if (wid >= 4) {
      const int t2 = TIDX() - 256, lane = t2 & 63, lw = t2 >> 6;
      u32x4 R0[20], R1[20]; float g0 = 0.f, g1 = 0.f;
#define SC_LOAD(R, G, STEP) do { const int ch_ = dir ? nch - 1 - (STEP) : (STEP); const int tok0_ = tokS + ch_ * 64; \
        const size_t tm_ = ((size_t)((tok0_ >> 6) * 4 + head) * 2 + dir) * 4096; \
        _Pragma("unroll") for (int j_ = 0; j_ < 4; ++j_) { const int c_ = t2 + 256 * j_, row_ = c_ >> 4, d8_ = (c_ & 15) * 8; \
          R[j_]      = *(const u32x4*)(QK + (size_t)(tok0_ + row_) * DM + head * 128 + d8_); \
          R[4 + j_]  = *(const u32x4*)(QK + (size_t)(tok0_ + row_) * DM + 512 + head * 128 + d8_); \
          R[8 + j_]  = *(const u32x4*)(QK + (size_t)(tok0_ + lane) * DM + 512 + head * 128 + (lw * 4 + j_) * 8); \
          R[12 + j_] = *(const u32x4*)(VC + (size_t)(tok0_ + row_) * 512 + head * 128 + d8_); } \
        _Pragma("unroll") for (int j_ = 0; j_ < 2; ++j_) { const int c_ = t2 + 256 * j_; \
          R[16 + j_] = *(const u32x4*)((const u16*)(p.ws + WS_TB) + tm_ + (c_ >> 3) * 64 + (c_ & 7) * 8); \
          R[18 + j_] = *(const u32x4*)((const u16*)(p.ws + WS_AM) + tm_ + (c_ >> 3) * 64 + (c_ & 7) * 8); } \
        if (lw == 3) G = GB[(size_t)(tok0_ + lane) * 16 + dir * 4 + head]; } while (0)
#define SC_W2(BASE, STRIDE, ROW, C0, W) do { const int a_ = ((C0) >> 3) & 1, g_ = (C0) & ~15; \
        u32x2 lo_ = {(W)[0], (W)[1]}, hi_ = {(W)[2], (W)[3]}; \
        *(u32x2*)((BASE) + (ROW) * (STRIDE) + g_ + 4 * a_) = lo_; *(u32x2*)((BASE) + (ROW) * (STRIDE) + g_ + 8 + 4 * a_) = hi_; } while (0)
#define SC_WRITE1(R) do { \
        _Pragma("unroll") for (int j_ = 0; j_ < 4; ++j_) { const int c_ = t2 + 256 * j_, row_ = c_ >> 4, d8_ = (c_ & 15) * 8; \
          SC_W2(sq, 136, row_, d8_, R[j_]); SC_W2(sk, 136, row_, d8_, R[4 + j_]); \
          *(u32x4*)(sv + row_ * 136 + d8_) = R[12 + j_]; } \
        _Pragma("unroll") for (int j_ = 0; j_ < 2; ++j_) { const int c_ = t2 + 256 * j_; \
          SC_W2(sTb, 72, c_ >> 3, (c_ & 7) * 8, R[16 + j_]); SC_W2(sA, 72, c_ >> 3, (c_ & 7) * 8, R[18 + j_]); } } while (0)
#define SC_WKT(R) do { \
        _Pragma("unroll") for (int j_ = 0; j_ < 4; ++j_) { \
          { const int dd_ = (lw * 4 + j_) * 8, pos_ = (lane & ~15) + swz16(lane & 15); \
            _Pragma("unroll") for (int e_ = 0; e_ < 4; ++e_) { skT[(dd_ + 2 * e_) * 72 + pos_] = (u16)(R[8 + j_][e_] & 0xffffu); skT[(dd_ + 2 * e_ + 1) * 72 + pos_] = (u16)(R[8 + j_][e_] >> 16); } } } } while (0)
#define SC_VEC(G, PAR) do { \
        if (lw == 3) { float* vw_ = vec0 + (PAR) * 132; float pre_ = G; \
          _Pragma("unroll") for (int o_ = 1; o_ < 64; o_ <<= 1) { const float t_ = __shfl_up(pre_, o_); if (lane >= o_) pre_ += t_; } \
          const float tot_ = __shfl(pre_, 63); const float gc_ = dir ? (tot_ - pre_ + G) : pre_; \
          vw_[lane] = __expf(gc_); vw_[64 + lane] = __expf(tot_ - gc_); if (lane == 0) vw_[128] = __expf(tot_); } } while (0)
      SC_LOAD(R0, g0, 0);
      if (nch > 1) SC_LOAD(R1, g1, 1);
      SC_WRITE1(R0); SC_VEC(g0, 0);
#pragma unroll 1
      for (int step = 0; step < nch; step += 2) {
        __syncthreads();
        SC_WKT(R0);
        if (s >= 16 && step + 2 == 12) chunkprep_wait_deferred(p, lane);
        float g0n = g0;
        if (step + 2 < nch) SC_LOAD(R0, g0n, step + 2);
        __syncthreads();
        SC_WRITE1(R1); SC_VEC(g1, 1);
        __syncthreads();
        SC_WKT(R1);
        if (step + 3 < nch) SC_LOAD(R1, g1, step + 3);
        __syncthreads();
        g0 = g0n;
        if (step + 2 < nch) { SC_WRITE1(R0); SC_VEC(g0, 0); }
      }
#undef SC_LOAD
#undef SC_W2
#undef SC_WRITE1
#undef SC_WKT
#undef SC_VEC
    } else {
      const int lane = TIDX() & 63, r32 = lane & 31, h = lane >> 5;
      u16* O = (u16*)(p.ws + (dir ? WS_OB : WS_OF));
      const int e0 = 32 * wid;
      f32x16 S[4];
      if (s >= 16) {
        const float* st = p.c_state + ((size_t)(((s - 16) * 2 + dir) * 4 + head)) * 16384;
#pragma unroll
        for (int db = 0; db < 4; ++db)
#pragma unroll
          for (int r = 0; r < 16; ++r) S[db][r] = st[(32 * db + crow(r, h)) * 128 + e0 + r32];
      } else {
#pragma unroll
        for (int db = 0; db < 4; ++db)
#pragma unroll
          for (int r = 0; r < 16; ++r) S[db][r] = 0.f;
      }
#define SC_AF(BASE, STRIDE, ROW, KB) (*(const bf16x8*)((BASE) + (ROW) * (STRIDE) + (KB) + 8 * h))
#pragma unroll 1
      for (int step = 0; step < nch; ++step) {
        const int ch = dir ? nch - 1 - step : step;
        const int tok0 = tokS + ch * 64;
        const float* vec = vec0 + (step & 1) * 132;
        __syncthreads();
#define SC_SB() __builtin_amdgcn_sched_barrier(0)
        f32x16 VN[2], Oa[2], KS[2];
#pragma unroll
        for (int ib = 0; ib < 2; ++ib)
#pragma unroll
          for (int r = 0; r < 16; ++r) { KS[ib][r] = 0.f; Oa[ib][r] = 0.f; }
        {
          bf16x8 fa[2][8];
#define SC_LD8(BUF, DB) do { _Pragma("unroll") for (int s2_ = 0; s2_ < 2; ++s2_) _Pragma("unroll") for (int ib_ = 0; ib_ < 2; ++ib_) { \
            fa[BUF][s2_ * 4 + ib_] = SC_AF(sk, 136, 32 * ib_ + r32, 32 * (DB) + 16 * s2_); fa[BUF][s2_ * 4 + 2 + ib_] = SC_AF(sq, 136, 32 * ib_ + r32, 32 * (DB) + 16 * s2_); } } while (0)
          SC_LD8(0, 0);
#pragma unroll
          for (int db = 0; db < 4; ++db) {
            if (db < 3) SC_LD8((db + 1) & 1, db + 1);
            SC_SB();
#pragma unroll
            for (int s2 = 0; s2 < 2; ++s2) {
              const bf16x8 sb = pack8(S[db], s2);
              KS[0] = MFMA(fa[db & 1][s2 * 4 + 0], sb, KS[0]); KS[1] = MFMA(fa[db & 1][s2 * 4 + 1], sb, KS[1]);
              Oa[0] = MFMA(fa[db & 1][s2 * 4 + 2], sb, Oa[0]); Oa[1] = MFMA(fa[db & 1][s2 * 4 + 3], sb, Oa[1]);
            }
            SC_SB();
          }
#undef SC_LD8
        }
        bf16x8 ft[8];
        {
          float xv[2][16], eg[2][16];
#pragma unroll
          for (int ib = 0; ib < 2; ++ib)
#pragma unroll
            for (int r = 0; r < 16; ++r) { const int i = 32 * ib + crow(r, h); xv[ib][r] = bf2f(sv[i * 136 + e0 + r32]); eg[ib][r] = vec[i]; }
#pragma unroll
          for (int ib = 0; ib < 2; ++ib)
#pragma unroll
            for (int s2 = 0; s2 < 2; ++s2)
#pragma unroll
              for (int i2 = 0; i2 < 2; ++i2) ft[(ib * 2 + s2) * 2 + i2] = SC_AF(sTb, 72, 32 * i2 + r32, 32 * ib + 16 * s2);
          SC_SB();
#pragma unroll
          for (int ib = 0; ib < 2; ++ib)
#pragma unroll
            for (int r = 0; r < 16; ++r) { KS[ib][r] = xv[ib][r] - eg[ib][r] * KS[ib][r]; Oa[ib][r] *= eg[ib][r]; }
        }
#pragma unroll
        for (int ib = 0; ib < 2; ++ib)
#pragma unroll
          for (int r = 0; r < 16; ++r) VN[ib][r] = 0.f;
        {
          bf16x8 xb[4];
#pragma unroll
          for (int ib = 0; ib < 2; ++ib)
#pragma unroll
            for (int s2 = 0; s2 < 2; ++s2) xb[ib * 2 + s2] = pack8(KS[ib], s2);
          SC_SB();
#pragma unroll
          for (int q = 0; q < 4; ++q)
#pragma unroll
            for (int i2 = 0; i2 < 2; ++i2) VN[i2] = MFMA(ft[q * 2 + i2], xb[q], VN[i2]);
          SC_SB();
        }
#pragma unroll
        for (int ib = 0; ib < 2; ++ib)
#pragma unroll
          for (int s2 = 0; s2 < 2; ++s2)
#pragma unroll
            for (int i2 = 0; i2 < 2; ++i2) ft[(ib * 2 + s2) * 2 + i2] = SC_AF(sA, 72, 32 * i2 + r32, 32 * ib + 16 * s2);
        {
          bf16x8 vb[4];
#pragma unroll
          for (int ib = 0; ib < 2; ++ib)
#pragma unroll
            for (int s2 = 0; s2 < 2; ++s2) vb[ib * 2 + s2] = pack8(VN[ib], s2);
          SC_SB();
#pragma unroll
          for (int q = 0; q < 4; ++q)
#pragma unroll
            for (int i2 = 0; i2 < 2; ++i2) Oa[i2] = MFMA(ft[q * 2 + i2], vb[q], Oa[i2]);
        }
        __syncthreads();
        {
          float dl[2][16];
#pragma unroll
          for (int db = 0; db < 4; ++db)
#pragma unroll
            for (int s2 = 0; s2 < 2; ++s2) ft[db * 2 + s2] = SC_AF(skT, 72, 32 * db + r32, 16 * s2);
#pragma unroll
          for (int ib = 0; ib < 2; ++ib)
#pragma unroll
            for (int r = 0; r < 16; ++r) dl[ib][r] = vec[64 + 32 * ib + crow(r, h)];
          const float eg = vec[128];
          SC_SB();
#pragma unroll
          for (int ib = 0; ib < 2; ++ib) {
            u16* op_ = O + (size_t)(tok0 + 32 * ib + 4 * h) * 512 + head * 128 + e0 + r32;
#pragma unroll
            for (int r = 0; r < 16; r += 2) { const unsigned w_ = pack2(Oa[ib][r], Oa[ib][r + 1]);
              op_[(size_t)((r & 3) + 8 * (r >> 2)) * 512] = (u16)(w_ & 0xffffu); op_[(size_t)((r & 3) + 8 * (r >> 2) + 1) * 512] = (u16)(w_ >> 16); }
          }
#pragma unroll
          for (int db = 0; db < 4; ++db)
#pragma unroll
            for (int r = 0; r < 16; ++r) S[db][r] *= eg;
#pragma unroll
          for (int ib = 0; ib < 2; ++ib)
#pragma unroll
            for (int r = 0; r < 16; ++r) VN[ib][r] *= dl[ib][r];
          bf16x8 vb[4];
#pragma unroll
          for (int ib = 0; ib < 2; ++ib)
#pragma unroll
            for (int s2 = 0; s2 < 2; ++s2) vb[ib * 2 + s2] = pack8(VN[ib], s2);
          bf16x8 ft2[8];
#pragma unroll
          for (int db = 0; db < 4; ++db)
#pragma unroll
            for (int s2 = 0; s2 < 2; ++s2) ft2[db * 2 + s2] = SC_AF(skT, 72, 32 * db + r32, 32 + 16 * s2);
          SC_SB();
#pragma unroll
          for (int s2 = 0; s2 < 2; ++s2)
#pragma unroll
            for (int db = 0; db < 4; ++db) S[db] = MFMA(ft[db * 2 + s2], vb[s2], S[db]);
          SC_SB();
#pragma unroll
          for (int s2 = 0; s2 < 2; ++s2)
#pragma unroll
            for (int db = 0; db < 4; ++db) S[db] = MFMA(ft2[db * 2 + s2], vb[2 + s2], S[db]);
        }
#undef SC_SB
      }
#undef SC_AF
      if (s < 16) {
        float* st = p.out + O_STATE + ((size_t)((s * 2 + dir) * 4 + head)) * 16384;
#pragma unroll
        for (int db = 0; db < 4; ++db)
#pragma unroll
          for (int r = 0; r < 16; ++r) st[(32 * db + crow(r, h)) * 128 + e0 + r32] = S[db][r];
      }
    }
  }
  __syncthreads();
  if (gridDim.x == 256 && blockIdx.x >= 64) l1prep_t<false, true>(p, lds, (int)blockIdx.x - 64, 192);
}

#ifndef DBG_CHECK
#define DBG_CHECK 0
#endif
#ifndef DBG_AMP
#define DBG_AMP 10.f
#endif
constexpr size_t WS_DBG = WS_END + 16384;
DI void fingerprint(const Params& p, const void* buf, size_t n, bool isf32, int slot, char* lds) {
  float acc[9];
#pragma unroll
  for (int k = 0; k < 9; ++k) acc[k] = 0.f;
  for (size_t i = (size_t)blockIdx.x * NTHREADS + threadIdx.x; i < n; i += (size_t)gridDim.x * NTHREADS) {
    const float x = isf32 ? ((const float*)buf)[i] : bf2f(((const u16*)buf)[i]);
    unsigned hsh = (unsigned)i * 0x9E3779B1u; hsh ^= hsh >> 15; hsh *= 0x85EBCA77u; hsh ^= hsh >> 13;
#pragma unroll
    for (int k = 0; k < 8; ++k) acc[k] += ((hsh >> k) & 1u) ? x : -x;
    acc[8] += x * x;
  }
  float* red = (float*)lds;
  __syncthreads();
#pragma unroll
  for (int k = 0; k < 9; ++k) { const float v = wave_sum(acc[k]); if ((threadIdx.x & 63) == 0) red[(threadIdx.x >> 6) * 9 + k] = v; }
  __syncthreads();
  if (threadIdx.x < 9) {
    float v = 0.f;
    for (int w = 0; w < 8; ++w) v += red[w * 9 + threadIdx.x];
    ((float*)(p.ws + WS_DBG))[((size_t)slot * 256 + blockIdx.x) * 16 + threadIdx.x] = v;
  }
  __syncthreads();
}
DI float dbg_rel(const Params& p) {
  const float* d = (const float*)(p.ws + WS_DBG);
  float fn[9], ff[9];
#pragma unroll
  for (int k = 0; k < 9; ++k) { fn[k] = 0.f; ff[k] = 0.f; }
  for (int b = 0; b < (int)gridDim.x; ++b)
#pragma unroll
    for (int k = 0; k < 9; ++k) { fn[k] += d[((size_t)b) * 16 + k]; ff[k] += d[((size_t)256 + b) * 16 + k]; }
  float s = 0.f;
#pragma unroll
  for (int k = 0; k < 8; ++k) s += (ff[k] - fn[k]) * (ff[k] - fn[k]);
  return sqrtf(s * 0.125f / fn[8]);
}


#define XB_TMO      128
#define XB_XCNT(j)  (256  + 64 * (j))
#define XB_XSUB(j)  (1280 + 64 * (j))
#define XB_XGEN(j)  (2304 + 64 * (j))
#define XB_TOP      3328
#define XB_TOPGEN   3392
#define XCD_BAR_WORDS 3456
#define XB_SPIN_CAP (1u << 18)
#define LAS __attribute__((address_space(3)))
DI unsigned xb_ld(unsigned* p)              { return __hip_atomic_load(p, __ATOMIC_RELAXED, __HIP_MEMORY_SCOPE_AGENT); }
DI unsigned xb_add(unsigned* p, unsigned v) { return __hip_atomic_fetch_add(p, v, __ATOMIC_RELAXED, __HIP_MEMORY_SCOPE_AGENT); }
DI unsigned xb_xcc_id() { return (unsigned)__builtin_amdgcn_s_getreg((3 << 11) | 20) & 0xFu; }
#define XB_SPIN(cond, bar) do { unsigned _sp = 0; while (cond) { __builtin_amdgcn_s_sleep(1); \
    if ((++_sp & 255u) == 0u) { if (xb_ld(&(bar)[XB_TMO])) break; if (_sp > XB_SPIN_CAP) { atomicAdd(&(bar)[XB_TMO], 1u); break; } } } } while (0)
struct XcdBarrier { unsigned* bar; unsigned x; volatile LAS unsigned* st; };
DI XcdBarrier xcd_barrier_post(unsigned* bar, volatile LAS unsigned* st) {
  XcdBarrier b; b.bar = bar; b.x = xb_xcc_id(); b.st = st;
  if (threadIdx.x == 0) (void)xb_add(&bar[XB_XCNT(b.x)], 1u);
  return b;
}
DI void xcd_barrier_complete(unsigned* bar, unsigned x, unsigned& nloc, unsigned& nx) {
  const unsigned G = gridDim.x * gridDim.y * gridDim.z;
  unsigned sum, cnt, mine, sp = 0u;
  for (;;) {
    sum = 0u; cnt = 0u; mine = 0u;
#pragma unroll
    for (unsigned j = 0; j < 16; ++j) { const unsigned c = xb_ld(&bar[XB_XCNT(j)]); sum += c; cnt += (c > 0u) ? 1u : 0u; mine = (j == x) ? c : mine; }
    if (sum == G) break;
    __builtin_amdgcn_s_sleep(1);
    if ((++sp & 255u) == 0u) { if (xb_ld(&bar[XB_TMO])) break; if (sp > XB_SPIN_CAP) { atomicAdd(&bar[XB_TMO], 1u); break; } }
  }
  nloc = mine > 0u ? mine : 1u; nx = cnt > 0u ? cnt : 1u;
}
DI void xcd_barrier(const XcdBarrier& b) {
  asm volatile("s_waitcnt vmcnt(0)" ::: "memory");
  __syncthreads();
  if (threadIdx.x == 0) {
    unsigned* bar = b.bar;
    __builtin_amdgcn_s_waitcnt(0);
    unsigned nloc = b.st[0], nx = b.st[1];
    if (nloc == 0u) { xcd_barrier_complete(bar, b.x, nloc, nx); b.st[0] = nloc; b.st[1] = nx; }
    const unsigned old = xb_add(&bar[XB_XSUB(b.x)], 1u);
    const unsigned gen = old / nloc;
    if (old + 1u == (gen + 1u) * nloc) {
      __builtin_amdgcn_fence(__ATOMIC_RELEASE, "agent");
      asm volatile("s_waitcnt vmcnt(0)" ::: "memory");
      const unsigned og = xb_add(&bar[XB_TOP], 1u);
      const unsigned tg = og / nx;
      if (og + 1u == (tg + 1u) * nx) xb_add(&bar[XB_TOPGEN], 1u);
      else XB_SPIN(xb_ld(&bar[XB_TOPGEN]) == tg, bar);
      __builtin_amdgcn_fence(__ATOMIC_ACQUIRE, "agent");
      xb_add(&bar[XB_XGEN(b.x)], 1u);
      asm volatile("s_waitcnt vmcnt(0)" ::: "memory");
    } else {
      XB_SPIN(xb_ld(&bar[XB_XGEN(b.x)]) == gen, bar);
      __builtin_amdgcn_fence(__ATOMIC_ACQUIRE, "agent");
      asm volatile("s_waitcnt vmcnt(0)" ::: "memory");
    }
  }
  __syncthreads();
}

extern __shared__ __attribute__((aligned(16))) char smem[];
constexpr int LDS_BYTES = 147456;

#ifndef REPEAT
#define REPEAT 0
#endif
#ifndef FAST_MASK
#define FAST_MASK 255
#endif
DI void code_prefetch(unsigned long long code_end) {
  unsigned long long pc;
  asm volatile("s_getpc_b64 %0" : "=s"(pc));
  pc &= ~63ull;
  const unsigned rem = code_end > pc ? (unsigned)(code_end - pc) : 0u;
  const unsigned o0 = threadIdx.x * 64u, o1 = o0 + 32768u;
  const char* base = (const char*)pc;
  const int v0 = *(const volatile int*)(base + (o0 < rem ? o0 : rem));
  const int v1 = *(const volatile int*)(base + (o1 < rem ? o1 : rem));
  asm volatile("" :: "v"(v0), "v"(v1));
}
#define GSYNC() do { code_prefetch(code_end); xcd_barrier(xb); } while (0)
#define GSYNC_KB(kb) GSYNC()

#ifndef DBG_TIME
#define DBG_TIME -1
#endif
#if DBG_TIME >= 0
#define TSTAMP(i) do { if (blockIdx.x == 0 && threadIdx.x == 0) ((volatile unsigned long long*)(smem + LDS_BYTES - 512))[i] = __builtin_amdgcn_s_memrealtime(); } while (0)
#else
#define TSTAMP(i) do {} while (0)
#endif
__global__ void __launch_bounds__(NTHREADS) fwd_megakernel(Params p) {
  unsigned long long code_end; unsigned code_len;
  asm volatile("s_getpc_b64 %0\n.Lcp_base:\n\ts_mov_b32 %1, .Lcp_end-.Lcp_base" : "=s"(code_end), "=s"(code_len));
  code_end = (code_end + code_len) & ~63ull;
  cg::grid_group grid = cg::this_grid();
  char* lds = smem;
  __shared__ uint4 xb_words;
  if (threadIdx.x == 0) xb_words = make_uint4(0u, 0u, 0u, 0u);
  __syncthreads();
  XcdBarrier xb = xcd_barrier_post((unsigned*)(p.ws + WS_BAR), (volatile LAS unsigned*)&xb_words);
  TSTAMP(0);
  phase_prep(p, lds);            GSYNC(); TSTAMP(1);
  if (p.ws == nullptr) grid.sync();
  phase_adaln(p, 0);             GSYNC(); TSTAMP(2);
  phase8_layer0_gemms(p, lds, [&]() { GSYNC(); });   GSYNC(); TSTAMP(5);
  phase_attn0(p, lds, code_end); GSYNC(); TSTAMP(6);
  phase8_outproj(p, 0, lds);     prep_deferred_layer1_weights(p, lds); GSYNC(); TSTAMP(7);
  phase_adaln(p, 1);             GSYNC(); TSTAMP(8);
  phase8_inproj1(p, lds);        GSYNC(); TSTAMP(9);
  phase_l1prep(p, lds);
  if (gridDim.x == 256) { asm volatile("s_waitcnt vmcnt(0)" ::: "memory"); __syncthreads(); }
  else GSYNC();
  TSTAMP(10);
  phase_chunkprep(p, lds);       GSYNC_KB(32); TSTAMP(11);
  phase_scan(p, lds);            GSYNC_KB(24); TSTAMP(12);
  phase_gdnfinal(p);
  code_prefetch(code_end);
  phase_attn1(p, lds);           GSYNC_KB(12); TSTAMP(13);
  phase8_outproj(p, 1, lds);     GSYNC_KB(3); TSTAMP(14);
  phase_final(p);
#if DBG_TIME >= 0
  GSYNC(); TSTAMP(15);
  if (blockIdx.x == 0) {
    __syncthreads();
    const size_t offs[7] = {O_CKV, O_KROPE, O_SWAK, O_SWAV, O_STATE, O_ATTK, O_ATTV};
    volatile unsigned long long* tb = (volatile unsigned long long*)(smem + LDS_BYTES - 512);
    for (int k = 0; k < 7; ++k) {
      const int i0 = DBG_TIME + k;
      if (i0 + 1 > 15) break;
      const unsigned long long dt = tb[i0 + 1] - tb[i0];
      const int n = (int)(dt / 100ull);
      for (int e = threadIdx.x; e < n; e += NTHREADS) ((unsigned*)p.out)[offs[k] + e] = 0xAAAAAAAAu;
    }
  }
#endif
  asm volatile(".Lcp_end:");
}

extern "C" void kernel_launch(void* const* d_in, const int* in_sizes, int n_in, void* d_out, int out_size, void* d_ws, size_t ws_size, hipStream_t stream) {
  static int grid_blocks = 0;
  if (!grid_blocks) {
    int dev = 0, cus = 0, per_cu = 0;
    (void)hipGetDevice(&dev);
    (void)hipDeviceGetAttribute(&cus, hipDeviceAttributeMultiprocessorCount, dev);
    (void)hipFuncSetAttribute((const void*)fwd_megakernel, hipFuncAttributeMaxDynamicSharedMemorySize, LDS_BYTES);
    (void)hipOccupancyMaxActiveBlocksPerMultiprocessor(&per_cu, fwd_megakernel, NTHREADS, LDS_BYTES);
    if (per_cu > 1) per_cu = 1;
    grid_blocks = (cus * per_cu) & ~7;
    if (grid_blocks <= 0) { fprintf(stderr, "occupancy query failed (cus %d per_cu %d)\n", cus, per_cu); grid_blocks = 0; return; }
  }
  if (n_in != 33 || ws_size < WS_END + 65536) { fprintf(stderr, "kernel_launch: unexpected n_in %d / ws %zu\n", n_in, ws_size); return; }
  Params p{};
  const float** pp = (const float**)&p;
  for (int i = 0; i < 33; ++i) pp[i] = (const float*)d_in[i];
  p.out = (float*)d_out;
  p.ws = (char*)d_ws;
  (void)hipMemsetAsync((char*)d_ws + WS_BAR, 0, 16384, stream);
  void* args[] = {&p};
  hipError_t e = hipLaunchCooperativeKernel((void*)fwd_megakernel, dim3(grid_blocks), dim3(NTHREADS), args, LDS_BYTES, stream);
  if (e != hipSuccess) fprintf(stderr, "cooperative launch failed: %s (grid %d)\n", hipGetErrorString(e), grid_blocks);
}
```
